# Optimizing an MI355X kernel written in HIP

```python
import jax, jax.numpy as jnp
from jax import lax
import numpy as np

D_MODEL = 4096
BATCH = 4
SEQ = 4096
DEPTH = 2

BLOCK_Q = 128
N_BRANCH = 4
BRANCH_WIDTH = 1024
A_HEADS = 8
A_KV_HEADS = 2
A_DIM = 128
IDX_HEADS = 16
IDX_DIM = 64
IDX_TOPK_MAX = 256
B_HEADS = 8
B_DIM = 128
C_HEADS = 16
C_KV_HEADS = 2
C_DIM = 64
WINDOW = 128
D_HEADS = 8
D_Q_LORA = 768
D_KV_LORA = 256
D_NOPE = 128
D_ROPE = 64
D_VDIM = 128
ROPE_THETA = 10000.0
RMS_EPS = 1e-6
LN_EPS = 1e-5
DEEPNORM_ALPHA = (2 * DEPTH) ** 0.25
DEEPNORM_BETA = (8 * DEPTH) ** -0.25
MAX_START_POS = 1024

IN_SEGMENTS = (
    ('a_q', A_HEADS * A_DIM), ('a_k', A_KV_HEADS * A_DIM), ('a_v', A_KV_HEADS * A_DIM),
    ('a_iq', IDX_HEADS * IDX_DIM), ('a_ik', IDX_DIM), ('a_iw', IDX_HEADS), ('a_z', BRANCH_WIDTH),
    ('b_q', B_HEADS * B_DIM), ('b_k', B_HEADS * B_DIM), ('b_v', B_HEADS * B_DIM), ('b_f', B_HEADS), ('b_z', BRANCH_WIDTH),
    ('c_q', C_HEADS * C_DIM), ('c_k', C_KV_HEADS * C_DIM), ('c_v', C_KV_HEADS * C_DIM), ('c_z', BRANCH_WIDTH),
    ('d_cq', D_Q_LORA), ('d_ckv', D_KV_LORA), ('d_kr', D_ROPE), ('d_z', BRANCH_WIDTH),
)
IN_WIDTH = sum(n for _, n in IN_SEGMENTS)

kernel_name = 'hybrid_gated_four_mixer_deepnorm'


def split_columns(h):
    sizes = [n for _, n in IN_SEGMENTS]
    offsets = [int(o) for o in np.cumsum(sizes)[:-1]]
    return dict(zip([name for name, _ in IN_SEGMENTS], jnp.split(h, offsets, axis=-1)))


def alibi_slopes(n_heads):
    return jnp.asarray([2.0 ** (-8.0 * (h + 1) / n_heads) for h in range(n_heads)], dtype=jnp.float32)


def to_blocks(t, nb):
    return jnp.moveaxis(t.reshape(t.shape[0], nb, BLOCK_Q, *t.shape[2:]), 1, 0)


def from_blocks(t):
    t = jnp.moveaxis(t, 0, 1)
    return t.reshape(t.shape[0], t.shape[1] * t.shape[2], -1)


def rms_norm(x, g):
    xf = x.astype(jnp.float32)
    return (xf * lax.rsqrt(jnp.mean(jnp.square(xf), -1, keepdims=True) + RMS_EPS) * g).astype(x.dtype)


def layer_norm(x, g, b):
    xf = x.astype(jnp.float32)
    mu = jnp.mean(xf, -1, keepdims=True)
    var = jnp.mean(jnp.square(xf - mu), -1, keepdims=True)
    return ((xf - mu) * lax.rsqrt(var + LN_EPS) * g + b).astype(x.dtype)


def rope(t, positions):
    half = t.shape[-1] // 2
    inv_freq = ROPE_THETA ** (-jnp.arange(half, dtype=jnp.float32) / half)
    ang = positions.astype(jnp.float32)[..., None] * inv_freq
    cos = jnp.cos(ang)[:, :, None, :]
    sin = jnp.sin(ang)[:, :, None, :]
    t1 = t[..., :half].astype(jnp.float32)
    t2 = t[..., half:].astype(jnp.float32)
    return jnp.concatenate([t1 * cos - t2 * sin, t1 * sin + t2 * cos], -1).astype(t.dtype)


def indexed_sparse_attention(q, k, v, iq, ik, iw):
    B, S = q.shape[:2]
    nb = S // BLOCK_Q
    topk = min(IDX_TOPK_MAX, S // 4)
    slopes = alibi_slopes(A_HEADS).reshape(A_KV_HEADS, A_HEADS // A_KV_HEADS)
    scale = A_DIM ** -0.5
    w = iw.astype(jnp.float32) * (IDX_HEADS ** -0.5 * IDX_DIM ** -0.5)
    kpos = jnp.arange(S)
    gather = jax.vmap(lambda arr, idx: arr[idx])

    def block(args):
        i, q_i, iq_i, w_i = args
        qpos = i * BLOCK_Q + jnp.arange(BLOCK_Q)
        causal = kpos[None, :] <= qpos[:, None]
        rel = jax.nn.relu(jnp.einsum('bqhd,bsd->bqhs', iq_i, ik).astype(jnp.float32))
        score = jnp.einsum('bqhs,bqh->bqs', rel, w_i)
        score = jnp.where(causal[None], score, -jnp.inf)
        top_val, top_idx = lax.top_k(score, topk)
        valid = jnp.isfinite(top_val)
        k_sel = gather(k, top_idx)
        v_sel = gather(v, top_idx)
        logits = jnp.einsum('bqgrd,bqkgd->bgrqk', q_i, k_sel).astype(jnp.float32) * scale
        dist = (qpos[None, :, None] - top_idx).astype(jnp.float32)
        logits = logits - slopes[None, :, :, None, None] * dist[:, None, None]
        logits = jnp.where(valid[:, None, None], logits, -jnp.inf)
        p = jax.nn.softmax(logits, axis=-1)
        return jnp.einsum('bgrqk,bqkgd->bqgrd', p.astype(v.dtype), v_sel)

    out = lax.map(block, (jnp.arange(nb), to_blocks(q, nb), to_blocks(iq, nb), to_blocks(w, nb)))
    return from_blocks(out)


def blocked_causal_attention(q, k, v, scale, cum_log_forget=None):
    B, S = q.shape[:2]
    nb = S // BLOCK_Q
    kpos = jnp.arange(S)
    xs = (jnp.arange(nb), to_blocks(q, nb))
    if cum_log_forget is not None:
        c_keys = jnp.transpose(cum_log_forget, (0, 2, 1))
        xs = xs + (to_blocks(cum_log_forget, nb),)

    def block(args):
        i, q_i = args[0], args[1]
        qpos = i * BLOCK_Q + jnp.arange(BLOCK_Q)
        logits = jnp.einsum('bqhd,bkhd->bhqk', q_i, k).astype(jnp.float32) * scale
        if cum_log_forget is not None:
            c_q = jnp.transpose(args[2], (0, 2, 1))
            logits = logits + (c_q[..., None] - c_keys[:, :, None, :])
        causal = kpos[None, :] <= qpos[:, None]
        logits = jnp.where(causal[None, None], logits, -jnp.inf)
        p = jax.nn.softmax(logits, axis=-1)
        return jnp.einsum('bhqk,bkhd->bqhd', p.astype(v.dtype), v)

    return from_blocks(lax.map(block, xs))


def sliding_window_sink_attention(q, k, v, sinks):
    B, S = q.shape[:2]
    nb = S // WINDOW
    G, R = C_KV_HEADS, C_HEADS // C_KV_HEADS
    slopes = alibi_slopes(C_HEADS).reshape(G, R)
    qb = q.reshape(B, nb, WINDOW, G, R, C_DIM)
    kb = k.reshape(B, nb, WINDOW, G, C_DIM)
    vb = v.reshape(B, nb, WINDOW, G, C_DIM)
    shift = lambda t: jnp.pad(t, ((0, 0), (1, 0), (0, 0), (0, 0), (0, 0)))[:, :-1]
    kcat = jnp.concatenate([shift(kb), kb], axis=2)
    vcat = jnp.concatenate([shift(vb), vb], axis=2)
    logits = jnp.einsum('bnqgrd,bnkgd->bngrqk', qb, kcat).astype(jnp.float32) * (C_DIM ** -0.5)
    qi = jnp.arange(WINDOW)[:, None]
    kj = jnp.arange(2 * WINDOW)[None, :]
    dist = qi + WINDOW - kj
    band = (dist >= 0) & (dist < WINDOW)
    has_prev = (jnp.arange(nb) > 0)[:, None, None] | (kj >= WINDOW)[None]
    mask = band[None] & has_prev
    logits = logits - slopes[None, None, :, :, None, None] * dist.astype(jnp.float32)
    logits = jnp.where(mask[None, :, None, None], logits, -jnp.inf)
    sink = sinks.astype(jnp.float32).reshape(G, R)[None, None, :, :, None]
    lse = jnp.logaddexp(jax.nn.logsumexp(logits, axis=-1), sink)
    p = jnp.exp(logits - lse[..., None])
    out = jnp.einsum('bngrqk,bnkgd->bnqgrd', p.astype(v.dtype), vcat)
    return out.reshape(B, S, C_HEADS * C_DIM)


def latent_attention(c_q, c_kv, k_rope_in, positions, q_gain, q_up, kv_gain, kv_up):
    B, S = c_q.shape[:2]
    q = jnp.einsum('bsc,ce->bse', rms_norm(c_q, q_gain), q_up).reshape(B, S, D_HEADS, D_NOPE + D_ROPE)
    q = jnp.concatenate([q[..., :D_NOPE], rope(q[..., D_NOPE:], positions)], -1)
    kv = jnp.einsum('bsc,ce->bse', rms_norm(c_kv, kv_gain), kv_up).reshape(B, S, D_HEADS, D_NOPE + D_VDIM)
    k_rope = rope(k_rope_in[:, :, None, :], positions)
    k = jnp.concatenate([kv[..., :D_NOPE], jnp.broadcast_to(k_rope, (B, S, D_HEADS, D_ROPE))], -1)
    v = kv[..., D_NOPE:]
    return blocked_causal_attention(q, k, v, (D_NOPE + D_ROPE) ** -0.5)


def hybrid_layer(x, positions, w_in, w_gate, w_branch, w_out, dq_gain, dq_up, dkv_gain, dkv_up, f_bias, sinks, ln_gain, ln_bias):
    B, S, _ = x.shape
    p = split_columns(jnp.einsum('bsd,de->bse', x, w_in))
    o_a = indexed_sparse_attention(
        p['a_q'].reshape(B, S, A_KV_HEADS, A_HEADS // A_KV_HEADS, A_DIM),
        p['a_k'].reshape(B, S, A_KV_HEADS, A_DIM), p['a_v'].reshape(B, S, A_KV_HEADS, A_DIM),
        p['a_iq'].reshape(B, S, IDX_HEADS, IDX_DIM), p['a_ik'], p['a_iw'])
    log_f = jax.nn.log_sigmoid(p['b_f'].astype(jnp.float32) + f_bias.astype(jnp.float32))
    o_b = blocked_causal_attention(
        p['b_q'].reshape(B, S, B_HEADS, B_DIM), p['b_k'].reshape(B, S, B_HEADS, B_DIM),
        p['b_v'].reshape(B, S, B_HEADS, B_DIM), B_DIM ** -0.5, cum_log_forget=jnp.cumsum(log_f, axis=1))
    o_c = sliding_window_sink_attention(
        p['c_q'].reshape(B, S, C_KV_HEADS, C_HEADS // C_KV_HEADS, C_DIM),
        p['c_k'].reshape(B, S, C_KV_HEADS, C_DIM), p['c_v'].reshape(B, S, C_KV_HEADS, C_DIM), sinks)
    o_d = latent_attention(p['d_cq'], p['d_ckv'], p['d_kr'], positions, dq_gain, dq_up, dkv_gain, dkv_up)
    branches = (o_a * jax.nn.silu(p['a_z']), o_b * jax.nn.silu(p['b_z']),
                o_c * jax.nn.silu(p['c_z']), o_d * jax.nn.silu(p['d_z']))
    merged = jnp.zeros_like(x)
    for n in range(N_BRANCH):
        gate = jax.nn.sigmoid(jnp.einsum('bsd,de->bse', x, w_gate[n]))
        merged = merged + gate * jnp.einsum('bsc,cd->bsd', branches[n], w_branch[n])
    y = jnp.einsum('bsd,de->bse', merged, w_out)
    return layer_norm(DEEPNORM_ALPHA * x + y, ln_gain, ln_bias)


def setup_inputs(seed: int = 0) -> dict:
    key = jax.random.key(seed)
    ks = jax.random.split(key, 16)
    nrm = lambda k, shape, s: jax.random.normal(k, shape, jnp.float32) * s
    x = nrm(ks[0], (BATCH, SEQ, D_MODEL), 1.0)
    start = jax.random.randint(ks[1], (BATCH, 1), 0, MAX_START_POS, dtype=jnp.int32)
    positions = start + jnp.arange(SEQ, dtype=jnp.int32)[None, :]
    w_in = nrm(ks[2], (DEPTH, D_MODEL, IN_WIDTH), D_MODEL ** -0.5)
    w_gate = nrm(ks[3], (DEPTH, N_BRANCH, D_MODEL, D_MODEL), D_MODEL ** -0.5)
    w_branch = nrm(ks[4], (DEPTH, N_BRANCH, BRANCH_WIDTH, D_MODEL), BRANCH_WIDTH ** -0.5 * DEEPNORM_BETA)
    w_out = nrm(ks[5], (DEPTH, D_MODEL, D_MODEL), D_MODEL ** -0.5 * DEEPNORM_BETA)
    dq_gain = 1.0 + nrm(ks[6], (DEPTH, D_Q_LORA), 0.02)
    dq_up = nrm(ks[7], (DEPTH, D_Q_LORA, D_HEADS * (D_NOPE + D_ROPE)), D_Q_LORA ** -0.5)
    dkv_gain = 1.0 + nrm(ks[8], (DEPTH, D_KV_LORA), 0.02)
    dkv_up = nrm(ks[9], (DEPTH, D_KV_LORA, D_HEADS * (D_NOPE + D_VDIM)), D_KV_LORA ** -0.5)
    f_bias = jax.random.uniform(ks[10], (DEPTH, B_HEADS), jnp.float32, 1.0, 5.0)
    sinks = nrm(ks[11], (DEPTH, C_HEADS), 0.5)
    ln_gain = 1.0 + nrm(ks[12], (DEPTH, D_MODEL), 0.02)
    ln_bias = nrm(ks[13], (DEPTH, D_MODEL), 0.02)
    return {'x': x, 'positions': positions, 'w_in': w_in, 'w_gate': w_gate, 'w_branch': w_branch,
            'w_out': w_out, 'dq_gain': dq_gain, 'dq_up': dq_up, 'dkv_gain': dkv_gain, 'dkv_up': dkv_up,
            'f_bias': f_bias, 'sinks': sinks, 'ln_gain': ln_gain, 'ln_bias': ln_bias}


def reference(x, positions, w_in, w_gate, w_branch, w_out, dq_gain, dq_up, dkv_gain, dkv_up, f_bias, sinks, ln_gain, ln_bias):
    for l in range(DEPTH):
        x = hybrid_layer(x, positions, w_in[l], w_gate[l], w_branch[l], w_out[l], dq_gain[l], dq_up[l],
                         dkv_gain[l], dkv_up[l], f_bias[l], sinks[l], ln_gain[l], ln_bias[l])
    return x
```

```cpp
#include <hip/hip_runtime.h>
#include <cstdio>
#include <cstdint>

#define LAS __attribute__((address_space(3)))
#define GAS __attribute__((address_space(1)))
typedef unsigned short bf16_t;
typedef short bf16x8 __attribute__((ext_vector_type(8)));
typedef short s16x4 __attribute__((ext_vector_type(4)));
typedef float f32x4 __attribute__((ext_vector_type(4)));
typedef float f32x2 __attribute__((ext_vector_type(2)));
typedef float f32x16 __attribute__((ext_vector_type(16)));
typedef unsigned u32x4 __attribute__((ext_vector_type(4)));
typedef unsigned u32x2 __attribute__((ext_vector_type(2)));

typedef __bf16 bf16x2_t __attribute__((ext_vector_type(2)));
__device__ __forceinline__ unsigned cvt_pk_bf16(float lo, float hi) { const f32x2 v = {lo, hi}; const bf16x2_t b = __builtin_convertvector(v, bf16x2_t); return __builtin_bit_cast(unsigned, b); }
__device__ __forceinline__ int ptid() { int t = threadIdx.x; asm volatile("" : "+v"(t)); return t; }
__device__ __forceinline__ float bf2f(unsigned short b) { return __uint_as_float(((unsigned)b) << 16); }

namespace pg8 {
constexpr int BM = 256, BK = 64, HALF = 128, HTB = HALF * BK * 2  , STAGE_BYTES = 8 * HTB, NXCD = 8, WGM = 4;
__host__ __device__ __forceinline__ int lds_byte(int r, int c) { const int st = (r >> 4) * 2 + (c >> 5), rr = r & 15, cc = c & 31, ob = rr * 64 + cc * 2; return st * 1024 + (ob ^ (((ob >> 9) & 1) << 5)); }
__host__ __device__ __forceinline__ void stage_rc(int b, int& R, int& C) { const int st = b / 1024, sb = b % 1024, swz = sb ^ (((sb >> 9) & 1) << 5); R = (st >> 1) * 16 + swz / 64; C = (st & 1) * 32 + (swz % 64) / 2; }
__host__ __device__ __forceinline__ int perm32(int rho) { const int n = rho >> 4, i = rho & 15; return 8 * (i >> 2) + 4 * n + (i & 3); }

struct Unit { int pm, pn, z; };
struct Gemm { const bf16_t* A; const bf16_t* Bt; int K, lda, ldb; size_t zA, zB; };

__device__ __forceinline__ void tile_of(int L, int nM, int nN, int& pm, int& pn, int WGM = pg8::WGM) {
    const int nwg = nM * nN; int wgid = L; { const int q = nwg / NXCD, r = nwg % NXCD, xcd = wgid % NXCD, off = wgid / NXCD; wgid = (xcd < r ? xcd * (q + 1) : r * (q + 1) + (xcd - r) * q) + off; }
    const int nig = WGM * nN, gid = wgid / nig, fm = gid * WGM, gsz = (nM - fm) < WGM ? (nM - fm) : WGM;
    pm = fm + ((wgid % nig) % gsz); pn = (wgid % nig) / gsz;
}
struct StaticOrder {
    int nM, nN, nwg, G, c, wgm;
    __device__ void init(int M, int N, int G_, int c_, int wgm_ = WGM) { nM = M / BM; nN = N / BM; nwg = nM * nN; G = G_; c = c_; wgm = wgm_; }
    __device__ bool next(int i, Unit& u) const { const long L = (long)i * G + c; if (L >= nwg) return false; tile_of((int)L, nM, nN, u.pm, u.pn, wgm); u.z = 0; return true; }
};
template <int Z> struct ZOrder {
    int nM, nN, nwg, G, c;
    __device__ void init(int M, int N, int G_, int c_) { nM = M / BM; nN = N / BM; nwg = nM * nN; G = G_; c = c_; }
    __device__ bool next(int i, Unit& u) const { const long L = (long)(i / Z) * G + c; if (L >= nwg) return false; tile_of((int)L, nM, nN, u.pm, u.pn); u.z = i % Z; return true; }
};

typedef int v8i_t __attribute__((ext_vector_type(8)));
typedef int v4i_t __attribute__((ext_vector_type(4)));
__device__ __forceinline__ v8i_t cat8(bf16x8 lo, bf16x8 hi) { const v4i_t a = __builtin_bit_cast(v4i_t, lo), b = __builtin_bit_cast(v4i_t, hi); return __builtin_shufflevector(a, b, 0, 1, 2, 3, 4, 5, 6, 7); }
template <class Epi, class Sched, bool ALIGN_EPI = true, bool F8 = false, bool F4 = false>
__device__ __forceinline__ void gemm_phase(LAS unsigned char* lds, const Gemm g, const Sched& S, const Epi& E) {
    const int tid = ptid(), wid = __builtin_amdgcn_readfirstlane(tid >> 6), lane = tid & 63, wr = wid >> 2, wc = wid & 3, fr = lane & 15, fq = lane >> 4;
    const int K = g.K, nt = K / BK;
    unsigned voffA[2], voffB[2];
#pragma unroll
    for (int i = 0; i < 2; ++i) { int R, C; stage_rc(tid * 16 + i * 8192, R, C);
        const int Rb = (int)Epi::PERM == 2 ? (64 * (R >> 5) + 16 * ((R >> 2) & 3) + 4 * ((R >> 4) & 1) + (R & 3)) : ((int)Epi::PERM == 1 ? ((R & ~31) + perm32(R & 31)) : R);
        voffA[i] = (unsigned)(R * g.lda + C) * 2u; voffB[i] = (unsigned)(Rb * g.ldb + C) * 2u; }
    const size_t kstep = (size_t)(BK * 2);
    const size_t hstepA = (size_t)HALF * g.lda * 2, hstepB = (size_t)((int)Epi::PERM == 2 ? 8 : HALF) * g.ldb * 2;
    const size_t tstepA = 2 * hstepA, tstepB = (size_t)BM * g.ldb * 2;
    const unsigned ldsw = (unsigned)wid * 1024u;
    const int aoff = lds_byte(wr * 64 + fr, fq * 8), boff = lds_byte(wc * 32 + fr, fq * 8);
#define PG8_SA(b, h) (((b) * 2 + (h)) * HTB)
#define PG8_SB(b, h) ((4 + (b) * 2 + (h)) * HTB)
#define PG8_STAGE(bufoff, gbase, voff) do { _Pragma("unroll") for (int _i = 0; _i < 2; ++_i) \
        __builtin_amdgcn_global_load_lds((const unsigned*)((const char*)(gbase) + (voff)[_i]), (LAS unsigned*)(lds + (bufoff) + ldsw + _i * 8192), 16, 0, 0); } while (0)
#define PG8_LDA(dst, b, h) do { _Pragma("unroll") for (int m = 0; m < 4; ++m) { if constexpr (F8) dst##8[m] = cat8(*(const LAS bf16x8*)(lds + PG8_SA(b, h) + aoff + m * 2048), *(const LAS bf16x8*)(lds + PG8_SA(b, h) + aoff + m * 2048 + 1024)); \
        else { _Pragma("unroll") for (int k = 0; k < 2; ++k) dst[m][k] = *(const LAS bf16x8*)(lds + PG8_SA(b, h) + aoff + m * 2048 + k * 1024); } } } while (0)
#define PG8_LDB(dst, b, h) do { _Pragma("unroll") for (int n = 0; n < 2; ++n) { if constexpr (F8) dst##8[n] = cat8(*(const LAS bf16x8*)(lds + PG8_SB(b, h) + boff + n * 2048), *(const LAS bf16x8*)(lds + PG8_SB(b, h) + boff + n * 2048 + 1024)); \
        else { _Pragma("unroll") for (int k = 0; k < 2; ++k) dst[n][k] = *(const LAS bf16x8*)(lds + PG8_SB(b, h) + boff + n * 2048 + k * 1024); } } } while (0)
#define PG8_MMA(ai, bj, At, Bt) do { __builtin_amdgcn_s_setprio(1); _Pragma("unroll") for (int m = 0; m < 4; ++m) _Pragma("unroll") for (int n = 0; n < 2; ++n) { \
        if constexpr (F8) asm volatile("v_mfma_f32_16x16x128_f8f6f4 %0, %1, %2, %0" : "+v"(acc[ai][bj][m][n]) : "v"(Bt##8[n]), "v"(At##8[m]));   \
        else if constexpr (F4) { _Pragma("unroll") for (int k = 0; k < 2; ++k) asm volatile("v_mfma_f32_16x16x128_f8f6f4 %0, %1, %2, %0 cbsz:4 blgp:4" : "+v"(acc[ai][bj][m][n]) : "v"(Bt[n][k]), "v"(At[m][k])); } \
        else { _Pragma("unroll") for (int k = 0; k < 2; ++k) acc[ai][bj][m][n] = __builtin_amdgcn_mfma_f32_16x16x32_bf16(Bt[n][k], At[m][k], acc[ai][bj][m][n], 0, 0, 0); } } \
        __builtin_amdgcn_s_setprio(0); } while (0)
#define PG8_WAIT_V(n) asm volatile("s_waitcnt vmcnt(" #n ")" ::: "memory")
#define PG8_WAIT_L(n) asm volatile("s_waitcnt lgkmcnt(" #n ")" ::: "memory")
#define PG8_BAR __builtin_amdgcn_s_barrier()
#define PG8_SCHED __builtin_amdgcn_sched_barrier(0)
    Unit cur, nxt; int ui = 0;
    if (!S.next(0, cur)) return;
    f32x4 acc[2][2][4][2];
#pragma unroll
    for (int a = 0; a < 2; ++a)
#pragma unroll
        for (int b = 0; b < 2; ++b)
#pragma unroll
            for (int m = 0; m < 4; ++m)
#pragma unroll
                for (int n = 0; n < 2; ++n) acc[a][b][m][n] = (f32x4){0.f, 0.f, 0.f, 0.f};
    bf16x8 At[4][2], B0[2][2], B1[2][2]; v8i_t At8[4], B08[2], B18[2];
    const char* cA = (const char*)g.A + (size_t)cur.z * g.zA + (size_t)cur.pm * tstepA; const char* cB = (const char*)g.Bt + (size_t)cur.z * g.zB + (size_t)cur.pn * tstepB;
    PG8_STAGE(PG8_SB(0, 0), cB, voffB); PG8_STAGE(PG8_SB(0, 1), cB + hstepB, voffB); PG8_STAGE(PG8_SA(0, 0), cA, voffA); PG8_STAGE(PG8_SA(0, 1), cA + hstepA, voffA);
    if (wr == 1) PG8_BAR;
    PG8_WAIT_V(2); PG8_BAR;
    PG8_STAGE(PG8_SB(1, 0), cB + kstep, voffB); PG8_STAGE(PG8_SA(1, 0), cA + kstep, voffA); PG8_STAGE(PG8_SB(1, 1), cB + hstepB + kstep, voffB);
    PG8_WAIT_V(6); PG8_BAR;
    for (;;) {
        const bool has_next = S.next(ui + 1, nxt);
        const char* nA = has_next ? (const char*)g.A + (size_t)nxt.z * g.zA + (size_t)nxt.pm * tstepA : cA; const char* nB = has_next ? (const char*)g.Bt + (size_t)nxt.z * g.zB + (size_t)nxt.pn * tstepB : cB;
#pragma unroll 1
        for (int t = 0; t < nt; t += 2) {
            const bool last = (t == nt - 2);
            const char* a1 = cA + (size_t)(t + 1) * kstep;
            const char* a2 = last ? nA : cA + (size_t)(t + 2) * kstep; const char* b2 = last ? nB : cB + (size_t)(t + 2) * kstep;
            const char* a3 = a2 + kstep; const char* b3 = b2 + kstep;
            PG8_LDB(B0, 0, 0); PG8_LDB(B1, 0, 1); PG8_SCHED; PG8_LDA(At, 0, 0); PG8_STAGE(PG8_SA(1, 1), a1 + hstepA, voffA);
            PG8_WAIT_V(8); PG8_WAIT_L(0); PG8_BAR; PG8_MMA(0, 0, At, B0); PG8_MMA(0, 1, At, B1); PG8_BAR; PG8_SCHED;
            PG8_LDA(At, 0, 1); PG8_STAGE(PG8_SB(0, 0), b2, voffB); PG8_STAGE(PG8_SB(0, 1), b2 + hstepB, voffB); PG8_STAGE(PG8_SA(0, 0), a2, voffA);
            PG8_WAIT_V(8); PG8_WAIT_L(0); PG8_BAR; PG8_MMA(1, 0, At, B0); PG8_MMA(1, 1, At, B1); PG8_BAR; PG8_SCHED;
            PG8_LDB(B0, 1, 0); PG8_LDB(B1, 1, 1); PG8_SCHED; PG8_LDA(At, 1, 0); PG8_STAGE(PG8_SA(0, 1), a2 + hstepA, voffA);
            PG8_WAIT_V(8); PG8_WAIT_L(0); PG8_BAR; PG8_MMA(0, 0, At, B0); PG8_MMA(0, 1, At, B1); PG8_BAR; PG8_SCHED;
            PG8_LDA(At, 1, 1); PG8_STAGE(PG8_SB(1, 0), b3, voffB); PG8_STAGE(PG8_SB(1, 1), b3 + hstepB, voffB); PG8_STAGE(PG8_SA(1, 0), a3, voffA);
            PG8_WAIT_V(8); PG8_WAIT_L(0); PG8_BAR; PG8_MMA(1, 0, At, B0); PG8_MMA(1, 1, At, B1); PG8_BAR; PG8_SCHED;
        }
        if constexpr (ALIGN_EPI) { if (wr == 0) PG8_BAR; }
        if constexpr (F8 || F4) asm volatile("s_nop 15\n\ts_nop 15" ::: "memory");
        E(acc, cur, wr, wc, fr, fq);
        if (!has_next) break;
        if (!(Epi::CARRY && nxt.z != 0))
#pragma unroll
        for (int a = 0; a < 2; ++a)
#pragma unroll
            for (int b = 0; b < 2; ++b)
#pragma unroll
                for (int m = 0; m < 4; ++m)
#pragma unroll
                    for (int n = 0; n < 2; ++n) acc[a][b][m][n] = (f32x4){0.f, 0.f, 0.f, 0.f};
        cur = nxt; cA = nA; cB = nB; ++ui;
        if constexpr (ALIGN_EPI) { if (wr == 1) PG8_BAR; }
    }
    PG8_WAIT_V(0);
    if constexpr (!ALIGN_EPI) { if (wr == 0) PG8_BAR; }
    PG8_BAR;
#undef PG8_SA
#undef PG8_SB
#undef PG8_STAGE
#undef PG8_LDA
#undef PG8_LDB
#undef PG8_MMA
#undef PG8_WAIT_V
#undef PG8_WAIT_L
#undef PG8_BAR
#undef PG8_SCHED
}
}

constexpr int BATCH = 4, SEQ = 4096, DM = 4096, MTOK = BATCH * SEQ, DEPTH = 2;
constexpr int INW = 12184, INP = 12288, NGATE = 4 * DM, N1 = INP + NGATE;
constexpr float LOG2E = 1.4426950408889634f;
constexpr float RMS_EPS = 1e-6f, LN_EPS = 1e-5f;
constexpr float DN_ALPHA = 1.4142135623730951f;
constexpr int PC_AQ = 0, PC_AK = 1024, PC_AV = 1280, PC_AIQ = 1536, PC_AZ = 2560, PC_BQ = 3584, PC_BK = 4608, PC_BV = 5632, PC_BZ = 6656,
              PC_CQ = 7680, PC_CK = 8704, PC_CV = 8832, PC_CZ = 8960, PC_DCQ = 9984, PC_DCKV = 10752, PC_DZ = 11008,
              PC_AIK = 12032, PC_AIW = 12096, PC_BF = 12112, PC_DKR = 12120, PC_END = 12184;
constexpr int SC_AQ = 0, SC_AK = 1024, SC_AV = 1280, SC_AIQ = 1536, SC_AIK = 2560, SC_AIW = 2624, SC_AZ = 2640, SC_BQ = 3664, SC_BK = 4688, SC_BV = 5712,
              SC_BF = 6736, SC_BZ = 6744, SC_CQ = 7768, SC_CK = 8792, SC_CV = 8920, SC_CZ = 9048, SC_DCQ = 10072, SC_DCKV = 10840, SC_DKR = 11096, SC_DZ = 11160;
static_assert(SC_DZ + 1024 == INW, "w_in column partition");
constexpr int SMC_AIK = 0, SMC_AIW = 64, SMC_BF = 80, SMC_DKR = 88;

constexpr size_t MiB = 1u << 20;
constexpr size_t WS_CTL = 0, CTL_ZERO_BYTES = 1 * MiB;
constexpr size_t WS_W = 2 * MiB;
constexpr int NIN8 = 27 * 256, NINZ = 16 * 256, NINB = 5 * 256;
constexpr size_t WO_WIN8 = 0                                         , WO_WZ4 = WO_WIN8 + (size_t)NIN8 * DM  ,
                 WO_WINB = WO_WZ4 + (size_t)NINZ * (DM / 2)          ,
                 WO_WG8 = WO_WINB + (size_t)NINB * DM * 2            , WO_WBR = WO_WG8 + (size_t)NGATE * DM  ,
                 WO_WOUT = WO_WBR + (size_t)4 * DM * 1024            , WO_DQUP = WO_WOUT + (size_t)DM * DM,
                 WO_DKVUP = WO_DQUP + (size_t)1536 * 768 * 2, WO_END = WO_DKVUP + (size_t)2048 * 256 * 2;
static_assert(WO_END <= 292 * MiB, "weights region");
constexpr size_t WS_XB = 294 * MiB;
constexpr size_t WS_P = 422 * MiB;
constexpr size_t WS_MRGF = WS_P;
constexpr size_t WS_G = 806 * MiB;
constexpr size_t WS_R = WS_G;
constexpr size_t WS_SC = 1318 * MiB;
constexpr size_t WS_MRG = WS_SC;
constexpr size_t WS_BR = 1574 * MiB;
constexpr size_t WS_DQ = 1702 * MiB;
constexpr size_t WS_DKV = 1750 * MiB;
constexpr size_t WS_MASK = 1814 * MiB;
constexpr size_t WS_SM = 1822 * MiB;
constexpr size_t WS_CS = 1838 * MiB;
constexpr size_t WS_RSS = 1842 * MiB;
constexpr size_t WS_CUM = 1843 * MiB;
constexpr size_t WS_DKR = 1844 * MiB;
constexpr size_t WS_X8 = 1846 * MiB;
constexpr size_t WS_KV8 = 1096 * MiB;
constexpr int KV8W = 2560;
constexpr size_t WS_D8 = 1136 * MiB;
constexpr int D8W = 2112;
constexpr size_t WS_L8 = 1170 * MiB;
constexpr float DQ_WS = 64.0f, DKV_WS = 8.0f;
constexpr size_t WS_X4 = 1062 * MiB;
constexpr size_t WS_END = 1910 * MiB;
constexpr int CW_TMO = 0;
constexpr int CW_Q = 64;
constexpr int CW_BAR = 16384;

constexpr int RING_BYTES = 131072;
constexpr int LDSCTL_OFF = RING_BYTES, MISC_OFF = LDSCTL_OFF + 320;
constexpr int LDS_BYTES = 147456;
constexpr int NWAVES = 8, NTHREADS = 512;

#define RLX_AGENT __ATOMIC_RELAXED, __HIP_MEMORY_SCOPE_AGENT
#define LDS_WAIT() asm volatile("s_waitcnt lgkmcnt(0)" ::: "memory")
#define VM_WAIT() asm volatile("s_waitcnt vmcnt(0)" ::: "memory")

#define XB_TMO      128
#define XB_XCNT(j)  (256  + 64 * (j))
#define XB_XSUB(j)  (1280 + 64 * (j))
#define XB_XGEN(j)  (2304 + 64 * (j))
#define XB_TOP      3328
#define XB_TOPGEN   3392
#define XCD_BAR_WORDS 3456
#define XB_SPIN_CAP (1u << 23)
__device__ __forceinline__ unsigned xb_ld(unsigned* p)              { return __hip_atomic_load(p, __ATOMIC_RELAXED, __HIP_MEMORY_SCOPE_AGENT); }
__device__ __forceinline__ unsigned xb_add(unsigned* p, unsigned v) { return __hip_atomic_fetch_add(p, v, __ATOMIC_RELAXED, __HIP_MEMORY_SCOPE_AGENT); }
__device__ __forceinline__ unsigned xb_xcc_id() { return (unsigned)__builtin_amdgcn_s_getreg((3 << 11) | 20) & 0xFu; }
#define XB_SPIN(cond, bar) do { unsigned _sp = 0; while (cond) { __builtin_amdgcn_s_sleep(1); \
    if ((++_sp & 255u) == 0u) { if (xb_ld(&(bar)[XB_TMO])) break; if (_sp > XB_SPIN_CAP) { atomicAdd(&(bar)[XB_TMO], 1u); break; } } } } while (0)
struct XcdBarrier { unsigned* bar; unsigned x; volatile LAS unsigned* st; };
__device__ __forceinline__ XcdBarrier xcd_barrier_post(unsigned* bar, volatile LAS unsigned* st) {
    XcdBarrier b; b.bar = bar; b.x = xb_xcc_id(); b.st = st;
    if (threadIdx.x == 0) (void)xb_add(&bar[XB_XCNT(b.x)], 1u);
    return b;
}
__device__ __forceinline__ void xcd_barrier_complete(unsigned* bar, unsigned x, unsigned& nloc, unsigned& nx) {
    const unsigned G = gridDim.x * gridDim.y * gridDim.z;
    unsigned sum, cnt, mine, sp = 0u;
    for (;;) {
        sum = 0u; cnt = 0u; mine = 0u;
#pragma unroll
        for (unsigned j = 0; j < 16; ++j) { const unsigned c = xb_ld(&bar[XB_XCNT(j)]); sum += c; cnt += (c > 0u) ? 1u : 0u; mine = (j == x) ? c : mine; }
        if (sum == G) break;
        __builtin_amdgcn_s_sleep(1);
        if ((++sp & 255u) == 0u) { if (xb_ld(&bar[XB_TMO])) break; if (sp > XB_SPIN_CAP) { atomicAdd(&bar[XB_TMO], 1u); break; } }
    }
    nloc = mine > 0u ? mine : 1u; nx = cnt > 0u ? cnt : 1u;
}
__device__ __forceinline__ void xcd_barrier(const XcdBarrier& b) {
    asm volatile("s_waitcnt vmcnt(0)" ::: "memory");
    __syncthreads();
    if (threadIdx.x == 0) {
        unsigned* bar = b.bar;
        __builtin_amdgcn_s_waitcnt(0);
        unsigned nloc = b.st[0], nx = b.st[1];
        if (nloc == 0u) { xcd_barrier_complete(bar, b.x, nloc, nx); b.st[0] = nloc; b.st[1] = nx; }
        const unsigned old = xb_add(&bar[XB_XSUB(b.x)], 1u);
        const unsigned gen = old / nloc;
        if (old + 1u == (gen + 1u) * nloc) {
            __builtin_amdgcn_fence(__ATOMIC_RELEASE, "agent");
            asm volatile("s_waitcnt vmcnt(0)" ::: "memory");
            const unsigned og = xb_add(&bar[XB_TOP], 1u);
            const unsigned tg = og / nx;
            if (og + 1u == (tg + 1u) * nx) xb_add(&bar[XB_TOPGEN], 1u);
            else XB_SPIN(xb_ld(&bar[XB_TOPGEN]) == tg, bar);
            __builtin_amdgcn_fence(__ATOMIC_ACQUIRE, "agent");
            xb_add(&bar[XB_XGEN(b.x)], 1u);
            asm volatile("s_waitcnt vmcnt(0)" ::: "memory");
        } else {
            XB_SPIN(xb_ld(&bar[XB_XGEN(b.x)]) == gen, bar);
            __builtin_amdgcn_fence(__ATOMIC_ACQUIRE, "agent");
            asm volatile("s_waitcnt vmcnt(0)" ::: "memory");
        }
    }
    __syncthreads();
}

struct Args {
    const float* x; const int* pos; const float* w_in; const float* w_gate; const float* w_branch; const float* w_out;
    const float* dq_gain; const float* dq_up; const float* dkv_gain; const float* dkv_up; const float* f_bias; const float* sinks; const float* ln_gain; const float* ln_bias;
    float* out; unsigned char* ws; int ph_lo, ph_hi;
};

__device__ __forceinline__ float wave_sum(float v) {
#pragma unroll
    for (int o = 1; o < 64; o <<= 1) v += __shfl_xor(v, o);
    return v;
}
__device__ __forceinline__ unsigned pack_fp4x8(float a0, float a1, float a2, float a3, float a4, float a5, float a6, float a7) {
    unsigned w = 0u;
    w = __builtin_amdgcn_cvt_scalef32_pk_fp4_f32(w, a0, a1, 1.0f, 0); w = __builtin_amdgcn_cvt_scalef32_pk_fp4_f32(w, a2, a3, 1.0f, 1);
    w = __builtin_amdgcn_cvt_scalef32_pk_fp4_f32(w, a4, a5, 1.0f, 2); w = __builtin_amdgcn_cvt_scalef32_pk_fp4_f32(w, a6, a7, 1.0f, 3);
    return w; }
constexpr float FP4_XS = 2.0f, FP4_WS = 128.0f;
__device__ __forceinline__ float fast_sigmoid(float v) { return __builtin_amdgcn_rcpf(1.0f + __builtin_amdgcn_exp2f(-v * LOG2E)); }

__device__ __forceinline__ int in_src(int j, float& sc) {
    sc = 1.0f;
    if (j < PC_AK)   return SC_AQ + (j - PC_AQ);
    if (j < PC_AV)   return SC_AK + (j - PC_AK);
    if (j < PC_AIQ)  return SC_AV + (j - PC_AV);
    if (j < PC_AZ)   return SC_AIQ + (j - PC_AIQ);
    if (j < PC_BQ)   return SC_AZ + (j - PC_AZ);
    if (j < PC_BK)   return SC_BQ + (j - PC_BQ);
    if (j < PC_BV)   return SC_BK + (j - PC_BK);
    if (j < PC_BZ)   return SC_BV + (j - PC_BV);
    if (j < PC_CQ)   return SC_BZ + (j - PC_BZ);
    if (j < PC_CK)   return SC_CQ + (j - PC_CQ);
    if (j < PC_CV)   return SC_CK + (j - PC_CK);
    if (j < PC_CZ)   return SC_CV + (j - PC_CV);
    if (j < PC_DCQ)  return SC_CZ + (j - PC_CZ);
    if (j < PC_DCKV) return SC_DCQ + (j - PC_DCQ);
    if (j < PC_DZ)   return SC_DCKV + (j - PC_DCKV);
    if (j < PC_AIK)  return SC_DZ + (j - PC_DZ);
    if (j < PC_AIW)  return SC_AIK + (j - PC_AIK);
    if (j < PC_BF)   return SC_AIW + (j - PC_AIW);
    if (j < PC_DKR)  return SC_BF + (j - PC_BF);
    if (j < PC_END)  { const int p = j - PC_DKR; return SC_DKR + (p >> 1) + 32 * (p & 1); }
    return -1;
}
__host__ __device__ __forceinline__ int in8_tile(int i) { return i < 6 ? i : (i < 22 ? i + 4 : i + 8); }
__host__ __device__ __forceinline__ int inz_tile(int j) { return j < 4 ? 26 + j : 31 + j; }
struct CvtItem {
    const float* p;
    unsigned ld;
    const float* gain;
    float sc;
    unsigned char* dst;
    int K, n0, k0, f8;
};
__device__ __forceinline__ CvtItem cvt_decode(const Args& a, int layer, int it, int lane) {
    unsigned char* W = a.ws + WS_W;
    constexpr int I_IN8 = (NIN8 / 32) * (DM / 64), I_INZ = (NINZ / 32) * (DM / 64), I_INB = (NINB / 32) * (DM / 64), I_G = (NGATE / 32) * (DM / 64), I_BR = 4 * (DM / 32) * (1024 / 64), I_OUT = (DM / 32) * (DM / 64), I_DQ = (1536 / 32) * (768 / 64);
    CvtItem d; d.gain = nullptr; d.sc = 1.0f; d.f8 = 1; d.K = DM; d.ld = DM;
    const int ln = lane & 31; int r = it;
    if (r < I_IN8) { const int nb = r % (NIN8 / 32), kb = r / (NIN8 / 32); d.n0 = nb * 32; d.k0 = kb * 64;
        const int j = in8_tile(d.n0 >> 8) * 256 + (d.n0 & 255) + ln; float s_; const int c = in_src(j, s_);
        d.p = a.w_in + (size_t)layer * DM * INW + (c < 0 ? 0 : c); d.ld = INW; d.sc = c < 0 ? 0.f : 64.0f; d.dst = W + WO_WIN8; return d; }
    r -= I_IN8;
    if (r < I_INZ) { const int nb = r % (NINZ / 32), kb = r / (NINZ / 32); d.n0 = nb * 32; d.k0 = kb * 64;
        const int j = inz_tile(d.n0 >> 8) * 256 + (d.n0 & 255) + ln; float s_; const int c = in_src(j, s_);
        d.p = a.w_in + (size_t)layer * DM * INW + (c < 0 ? 0 : c); d.ld = INW; d.sc = c < 0 ? 0.f : FP4_WS; d.dst = W + WO_WZ4; d.f8 = 2; return d; }
    r -= I_INZ;
    if (r < I_INB) { const int nb = r % (NINB / 32), kb = r / (NINB / 32); d.n0 = nb * 32; d.k0 = kb * 64;
        const int j = d.n0 + ln + (d.n0 < 1024 ? 1536 : 12032 - 1024); float s_; const int c = in_src(j, s_);
        d.p = a.w_in + (size_t)layer * DM * INW + (c < 0 ? 0 : c); d.ld = INW; d.sc = c < 0 ? 0.f : 1.0f; d.dst = W + WO_WINB; d.f8 = 0; return d; }
    r -= I_INB;
    if (r < I_G) { const int nb = r % (NGATE / 32), kb = r / (NGATE / 32), g = nb / (DM / 32); d.n0 = (nb % (DM / 32)) * 32; d.k0 = kb * 64;
        d.p = a.w_gate + ((size_t)layer * 4 + g) * DM * DM + d.n0 + ln; d.sc = FP4_WS; d.dst = W + WO_WG8 + (size_t)g * DM * (DM / 2); d.f8 = 2; return d; }
    r -= I_G;
    if (r < I_BR) { const int n = r / ((DM / 32) * 16), q = r % ((DM / 32) * 16), nb = q % (DM / 32), kb = q / (DM / 32); d.n0 = nb * 32; d.k0 = kb * 64;
        d.p = a.w_branch + ((size_t)layer * 4 + n) * 1024 * DM + d.n0 + ln; d.sc = 64.0f; d.dst = W + WO_WBR + (size_t)n * DM * 1024; d.K = 1024; return d; }
    r -= I_BR;
    if (r < I_OUT) { const int nb = r % (DM / 32), kb = r / (DM / 32); d.n0 = nb * 32; d.k0 = kb * 64;
        d.p = a.w_out + (size_t)layer * DM * DM + d.n0 + ln; d.sc = 128.0f; d.dst = W + WO_WOUT; return d; }
    r -= I_OUT;
    if (r < I_DQ) { const int nb = r % 48, kb = r / 48; d.n0 = nb * 32; d.k0 = kb * 64;
        const int j = d.n0 + ln, h = j / 192, wv = j % 192; int c = wv; if (wv >= 128) { const int q = wv - 128; c = 128 + (q >> 1) + 32 * (q & 1); }
        d.p = a.dq_up + (size_t)layer * 768 * 1536 + h * 192 + c; d.ld = 1536; d.gain = a.dq_gain + layer * 768; d.sc = 0.07216878364870322f * LOG2E * DQ_WS; d.dst = W + WO_DQUP; d.K = 768; d.f8 = 1; return d; }
    r -= I_DQ;
    { const int nb = r % 64, kb = r / 64; d.n0 = nb * 32; d.k0 = kb * 64;
      d.p = a.dkv_up + (size_t)layer * 256 * 2048 + d.n0 + ln; d.ld = 2048; d.gain = a.dkv_gain + layer * 256; d.sc = DKV_WS; d.dst = W + WO_DKVUP; d.K = 256; d.f8 = 1; return d; }
}
__device__ __forceinline__ void cvt_load(const CvtItem& d, float (&v)[32], int lane) {
    const float* p = d.p + (size_t)(d.k0 + (lane >> 5)) * d.ld;
#pragma unroll
    for (int i = 0; i < 32; ++i) v[i] = p[(size_t)(2 * i) * d.ld];
}
__device__ __forceinline__ void cvt_finish(const CvtItem& d, const float (&v)[32], LAS float* scr, int lane) {
#pragma unroll
    for (int i = 0; i < 32; ++i) { const int kk = 2 * i + (lane >> 5); float x = v[i] * d.sc; if (d.gain) x *= d.gain[d.k0 + kk]; scr[kk * 33 + (lane & 31)] = x; }
    LDS_WAIT(); asm volatile("" ::: "memory");
    const int c = lane & 7;
#pragma unroll
    for (int j = 0; j < 4; ++j) { const int n = (lane >> 3) + 8 * j; const LAS float* s = scr + (8 * c) * 33 + n;
        if (d.f8 == 2) *(unsigned*)(d.dst + (((size_t)(d.n0 + n) * d.K + d.k0 + 8 * c) >> 1)) = pack_fp4x8(s[0], s[33], s[2 * 33], s[3 * 33], s[4 * 33], s[5 * 33], s[6 * 33], s[7 * 33]);
        else if (d.f8) { int w0 = 0, w1 = 0;
            w0 = __builtin_amdgcn_cvt_pk_fp8_f32(s[0], s[33], w0, false); w0 = __builtin_amdgcn_cvt_pk_fp8_f32(s[2 * 33], s[3 * 33], w0, true);
            w1 = __builtin_amdgcn_cvt_pk_fp8_f32(s[4 * 33], s[5 * 33], w1, false); w1 = __builtin_amdgcn_cvt_pk_fp8_f32(s[6 * 33], s[7 * 33], w1, true);
            *(u32x2*)(d.dst + (size_t)(d.n0 + n) * d.K + d.k0 + 8 * c) = (u32x2){(unsigned)w0, (unsigned)w1}; }
        else { u32x4 o; o.x = cvt_pk_bf16(s[0], s[33]); o.y = cvt_pk_bf16(s[2 * 33], s[3 * 33]); o.z = cvt_pk_bf16(s[4 * 33], s[5 * 33]); o.w = cvt_pk_bf16(s[6 * 33], s[7 * 33]);
            *(u32x4*)((bf16_t*)d.dst + (size_t)(d.n0 + n) * d.K + d.k0 + 8 * c) = o; } }
    LDS_WAIT(); asm volatile("" ::: "memory");
}
__device__ __forceinline__ void convert_weights(const Args& a, int layer, LAS unsigned char* lds) {
    const int tid = ptid(), lane = tid & 63, wave = tid >> 6;
    LAS float* scr = (LAS float*)(lds + wave * 8448);
    const int NGW = gridDim.x * NWAVES, gw = blockIdx.x * NWAVES + wave;
    constexpr int NITEMS = (NIN8 / 32) * (DM / 64) + (NINZ / 32) * (DM / 64) + (NINB / 32) * (DM / 64) + (NGATE / 32) * (DM / 64) + 4 * (DM / 32) * (1024 / 64) + (DM / 32) * (DM / 64) + (1536 / 32) * (768 / 64) + (2048 / 32) * (256 / 64);
    float va[32], vb[32]; CvtItem da, db;
    int it = gw;
    if (it < NITEMS) { da = cvt_decode(a, layer, it, lane); cvt_load(da, va, lane); }
    while (it < NITEMS) {
        const int itb = it + NGW;
        if (itb < NITEMS) { db = cvt_decode(a, layer, itb, lane); cvt_load(db, vb, lane); }
        cvt_finish(da, va, scr, lane);
        if (itb >= NITEMS) break;
        const int ita = itb + NGW;
        if (ita < NITEMS) { da = cvt_decode(a, layer, ita, lane); cvt_load(da, va, lane); }
        cvt_finish(db, vb, scr, lane);
        it = ita;
    }
    __syncthreads();
}
__device__ __forceinline__ void prologue_misc(const Args& a) {
    const size_t gt = (size_t)blockIdx.x * NTHREADS + ptid(), GT = (size_t)gridDim.x * NTHREADS;
    bf16_t* XB = (bf16_t*)(a.ws + WS_XB);
    constexpr size_t NCH = (size_t)MTOK * DM / 8;
    for (size_t i0 = gt; i0 < NCH; i0 += 4 * GT) {
        f32x4 v0[4], v1[4];
#pragma unroll
        for (int u = 0; u < 4; ++u) { const size_t i = i0 + u * GT; if (i < NCH) { v0[u] = *(const f32x4*)(a.x + i * 8); v1[u] = *(const f32x4*)(a.x + i * 8 + 4); } }
#pragma unroll
        for (int u = 0; u < 4; ++u) { const size_t i = i0 + u * GT; if (i < NCH) {
            u32x4 o; o.x = cvt_pk_bf16(v0[u][0], v0[u][1]); o.y = cvt_pk_bf16(v0[u][2], v0[u][3]); o.z = cvt_pk_bf16(v1[u][0], v1[u][1]); o.w = cvt_pk_bf16(v1[u][2], v1[u][3]);
            *(u32x4*)(XB + i * 8) = o;
            int w0 = 0, w1 = 0;
            w0 = __builtin_amdgcn_cvt_pk_fp8_f32(v0[u][0], v0[u][1], w0, false); w0 = __builtin_amdgcn_cvt_pk_fp8_f32(v0[u][2], v0[u][3], w0, true);
            w1 = __builtin_amdgcn_cvt_pk_fp8_f32(v1[u][0], v1[u][1], w1, false); w1 = __builtin_amdgcn_cvt_pk_fp8_f32(v1[u][2], v1[u][3], w1, true);
            *(u32x2*)(a.ws + WS_X8 + i * 8) = (u32x2){(unsigned)w0, (unsigned)w1};
            *(unsigned*)(a.ws + WS_X4 + i * 4) = pack_fp4x8(v0[u][0] * FP4_XS, v0[u][1] * FP4_XS, v0[u][2] * FP4_XS, v0[u][3] * FP4_XS, v1[u][0] * FP4_XS, v1[u][1] * FP4_XS, v1[u][2] * FP4_XS, v1[u][3] * FP4_XS); } }
    }
    f32x2* CS = (f32x2*)(a.ws + WS_CS);
    for (size_t i = gt; i < (size_t)MTOK * 32; i += GT) {
        const int row = (int)(i >> 5), fi = (int)(i & 31);
        const float invf = __builtin_amdgcn_exp2f(-(float)fi * (13.287712379549449f / 32.0f));
        const float ang = (float)a.pos[row] * invf;
        const double rev = (double)ang * 0.15915494309189535;
        const float fr = (float)(rev - floor(rev));
        CS[i] = (f32x2){__builtin_amdgcn_cosf(fr), __builtin_amdgcn_sinf(fr)};
    }
}

struct EpiIn {
    static constexpr int PERM = 2; static constexpr bool CARRY = false;
    bf16_t* P; float* SM; float* RSS; int f8; unsigned char* KV8; unsigned char* L8;
    template <int MODE>
    __device__ __forceinline__ void run(const f32x4 (&acc)[2][2][4][2], int pn, int row0, int cw, int wc, int fq, float sc) const {
        bf16_t* base = P + (size_t)pn * 256 + cw;
        unsigned char* k8b = (MODE == 3) ? L8 + (pn - 39) * 256 + cw : KV8 + (pn < 6 ? (pn - 4) * 256 : 512 + (pn - 18) * 256) + cw;
#pragma unroll
        for (int ai = 0; ai < 2; ++ai)
#pragma unroll
            for (int m = 0; m < 4; ++m) { const int row = row0 + ai * 128 + m * 16; bf16_t* rowp = base + (size_t)row * INP; float ss = 0.f;
                u32x4 k8w;
#pragma unroll
                for (int bj = 0; bj < 2; ++bj) { f32x4 v0 = acc[ai][bj][m][0] * sc, v1 = acc[ai][bj][m][1] * sc;
                    if constexpr (MODE == 3) ss += ((v0[0] * v0[0] + v0[1] * v0[1]) + (v0[2] * v0[2] + v0[3] * v0[3])) + ((v1[0] * v1[0] + v1[1] * v1[1]) + (v1[2] * v1[2] + v1[3] * v1[3]));
                    if constexpr (MODE == 4 || MODE == 3) { int w0 = 0, w1 = 0;
                        w0 = __builtin_amdgcn_cvt_pk_fp8_f32(v0[0], v0[1], w0, false); w0 = __builtin_amdgcn_cvt_pk_fp8_f32(v0[2], v0[3], w0, true);
                        w1 = __builtin_amdgcn_cvt_pk_fp8_f32(v1[0], v1[1], w1, false); w1 = __builtin_amdgcn_cvt_pk_fp8_f32(v1[2], v1[3], w1, true);
                        if (bj == 0) { k8w.x = (unsigned)w0; k8w.y = (unsigned)w1; } else { k8w.z = (unsigned)w0; k8w.w = (unsigned)w1; } continue; }
                    if constexpr (MODE == 1) {
#pragma unroll
                        for (int j = 0; j < 4; ++j) { v0[j] = v0[j] * fast_sigmoid(v0[j]); v1[j] = v1[j] * fast_sigmoid(v1[j]); } }
                    if constexpr (MODE == 2) { float* sp = SM + (size_t)row * 256 + cw + bj * 8; *(f32x4*)sp = v0; *(f32x4*)(sp + 4) = v1; }
                    u32x4 w; w.x = cvt_pk_bf16(v0[0], v0[1]); w.y = cvt_pk_bf16(v0[2], v0[3]); w.z = cvt_pk_bf16(v1[0], v1[1]); w.w = cvt_pk_bf16(v1[2], v1[3]);
                    *(u32x4*)(rowp + bj * 8) = w; }
                if constexpr (MODE == 4) *(u32x4*)(k8b + (size_t)row * KV8W) = k8w;
                if constexpr (MODE == 3) *(u32x4*)(k8b + (size_t)row * 1024) = k8w;
                if constexpr (MODE == 3) { ss += __shfl_xor(ss, 16); ss += __shfl_xor(ss, 32); if (fq == 0) RSS[(size_t)row * 16 + (pn - 39) * 4 + wc] = ss; }
                asm volatile("" ::: "memory"); }
    }
    __device__ __forceinline__ void operator()(f32x4 (&acc)[2][2][4][2], const pg8::Unit& u, int wr, int wc, int fr, int fq) const {
        asm volatile("" : "+v"(fr), "+v"(fq));
        const int pn = f8 == 1 ? in8_tile(u.pn) : (f8 == 2 ? inz_tile(u.pn) : (u.pn < 4 ? u.pn + 6 : 47)), row0 = u.pm * 256 + wr * 64 + fr, cw = wc * 64 + 16 * fq;
        const float qs = (pn < 4 || (pn >= 14 && pn < 18)) ? 0.08838834764831845f * LOG2E : ((pn >= 30 && pn < 34) ? 0.125f * LOG2E : 1.0f), sc = f8 == 1 ? qs * 0.015625f : (f8 == 2 ? 1.0f / (FP4_XS * FP4_WS * 0.9761f) : qs);
        if (pn == 47) run<2>(acc, pn, row0, cw, wc, fq, sc);
        else if (pn >= 39 && pn < 43) run<3>(acc, pn, row0, cw, wc, fq, sc);
        else if (pn == 4 || pn == 5 || (pn >= 18 && pn < 26)) run<4>(acc, pn, row0, cw, wc, fq, sc);
        else run<0>(acc, pn, row0, cw, wc, fq, sc);
    }
};
struct EpiGate {
    static constexpr int PERM = 2; static constexpr bool CARRY = false;
    unsigned char* G; float sc;
    __device__ __forceinline__ void operator()(f32x4 (&acc)[2][2][4][2], const pg8::Unit& u, int wr, int wc, int fr, int fq) const {
        asm volatile("" : "+v"(fr), "+v"(fq));
        const int row0 = u.pm * 256 + wr * 64 + fr, cw = wc * 64 + 16 * fq;
        unsigned char* base = G + (size_t)u.pn * 256 + cw;
#pragma unroll
        for (int ai = 0; ai < 2; ++ai)
#pragma unroll
            for (int m = 0; m < 4; ++m) { unsigned char* rowp = base + (size_t)(row0 + ai * 128 + m * 16) * NGATE; u32x4 w;
#pragma unroll
                for (int bj = 0; bj < 2; ++bj) { const f32x4 v0 = acc[ai][bj][m][0] * sc, v1 = acc[ai][bj][m][1] * sc; int w0 = 0, w1 = 0;
                    w0 = __builtin_amdgcn_cvt_pk_fp8_f32(v0[0], v0[1], w0, false); w0 = __builtin_amdgcn_cvt_pk_fp8_f32(v0[2], v0[3], w0, true);
                    w1 = __builtin_amdgcn_cvt_pk_fp8_f32(v1[0], v1[1], w1, false); w1 = __builtin_amdgcn_cvt_pk_fp8_f32(v1[2], v1[3], w1, true);
                    if (bj == 0) { w.x = (unsigned)w0; w.y = (unsigned)w1; } else { w.z = (unsigned)w0; w.w = (unsigned)w1; } }
                *(u32x4*)rowp = w; }
    }
};
struct EpiNull {
    static constexpr int PERM = 1; static constexpr bool CARRY = false;
    float* D;
    __device__ __forceinline__ void operator()(f32x4 (&acc)[2][2][4][2], const pg8::Unit& u, int wr, int wc, int fr, int fq) const {
        f32x4 s = (f32x4){0.f, 0.f, 0.f, 0.f};
#pragma unroll
        for (int ai = 0; ai < 2; ++ai)
#pragma unroll
            for (int bj = 0; bj < 2; ++bj)
#pragma unroll
                for (int m = 0; m < 4; ++m)
#pragma unroll
                    for (int n = 0; n < 2; ++n) s += acc[ai][bj][m][n];
        *(f32x4*)(D + ((size_t)(u.pm * 64 + u.pn) * 512 + wr * 256 + wc * 64 + fq * 16 + fr) * 4) = s;
    }
};
struct EpiDq {
    static constexpr int PERM = 2; static constexpr bool CARRY = false;
    bf16_t* DQ; const float* RSS; const float* CS; float wsc;
    __device__ __forceinline__ void operator()(f32x4 (&acc)[2][2][4][2], const pg8::Unit& u, int wr, int wc, int fr, int fq) const {
        asm volatile("" : "+v"(fr), "+v"(fq));
        const int row0 = u.pm * 256 + wr * 64 + fr, col0 = u.pn * 256 + wc * 64 + 16 * fq;
#pragma unroll
        for (int ai = 0; ai < 2; ++ai)
#pragma unroll
            for (int m = 0; m < 4; ++m) { const int row = row0 + ai * 128 + m * 16;
                const f32x4 r0 = *(const f32x4*)(RSS + (size_t)row * 16), r1 = *(const f32x4*)(RSS + (size_t)row * 16 + 4), r2 = *(const f32x4*)(RSS + (size_t)row * 16 + 8);
                const float ss = ((r0[0] + r0[1]) + (r0[2] + r0[3])) + ((r1[0] + r1[1]) + (r1[2] + r1[3])) + ((r2[0] + r2[1]) + (r2[2] + r2[3]));
                const float rs = __builtin_amdgcn_rsqf(ss * (1.0f / 768.0f) + RMS_EPS) * wsc;
                bf16_t* rowp = DQ + (size_t)row * 1536 + col0;
#pragma unroll
                for (int bj = 0; bj < 2; ++bj) { f32x4 v[2];
#pragma unroll
                    for (int n = 0; n < 2; ++n) { v[n] = acc[ai][bj][m][n] * rs; const int c = col0 + bj * 8 + 4 * n, w = c % 192;
                        if (w >= 128) { const f32x4 cs = *(const f32x4*)(CS + (size_t)row * 64 + (w - 128));
                            const f32x4 t = v[n]; v[n][0] = t[0] * cs[0] - t[1] * cs[1]; v[n][1] = t[0] * cs[1] + t[1] * cs[0]; v[n][2] = t[2] * cs[2] - t[3] * cs[3]; v[n][3] = t[2] * cs[3] + t[3] * cs[2]; } }
                    u32x4 w4; w4.x = cvt_pk_bf16(v[0][0], v[0][1]); w4.y = cvt_pk_bf16(v[0][2], v[0][3]); w4.z = cvt_pk_bf16(v[1][0], v[1][1]); w4.w = cvt_pk_bf16(v[1][2], v[1][3]);
                    *(u32x4*)(rowp + bj * 8) = w4; }
                asm volatile("" ::: "memory"); }
    }
};
struct EpiDkv {
    static constexpr int PERM = 2; static constexpr bool CARRY = false;
    unsigned char* D8; const float* RSS; float wsc;
    __device__ __forceinline__ void operator()(f32x4 (&acc)[2][2][4][2], const pg8::Unit& u, int wr, int wc, int fr, int fq) const {
        asm volatile("" : "+v"(fr), "+v"(fq));
        const int row0 = u.pm * 256 + wr * 64 + fr, col0 = u.pn * 256 + wc * 64 + 16 * fq;
        f32x4 r3v[2][4];
#pragma unroll
        for (int ai = 0; ai < 2; ++ai)
#pragma unroll
            for (int m = 0; m < 4; ++m) r3v[ai][m] = *(const f32x4*)(RSS + (size_t)(row0 + ai * 128 + m * 16) * 16 + 12);
#pragma unroll
        for (int ai = 0; ai < 2; ++ai)
#pragma unroll
            for (int m = 0; m < 4; ++m) { const int row = row0 + ai * 128 + m * 16;
                const f32x4 r3 = r3v[ai][m];
                const float rs = __builtin_amdgcn_rsqf(((r3[0] + r3[1]) + (r3[2] + r3[3])) * (1.0f / 256.0f) + RMS_EPS) * wsc;
                u32x4 w4;
#pragma unroll
                for (int bj = 0; bj < 2; ++bj) { const f32x4 v0 = acc[ai][bj][m][0] * rs, v1 = acc[ai][bj][m][1] * rs; int w0 = 0, w1 = 0;
                    w0 = __builtin_amdgcn_cvt_pk_fp8_f32(v0[0], v0[1], w0, false); w0 = __builtin_amdgcn_cvt_pk_fp8_f32(v0[2], v0[3], w0, true);
                    w1 = __builtin_amdgcn_cvt_pk_fp8_f32(v1[0], v1[1], w1, false); w1 = __builtin_amdgcn_cvt_pk_fp8_f32(v1[2], v1[3], w1, true);
                    if (bj == 0) { w4.x = (unsigned)w0; w4.y = (unsigned)w1; } else { w4.z = (unsigned)w0; w4.w = (unsigned)w1; } }
                *(u32x4*)(D8 + (size_t)row * D8W + col0) = w4;
                asm volatile("" ::: "memory"); }
    }
};
struct EpiMerge {
    static constexpr int PERM = 2; static constexpr bool CARRY = true;
    const unsigned char* G; unsigned char* MRG;
    __device__ __forceinline__ void operator()(f32x4 (&acc)[2][2][4][2], const pg8::Unit& u, int wr, int wc, int fr, int fq) const {
        asm volatile("" : "+v"(fr), "+v"(fq));
        const int row0 = u.pm * 256 + wr * 64 + fr, col0 = u.pn * 256 + wc * 64 + 16 * fq, z = u.z;
        const float fin = 0.001953125f * 16.0f;
        u32x4 ga[2][4], gb[2][4];
#define MG_LOAD(ai_, m_) do { const size_t row_ = (size_t)(row0 + (ai_) * 128 + (m_) * 16); ga[ai_][m_] = *(const u32x4*)(G + row_ * NGATE + z * DM + col0); \
            gb[ai_][m_] = *(const u32x4*)(G + row_ * NGATE + (z < 3 ? z + 1 : z) * DM + col0); } while (0)
#pragma unroll
        for (int m = 0; m < 4; ++m) MG_LOAD(0, m);
#pragma unroll
        for (int ai = 0; ai < 2; ++ai) {
#pragma unroll
            for (int m = 0; m < 4; ++m) { const size_t row = (size_t)(row0 + ai * 128 + m * 16); u32x4 wo;
                if (ai == 0) MG_LOAD(1, m);
#pragma unroll
                for (int bj = 0; bj < 2; ++bj) { const unsigned ax = bj ? ga[ai][m].z : ga[ai][m].x, ay = bj ? ga[ai][m].w : ga[ai][m].y, bx = bj ? gb[ai][m].z : gb[ai][m].x, by = bj ? gb[ai][m].w : gb[ai][m].y;
                    float fa[8], fb[8];
                    { const f32x2 t0 = __builtin_amdgcn_cvt_pk_f32_fp8((int)ax, false), t1 = __builtin_amdgcn_cvt_pk_f32_fp8((int)ax, true), t2 = __builtin_amdgcn_cvt_pk_f32_fp8((int)ay, false), t3 = __builtin_amdgcn_cvt_pk_f32_fp8((int)ay, true);
                      fa[0] = t0[0]; fa[1] = t0[1]; fa[2] = t1[0]; fa[3] = t1[1]; fa[4] = t2[0]; fa[5] = t2[1]; fa[6] = t3[0]; fa[7] = t3[1]; }
                    { const f32x2 t0 = __builtin_amdgcn_cvt_pk_f32_fp8((int)bx, false), t1 = __builtin_amdgcn_cvt_pk_f32_fp8((int)bx, true), t2 = __builtin_amdgcn_cvt_pk_f32_fp8((int)by, false), t3 = __builtin_amdgcn_cvt_pk_f32_fp8((int)by, true);
                      fb[0] = t0[0]; fb[1] = t0[1]; fb[2] = t1[0]; fb[3] = t1[1]; fb[4] = t2[0]; fb[5] = t2[1]; fb[6] = t3[0]; fb[7] = t3[1]; }
                    float f[8];
#pragma unroll
                    for (int e = 0; e < 8; ++e) { const float ra = __builtin_amdgcn_rcpf(1.0f + __builtin_amdgcn_exp2f(fa[e]));
                        f[e] = (z < 3) ? ra * (1.0f + __builtin_amdgcn_exp2f(fb[e])) : ra * fin; }
                    f32x4 v0 = acc[ai][bj][m][0], v1 = acc[ai][bj][m][1];
                    v0[0] *= f[0]; v0[1] *= f[1]; v0[2] *= f[2]; v0[3] *= f[3]; v1[0] *= f[4]; v1[1] *= f[5]; v1[2] *= f[6]; v1[3] *= f[7];
                    if (z < 3) { acc[ai][bj][m][0] = v0; acc[ai][bj][m][1] = v1; }
                    else { int w0 = 0, w1 = 0;
                        w0 = __builtin_amdgcn_cvt_pk_fp8_f32(v0[0], v0[1], w0, false); w0 = __builtin_amdgcn_cvt_pk_fp8_f32(v0[2], v0[3], w0, true);
                        w1 = __builtin_amdgcn_cvt_pk_fp8_f32(v1[0], v1[1], w1, false); w1 = __builtin_amdgcn_cvt_pk_fp8_f32(v1[2], v1[3], w1, true);
                        if (bj == 0) { wo.x = (unsigned)w0; wo.y = (unsigned)w1; } else { wo.z = (unsigned)w0; wo.w = (unsigned)w1; } } }
                if (z == 3) *(u32x4*)(MRG + row * DM + col0) = wo; }
            asm volatile("" ::: "memory"); }
#undef MG_LOAD
    }
};
struct EpiOut {
    static constexpr int PERM = 2; static constexpr bool CARRY = false;
    const bf16_t* XBr; bf16_t* R;
    __device__ __forceinline__ void operator()(f32x4 (&acc)[2][2][4][2], const pg8::Unit& u, int wr, int wc, int fr, int fq) const {
        asm volatile("" : "+v"(fr), "+v"(fq));
        const int row0 = u.pm * 256 + wr * 64 + fr, col0 = u.pn * 256 + wc * 64 + 16 * fq;
        u32x4 xw[2][4][2];
#pragma unroll
        for (int ai = 0; ai < 2; ++ai)
#pragma unroll
            for (int m = 0; m < 4; ++m) { const size_t off = (size_t)(row0 + ai * 128 + m * 16) * DM + col0;
#pragma unroll
                for (int bj = 0; bj < 2; ++bj) xw[ai][m][bj] = *(const u32x4*)(XBr + off + bj * 8); }
#pragma unroll
        for (int ai = 0; ai < 2; ++ai) {
#pragma unroll
            for (int m = 0; m < 4; ++m) { const size_t off = (size_t)(row0 + ai * 128 + m * 16) * DM + col0;
#pragma unroll
                for (int bj = 0; bj < 2; ++bj) { const u32x4 w = xw[ai][m][bj];
                    const f32x4 x0 = (f32x4){__uint_as_float(w.x << 16), __uint_as_float(w.x & 0xffff0000u), __uint_as_float(w.y << 16), __uint_as_float(w.y & 0xffff0000u)};
                    const f32x4 x1 = (f32x4){__uint_as_float(w.z << 16), __uint_as_float(w.z & 0xffff0000u), __uint_as_float(w.w << 16), __uint_as_float(w.w & 0xffff0000u)};
                    const f32x4 r0 = x0 * DN_ALPHA + acc[ai][bj][m][0] * 0.00048828125f, r1 = x1 * DN_ALPHA + acc[ai][bj][m][1] * 0.00048828125f;
                    u32x4 w4; w4.x = cvt_pk_bf16(r0[0], r0[1]); w4.y = cvt_pk_bf16(r0[2], r0[3]); w4.z = cvt_pk_bf16(r1[0], r1[1]); w4.w = cvt_pk_bf16(r1[2], r1[3]);
                    *(u32x4*)(R + off + bj * 8) = w4; } }
            asm volatile("" ::: "memory"); }
    }
};

__device__ __forceinline__ void ln_phase(const bf16_t* R, const float* gain, const float* bias, float* OUTF, bf16_t* XB, unsigned char* X8, unsigned char* X4) {
    const int tid_ = ptid(), lane = tid_ & 63, wave = tid_ >> 6;
    const int gw = blockIdx.x * NWAVES + wave, NGW = gridDim.x * NWAVES;
    for (int row = gw; row < MTOK; row += NGW) {
        const u32x4* rp = (const u32x4*)(R + (size_t)row * DM) + lane;
        float v[8][8]; float s = 0.f;
#pragma unroll
        for (int j = 0; j < 8; ++j) { const u32x4 w = rp[64 * j];
            v[j][0] = __uint_as_float(w.x << 16); v[j][1] = __uint_as_float(w.x & 0xffff0000u); v[j][2] = __uint_as_float(w.y << 16); v[j][3] = __uint_as_float(w.y & 0xffff0000u);
            v[j][4] = __uint_as_float(w.z << 16); v[j][5] = __uint_as_float(w.z & 0xffff0000u); v[j][6] = __uint_as_float(w.w << 16); v[j][7] = __uint_as_float(w.w & 0xffff0000u);
#pragma unroll
            for (int e = 0; e < 8; ++e) s += v[j][e]; }
        const float mean = wave_sum(s) * (1.0f / DM); float q = 0.f;
#pragma unroll
        for (int j = 0; j < 8; ++j)
#pragma unroll
            for (int e = 0; e < 8; ++e) { v[j][e] -= mean; q += v[j][e] * v[j][e]; }
        const float rstd = __builtin_amdgcn_rsqf(wave_sum(q) * (1.0f / DM) + LN_EPS);
#pragma unroll
        for (int j = 0; j < 8; ++j) { const int c8 = (lane + 64 * j) * 8;
            const f32x4 g0 = *(const f32x4*)(gain + c8), g1 = *(const f32x4*)(gain + c8 + 4), b0 = *(const f32x4*)(bias + c8), b1 = *(const f32x4*)(bias + c8 + 4);
            const f32x4 o0 = (f32x4){v[j][0], v[j][1], v[j][2], v[j][3]} * rstd * g0 + b0, o1 = (f32x4){v[j][4], v[j][5], v[j][6], v[j][7]} * rstd * g1 + b1;
            if (OUTF) { *(f32x4*)(OUTF + (size_t)row * DM + c8) = o0; *(f32x4*)(OUTF + (size_t)row * DM + c8 + 4) = o1; }
            if (XB) { u32x4 w; w.x = cvt_pk_bf16(o0[0], o0[1]); w.y = cvt_pk_bf16(o0[2], o0[3]); w.z = cvt_pk_bf16(o1[0], o1[1]); w.w = cvt_pk_bf16(o1[2], o1[3]); *(u32x4*)(XB + (size_t)row * DM + c8) = w;
                int w0 = 0, w1 = 0; w0 = __builtin_amdgcn_cvt_pk_fp8_f32(o0[0], o0[1], w0, false); w0 = __builtin_amdgcn_cvt_pk_fp8_f32(o0[2], o0[3], w0, true);
                w1 = __builtin_amdgcn_cvt_pk_fp8_f32(o1[0], o1[1], w1, false); w1 = __builtin_amdgcn_cvt_pk_fp8_f32(o1[2], o1[3], w1, true);
                *(u32x2*)(X8 + (size_t)row * DM + c8) = (u32x2){(unsigned)w0, (unsigned)w1};
                *(unsigned*)(X4 + (((size_t)row * DM + c8) >> 1)) = pack_fp4x8(o0[0] * FP4_XS, o0[1] * FP4_XS, o0[2] * FP4_XS, o0[3] * FP4_XS, o1[0] * FP4_XS, o1[1] * FP4_XS, o1[2] * FP4_XS, o1[3] * FP4_XS); } }
    }
}
__device__ __forceinline__ void cumsum_phase(const float* SM, const float* f_bias, float* CUM) {
    if ((int)blockIdx.x < (int)gridDim.x - BATCH) return;
    const int tid_ = ptid(), b = (int)blockIdx.x - ((int)gridDim.x - BATCH), h = tid_ >> 6, lane = tid_ & 63;
    const float fb = f_bias[h];
    const float* src = SM + ((size_t)b * SEQ + lane * 64) * 256 + SMC_BF + h;
    float run = 0.f; float vals[64];
#pragma unroll
    for (int j = 0; j < 64; ++j) { const float xv = src[(size_t)j * 256] + fb; const float ls = fminf(xv, 0.f) - log1pf(__expf(-fabsf(xv))); run += ls; vals[j] = run; }
    float incl = run;
#pragma unroll
    for (int o = 1; o < 64; o <<= 1) { const float t = __shfl_up(incl, o); if (lane >= o) incl += t; }
    const float offs = incl - run;
    float* dst = CUM + ((size_t)b * 8 + h) * SEQ + lane * 64;
#pragma unroll
    for (int j = 0; j < 64; j += 4) *(f32x4*)(dst + j) = (f32x4){(vals[j] + offs) * LOG2E, (vals[j + 1] + offs) * LOG2E, (vals[j + 2] + offs) * LOG2E, (vals[j + 3] + offs) * LOG2E};
}
__device__ __forceinline__ void krope_phase(const float* SM, const float* CS, unsigned char* D8) {
    const size_t gt = (size_t)blockIdx.x * NTHREADS + ptid(), GT = (size_t)gridDim.x * NTHREADS;
    for (size_t i = gt; i < (size_t)MTOK * 32; i += GT) {
        const size_t row = i >> 5; const int p = (int)(i & 31);
        const f32x2 t = *(const f32x2*)(SM + row * 256 + SMC_DKR + 2 * p), cs = *(const f32x2*)(CS + row * 64 + 2 * p);
        { int w = 0; w = __builtin_amdgcn_cvt_pk_fp8_f32(t[0] * cs[0] - t[1] * cs[1], t[0] * cs[1] + t[1] * cs[0], w, false); *(unsigned short*)(D8 + row * D8W + 2048 + 2 * p) = (unsigned short)w; }
    }
}

__device__ __forceinline__ int wave_count7(unsigned c) { int t = 0;
#pragma unroll
    for (int b = 0; b < 7; ++b) t += __builtin_popcountll(__ballot((c >> b) & 1u)) << b;
    return t; }
__device__ __forceinline__ unsigned f2ord(float f) { const unsigned u = __float_as_uint(f); return u ^ ((u >> 31) ? 0xffffffffu : 0x80000000u); }
template <int DBG = 0>
__device__ __forceinline__ void indexer_unit(LAS unsigned char* lds, const bf16_t* P, const float* SM, float* SC, unsigned long long* MASK, int b, int qb) {
    constexpr int QSTR = 2064 + 256;
    constexpr int L_IQ = 0, L_STG = 32 * QSTR;
    const int tid = ptid(), wid = __builtin_amdgcn_readfirstlane(tid >> 6), lane = tid & 63, r32 = lane & 31, hi = lane >> 5;
    const int t0 = qb * 32; const size_t row0 = (size_t)b * SEQ + t0;
#pragma unroll
    for (int i = 0; i < 8; ++i) { const int ci = tid + 512 * i, r = ci >> 7, cc = ci & 127;
        const bf16x8 v = *(const bf16x8*)(P + (row0 + r) * INP + PC_AIQ + cc * 8);
        *(LAS bf16x8*)(lds + L_IQ + r * QSTR + cc * 16) = v; }
    float w[16];
    { const float* wp = SM + (row0 + r32) * 256 + SMC_AIW;
#pragma unroll
      for (int j = 0; j < 4; ++j) { const f32x4 v = *(const f32x4*)(wp + 4 * j); w[4 * j] = v[0] * 0.03125f; w[4 * j + 1] = v[1] * 0.03125f; w[4 * j + 2] = v[2] * 0.03125f; w[4 * j + 3] = v[3] * 0.03125f; } }
    __syncthreads();
    { const int r = tid >> 4, d0 = (tid & 15) * 4;
      const float* wp = SM + (row0 + r) * 256 + SMC_AIW; float qb4[4] = {0.f, 0.f, 0.f, 0.f};
#pragma unroll
      for (int h = 0; h < 16; ++h) { const float wh = wp[h] * 0.03125f; const u32x2 q2 = *(const LAS u32x2*)(lds + L_IQ + r * QSTR + (h * 64 + d0) * 2);
          qb4[0] = fmaf(wh, __uint_as_float(q2.x << 16), qb4[0]); qb4[1] = fmaf(wh, __uint_as_float(q2.x & 0xffff0000u), qb4[1]);
          qb4[2] = fmaf(wh, __uint_as_float(q2.y << 16), qb4[2]); qb4[3] = fmaf(wh, __uint_as_float(q2.y & 0xffff0000u), qb4[3]); }
      u32x2 hi2, lo2; hi2.x = cvt_pk_bf16(qb4[0], qb4[1]); hi2.y = cvt_pk_bf16(qb4[2], qb4[3]);
      lo2.x = cvt_pk_bf16(qb4[0] - __uint_as_float(hi2.x << 16), qb4[1] - __uint_as_float(hi2.x & 0xffff0000u)); lo2.y = cvt_pk_bf16(qb4[2] - __uint_as_float(hi2.y << 16), qb4[3] - __uint_as_float(hi2.y & 0xffff0000u));
      *(LAS u32x2*)(lds + L_IQ + r * QSTR + (1024 + d0) * 2) = hi2; *(LAS u32x2*)(lds + L_IQ + r * QSTR + (1088 + d0) * 2) = lo2; }
    __syncthreads();
    LAS float* stg = (LAS float*)(lds + L_STG + wid * 4608);
    const int nkt = qb + 1;
    bf16x8 kfn[4];
    if (wid < nkt) { const bf16_t* kp = P + ((size_t)b * SEQ + wid * 32 + r32) * INP + PC_AIK + 8 * hi;
#pragma unroll
      for (int st = 0; st < 4; ++st) kfn[st] = *(const bf16x8*)(kp + 16 * st); }
    for (int kt = wid; kt < (DBG == 2 ? 0 : nkt); kt += NWAVES) {
        const int s0 = kt * 32;
        int qoff = L_IQ + r32 * QSTR + hi * 16; asm volatile("" : "+v"(qoff));
        bf16x8 kf[4];
#pragma unroll
        for (int st = 0; st < 4; ++st) kf[st] = kfn[st];
        if (kt + NWAVES < nkt) { const bf16_t* kp = P + ((size_t)b * SEQ + s0 + NWAVES * 32 + r32) * INP + PC_AIK + 8 * hi;
#pragma unroll
          for (int st = 0; st < 4; ++st) kfn[st] = *(const bf16x8*)(kp + 16 * st); }
        f32x16 sc;
#pragma unroll
        for (int r = 0; r < 16; ++r) sc[r] = 0.f;
#pragma unroll
        for (int st = 0; st < 8; ++st) { const bf16x8 qf = *(const LAS bf16x8*)(lds + qoff + (1024 + 16 * st) * 2);
            sc = __builtin_amdgcn_mfma_f32_32x32x16_bf16(kf[st & 3], qf, sc, 0, 0, 0); }
        f32x16 accA, accB;
#define IDX_MM(dst, h_) do { _Pragma("unroll") for (int r = 0; r < 16; ++r) dst[r] = 0.f; \
            _Pragma("unroll") for (int st = 0; st < 4; ++st) { const bf16x8 qf = *(const LAS bf16x8*)(lds + qoff + ((h_) * 64 + 16 * st) * 2); dst = __builtin_amdgcn_mfma_f32_32x32x16_bf16(kf[st], qf, dst, 0, 0, 0); } } while (0)
#define IDX_FMA(src, h_) do { asm volatile("s_nop 15" ::: ); \
            _Pragma("unroll") for (int r = 0; r < 16; ++r) asm volatile("v_fma_f32 %0, %1, |%2|, %0" : "+v"(sc[r]) : "v"(w[h_]), "v"(src[r])); } while (0)
        IDX_MM(accA, 0);
#pragma unroll
        for (int h = 0; h < 16; h += 2) {
            IDX_MM(accB, h + 1);
            __builtin_amdgcn_sched_barrier(0);
            IDX_FMA(accA, h);
            __builtin_amdgcn_sched_barrier(0);
            if (h + 2 < 16) IDX_MM(accA, h + 2);
            __builtin_amdgcn_sched_barrier(0);
            if (h + 2 >= 16) asm volatile("s_nop 15" ::: );
            IDX_FMA(accB, h + 1);
            __builtin_amdgcn_sched_barrier(0);
        }
#undef IDX_MM
#undef IDX_FMA
#pragma unroll
        for (int g = 0; g < 4; ++g) *(LAS f32x4*)(stg + r32 * 36 + 8 * g + 4 * hi) = (f32x4){sc[4 * g], sc[4 * g + 1], sc[4 * g + 2], sc[4 * g + 3]};
        LDS_WAIT();
#pragma unroll
        for (int i = 0; i < 16; ++i) { const float v = stg[(2 * i + hi) * 36 + r32]; SC[(row0 + 2 * i + hi) * SEQ + s0 + r32] = v; }
        LDS_WAIT();
    }
    VM_WAIT();
    __syncthreads();
#define IDX_LOADROW(dst, qi_) do { int ln_ = lane; asm volatile("" : "+v"(ln_)); const float* sr_ = SC + (row0 + wid * 4 + (qi_)) * SEQ + ln_; \
        _Pragma("unroll") for (int j = 0; j < 64; ++j) dst[j] = __float_as_uint(sr_[64 * j]); } while (0)
    auto process = [&](unsigned (&key)[64], const int qi) __attribute__((always_inline)) {
        const int t = t0 + wid * 4 + qi, n = t + 1;
        int ln = lane; asm volatile("" : "+v"(ln));
#pragma unroll
        for (int j = 0; j < 64; ++j) asm volatile("" : "+v"(key[j]));
#pragma unroll
        for (int j = 0; j < 64; ++j) key[j] = (ln < n - 64 * j) ? f2ord(__uint_as_float(key[j])) : 0u;
        unsigned T = 0u; int need = 0;
        const int ng = (n + 511) >> 9;
        if (n > 256) {
            bool exact = false;
#pragma unroll 1
            for (int bit = 31; bit >= 0; --bit) {
                const unsigned cand = T | (1u << bit); int cnt = 0;
#pragma unroll
                for (int g = 0; g < 8; ++g) { if (g < ng) {
#pragma unroll
                    for (int jj = 0; jj < 8; ++jj) cnt += __builtin_popcountll(__ballot(key[8 * g + jj] >= cand)); }
                    __builtin_amdgcn_sched_barrier(0); }
                if (cnt == 256) { T = cand - 1u; exact = true; break; }
                if (cnt > 256) T = cand;
            }
            if (!exact) {
                int cgt = 0;
#pragma unroll
                for (int g = 0; g < 8; ++g) { if (g < ng) {
#pragma unroll
                    for (int jj = 0; jj < 8; ++jj) cgt += __builtin_popcountll(__ballot(key[8 * g + jj] > T)); }
                    __builtin_amdgcn_sched_barrier(0); }
                need = 256 - cgt;
            }
        }
        int mwlo = 0, mwhi = 0, run = 0; int ln2 = ln; asm volatile("" : "+v"(ln2));
#pragma unroll
        for (int g = 0; g < 8; ++g) { if (g < ng) {
#pragma unroll
            for (int jj = 0; jj < 8; ++jj) { const int j = 8 * g + jj;
                const bool eq = key[j] == T;
                const unsigned long long eqm = __ballot(eq);
                const int rank = run + (int)__builtin_amdgcn_mbcnt_hi((unsigned)(eqm >> 32), __builtin_amdgcn_mbcnt_lo((unsigned)eqm, 0u));
                const unsigned long long sel = __ballot(key[j] > T || (eq && rank < need));
                run += __builtin_popcountll(eqm);
                mwlo = (ln2 == j) ? (int)(unsigned)sel : mwlo; mwhi = (ln2 == j) ? (int)(unsigned)(sel >> 32) : mwhi;
                __builtin_amdgcn_sched_barrier(0); } }
        }
        MASK[(row0 + wid * 4 + qi) * 64 + lane] = ((unsigned long long)(unsigned)mwhi << 32) | (unsigned)mwlo;
    };
    if (DBG != 1) {
        unsigned ka[64], kb[64];
        IDX_LOADROW(ka, 0);
#pragma unroll 1
        for (int pr = 0; pr < 2; ++pr) {
            IDX_LOADROW(kb, 2 * pr + 1);
            process(ka, 2 * pr);
            if (pr == 0) IDX_LOADROW(ka, 2);
            process(kb, 2 * pr + 1);
        }
    }
#undef IDX_LOADROW
    __syncthreads();
}
template <int DBG = 0>
__device__ __forceinline__ void indexer_phase(LAS unsigned char* lds, const Args& a) {
    const bf16_t* P = (const bf16_t*)(a.ws + WS_P); const float* SM = (const float*)(a.ws + WS_SM); float* SC = (float*)(a.ws + WS_SC); unsigned long long* MASK = (unsigned long long*)(a.ws + WS_MASK);
    for (int p = blockIdx.x; p < 256; p += gridDim.x) { const int b = p >> 6, q = p & 63;
#pragma unroll 1
        for (int k = 0; k < 2; ++k) indexer_unit<DBG>(lds, P, SM, SC, MASK, b, k == 0 ? 127 - q : q); }
}

template <int OFF> __device__ __forceinline__ s16x4 tr_read(int vb) { s16x4 r; asm volatile("ds_read_b64_tr_b16 %0, %1 offset:%2" : "=&v"(r) : "v"(vb), "i"(OFF) : "memory"); return r; }
using pg8::v8i_t; using pg8::cat8;
__device__ __forceinline__ u32x2 bf8_to_fp8(bf16x8 v) { const u32x4 w = __builtin_bit_cast(u32x4, v); int a = 0, b = 0;
    a = __builtin_amdgcn_cvt_pk_fp8_f32(__uint_as_float(w.x << 16), __uint_as_float(w.x & 0xffff0000u), a, false); a = __builtin_amdgcn_cvt_pk_fp8_f32(__uint_as_float(w.y << 16), __uint_as_float(w.y & 0xffff0000u), a, true);
    b = __builtin_amdgcn_cvt_pk_fp8_f32(__uint_as_float(w.z << 16), __uint_as_float(w.z & 0xffff0000u), b, false); b = __builtin_amdgcn_cvt_pk_fp8_f32(__uint_as_float(w.w << 16), __uint_as_float(w.w & 0xffff0000u), b, true);
    return (u32x2){(unsigned)a, (unsigned)b}; }
#ifndef ATT_PV8_MASK
#define ATT_PV8_MASK 0xB
#endif
#ifndef ATT_Q8_MASK
#define ATT_Q8_MASK 0xF
#endif
template <int VAR, int DBG = 0>
__device__ __forceinline__ void attn_unit(LAS unsigned char* lds, const Args& a, int layer, int b, int hidx, int qblk, unsigned* qh, volatile LAS unsigned* bw) {
    constexpr int DQK = (VAR == 2) ? 64 : (VAR == 3 ? 192 : 128), DV = (VAR == 2) ? 64 : 128;
    constexpr bool Q8 = ((ATT_Q8_MASK >> VAR) & 1) != 0;
    constexpr bool PV8 = Q8 && ((ATT_PV8_MASK >> VAR) & 1) != 0 && DV == 128;
    constexpr bool KV8S = PV8 && VAR != 2;
    constexpr int KSTR = Q8 ? DQK + 16 : DQK * 2 + 16, VSTR = PV8 ? DV + 32 : DV * 2 + 64;
    constexpr int KCH = DQK / 8, VCH = DV / 8, KPT = DQK / 64, VPT = DV / 64, NST = DQK / 16, ND0 = DV / 32;
    constexpr int LK = 0, LV = 2 * 64 * KSTR, LCK = LV + 2 * 64 * VSTR;
    constexpr float THR = 8.0f;
    const int tid = ptid(), wid = __builtin_amdgcn_readfirstlane(tid >> 6), lane = tid & 63, r32 = lane & 31, hi = lane >> 5;
    const bf16_t* P = (const bf16_t*)(a.ws + WS_P);
    int head, q0u, tq0w, kt_lo, kt_hi, kt_last_w;
    if constexpr (VAR == 0) { head = hidx * 4 + (wid >> 1); q0u = qblk * 64; tq0w = q0u + 32 * (wid & 1); kt_lo = 0; kt_hi = qblk; kt_last_w = qblk; }
    else if constexpr (VAR == 2) { head = hidx * 8 + wid; q0u = qblk * 32; tq0w = q0u; kt_lo = (q0u > 127 ? q0u - 127 : 0) >> 6; kt_hi = (q0u + 31) >> 6; kt_last_w = kt_hi; }
    else { head = hidx; q0u = qblk * 256; tq0w = q0u + 32 * wid; kt_lo = 0; kt_hi = 4 * qblk + 3; kt_last_w = 4 * qblk + (wid >> 1); }
    const int tq = tq0w + r32; const size_t rowq = (size_t)b * SEQ + tq;
    const bf16_t* qp;
    if constexpr (VAR == 0) qp = P + rowq * INP + PC_AQ + head * 128;
    else if constexpr (VAR == 1) qp = P + rowq * INP + PC_BQ + head * 128;
    else if constexpr (VAR == 2) qp = P + rowq * INP + PC_CQ + head * 64;
    else qp = (const bf16_t*)(a.ws + WS_DQ) + rowq * 1536 + head * 192;
    bf16x8 qf[Q8 ? 1 : NST]; v8i_t q8[Q8 ? NST / 4 : 1];
    if constexpr (Q8) {
#pragma unroll
        for (int s4 = 0; s4 < NST / 4; ++s4) { const bf16_t* q4 = qp + 64 * s4 + 32 * hi;
            const u32x2 c0 = bf8_to_fp8(*(const bf16x8*)(q4)), c1 = bf8_to_fp8(*(const bf16x8*)(q4 + 8)), c2 = bf8_to_fp8(*(const bf16x8*)(q4 + 16)), c3 = bf8_to_fp8(*(const bf16x8*)(q4 + 24));
            q8[s4] = (v8i_t){(int)c0.x, (int)c0.y, (int)c1.x, (int)c1.y, (int)c2.x, (int)c2.y, (int)c3.x, (int)c3.y}; }
    } else {
#pragma unroll
        for (int st = 0; st < NST; ++st) qf[st] = *(const bf16x8*)(qp + 16 * st + 8 * hi); }
    const bf16_t *kb, *vb_, *kb2 = nullptr; int ldk;
    if constexpr (VAR == 0) { kb = P + PC_AK + hidx * 128; vb_ = P + PC_AV + hidx * 128; ldk = INP; }
    else if constexpr (VAR == 1) { kb = P + PC_BK + head * 128; vb_ = P + PC_BV + head * 128; ldk = INP; }
    else if constexpr (VAR == 2) { kb = P + PC_CK + hidx * 64; vb_ = P + PC_CV + hidx * 64; ldk = INP; }
    else { kb = (const bf16_t*)(a.ws + WS_DKV) + head * 256; vb_ = kb + 128; kb2 = (const bf16_t*)(a.ws + WS_DKR); ldk = 2048; }
    const size_t brow = (size_t)b * SEQ;
    unsigned gk[KPT], lk[KPT], gv[VPT], lv[VPT]; bool krope[KPT];
#pragma unroll
    for (int i = 0; i < KPT; ++i) { const int ci = tid + 512 * i, kr = ci / KCH, kc = ci % KCH; krope[i] = (VAR == 3) && kc >= 16;
        gk[i] = krope[i] ? (unsigned)(kr * 64 + (kc - 16) * 8) * 2u : (unsigned)(kr * ldk + kc * 8) * 2u; lk[i] = (unsigned)(LK + kr * KSTR + kc * (Q8 ? 8 : 16)); }
#pragma unroll
    for (int i = 0; i < VPT; ++i) { const int ci = tid + 512 * i, vr = ci / VCH, vc = ci % VCH; gv[i] = (unsigned)(vr * ldk + vc * 8) * 2u; const int vrp = PV8 ? ((vr & ~15) | (vr & 3) | ((vr & 8) >> 1) | ((vr & 4) << 1)) : vr; lv[i] = (unsigned)(LV + vrp * VSTR + vc * (PV8 ? 8 : 16)); }
    const int r8_ = tid >> 3, c8_ = tid & 7, r8p_ = (r8_ & ~15) | (r8_ & 3) | ((r8_ & 8) >> 1) | ((r8_ & 4) << 1);
    constexpr int W8 = (VAR == 3) ? D8W : KV8W, VOFF8 = (VAR == 0) ? 256 : (VAR == 1 ? 1024 : 128);
    const unsigned char* kv8p = a.ws + (VAR == 3 ? WS_D8 : WS_KV8) + (VAR == 0 ? hidx * 128 : (VAR == 1 ? 512 + head * 128 : head * 256)) + (size_t)r8_ * W8 + c8_ * 16;
    const unsigned char* kr8p = a.ws + WS_D8 + 2048 + (size_t)(tid >> 2) * D8W + (tid & 3) * 16; const unsigned lkr8 = (unsigned)(LK + (tid >> 2) * KSTR + 128 + (tid & 3) * 16); u32x4 kr8 = (u32x4){0u, 0u, 0u, 0u};
    const unsigned lk8 = (unsigned)(LK + r8_ * KSTR + c8_ * 16), lv8 = (unsigned)(LV + r8p_ * VSTR + c8_ * 16); u32x4 ks8 = (u32x4){0u, 0u, 0u, 0u}, vs8 = (u32x4){0u, 0u, 0u, 0u};
    bf16x8 ks[1][KPT], vs[1][VPT]; float ckv[1] = {0.f}; unsigned long long mnx[1] = {0ull};
    const float* cum = (const float*)(a.ws + WS_CUM) + ((size_t)b * 8 + head) * SEQ;
    float cref = 0.f; if constexpr (VAR == 1) cref = cum[q0u];
    const unsigned long long* mrow = (const unsigned long long*)(a.ws + WS_MASK) + rowq * 64;
#define AT_ISSUE(kt_, S_) do { const int k0_ = (kt_) * 64; \
        const char* kt_base_ = (const char*)(kb + (brow + k0_) * ldk); const char* vt_base_ = (const char*)(vb_ + (brow + k0_) * ldk); \
        const char* k2_base_ = (VAR == 3) ? (const char*)(kb2 + (brow + k0_) * 64) : kt_base_; \
        if constexpr (KV8S) { ks8 = *(const u32x4*)(kv8p + (brow + k0_) * W8); vs8 = *(const u32x4*)(kv8p + (brow + k0_) * W8 + VOFF8); \
            if (VAR == 3 && tid < 256) kr8 = *(const u32x4*)(kr8p + (brow + k0_) * D8W); } \
        else { _Pragma("unroll") for (int i = 0; i < KPT; ++i) ks[S_][i] = *(const bf16x8*)((krope[i] ? k2_base_ : kt_base_) + gk[i]); \
               _Pragma("unroll") for (int i = 0; i < VPT; ++i) vs[S_][i] = *(const bf16x8*)(vt_base_ + gv[i]); } \
        if (VAR == 1 && tid < 64) ckv[S_] = cum[k0_ + tid]; \
        if (VAR == 0) mnx[S_] = mrow[(kt_)]; } while (0)
#define AT_WRITE(buf_, S_) do { \
        if constexpr (KV8S) { *(LAS u32x4*)(lds + (buf_) * 64 * KSTR + lk8) = ks8; *(LAS u32x4*)(lds + (buf_) * 64 * VSTR + lv8) = vs8; \
            if (VAR == 3 && tid < 256) *(LAS u32x4*)(lds + (buf_) * 64 * KSTR + lkr8) = kr8; } else { \
        _Pragma("unroll") for (int i = 0; i < KPT; ++i) { if constexpr (Q8) *(LAS u32x2*)(lds + (buf_) * 64 * KSTR + lk[i]) = bf8_to_fp8(ks[S_][i]); else *(LAS bf16x8*)(lds + (buf_) * 64 * KSTR + lk[i]) = ks[S_][i]; } \
        _Pragma("unroll") for (int i = 0; i < VPT; ++i) { if constexpr (PV8) *(LAS u32x2*)(lds + (buf_) * 64 * VSTR + lv[i]) = bf8_to_fp8(vs[S_][i]); else *(LAS bf16x8*)(lds + (buf_) * 64 * VSTR + lv[i]) = vs[S_][i]; } } \
        if (VAR == 1 && tid < 64) *(LAS float*)(lds + LCK + (buf_) * 256 + tid * 4) = cref - ckv[S_]; } while (0)
    f32x16 o[ND0];
#pragma unroll
    for (int d = 0; d < ND0; ++d)
#pragma unroll
        for (int r = 0; r < 16; ++r) o[d][r] = 0.f;
    constexpr bool MF = (VAR != 1);
    float m = MF ? -65536.0f : -1e30f, l = 0.f;
    float slope2 = 0.f;
    if constexpr (VAR == 0) slope2 = __builtin_amdgcn_exp2f(-(float)(head + 1)) * LOG2E;
    if constexpr (VAR == 2) slope2 = __builtin_amdgcn_exp2f(-0.5f * (float)(head + 1)) * LOG2E;
    const int g4 = lane >> 4, i16 = lane & 15;
    const int kq_off = r32 * KSTR + hi * (Q8 ? 32 : 16);
    const int vrd0 = (int)(uintptr_t)(lds + LV) + (4 * (g4 >> 1) + (i16 >> 2)) * VSTR + (16 * (g4 & 1) + 4 * (i16 & 3)) * 2;
    const int vrd8 = (int)(uintptr_t)(lds + LV) + (8 * (g4 >> 1) + (i16 >> 1)) * VSTR + 16 * (g4 & 1) + 8 * (i16 & 1);
    AT_ISSUE(kt_lo, 0); unsigned long long mcur = 0ull; if constexpr (VAR == 0) mcur = mnx[0];
    AT_WRITE(0, 0);
    if (DBG != 4 && kt_lo < kt_hi) AT_ISSUE(kt_lo + 1, 0);
    __syncthreads();
    bf16x8 pb[4]; v8i_t p8 = (v8i_t){0, 0, 0, 0, 0, 0, 0, 0};
#define AT_PV(D0, vrd) do { \
                const s16x4 l0 = tr_read<0 * 16 * VSTR + (D0) * 64>(vrd), h0 = tr_read<0 * 16 * VSTR + 8 * VSTR + (D0) * 64>(vrd); \
                const s16x4 l1 = tr_read<1 * 16 * VSTR + (D0) * 64>(vrd), h1 = tr_read<1 * 16 * VSTR + 8 * VSTR + (D0) * 64>(vrd); \
                const s16x4 l2 = tr_read<2 * 16 * VSTR + (D0) * 64>(vrd), h2 = tr_read<2 * 16 * VSTR + 8 * VSTR + (D0) * 64>(vrd); \
                const s16x4 l3 = tr_read<3 * 16 * VSTR + (D0) * 64>(vrd), h3 = tr_read<3 * 16 * VSTR + 8 * VSTR + (D0) * 64>(vrd); \
                asm volatile("s_waitcnt lgkmcnt(0)" ::: "memory"); __builtin_amdgcn_sched_barrier(0); \
                o[D0] = __builtin_amdgcn_mfma_f32_32x32x16_bf16((bf16x8){l0[0], l0[1], l0[2], l0[3], h0[0], h0[1], h0[2], h0[3]}, pb[0], o[D0], 0, 0, 0); \
                o[D0] = __builtin_amdgcn_mfma_f32_32x32x16_bf16((bf16x8){l1[0], l1[1], l1[2], l1[3], h1[0], h1[1], h1[2], h1[3]}, pb[1], o[D0], 0, 0, 0); \
                o[D0] = __builtin_amdgcn_mfma_f32_32x32x16_bf16((bf16x8){l2[0], l2[1], l2[2], l2[3], h2[0], h2[1], h2[2], h2[3]}, pb[2], o[D0], 0, 0, 0); \
                o[D0] = __builtin_amdgcn_mfma_f32_32x32x16_bf16((bf16x8){l3[0], l3[1], l3[2], l3[3], h3[0], h3[1], h3[2], h3[3]}, pb[3], o[D0], 0, 0, 0); } while (0)
#define AT_PV8(D0, vrd) do { \
                u32x2 t0_, t1_, t2_, t3_; \
                asm volatile("ds_read_b64_tr_b8 %0, %1 offset:%2" : "=&v"(t0_) : "v"(vrd), "i"(0 * 16 * VSTR + (D0) * 32) : "memory"); \
                asm volatile("ds_read_b64_tr_b8 %0, %1 offset:%2" : "=&v"(t1_) : "v"(vrd), "i"(1 * 16 * VSTR + (D0) * 32) : "memory"); \
                asm volatile("ds_read_b64_tr_b8 %0, %1 offset:%2" : "=&v"(t2_) : "v"(vrd), "i"(2 * 16 * VSTR + (D0) * 32) : "memory"); \
                asm volatile("ds_read_b64_tr_b8 %0, %1 offset:%2" : "=&v"(t3_) : "v"(vrd), "i"(3 * 16 * VSTR + (D0) * 32) : "memory"); \
                asm volatile("s_waitcnt lgkmcnt(0)" : "+v"(t0_), "+v"(t1_), "+v"(t2_), "+v"(t3_) :: "memory"); __builtin_amdgcn_sched_barrier(0); \
                { const v8i_t va_ = (v8i_t){(int)t0_.x, (int)t0_.y, (int)t1_.x, (int)t1_.y, (int)t2_.x, (int)t2_.y, (int)t3_.x, (int)t3_.y}; \
                  asm volatile("v_mfma_f32_32x32x64_f8f6f4 %0, %1, %2, %0" : "+v"(o[D0]) : "v"(va_), "v"(p8)); } } while (0)
#define AT_PV_ALL(vbuf_) do { if constexpr (PV8) { const int vrd_ = vrd8 + (vbuf_) * 64 * VSTR; asm volatile("s_nop 1" ::: "memory"); AT_PV8(0, vrd_); AT_PV8(1, vrd_); AT_PV8(2, vrd_); AT_PV8(3, vrd_); } \
        else { const int vrd_ = vrd0 + (vbuf_) * 64 * VSTR; AT_PV(0, vrd_); AT_PV(1, vrd_); if constexpr (ND0 == 4) { AT_PV(2, vrd_); AT_PV(3, vrd_); } } } while (0)
    for (int kt2 = kt_lo; kt2 <= kt_hi; kt2 += 2) {
#pragma unroll
    for (int hs = 0; hs < 2; ++hs) {
        const int kt = kt2 + hs; if (kt > kt_hi) break;
        const int buf = hs, k0 = kt * 64;
        if (kt <= kt_last_w && !(DBG == 6 && wid >= 4)) {
            f32x16 p[2];
            const int dq = tq - k0 - 4 * hi;
            if constexpr (VAR == 0 || VAR == 2) { const float base = -slope2 * (float)dq - m;
#pragma unroll
                for (int sub = 0; sub < 2; ++sub)
#pragma unroll
                    for (int r = 0; r < 16; ++r) p[sub][r] = fmaf(slope2, (float)(32 * sub + (r & 3) + 8 * (r >> 2)), base); }
            else if constexpr (VAR == 1) { const LAS float* ck = (const LAS float*)(lds + LCK + buf * 256);
#pragma unroll
                for (int sub = 0; sub < 2; ++sub)
#pragma unroll
                    for (int g = 0; g < 4; ++g) { const f32x4 c4 = *(const LAS f32x4*)(ck + 32 * sub + 8 * g + 4 * hi);
                        p[sub][4 * g] = c4[0]; p[sub][4 * g + 1] = c4[1]; p[sub][4 * g + 2] = c4[2]; p[sub][4 * g + 3] = c4[3]; } }
            else {
#pragma unroll
                for (int sub = 0; sub < 2; ++sub)
#pragma unroll
                    for (int r = 0; r < 16; ++r) p[sub][r] = -m; }
            const LAS unsigned char* kbuf = lds + LK + buf * 64 * KSTR + kq_off;
            if constexpr (Q8) {
                asm volatile("s_nop 1" ::: "memory");
#pragma unroll
                for (int s4 = 0; s4 < NST / 4; ++s4) {
                    const v8i_t ka = cat8(*(const LAS bf16x8*)(kbuf + s4 * 64), *(const LAS bf16x8*)(kbuf + s4 * 64 + 16));
                    const v8i_t kb8 = cat8(*(const LAS bf16x8*)(kbuf + 32 * KSTR + s4 * 64), *(const LAS bf16x8*)(kbuf + 32 * KSTR + s4 * 64 + 16));
                    if (DBG != 3) { asm volatile("v_mfma_f32_32x32x64_f8f6f4 %0, %1, %2, %0" : "+v"(p[0]) : "v"(ka), "v"(q8[s4]));
                                    asm volatile("v_mfma_f32_32x32x64_f8f6f4 %0, %1, %2, %0" : "+v"(p[1]) : "v"(kb8), "v"(q8[s4])); } }
                asm volatile("s_nop 15\n\ts_nop 7" : "+v"(p[0]), "+v"(p[1]) :: "memory");
            } else {
            constexpr int GS = (VAR == 3) ? 1 : 2, NG = NST / GS;
            bf16x8 kfa[2 * GS], kfb[2 * GS];
#define AT_LDK(dst, g_) do { _Pragma("unroll") for (int e = 0; e < GS; ++e) { dst[2 * e] = *(const LAS bf16x8*)(kbuf + (GS * (g_) + e) * 32); dst[2 * e + 1] = *(const LAS bf16x8*)(kbuf + 32 * KSTR + (GS * (g_) + e) * 32); } } while (0)
#define AT_MMK(src, g_) do { _Pragma("unroll") for (int e = 0; e < GS; ++e) { p[0] = __builtin_amdgcn_mfma_f32_32x32x16_bf16(src[2 * e], qf[GS * (g_) + e], p[0], 0, 0, 0); \
                                 p[1] = __builtin_amdgcn_mfma_f32_32x32x16_bf16(src[2 * e + 1], qf[GS * (g_) + e], p[1], 0, 0, 0); } } while (0)
            AT_LDK(kfa, 0);
#pragma unroll
            for (int g = 0; g < NG; g += 2) {
                if (g + 1 < NG) AT_LDK(kfb, g + 1);
                __builtin_amdgcn_sched_barrier(0);
                if (DBG != 3) AT_MMK(kfa, g);
                if (g + 1 < NG) { if (g + 2 < NG) AT_LDK(kfa, g + 2);
                    __builtin_amdgcn_sched_barrier(0);
                    if (DBG != 3) AT_MMK(kfb, g + 1); }
            }
#undef AT_LDK
#undef AT_MMK
            }
            if constexpr (VAR == 0) {
#pragma unroll
                for (int sub = 0; sub < 2; ++sub) { const unsigned wb = (unsigned)(mcur >> (32 * sub)) >> (4 * hi);
#pragma unroll
                    for (int r = 0; r < 16; ++r) p[sub][r] = ((wb >> ((r & 3) + 8 * (r >> 2))) & 1u) ? p[sub][r] : -INFINITY; }
            } else if constexpr (VAR == 2) {
#pragma unroll
                for (int sub = 0; sub < 2; ++sub)
#pragma unroll
                    for (int r = 0; r < 16; ++r) p[sub][r] = ((unsigned)(dq - (32 * sub + (r & 3) + 8 * (r >> 2))) <= 127u) ? p[sub][r] : -INFINITY;
            } else {
                if (k0 + 63 > tq0w) {
#pragma unroll
                    for (int sub = 0; sub < 2; ++sub)
#pragma unroll
                        for (int r = 0; r < 16; ++r) p[sub][r] = ((32 * sub + (r & 3) + 8 * (r >> 2)) <= dq) ? p[sub][r] : -INFINITY; }
            }
            if constexpr (DBG != 2) {
            asm volatile("s_nop 15\n\ts_nop 7" ::: "memory");
            float pm;
            { float ma, mb_;
              asm volatile("v_max3_f32 %0, %1, %2, %3" : "=v"(ma) : "v"(p[0][0]), "v"(p[0][1]), "v"(p[1][0]));
              asm volatile("v_max3_f32 %0, %1, %2, %3" : "=v"(mb_) : "v"(p[0][2]), "v"(p[0][3]), "v"(p[1][1]));
              asm volatile("v_max3_f32 %0, %1, %2, %3" : "+v"(ma) : "v"(ma), "v"(p[1][2]), "v"(p[1][3]));
#pragma unroll
              for (int r = 4; r < 16; r += 4) {
                  asm volatile("v_max3_f32 %0, %1, %2, %3" : "+v"(ma) : "v"(ma), "v"(p[0][r]), "v"(p[0][r + 1]));
                  asm volatile("v_max3_f32 %0, %1, %2, %3" : "+v"(mb_) : "v"(mb_), "v"(p[0][r + 2]), "v"(p[0][r + 3]));
                  asm volatile("v_max3_f32 %0, %1, %2, %3" : "+v"(ma) : "v"(ma), "v"(p[1][r]), "v"(p[1][r + 1]));
                  asm volatile("v_max3_f32 %0, %1, %2, %3" : "+v"(mb_) : "v"(mb_), "v"(p[1][r + 2]), "v"(p[1][r + 3])); }
              asm volatile("v_max_f32 %0, %1, %2" : "=v"(pm) : "v"(ma), "v"(mb_)); }
            { auto rr = __builtin_amdgcn_permlane32_swap(__float_as_uint(pm), __float_as_uint(pm), false, false); pm = fmaxf(__uint_as_float(rr[0]), __uint_as_float(rr[1])); }
            if constexpr (MF) {
                if (!__all(pm <= THR)) {
                    const float dm = fmaxf(pm, 0.f), alpha = __builtin_amdgcn_exp2f(-dm); m += dm; l *= alpha;
#pragma unroll
                    for (int d = 0; d < ND0; ++d)
#pragma unroll
                        for (int r = 0; r < 16; ++r) o[d][r] *= alpha;
#pragma unroll
                    for (int sub = 0; sub < 2; ++sub)
#pragma unroll
                        for (int r = 0; r < 16; ++r) p[sub][r] -= dm;
                }
            } else if (!__all(pm - m <= THR)) {
                const float mn = fmaxf(m, pm), alpha = __builtin_amdgcn_exp2f(m - mn); m = mn; l *= alpha;
#pragma unroll
                for (int d = 0; d < ND0; ++d)
#pragma unroll
                    for (int r = 0; r < 16; ++r) o[d][r] *= alpha;
            }
#pragma unroll
            for (int sub = 0; sub < 2; ++sub)
#pragma unroll
                for (int r = 0; r < 16; ++r) p[sub][r] = __builtin_amdgcn_exp2f(MF ? p[sub][r] : p[sub][r] - m);
            __builtin_amdgcn_sched_barrier(0);
            { float s0 = p[0][0], s1 = p[0][1], s2 = p[1][0], s3 = p[1][1];
#pragma unroll
              for (int r = 2; r < 16; r += 2) { s0 += p[0][r]; s1 += p[0][r + 1]; s2 += p[1][r]; s3 += p[1][r + 1]; }
              l += (s0 + s1) + (s2 + s3); }
            }
            if constexpr (PV8) {
#pragma unroll
                for (int w = 0; w < 8; ++w) { const int sub = w >> 2, r4 = 4 * (w & 3); int t = 0;
                    t = __builtin_amdgcn_cvt_pk_fp8_f32(p[sub][r4], p[sub][r4 + 1], t, false); t = __builtin_amdgcn_cvt_pk_fp8_f32(p[sub][r4 + 2], p[sub][r4 + 3], t, true); p8[w] = t; }
            } else {
#pragma unroll
            for (int s = 0; s < 4; ++s) { const int sub = s >> 1, k8 = 8 * (s & 1);
                u32x4 wv; wv.x = cvt_pk_bf16(p[sub][k8], p[sub][k8 + 1]); wv.y = cvt_pk_bf16(p[sub][k8 + 2], p[sub][k8 + 3]); wv.z = cvt_pk_bf16(p[sub][k8 + 4], p[sub][k8 + 5]); wv.w = cvt_pk_bf16(p[sub][k8 + 6], p[sub][k8 + 7]);
                pb[s] = __builtin_bit_cast(bf16x8, wv); }
            }
        }
        if (DBG != 4 && kt < kt_hi) AT_WRITE(buf ^ 1, 0);
        if constexpr (VAR == 0) mcur = mnx[0];
        if (DBG != 4 && kt + 1 < kt_hi) AT_ISSUE(kt + 2, 0);
        if (kt <= kt_last_w && !(DBG == 6 && wid >= 4)) {
            if (DBG != 1) AT_PV_ALL(buf);
            if (DBG == 1) { _Pragma("unroll") for (int i = 0; i < 4; ++i) o[0][i] += __uint_as_float((unsigned)pb[i][0]); }
        }
        if (DBG != 5) __syncthreads();
    }
    }
#undef AT_PV_ALL
#undef AT_PV8
#undef AT_PV
#undef AT_ISSUE
#undef AT_WRITE
    if constexpr (PV8) asm volatile("s_nop 15\n\ts_nop 15" : "+v"(o[0]), "+v"(o[1]), "+v"(o[ND0 - 2]), "+v"(o[ND0 - 1]) :: "memory");
    unsigned nx = 0u; if (threadIdx.x == 0) nx = __hip_atomic_fetch_add(qh, 1u, RLX_AGENT);
    { auto rr = __builtin_amdgcn_permlane32_swap(__float_as_uint(l), __float_as_uint(l), false, false); l = __uint_as_float(rr[0]) + __uint_as_float(rr[1]); }
    if constexpr (VAR == 2) l += __builtin_amdgcn_exp2f(a.sinks[layer * 16 + head] * LOG2E - m);
    const float inv = 1.0f / l;
    int zc, bc;
    if constexpr (VAR == 0) { zc = PC_AZ + head * 128; bc = 0 + head * 128; }
    else if constexpr (VAR == 1) { zc = PC_BZ + head * 128; bc = 1024 + head * 128; }
    else if constexpr (VAR == 2) { zc = PC_CZ + head * 64; bc = 2048 + head * 64; }
    else { zc = PC_DZ + head * 128; bc = 3072 + head * 128; }
    const bf16_t* zp = P + rowq * INP + zc + 4 * hi; unsigned char* op = a.ws + (DBG ? WS_SC : WS_BR) + rowq * 4096 + bc + 4 * hi;
#pragma unroll
    for (int d = 0; d < ND0; ++d)
#pragma unroll
        for (int g = 0; g < 4; ++g) { const u32x2 zw = *(const u32x2*)(zp + 32 * d + 8 * g);
            const float z0 = __uint_as_float(zw.x << 16), z1 = __uint_as_float(zw.x & 0xffff0000u), z2 = __uint_as_float(zw.y << 16), z3 = __uint_as_float(zw.y & 0xffff0000u);
            const float v0 = o[d][4 * g] * inv * (z0 * fast_sigmoid(z0)), v1 = o[d][4 * g + 1] * inv * (z1 * fast_sigmoid(z1));
            const float v2 = o[d][4 * g + 2] * inv * (z2 * fast_sigmoid(z2)), v3 = o[d][4 * g + 3] * inv * (z3 * fast_sigmoid(z3));
            int w8 = 0; w8 = __builtin_amdgcn_cvt_pk_fp8_f32(v0 * 8.0f, v1 * 8.0f, w8, false); w8 = __builtin_amdgcn_cvt_pk_fp8_f32(v2 * 8.0f, v3 * 8.0f, w8, true); *(int*)(op + 32 * d + 8 * g) = w8; }
    if (threadIdx.x == 0) bw[0] = nx;
}
template <int VAR, int DBG = 0>
__device__ __forceinline__ void attn_queue(LAS unsigned char* lds, const Args& a, int layer) {
    constexpr int NUX = (VAR == 2) ? 128 : 64;
    unsigned* qbase = (unsigned*)(a.ws + WS_CTL) + CW_Q + 64 * 8 * (layer * 4 + VAR);
    layer &= 1;
    volatile LAS unsigned* bw = (volatile LAS unsigned*)(lds + MISC_OFF + 64);
    const int myx = (int)(xb_xcc_id() & 7u);
    unsigned live = 0xffu;
    for (int qi = 0; qi < 8; ++qi) {
        const int x = (myx + qi) & 7;
        if (qi == 1) {
            if (threadIdx.x < 64) {
                const unsigned h = (threadIdx.x < 8) ? __hip_atomic_load(qbase + 64 * threadIdx.x, __ATOMIC_RELAXED, __HIP_MEMORY_SCOPE_AGENT) : (unsigned)NUX;
                const unsigned long long m = __ballot(h < (unsigned)NUX);
                if (threadIdx.x == 0) bw[1] = (unsigned)m; }
            __syncthreads();
            live = bw[1];
            __syncthreads();
        }
        if (qi >= 1 && !((live >> x) & 1u)) continue;
        unsigned* qh = qbase + 64 * x;
        if (threadIdx.x == 0) bw[0] = __hip_atomic_fetch_add(qh, 1u, RLX_AGENT);
        for (;;) {
            __syncthreads();
            const int idx = (int)bw[0];
            __syncthreads();
            if (idx >= NUX) break;
            int b, hidx, qblk;
            if constexpr (VAR == 0) { qblk = 63 - idx; b = x >> 1; hidx = x & 1; }
            else if constexpr (VAR == 2) { qblk = idx; b = x >> 1; hidx = x & 1; }
            else { const int pr = 4 * x + 2 * (idx >> 5) + (idx & 1); qblk = 15 - ((idx & 31) >> 1); b = pr >> 3; hidx = pr & 7; }
            attn_unit<VAR, DBG>(lds, a, layer, b, hidx, qblk, qh, bw);
        }
    }
}

constexpr int N_PHASES = 1 + 6 * DEPTH;
#ifndef DUP_PHASE
#define DUP_PHASE -1
#endif
__global__ void __launch_bounds__(NTHREADS, 2) mega_fwd(Args a) {
    extern __shared__ __attribute__((aligned(16))) unsigned char lds_raw[];
    LAS unsigned char* lds = (LAS unsigned char*)lds_raw;
    const int tid = threadIdx.x;
    for (int u = tid; u < (LDS_BYTES - LDSCTL_OFF) / 4; u += NTHREADS) ((LAS unsigned*)(lds + LDSCTL_OFF))[u] = 0u;
    __syncthreads();
    unsigned* ctl = (unsigned*)(a.ws + WS_CTL);
    const int lo = a.ph_lo, hi = a.ph_hi;
    const bool multi = (hi - lo) > 1;
    XcdBarrier bar; bar.bar = ctl + CW_BAR; bar.x = 0; bar.st = nullptr;
    if (multi) bar = xcd_barrier_post(ctl + CW_BAR, (volatile LAS unsigned*)(lds + MISC_OFF + 32));
#define IN(k) (lo <= (k) && (k) < hi)
#define SEAM(k) do { if (IN(k) && IN((k) + 1)) xcd_barrier(bar); } while (0)
    unsigned char* ws = a.ws;
    bf16_t* XB = (bf16_t*)(ws + WS_XB); bf16_t* P = (bf16_t*)(ws + WS_P); unsigned char* Gt = ws + WS_G;
    float* SM = (float*)(ws + WS_SM); float* RSS = (float*)(ws + WS_RSS); float* CS = (float*)(ws + WS_CS);
    unsigned char* W = ws + WS_W;

    if (IN(0)) { convert_weights(a, 0, lds); prologue_misc(a); }
    SEAM(0);
    for (int layer = 0; layer < DEPTH; ++layer) {
        const int pb = 1 + 6 * layer;
        if (IN(pb + 0)) {
            { pg8::Gemm g{(const bf16_t*)(ws + WS_X4), (const bf16_t*)(W + WO_WG8), DM / 4, DM / 4, DM / 4, 0, 0}; pg8::StaticOrder S; S.init(MTOK, NGATE, gridDim.x, blockIdx.x, 8);
              EpiGate E{Gt, -LOG2E / (FP4_XS * FP4_WS * 0.9761f)};
              pg8::gemm_phase<EpiGate, pg8::StaticOrder, true, false, true>(lds, g, S, E);
#if DUP_PHASE == 1001
              pg8::gemm_phase<EpiGate, pg8::StaticOrder, true, true>(lds, g, S, E);
#endif
#if DUP_PHASE == 1002
              { EpiNull E0{(float*)(ws + WS_SC)}; pg8::gemm_phase<EpiNull, pg8::StaticOrder, true, true>(lds, g, S, E0); }
#endif
              }
            { pg8::Gemm g{(const bf16_t*)(ws + WS_X8), (const bf16_t*)(W + WO_WIN8), DM / 2, DM / 2, DM / 2, 0, 0}; pg8::StaticOrder S; S.init(MTOK, NIN8, gridDim.x, blockIdx.x);
              EpiIn E{P, SM, RSS, 1, ws + WS_KV8, ws + WS_L8};
              pg8::gemm_phase<EpiIn, pg8::StaticOrder, true, true>(lds, g, S, E); }
            { pg8::Gemm g{(const bf16_t*)(ws + WS_X4), (const bf16_t*)(W + WO_WZ4), DM / 4, DM / 4, DM / 4, 0, 0}; pg8::StaticOrder S; S.init(MTOK, NINZ, gridDim.x, blockIdx.x, 8);
              EpiIn E{P, SM, RSS, 2, ws + WS_KV8, ws + WS_L8};
              pg8::gemm_phase<EpiIn, pg8::StaticOrder, true, false, true>(lds, g, S, E); }
            { pg8::Gemm g{XB, (const bf16_t*)(W + WO_WINB), DM, DM, DM, 0, 0}; pg8::StaticOrder S; S.init(MTOK, NINB, gridDim.x, (blockIdx.x + 64) % gridDim.x, 2);
              EpiIn E{P, SM, RSS, 0, ws + WS_KV8, ws + WS_L8};
              pg8::gemm_phase<EpiIn, pg8::StaticOrder>(lds, g, S, E); }
        }
        SEAM(pb + 0);
        if (IN(pb + 1)) {
            cumsum_phase(SM, a.f_bias + layer * 8, (float*)(ws + WS_CUM));
            krope_phase(SM, CS, ws + WS_D8);
            { pg8::Gemm g{(const bf16_t*)(ws + WS_L8), (const bf16_t*)(W + WO_DQUP), 384, 512, 384, 0, 0}; pg8::StaticOrder S; S.init(MTOK, 1536, gridDim.x, blockIdx.x);
              EpiDq E{(bf16_t*)(ws + WS_DQ), RSS, CS, 1.0f / DQ_WS};
              pg8::gemm_phase<EpiDq, pg8::StaticOrder, true, true>(lds, g, S, E); }
            { pg8::Gemm g{(const bf16_t*)(ws + WS_L8 + 768), (const bf16_t*)(W + WO_DKVUP), 128, 512, 128, 0, 0}; pg8::StaticOrder S; S.init(MTOK, 2048, gridDim.x, blockIdx.x);
              EpiDkv E{ws + WS_D8, RSS, 1.0f / DKV_WS};
              pg8::gemm_phase<EpiDkv, pg8::StaticOrder, true, true>(lds, g, S, E); }
            indexer_phase(lds, a);
#if DUP_PHASE == 1 || DUP_PHASE == 11
            { pg8::Gemm g{P + PC_DCQ, (const bf16_t*)(W + WO_DQUP), 768, INP, 768, 0, 0}; pg8::StaticOrder S; S.init(MTOK, 1536, gridDim.x, blockIdx.x);
              EpiDq E{(bf16_t*)(ws + WS_DQ), RSS, CS};
              pg8::gemm_phase<EpiDq, pg8::StaticOrder>(lds, g, S, E); }
            { pg8::Gemm g{P + PC_DCKV, (const bf16_t*)(W + WO_DKVUP), 256, INP, 256, 0, 0}; pg8::StaticOrder S; S.init(MTOK, 2048, gridDim.x, blockIdx.x);
              EpiDkv E{ws + WS_D8, RSS};
              pg8::gemm_phase<EpiDkv, pg8::StaticOrder>(lds, g, S, E); }
#endif
#if DUP_PHASE == 1 || DUP_PHASE == 12
            indexer_phase(lds, a);
#endif
        }
        SEAM(pb + 1);
        if (IN(pb + 2)) {
            attn_queue<3>(lds, a, layer);
            attn_queue<1>(lds, a, layer);
            attn_queue<0>(lds, a, layer);
            attn_queue<2>(lds, a, layer);
#if DUP_PHASE == 2 || DUP_PHASE == 23
            attn_queue<3>(lds, a, layer + 2);
#endif
#if DUP_PHASE == 2 || DUP_PHASE == 21
            attn_queue<1>(lds, a, layer + 2);
#endif
#if DUP_PHASE >= 210 && DUP_PHASE <= 219
            attn_queue<1, DUP_PHASE - 210>(lds, a, layer + 2);
#endif
#if DUP_PHASE == 2 || DUP_PHASE == 20
            attn_queue<0>(lds, a, layer + 2);
#endif
#if DUP_PHASE == 2 || DUP_PHASE == 22
            attn_queue<2>(lds, a, layer + 2);
#endif
        }
        SEAM(pb + 2);
        if (IN(pb + 3)) {
            pg8::Gemm g{(const bf16_t*)(ws + WS_BR), (const bf16_t*)(W + WO_WBR), 512, 2048, 512, (size_t)1024, (size_t)DM * 1024};
            pg8::ZOrder<4> S; S.init(MTOK, DM, gridDim.x, blockIdx.x);
            EpiMerge E{Gt, ws + WS_MRG};
            pg8::gemm_phase<EpiMerge, pg8::ZOrder<4>, true, true>(lds, g, S, E);
#if DUP_PHASE == 3
            pg8::gemm_phase<EpiMerge, pg8::ZOrder<4>, true, true>(lds, g, S, E);
#endif
        }
        SEAM(pb + 3);
        if (IN(pb + 4)) {
            pg8::Gemm g{(const bf16_t*)(ws + WS_MRG), (const bf16_t*)(W + WO_WOUT), DM / 2, DM / 2, DM / 2, 0, 0}; pg8::StaticOrder S; S.init(MTOK, DM, gridDim.x, blockIdx.x);
            EpiOut E{XB, (bf16_t*)(ws + WS_R)};
            pg8::gemm_phase<EpiOut, pg8::StaticOrder, true, true>(lds, g, S, E);
#if DUP_PHASE == 4
            pg8::gemm_phase<EpiOut, pg8::StaticOrder, true, true>(lds, g, S, E);
#endif
        }
        SEAM(pb + 4);
        if (IN(pb + 5)) {
            ln_phase((const bf16_t*)(ws + WS_R), a.ln_gain + layer * DM, a.ln_bias + layer * DM, layer + 1 < DEPTH ? nullptr : a.out, layer + 1 < DEPTH ? XB : nullptr, ws + WS_X8, ws + WS_X4);
            if (layer + 1 < DEPTH) convert_weights(a, layer + 1, lds);
#if DUP_PHASE == 5
            ln_phase((const bf16_t*)(ws + WS_R), a.ln_gain + layer * DM, a.ln_bias + layer * DM, layer + 1 < DEPTH ? nullptr : a.out, layer + 1 < DEPTH ? XB : nullptr, ws + WS_X8, ws + WS_X4);
            if (layer + 1 < DEPTH) convert_weights(a, layer + 1, lds);
#endif
        }
        if (layer + 1 < DEPTH) SEAM(pb + 5);
    }
#undef IN
#undef SEAM
}

#ifdef PROBE_KERNEL
__global__ void __launch_bounds__(NTHREADS, 2) probe_fwd(Args a) {
    extern __shared__ __attribute__((aligned(16))) unsigned char lds_raw[];
    LAS unsigned char* lds = (LAS unsigned char*)lds_raw;
    unsigned char* ws = a.ws; unsigned char* W = ws + WS_W;
#if PROBE_KERNEL == 1 || PROBE_KERNEL == 2 || PROBE_KERNEL == 4
    pg8::Gemm g{(const bf16_t*)(ws + WS_X8), (const bf16_t*)(W + WO_WG8), DM / 2, DM / 2, DM / 2, 0, 0}; pg8::StaticOrder S; S.init(MTOK, NGATE, gridDim.x, blockIdx.x);
#if PROBE_KERNEL == 1
    EpiGate E{ws + WS_G}; pg8::gemm_phase<EpiGate, pg8::StaticOrder, true, true>(lds, g, S, E);
#elif PROBE_KERNEL == 4
    EpiGate E{ws + WS_G}; pg8::gemm_phase<EpiGate, pg8::StaticOrder, false, true>(lds, g, S, E);
#else
    EpiNull E{(float*)(ws + WS_SC)}; pg8::gemm_phase<EpiNull, pg8::StaticOrder, true, true>(lds, g, S, E);
#endif
#endif
#if PROBE_KERNEL >= 10 && PROBE_KERNEL < 20
    attn_queue<1, PROBE_KERNEL - 10>(lds, a, 3);
#endif
#if PROBE_KERNEL == 20 || PROBE_KERNEL == 21
    { pg8::Gemm g{(const bf16_t*)(ws + WS_BR), (const bf16_t*)(W + WO_WBR), 512, 2048, 512, (size_t)1024, (size_t)DM * 1024}; pg8::ZOrder<4> S; S.init(MTOK, DM, gridDim.x, blockIdx.x);
#if PROBE_KERNEL == 20
      EpiMerge E{ws + WS_G, ws + WS_MRG}; pg8::gemm_phase<EpiMerge, pg8::ZOrder<4>, true, true>(lds, g, S, E);
#else
      EpiNull E{(float*)(ws + WS_SC)}; pg8::gemm_phase<EpiNull, pg8::ZOrder<4>, true, true>(lds, g, S, E);
#endif
    }
#endif
#if PROBE_KERNEL == 22
    { pg8::Gemm g{(const bf16_t*)(ws + WS_MRG), (const bf16_t*)(W + WO_WOUT), DM / 2, DM / 2, DM / 2, 0, 0}; pg8::StaticOrder S; S.init(MTOK, DM, gridDim.x, blockIdx.x);
      EpiOut E{(const bf16_t*)(ws + WS_XB), (bf16_t*)(ws + WS_SC)}; pg8::gemm_phase<EpiOut, pg8::StaticOrder, true, true>(lds, g, S, E); }
#endif
#if PROBE_KERNEL == 30
    convert_weights(a, 1, lds);
#endif
#if PROBE_KERNEL == 31
    ln_phase((const bf16_t*)(ws + WS_R), a.ln_gain + DM, a.ln_bias + DM, a.out, nullptr, ws + WS_X8);
#endif
#if PROBE_KERNEL == 32
    indexer_phase(lds, a);
#endif
#if PROBE_KERNEL == 33
    indexer_phase<1>(lds, a);
#endif
#if PROBE_KERNEL == 34
    indexer_phase<2>(lds, a);
#endif
#if PROBE_KERNEL == 3
    pg8::Gemm g{(const bf16_t*)(ws + WS_XB), (const bf16_t*)(W + WO_WG8), DM / 2, DM / 2, DM / 2, 0, 0}; pg8::StaticOrder S; S.init(MTOK, NGATE, gridDim.x, blockIdx.x);
    EpiNull E{(float*)(ws + WS_SC)}; pg8::gemm_phase<EpiNull, pg8::StaticOrder, true, false>(lds, g, S, E);
#endif
}
#endif

#ifndef MK_N_LAUNCHES
#define MK_N_LAUNCHES 1
#endif
extern "C" void kernel_launch(void* const* d_in, const int* in_sizes, int n_in, void* d_out, int out_size, void* d_ws, size_t ws_size, hipStream_t stream) {
    static int grid = 0;
    if (grid == 0) {
        if (n_in != 14 || in_sizes[0] != MTOK * DM || out_size != MTOK * DM || ws_size < WS_END) {
            fprintf(stderr, "kernel_launch: unexpected shapes / workspace: n_in %d in0 %d out %d ws %zu (need >= %zu)\n", n_in, n_in > 0 ? in_sizes[0] : -1, out_size, ws_size, (size_t)WS_END); grid = -1; return; }
        int dev = 0, cus = 0, per_cu = 0;
        if (hipGetDevice(&dev) != hipSuccess || hipDeviceGetAttribute(&cus, hipDeviceAttributeMultiprocessorCount, dev) != hipSuccess) { grid = -1; return; }
        if (hipFuncSetAttribute((const void*)mega_fwd, hipFuncAttributeMaxDynamicSharedMemorySize, LDS_BYTES) != hipSuccess) { fprintf(stderr, "kernel_launch: hipFuncSetAttribute failed\n"); grid = -1; return; }
        if (hipOccupancyMaxActiveBlocksPerMultiprocessor(&per_cu, (const void*)mega_fwd, NTHREADS, LDS_BYTES) != hipSuccess || per_cu < 1) {
            fprintf(stderr, "kernel_launch: occupancy query reports %d workgroups per CU\n", per_cu); }
        (void)hipGetLastError();
        grid = cus;
    }
    if (grid < 0) return;
    (void)hipMemsetAsync((char*)d_ws + WS_CTL, 0, CTL_ZERO_BYTES, stream);
    Args a{};
    a.x = (const float*)d_in[0]; a.pos = (const int*)d_in[1]; a.w_in = (const float*)d_in[2]; a.w_gate = (const float*)d_in[3]; a.w_branch = (const float*)d_in[4]; a.w_out = (const float*)d_in[5];
    a.dq_gain = (const float*)d_in[6]; a.dq_up = (const float*)d_in[7]; a.dkv_gain = (const float*)d_in[8]; a.dkv_up = (const float*)d_in[9]; a.f_bias = (const float*)d_in[10];
    a.sinks = (const float*)d_in[11]; a.ln_gain = (const float*)d_in[12]; a.ln_bias = (const float*)d_in[13];
    a.out = (float*)d_out; a.ws = (unsigned char*)d_ws;
#if MK_N_LAUNCHES == 1
    a.ph_lo = 0; a.ph_hi = N_PHASES;
    hipLaunchKernelGGL(mega_fwd, dim3(grid), dim3(NTHREADS), LDS_BYTES, stream, a);
#else
    for (int p = 0; p < N_PHASES; ++p) { a.ph_lo = p; a.ph_hi = p + 1; hipLaunchKernelGGL(mega_fwd, dim3(grid), dim3(NTHREADS), LDS_BYTES, stream, a); }
#endif
#ifdef PROBE_KERNEL
    { static int once = 0; if (!once) { (void)hipFuncSetAttribute((const void*)probe_fwd, hipFuncAttributeMaxDynamicSharedMemorySize, LDS_BYTES); once = 1; }
      hipLaunchKernelGGL(probe_fwd, dim3(grid), dim3(NTHREADS), LDS_BYTES, stream, a); }
#endif
    const hipError_t le = hipPeekAtLastError();
    if (le != hipSuccess) fprintf(stderr, "kernel_launch: launch failed: %s\n", hipGetErrorName(le));
}
```

```cpp
#include <hip/hip_runtime.h>
#include <cstdio>
#include <cstdint>

#define LAS __attribute__((address_space(3)))
#define GAS __attribute__((address_space(1)))
typedef unsigned short bf16_t;
typedef short bf16x8 __attribute__((ext_vector_type(8)));
typedef short s16x4 __attribute__((ext_vector_type(4)));
typedef float f32x4 __attribute__((ext_vector_type(4)));
typedef float f32x2 __attribute__((ext_vector_type(2)));
typedef float f32x16 __attribute__((ext_vector_type(16)));
typedef unsigned u32x4 __attribute__((ext_vector_type(4)));
typedef unsigned u32x2 __attribute__((ext_vector_type(2)));

typedef __bf16 bf16x2_t __attribute__((ext_vector_type(2)));
__device__ __forceinline__ unsigned cvt_pk_bf16(float lo, float hi) { const f32x2 v = {lo, hi}; const bf16x2_t b = __builtin_convertvector(v, bf16x2_t); return __builtin_bit_cast(unsigned, b); }
__device__ __forceinline__ int ptid() { int t = threadIdx.x; asm volatile("" : "+v"(t)); return t; }
__device__ __forceinline__ float bf2f(unsigned short b) { return __uint_as_float(((unsigned)b) << 16); }

namespace pg8 {
constexpr int BM = 256, BK = 64, HALF = 128, HTB = HALF * BK * 2  , STAGE_BYTES = 8 * HTB, NXCD = 8, WGM = 4;
__host__ __device__ __forceinline__ int lds_byte(int r, int c) { const int st = (r >> 4) * 2 + (c >> 5), rr = r & 15, cc = c & 31, ob = rr * 64 + cc * 2; return st * 1024 + (ob ^ (((ob >> 9) & 1) << 5)); }
__host__ __device__ __forceinline__ void stage_rc(int b, int& R, int& C) { const int st = b / 1024, sb = b % 1024, swz = sb ^ (((sb >> 9) & 1) << 5); R = (st >> 1) * 16 + swz / 64; C = (st & 1) * 32 + (swz % 64) / 2; }
__host__ __device__ __forceinline__ int perm32(int rho) { const int n = rho >> 4, i = rho & 15; return 8 * (i >> 2) + 4 * n + (i & 3); }

struct Unit { int pm, pn, z; };
struct Gemm { const bf16_t* A; const bf16_t* Bt; int K, lda, ldb; size_t zA, zB; };

__device__ __forceinline__ void tile_of(int L, int nM, int nN, int& pm, int& pn, int WGM = pg8::WGM) {
    const int nwg = nM * nN; int wgid = L; { const int q = nwg / NXCD, r = nwg % NXCD, xcd = wgid % NXCD, off = wgid / NXCD; wgid = (xcd < r ? xcd * (q + 1) : r * (q + 1) + (xcd - r) * q) + off; }
    const int nig = WGM * nN, gid = wgid / nig, fm = gid * WGM, gsz = (nM - fm) < WGM ? (nM - fm) : WGM;
    pm = fm + ((wgid % nig) % gsz); pn = (wgid % nig) / gsz;
}
struct StaticOrder {
    int nM, nN, nwg, G, c, wgm;
    __device__ void init(int M, int N, int G_, int c_, int wgm_ = WGM) { nM = M / BM; nN = N / BM; nwg = nM * nN; G = G_; c = c_; wgm = wgm_; }
    __device__ bool next(int i, Unit& u) const { const long L = (long)i * G + c; if (L >= nwg) return false; tile_of((int)L, nM, nN, u.pm, u.pn, wgm); u.z = 0; return true; }
};
template <int Z> struct ZOrder {
    int nM, nN, nwg, G, c;
    __device__ void init(int M, int N, int G_, int c_) { nM = M / BM; nN = N / BM; nwg = nM * nN; G = G_; c = c_; }
    __device__ bool next(int i, Unit& u) const { const long L = (long)(i / Z) * G + c; if (L >= nwg) return false; tile_of((int)L, nM, nN, u.pm, u.pn); u.z = i % Z; return true; }
};

typedef int v8i_t __attribute__((ext_vector_type(8)));
typedef int v4i_t __attribute__((ext_vector_type(4)));
__device__ __forceinline__ v8i_t cat8(bf16x8 lo, bf16x8 hi) { const v4i_t a = __builtin_bit_cast(v4i_t, lo), b = __builtin_bit_cast(v4i_t, hi); return __builtin_shufflevector(a, b, 0, 1, 2, 3, 4, 5, 6, 7); }
template <class Epi, class Sched, bool ALIGN_EPI = true, bool F8 = false, bool F4 = false>
__device__ __forceinline__ void gemm_phase(LAS unsigned char* lds, const Gemm g, const Sched& S, const Epi& E) {
    const int tid = ptid(), wid = __builtin_amdgcn_readfirstlane(tid >> 6), lane = tid & 63, wr = wid >> 2, wc = wid & 3, fr = lane & 15, fq = lane >> 4;
    const int K = g.K, nt = K / BK;
    unsigned voffA[2], voffB[2];
#pragma unroll
    for (int i = 0; i < 2; ++i) { int R, C; stage_rc(tid * 16 + i * 8192, R, C);
        const int Rb = (int)Epi::PERM == 2 ? (64 * (R >> 5) + 16 * ((R >> 2) & 3) + 4 * ((R >> 4) & 1) + (R & 3)) : ((int)Epi::PERM == 1 ? ((R & ~31) + perm32(R & 31)) : R);
        voffA[i] = (unsigned)(R * g.lda + C) * 2u; voffB[i] = (unsigned)(Rb * g.ldb + C) * 2u; }
    const size_t kstep = (size_t)(BK * 2);
    const size_t hstepA = (size_t)HALF * g.lda * 2, hstepB = (size_t)((int)Epi::PERM == 2 ? 8 : HALF) * g.ldb * 2;
    const size_t tstepA = 2 * hstepA, tstepB = (size_t)BM * g.ldb * 2;
    const unsigned ldsw = (unsigned)wid * 1024u;
    const int aoff = lds_byte(wr * 64 + fr, fq * 8), boff = lds_byte(wc * 32 + fr, fq * 8);
#define PG8_SA(b, h) (((b) * 2 + (h)) * HTB)
#define PG8_SB(b, h) ((4 + (b) * 2 + (h)) * HTB)
#define PG8_STAGE(bufoff, gbase, voff) do { _Pragma("unroll") for (int _i = 0; _i < 2; ++_i) \
        __builtin_amdgcn_global_load_lds((const unsigned*)((const char*)(gbase) + (voff)[_i]), (LAS unsigned*)(lds + (bufoff) + ldsw + _i * 8192), 16, 0, 0); } while (0)
#define PG8_LDA(dst, b, h) do { _Pragma("unroll") for (int m = 0; m < 4; ++m) { if constexpr (F8) dst##8[m] = cat8(*(const LAS bf16x8*)(lds + PG8_SA(b, h) + aoff + m * 2048), *(const LAS bf16x8*)(lds + PG8_SA(b, h) + aoff + m * 2048 + 1024)); \
        else { _Pragma("unroll") for (int k = 0; k < 2; ++k) dst[m][k] = *(const LAS bf16x8*)(lds + PG8_SA(b, h) + aoff + m * 2048 + k * 1024); } } } while (0)
#define PG8_LDB(dst, b, h) do { _Pragma("unroll") for (int n = 0; n < 2; ++n) { if constexpr (F8) dst##8[n] = cat8(*(const LAS bf16x8*)(lds + PG8_SB(b, h) + boff + n * 2048), *(const LAS bf16x8*)(lds + PG8_SB(b, h) + boff + n * 2048 + 1024)); \
        else { _Pragma("unroll") for (int k = 0; k < 2; ++k) dst[n][k] = *(const LAS bf16x8*)(lds + PG8_SB(b, h) + boff + n * 2048 + k * 1024); } } } while (0)
#define PG8_MMA(ai, bj, At, Bt) do { __builtin_amdgcn_s_setprio(1); _Pragma("unroll") for (int m = 0; m < 4; ++m) _Pragma("unroll") for (int n = 0; n < 2; ++n) { \
        if constexpr (F8) asm volatile("v_mfma_f32_16x16x128_f8f6f4 %0, %1, %2, %0" : "+v"(acc[ai][bj][m][n]) : "v"(Bt##8[n]), "v"(At##8[m]));   \
        else if constexpr (F4) { _Pragma("unroll") for (int k = 0; k < 2; ++k) asm volatile("v_mfma_f32_16x16x128_f8f6f4 %0, %1, %2, %0 cbsz:4 blgp:4" : "+v"(acc[ai][bj][m][n]) : "v"(Bt[n][k]), "v"(At[m][k])); } \
        else { _Pragma("unroll") for (int k = 0; k < 2; ++k) acc[ai][bj][m][n] = __builtin_amdgcn_mfma_f32_16x16x32_bf16(Bt[n][k], At[m][k], acc[ai][bj][m][n], 0, 0, 0); } } \
        __builtin_amdgcn_s_setprio(0); } while (0)
#define PG8_WAIT_V(n) asm volatile("s_waitcnt vmcnt(" #n ")" ::: "memory")
#define PG8_WAIT_L(n) asm volatile("s_waitcnt lgkmcnt(" #n ")" ::: "memory")
#define PG8_BAR __builtin_amdgcn_s_barrier()
#define PG8_SCHED __builtin_amdgcn_sched_barrier(0)
    Unit cur, nxt; int ui = 0;
    if (!S.next(0, cur)) return;
    f32x4 acc[2][2][4][2];
#pragma unroll
    for (int a = 0; a < 2; ++a)
#pragma unroll
        for (int b = 0; b < 2; ++b)
#pragma unroll
            for (int m = 0; m < 4; ++m)
#pragma unroll
                for (int n = 0; n < 2; ++n) acc[a][b][m][n] = (f32x4){0.f, 0.f, 0.f, 0.f};
    bf16x8 At[4][2], B0[2][2], B1[2][2]; v8i_t At8[4], B08[2], B18[2];
    const char* cA = (const char*)g.A + (size_t)cur.z * g.zA + (size_t)cur.pm * tstepA; const char* cB = (const char*)g.Bt + (size_t)cur.z * g.zB + (size_t)cur.pn * tstepB;
    PG8_STAGE(PG8_SB(0, 0), cB, voffB); PG8_STAGE(PG8_SB(0, 1), cB + hstepB, voffB); PG8_STAGE(PG8_SA(0, 0), cA, voffA); PG8_STAGE(PG8_SA(0, 1), cA + hstepA, voffA);
    if (wr == 1) PG8_BAR;
    PG8_WAIT_V(2); PG8_BAR;
    PG8_STAGE(PG8_SB(1, 0), cB + kstep, voffB); PG8_STAGE(PG8_SA(1, 0), cA + kstep, voffA); PG8_STAGE(PG8_SB(1, 1), cB + hstepB + kstep, voffB);
    PG8_WAIT_V(6); PG8_BAR;
    for (;;) {
        const bool has_next = S.next(ui + 1, nxt);
        const char* nA = has_next ? (const char*)g.A + (size_t)nxt.z * g.zA + (size_t)nxt.pm * tstepA : cA; const char* nB = has_next ? (const char*)g.Bt + (size_t)nxt.z * g.zB + (size_t)nxt.pn * tstepB : cB;
#pragma unroll 1
        for (int t = 0; t < nt; t += 2) {
            const bool last = (t == nt - 2);
            const char* a1 = cA + (size_t)(t + 1) * kstep;
            const char* a2 = last ? nA : cA + (size_t)(t + 2) * kstep; const char* b2 = last ? nB : cB + (size_t)(t + 2) * kstep;
            const char* a3 = a2 + kstep; const char* b3 = b2 + kstep;
            PG8_LDB(B0, 0, 0); PG8_LDB(B1, 0, 1); PG8_SCHED; PG8_LDA(At, 0, 0); PG8_STAGE(PG8_SA(1, 1), a1 + hstepA, voffA);
            PG8_WAIT_V(8); PG8_WAIT_L(0); PG8_BAR; PG8_MMA(0, 0, At, B0); PG8_MMA(0, 1, At, B1); PG8_BAR; PG8_SCHED;
            PG8_LDA(At, 0, 1); PG8_STAGE(PG8_SB(0, 0), b2, voffB); PG8_STAGE(PG8_SB(0, 1), b2 + hstepB, voffB); PG8_STAGE(PG8_SA(0, 0), a2, voffA);
            PG8_WAIT_V(8); PG8_WAIT_L(0); PG8_BAR; PG8_MMA(1, 0, At, B0); PG8_MMA(1, 1, At, B1); PG8_BAR; PG8_SCHED;
            PG8_LDB(B0, 1, 0); PG8_LDB(B1, 1, 1); PG8_SCHED; PG8_LDA(At, 1, 0); PG8_STAGE(PG8_SA(0, 1), a2 + hstepA, voffA);
            PG8_WAIT_V(8); PG8_WAIT_L(0); PG8_BAR; PG8_MMA(0, 0, At, B0); PG8_MMA(0, 1, At, B1); PG8_BAR; PG8_SCHED;
            PG8_LDA(At, 1, 1); PG8_STAGE(PG8_SB(1, 0), b3, voffB); PG8_STAGE(PG8_SB(1, 1), b3 + hstepB, voffB); PG8_STAGE(PG8_SA(1, 0), a3, voffA);
            PG8_WAIT_V(8); PG8_WAIT_L(0); PG8_BAR; PG8_MMA(1, 0, At, B0); PG8_MMA(1, 1, At, B1); PG8_BAR; PG8_SCHED;
        }
        if constexpr (ALIGN_EPI) { if (wr == 0) PG8_BAR; }
        if constexpr (F8 || F4) asm volatile("s_nop 15\n\ts_nop 15" ::: "memory");
        E(acc, cur, wr, wc, fr, fq);
        if (!has_next) break;
        if (!(Epi::CARRY && nxt.z != 0))
#pragma unroll
        for (int a = 0; a < 2; ++a)
#pragma unroll
            for (int b = 0; b < 2; ++b)
#pragma unroll
                for (int m = 0; m < 4; ++m)
#pragma unroll
                    for (int n = 0; n < 2; ++n) acc[a][b][m][n] = (f32x4){0.f, 0.f, 0.f, 0.f};
        cur = nxt; cA = nA; cB = nB; ++ui;
        if constexpr (ALIGN_EPI) { if (wr == 1) PG8_BAR; }
    }
    PG8_WAIT_V(0);
    if constexpr (!ALIGN_EPI) { if (wr == 0) PG8_BAR; }
    PG8_BAR;
#undef PG8_SA
#undef PG8_SB
#undef PG8_STAGE
#undef PG8_LDA
#undef PG8_LDB
#undef PG8_MMA
#undef PG8_WAIT_V
#undef PG8_WAIT_L
#undef PG8_BAR
#undef PG8_SCHED
}
}

constexpr int BATCH = 4, SEQ = 4096, DM = 4096, MTOK = BATCH * SEQ, DEPTH = 2;
constexpr int INW = 12184, INP = 12288, NGATE = 4 * DM, N1 = INP + NGATE;
constexpr float LOG2E = 1.4426950408889634f;
constexpr float RMS_EPS = 1e-6f, LN_EPS = 1e-5f;
constexpr float DN_ALPHA = 1.4142135623730951f;
constexpr int PC_AQ = 0, PC_AK = 1024, PC_AV = 1280, PC_AIQ = 1536, PC_AZ = 2560, PC_BQ = 3584, PC_BK = 4608, PC_BV = 5632, PC_BZ = 6656,
              PC_CQ = 7680, PC_CK = 8704, PC_CV = 8832, PC_CZ = 8960, PC_DCQ = 9984, PC_DCKV = 10752, PC_DZ = 11008,
              PC_AIK = 12032, PC_AIW = 12096, PC_BF = 12112, PC_DKR = 12120, PC_END = 12184;
constexpr int SC_AQ = 0, SC_AK = 1024, SC_AV = 1280, SC_AIQ = 1536, SC_AIK = 2560, SC_AIW = 2624, SC_AZ = 2640, SC_BQ = 3664, SC_BK = 4688, SC_BV = 5712,
              SC_BF = 6736, SC_BZ = 6744, SC_CQ = 7768, SC_CK = 8792, SC_CV = 8920, SC_CZ = 9048, SC_DCQ = 10072, SC_DCKV = 10840, SC_DKR = 11096, SC_DZ = 11160;
static_assert(SC_DZ + 1024 == INW, "w_in column partition");
constexpr int SMC_AIK = 0, SMC_AIW = 64, SMC_BF = 80, SMC_DKR = 88;

constexpr size_t MiB = 1u << 20;
constexpr size_t WS_CTL = 0, CTL_ZERO_BYTES = 1 * MiB;
constexpr size_t WS_W = 2 * MiB;
constexpr int NIN8 = 27 * 256, NINZ = 16 * 256, NINB = 5 * 256;
constexpr size_t WO_WIN8 = 0                                         , WO_WZ4 = WO_WIN8 + (size_t)NIN8 * DM  ,
                 WO_WINB = WO_WZ4 + (size_t)NINZ * (DM / 2)          ,
                 WO_WG8 = WO_WINB + (size_t)NINB * DM * 2            , WO_WBR = WO_WG8 + (size_t)NGATE * DM  ,
                 WO_WOUT = WO_WBR + (size_t)4 * DM * 1024            , WO_DQUP = WO_WOUT + (size_t)DM * DM,
                 WO_DKVUP = WO_DQUP + (size_t)1536 * 768 * 2, WO_END = WO_DKVUP + (size_t)2048 * 256 * 2;
static_assert(WO_END <= 292 * MiB, "weights region");
constexpr size_t WS_XB = 294 * MiB;
constexpr size_t WS_P = 422 * MiB;
constexpr size_t WS_MRGF = WS_P;
constexpr size_t WS_G = 806 * MiB;
constexpr size_t WS_R = WS_G;
constexpr size_t WS_SC = 1318 * MiB;
constexpr size_t WS_MRG = WS_SC;
constexpr size_t WS_BR = 1574 * MiB;
constexpr size_t WS_DQ = 1702 * MiB;
constexpr size_t WS_DKV = 1750 * MiB;
constexpr size_t WS_MASK = 1814 * MiB;
constexpr size_t WS_SM = 1822 * MiB;
constexpr size_t WS_CS = 1838 * MiB;
constexpr size_t WS_RSS = 1842 * MiB;
constexpr size_t WS_CUM = 1843 * MiB;
constexpr size_t WS_DKR = 1844 * MiB;
constexpr size_t WS_X8 = 1846 * MiB;
constexpr size_t WS_KV8 = 1096 * MiB;
constexpr int KV8W = 2560;
constexpr size_t WS_D8 = 1136 * MiB;
constexpr int D8W = 2112;
constexpr size_t WS_L8 = 1170 * MiB;
constexpr float DQ_WS = 64.0f, DKV_WS = 8.0f;
constexpr size_t WS_X4 = 1062 * MiB;
constexpr size_t WS_END = 1910 * MiB;
constexpr int CW_TMO = 0;
constexpr int CW_Q = 64;
constexpr int CW_BAR = 16384;

constexpr int RING_BYTES = 131072;
constexpr int LDSCTL_OFF = RING_BYTES, MISC_OFF = LDSCTL_OFF + 320;
constexpr int LDS_BYTES = 147456;
constexpr int NWAVES = 8, NTHREADS = 512;

#define RLX_AGENT __ATOMIC_RELAXED, __HIP_MEMORY_SCOPE_AGENT
#define LDS_WAIT() asm volatile("s_waitcnt lgkmcnt(0)" ::: "memory")
#define VM_WAIT() asm volatile("s_waitcnt vmcnt(0)" ::: "memory")

#define XB_TMO      128
#define XB_XCNT(j)  (256  + 64 * (j))
#define XB_XSUB(j)  (1280 + 64 * (j))
#define XB_XGEN(j)  (2304 + 64 * (j))
#define XB_TOP      3328
#define XB_TOPGEN   3392
#define XCD_BAR_WORDS 3456
#define XB_SPIN_CAP (1u << 23)
__device__ __forceinline__ unsigned xb_ld(unsigned* p)              { return __hip_atomic_load(p, __ATOMIC_RELAXED, __HIP_MEMORY_SCOPE_AGENT); }
__device__ __forceinline__ unsigned xb_add(unsigned* p, unsigned v) { return __hip_atomic_fetch_add(p, v, __ATOMIC_RELAXED, __HIP_MEMORY_SCOPE_AGENT); }
__device__ __forceinline__ unsigned xb_xcc_id() { return (unsigned)__builtin_amdgcn_s_getreg((3 << 11) | 20) & 0xFu; }
#define XB_SPIN(cond, bar) do { unsigned _sp = 0; while (cond) { __builtin_amdgcn_s_sleep(1); \
    if ((++_sp & 255u) == 0u) { if (xb_ld(&(bar)[XB_TMO])) break; if (_sp > XB_SPIN_CAP) { atomicAdd(&(bar)[XB_TMO], 1u); break; } } } } while (0)
struct XcdBarrier { unsigned* bar; unsigned x; volatile LAS unsigned* st; };
__device__ __forceinline__ XcdBarrier xcd_barrier_post(unsigned* bar, volatile LAS unsigned* st) {
    XcdBarrier b; b.bar = bar; b.x = xb_xcc_id(); b.st = st;
    if (threadIdx.x == 0) (void)xb_add(&bar[XB_XCNT(b.x)], 1u);
    return b;
}
__device__ __forceinline__ void xcd_barrier_complete(unsigned* bar, unsigned x, unsigned& nloc, unsigned& nx) {
    const unsigned G = gridDim.x * gridDim.y * gridDim.z;
    unsigned sum, cnt, mine, sp = 0u;
    for (;;) {
        sum = 0u; cnt = 0u; mine = 0u;
#pragma unroll
        for (unsigned j = 0; j < 16; ++j) { const unsigned c = xb_ld(&bar[XB_XCNT(j)]); sum += c; cnt += (c > 0u) ? 1u : 0u; mine = (j == x) ? c : mine; }
        if (sum == G) break;
        __builtin_amdgcn_s_sleep(1);
        if ((++sp & 255u) == 0u) { if (xb_ld(&bar[XB_TMO])) break; if (sp > XB_SPIN_CAP) { atomicAdd(&bar[XB_TMO], 1u); break; } }
    }
    nloc = mine > 0u ? mine : 1u; nx = cnt > 0u ? cnt : 1u;
}
__device__ __forceinline__ void xcd_barrier(const XcdBarrier& b) {
    asm volatile("s_waitcnt vmcnt(0)" ::: "memory");
    __syncthreads();
    if (threadIdx.x == 0) {
        unsigned* bar = b.bar;
        __builtin_amdgcn_s_waitcnt(0);
        unsigned nloc = b.st[0], nx = b.st[1];
        if (nloc == 0u) { xcd_barrier_complete(bar, b.x, nloc, nx); b.st[0] = nloc; b.st[1] = nx; }
        const unsigned old = xb_add(&bar[XB_XSUB(b.x)], 1u);
        const unsigned gen = old / nloc;
        if (old + 1u == (gen + 1u) * nloc) {
            __builtin_amdgcn_fence(__ATOMIC_RELEASE, "agent");
            asm volatile("s_waitcnt vmcnt(0)" ::: "memory");
            const unsigned og = xb_add(&bar[XB_TOP], 1u);
            const unsigned tg = og / nx;
            if (og + 1u == (tg + 1u) * nx) xb_add(&bar[XB_TOPGEN], 1u);
            else XB_SPIN(xb_ld(&bar[XB_TOPGEN]) == tg, bar);
            __builtin_amdgcn_fence(__ATOMIC_ACQUIRE, "agent");
            xb_add(&bar[XB_XGEN(b.x)], 1u);
            asm volatile("s_waitcnt vmcnt(0)" ::: "memory");
        } else {
            XB_SPIN(xb_ld(&bar[XB_XGEN(b.x)]) == gen, bar);
            __builtin_amdgcn_fence(__ATOMIC_ACQUIRE, "agent");
            asm volatile("s_waitcnt vmcnt(0)" ::: "memory");
        }
    }
    __syncthreads();
}

struct Args {
    const float* x; const int* pos; const float* w_in; const float* w_gate; const float* w_branch; const float* w_out;
    const float* dq_gain; const float* dq_up; const float* dkv_gain; const float* dkv_up; const float* f_bias; const float* sinks; const float* ln_gain; const float* ln_bias;
    float* out; unsigned char* ws; int ph_lo, ph_hi;
};

__device__ __forceinline__ float wave_sum(float v) {
#pragma unroll
    for (int o = 1; o < 64; o <<= 1) v += __shfl_xor(v, o);
    return v;
}
__device__ __forceinline__ unsigned pack_fp4x8(float a0, float a1, float a2, float a3, float a4, float a5, float a6, float a7) {
    unsigned w = 0u;
    w = __builtin_amdgcn_cvt_scalef32_pk_fp4_f32(w, a0, a1, 1.0f, 0); w = __builtin_amdgcn_cvt_scalef32_pk_fp4_f32(w, a2, a3, 1.0f, 1);
    w = __builtin_amdgcn_cvt_scalef32_pk_fp4_f32(w, a4, a5, 1.0f, 2); w = __builtin_amdgcn_cvt_scalef32_pk_fp4_f32(w, a6, a7, 1.0f, 3);
    return w; }
constexpr float FP4_XS = 2.0f, FP4_WS = 128.0f;
__device__ __forceinline__ float fast_sigmoid(float v) { return __builtin_amdgcn_rcpf(1.0f + __builtin_amdgcn_exp2f(-v * LOG2E)); }

__device__ __forceinline__ int in_src(int j, float& sc) {
    sc = 1.0f;
    if (j < PC_AK)   return SC_AQ + (j - PC_AQ);
    if (j < PC_AV)   return SC_AK + (j - PC_AK);
    if (j < PC_AIQ)  return SC_AV + (j - PC_AV);
    if (j < PC_AZ)   return SC_AIQ + (j - PC_AIQ);
    if (j < PC_BQ)   return SC_AZ + (j - PC_AZ);
    if (j < PC_BK)   return SC_BQ + (j - PC_BQ);
    if (j < PC_BV)   return SC_BK + (j - PC_BK);
    if (j < PC_BZ)   return SC_BV + (j - PC_BV);
    if (j < PC_CQ)   return SC_BZ + (j - PC_BZ);
    if (j < PC_CK)   return SC_CQ + (j - PC_CQ);
    if (j < PC_CV)   return SC_CK + (j - PC_CK);
    if (j < PC_CZ)   return SC_CV + (j - PC_CV);
    if (j < PC_DCQ)  return SC_CZ + (j - PC_CZ);
    if (j < PC_DCKV) return SC_DCQ + (j - PC_DCQ);
    if (j < PC_DZ)   return SC_DCKV + (j - PC_DCKV);
    if (j < PC_AIK)  return SC_DZ + (j - PC_DZ);
    if (j < PC_AIW)  return SC_AIK + (j - PC_AIK);
    if (j < PC_BF)   return SC_AIW + (j - PC_AIW);
    if (j < PC_DKR)  return SC_BF + (j - PC_BF);
    if (j < PC_END)  { const int p = j - PC_DKR; return SC_DKR + (p >> 1) + 32 * (p & 1); }
    return -1;
}
__host__ __device__ __forceinline__ int in8_tile(int i) { return i < 6 ? i : (i < 22 ? i + 4 : i + 8); }
__host__ __device__ __forceinline__ int inz_tile(int j) { return j < 4 ? 26 + j : 31 + j; }
struct CvtItem {
    const float* p;
    unsigned ld;
    const float* gain;
    float sc;
    unsigned char* dst;
    int K, n0, k0, f8;
};
__device__ __forceinline__ CvtItem cvt_decode(const Args& a, int layer, int it, int lane) {
    unsigned char* W = a.ws + WS_W;
    constexpr int I_IN8 = (NIN8 / 32) * (DM / 64), I_INZ = (NINZ / 32) * (DM / 64), I_INB = (NINB / 32) * (DM / 64), I_G = (NGATE / 32) * (DM / 64), I_BR = 4 * (DM / 32) * (1024 / 64), I_OUT = (DM / 32) * (DM / 64), I_DQ = (1536 / 32) * (768 / 64);
    CvtItem d; d.gain = nullptr; d.sc = 1.0f; d.f8 = 1; d.K = DM; d.ld = DM;
    const int ln = lane & 31; int r = it;
    if (r < I_IN8) { const int nb = r % (NIN8 / 32), kb = r / (NIN8 / 32); d.n0 = nb * 32; d.k0 = kb * 64;
        const int j = in8_tile(d.n0 >> 8) * 256 + (d.n0 & 255) + ln; float s_; const int c = in_src(j, s_);
        d.p = a.w_in + (size_t)layer * DM * INW + (c < 0 ? 0 : c); d.ld = INW; d.sc = c < 0 ? 0.f : 64.0f; d.dst = W + WO_WIN8; return d; }
    r -= I_IN8;
    if (r < I_INZ) { const int nb = r % (NINZ / 32), kb = r / (NINZ / 32); d.n0 = nb * 32; d.k0 = kb * 64;
        const int j = inz_tile(d.n0 >> 8) * 256 + (d.n0 & 255) + ln; float s_; const int c = in_src(j, s_);
        d.p = a.w_in + (size_t)layer * DM * INW + (c < 0 ? 0 : c); d.ld = INW; d.sc = c < 0 ? 0.f : FP4_WS; d.dst = W + WO_WZ4; d.f8 = 2; return d; }
    r -= I_INZ;
    if (r < I_INB) { const int nb = r % (NINB / 32), kb = r / (NINB / 32); d.n0 = nb * 32; d.k0 = kb * 64;
        const int j = d.n0 + ln + (d.n0 < 1024 ? 1536 : 12032 - 1024); float s_; const int c = in_src(j, s_);
        d.p = a.w_in + (size_t)layer * DM * INW + (c < 0 ? 0 : c); d.ld = INW; d.sc = c < 0 ? 0.f : 1.0f; d.dst = W + WO_WINB; d.f8 = 0; return d; }
    r -= I_INB;
    if (r < I_G) { const int nb = r % (NGATE / 32), kb = r / (NGATE / 32), g = nb / (DM / 32); d.n0 = (nb % (DM / 32)) * 32; d.k0 = kb * 64;
        d.p = a.w_gate + ((size_t)layer * 4 + g) * DM * DM + d.n0 + ln; d.sc = FP4_WS; d.dst = W + WO_WG8 + (size_t)g * DM * (DM / 2); d.f8 = 2; return d; }
    r -= I_G;
    if (r < I_BR) { const int n = r / ((DM / 32) * 16), q = r % ((DM / 32) * 16), nb = q % (DM / 32), kb = q / (DM / 32); d.n0 = nb * 32; d.k0 = kb * 64;
        d.p = a.w_branch + ((size_t)layer * 4 + n) * 1024 * DM + d.n0 + ln; d.sc = 64.0f; d.dst = W + WO_WBR + (size_t)n * DM * 1024; d.K = 1024; return d; }
    r -= I_BR;
    if (r < I_OUT) { const int nb = r % (DM / 32), kb = r / (DM / 32); d.n0 = nb * 32; d.k0 = kb * 64;
        d.p = a.w_out + (size_t)layer * DM * DM + d.n0 + ln; d.sc = 128.0f; d.dst = W + WO_WOUT; return d; }
    r -= I_OUT;
    if (r < I_DQ) { const int nb = r % 48, kb = r / 48; d.n0 = nb * 32; d.k0 = kb * 64;
        const int j = d.n0 + ln, h = j / 192, wv = j % 192; int c = wv; if (wv >= 128) { const int q = wv - 128; c = 128 + (q >> 1) + 32 * (q & 1); }
        d.p = a.dq_up + (size_t)layer * 768 * 1536 + h * 192 + c; d.ld = 1536; d.gain = a.dq_gain + layer * 768; d.sc = 0.07216878364870322f * LOG2E * DQ_WS; d.dst = W + WO_DQUP; d.K = 768; d.f8 = 1; return d; }
    r -= I_DQ;
    { const int nb = r % 64, kb = r / 64; d.n0 = nb * 32; d.k0 = kb * 64;
      d.p = a.dkv_up + (size_t)layer * 256 * 2048 + d.n0 + ln; d.ld = 2048; d.gain = a.dkv_gain + layer * 256; d.sc = DKV_WS; d.dst = W + WO_DKVUP; d.K = 256; d.f8 = 1; return d; }
}
__device__ __forceinline__ void cvt_load(const CvtItem& d, float (&v)[32], int lane) {
    const float* p = d.p + (size_t)(d.k0 + (lane >> 5)) * d.ld;
#pragma unroll
    for (int i = 0; i < 32; ++i) v[i] = p[(size_t)(2 * i) * d.ld];
}
__device__ __forceinline__ void cvt_finish(const CvtItem& d, const float (&v)[32], LAS float* scr, int lane) {
#pragma unroll
    for (int i = 0; i < 32; ++i) { const int kk = 2 * i + (lane >> 5); float x = v[i] * d.sc; if (d.gain) x *= d.gain[d.k0 + kk]; scr[kk * 33 + (lane & 31)] = x; }
    LDS_WAIT(); asm volatile("" ::: "memory");
    const int c = lane & 7;
#pragma unroll
    for (int j = 0; j < 4; ++j) { const int n = (lane >> 3) + 8 * j; const LAS float* s = scr + (8 * c) * 33 + n;
        if (d.f8 == 2) *(unsigned*)(d.dst + (((size_t)(d.n0 + n) * d.K + d.k0 + 8 * c) >> 1)) = pack_fp4x8(s[0], s[33], s[2 * 33], s[3 * 33], s[4 * 33], s[5 * 33], s[6 * 33], s[7 * 33]);
        else if (d.f8) { int w0 = 0, w1 = 0;
            w0 = __builtin_amdgcn_cvt_pk_fp8_f32(s[0], s[33], w0, false); w0 = __builtin_amdgcn_cvt_pk_fp8_f32(s[2 * 33], s[3 * 33], w0, true);
            w1 = __builtin_amdgcn_cvt_pk_fp8_f32(s[4 * 33], s[5 * 33], w1, false); w1 = __builtin_amdgcn_cvt_pk_fp8_f32(s[6 * 33], s[7 * 33], w1, true);
            *(u32x2*)(d.dst + (size_t)(d.n0 + n) * d.K + d.k0 + 8 * c) = (u32x2){(unsigned)w0, (unsigned)w1}; }
        else { u32x4 o; o.x = cvt_pk_bf16(s[0], s[33]); o.y = cvt_pk_bf16(s[2 * 33], s[3 * 33]); o.z = cvt_pk_bf16(s[4 * 33], s[5 * 33]); o.w = cvt_pk_bf16(s[6 * 33], s[7 * 33]);
            *(u32x4*)((bf16_t*)d.dst + (size_t)(d.n0 + n) * d.K + d.k0 + 8 * c) = o; } }
    LDS_WAIT(); asm volatile("" ::: "memory");
}
__device__ __forceinline__ void convert_weights(const Args& a, int layer, LAS unsigned char* lds) {
    const int tid = ptid(), lane = tid & 63, wave = tid >> 6;
    LAS float* scr = (LAS float*)(lds + wave * 8448);
    const int NGW = gridDim.x * NWAVES, gw = blockIdx.x * NWAVES + wave;
    constexpr int NITEMS = (NIN8 / 32) * (DM / 64) + (NINZ / 32) * (DM / 64) + (NINB / 32) * (DM / 64) + (NGATE / 32) * (DM / 64) + 4 * (DM / 32) * (1024 / 64) + (DM / 32) * (DM / 64) + (1536 / 32) * (768 / 64) + (2048 / 32) * (256 / 64);
    float va[32], vb[32]; CvtItem da, db;
    int it = gw;
    if (it < NITEMS) { da = cvt_decode(a, layer, it, lane); cvt_load(da, va, lane); }
    while (it < NITEMS) {
        const int itb = it + NGW;
        if (itb < NITEMS) { db = cvt_decode(a, layer, itb, lane); cvt_load(db, vb, lane); }
        cvt_finish(da, va, scr, lane);
        if (itb >= NITEMS) break;
        const int ita = itb + NGW;
        if (ita < NITEMS) { da = cvt_decode(a, layer, ita, lane); cvt_load(da, va, lane); }
        cvt_finish(db, vb, scr, lane);
        it = ita;
    }
    __syncthreads();
}
__device__ __forceinline__ void prologue_misc(const Args& a) {
    const size_t gt = (size_t)blockIdx.x * NTHREADS + ptid(), GT = (size_t)gridDim.x * NTHREADS;
    bf16_t* XB = (bf16_t*)(a.ws + WS_XB);
    constexpr size_t NCH = (size_t)MTOK * DM / 8;
    for (size_t i0 = gt; i0 < NCH; i0 += 4 * GT) {
        f32x4 v0[4], v1[4];
#pragma unroll
        for (int u = 0; u < 4; ++u) { const size_t i = i0 + u * GT; if (i < NCH) { v0[u] = *(const f32x4*)(a.x + i * 8); v1[u] = *(const f32x4*)(a.x + i * 8 + 4); } }
#pragma unroll
        for (int u = 0; u < 4; ++u) { const size_t i = i0 + u * GT; if (i < NCH) {
            u32x4 o; o.x = cvt_pk_bf16(v0[u][0], v0[u][1]); o.y = cvt_pk_bf16(v0[u][2], v0[u][3]); o.z = cvt_pk_bf16(v1[u][0], v1[u][1]); o.w = cvt_pk_bf16(v1[u][2], v1[u][3]);
            *(u32x4*)(XB + i * 8) = o;
            int w0 = 0, w1 = 0;
            w0 = __builtin_amdgcn_cvt_pk_fp8_f32(v0[u][0], v0[u][1], w0, false); w0 = __builtin_amdgcn_cvt_pk_fp8_f32(v0[u][2], v0[u][3], w0, true);
            w1 = __builtin_amdgcn_cvt_pk_fp8_f32(v1[u][0], v1[u][1], w1, false); w1 = __builtin_amdgcn_cvt_pk_fp8_f32(v1[u][2], v1[u][3], w1, true);
            *(u32x2*)(a.ws + WS_X8 + i * 8) = (u32x2){(unsigned)w0, (unsigned)w1};
            *(unsigned*)(a.ws + WS_X4 + i * 4) = pack_fp4x8(v0[u][0] * FP4_XS, v0[u][1] * FP4_XS, v0[u][2] * FP4_XS, v0[u][3] * FP4_XS, v1[u][0] * FP4_XS, v1[u][1] * FP4_XS, v1[u][2] * FP4_XS, v1[u][3] * FP4_XS); } }
    }
    f32x2* CS = (f32x2*)(a.ws + WS_CS);
    for (size_t i = gt; i < (size_t)MTOK * 32; i += GT) {
        const int row = (int)(i >> 5), fi = (int)(i & 31);
        const float invf = __builtin_amdgcn_exp2f(-(float)fi * (13.287712379549449f / 32.0f));
        const float ang = (float)a.pos[row] * invf;
        const double rev = (double)ang * 0.15915494309189535;
        const float fr = (float)(rev - floor(rev));
        CS[i] = (f32x2){__builtin_amdgcn_cosf(fr), __builtin_amdgcn_sinf(fr)};
    }
}

struct EpiIn {
    static constexpr int PERM = 2; static constexpr bool CARRY = false;
    bf16_t* P; float* SM; float* RSS; int f8; unsigned char* KV8; unsigned char* L8;
    template <int MODE>
    __device__ __forceinline__ void run(const f32x4 (&acc)[2][2][4][2], int pn, int row0, int cw, int wc, int fq, float sc) const {
        bf16_t* base = P + (size_t)pn * 256 + cw;
        unsigned char* k8b = (MODE == 3) ? L8 + (pn - 39) * 256 + cw : KV8 + (pn < 6 ? (pn - 4) * 256 : 512 + (pn - 18) * 256) + cw;
#pragma unroll
        for (int ai = 0; ai < 2; ++ai)
#pragma unroll
            for (int m = 0; m < 4; ++m) { const int row = row0 + ai * 128 + m * 16; bf16_t* rowp = base + (size_t)row * INP; float ss = 0.f;
                u32x4 k8w;
#pragma unroll
                for (int bj = 0; bj < 2; ++bj) { f32x4 v0 = acc[ai][bj][m][0] * sc, v1 = acc[ai][bj][m][1] * sc;
                    if constexpr (MODE == 3) ss += ((v0[0] * v0[0] + v0[1] * v0[1]) + (v0[2] * v0[2] + v0[3] * v0[3])) + ((v1[0] * v1[0] + v1[1] * v1[1]) + (v1[2] * v1[2] + v1[3] * v1[3]));
                    if constexpr (MODE == 4 || MODE == 3) { int w0 = 0, w1 = 0;
                        w0 = __builtin_amdgcn_cvt_pk_fp8_f32(v0[0], v0[1], w0, false); w0 = __builtin_amdgcn_cvt_pk_fp8_f32(v0[2], v0[3], w0, true);
                        w1 = __builtin_amdgcn_cvt_pk_fp8_f32(v1[0], v1[1], w1, false); w1 = __builtin_amdgcn_cvt_pk_fp8_f32(v1[2], v1[3], w1, true);
                        if (bj == 0) { k8w.x = (unsigned)w0; k8w.y = (unsigned)w1; } else { k8w.z = (unsigned)w0; k8w.w = (unsigned)w1; } continue; }
                    if constexpr (MODE == 1) {
#pragma unroll
                        for (int j = 0; j < 4; ++j) { v0[j] = v0[j] * fast_sigmoid(v0[j]); v1[j] = v1[j] * fast_sigmoid(v1[j]); } }
                    if constexpr (MODE == 2) { float* sp = SM + (size_t)row * 256 + cw + bj * 8; *(f32x4*)sp = v0; *(f32x4*)(sp + 4) = v1; }
                    u32x4 w; w.x = cvt_pk_bf16(v0[0], v0[1]); w.y = cvt_pk_bf16(v0[2], v0[3]); w.z = cvt_pk_bf16(v1[0], v1[1]); w.w = cvt_pk_bf16(v1[2], v1[3]);
                    *(u32x4*)(rowp + bj * 8) = w; }
                if constexpr (MODE == 4) *(u32x4*)(k8b + (size_t)row * KV8W) = k8w;
                if constexpr (MODE == 3) *(u32x4*)(k8b + (size_t)row * 1024) = k8w;
                if constexpr (MODE == 3) { ss += __shfl_xor(ss, 16); ss += __shfl_xor(ss, 32); if (fq == 0) RSS[(size_t)row * 16 + (pn - 39) * 4 + wc] = ss; }
                asm volatile("" ::: "memory"); }
    }
    __device__ __forceinline__ void operator()(f32x4 (&acc)[2][2][4][2], const pg8::Unit& u, int wr, int wc, int fr, int fq) const {
        asm volatile("" : "+v"(fr), "+v"(fq));
        const int pn = f8 == 1 ? in8_tile(u.pn) : (f8 == 2 ? inz_tile(u.pn) : (u.pn < 4 ? u.pn + 6 : 47)), row0 = u.pm * 256 + wr * 64 + fr, cw = wc * 64 + 16 * fq;
        const float qs = (pn < 4 || (pn >= 14 && pn < 18)) ? 0.08838834764831845f * LOG2E : ((pn >= 30 && pn < 34) ? 0.125f * LOG2E : 1.0f), sc = f8 == 1 ? qs * 0.015625f : (f8 == 2 ? 1.0f / (FP4_XS * FP4_WS * 0.9761f) : qs);
        if (pn == 47) run<2>(acc, pn, row0, cw, wc, fq, sc);
        else if (pn >= 39 && pn < 43) run<3>(acc, pn, row0, cw, wc, fq, sc);
        else if (pn == 4 || pn == 5 || (pn >= 18 && pn < 26)) run<4>(acc, pn, row0, cw, wc, fq, sc);
        else run<0>(acc, pn, row0, cw, wc, fq, sc);
    }
};
struct EpiGate {
    static constexpr int PERM = 2; static constexpr bool CARRY = false;
    unsigned char* G; float sc;
    __device__ __forceinline__ void operator()(f32x4 (&acc)[2][2][4][2], const pg8::Unit& u, int wr, int wc, int fr, int fq) const {
        asm volatile("" : "+v"(fr), "+v"(fq));
        unsigned char* base = G + ((((size_t)u.pm * 64 + u.pn) * 8 + (wr * 4 + wc)) * 8) * 1024 + (fq * 16 + fr) * 16;
#pragma unroll
        for (int ai = 0; ai < 2; ++ai)
#pragma unroll
            for (int m = 0; m < 4; ++m) { unsigned char* rowp = base + (ai * 4 + m) * 1024; u32x4 w;
#pragma unroll
                for (int bj = 0; bj < 2; ++bj) { const f32x4 v0 = acc[ai][bj][m][0] * sc, v1 = acc[ai][bj][m][1] * sc; int w0 = 0, w1 = 0;
                    w0 = __builtin_amdgcn_cvt_pk_fp8_f32(v0[0], v0[1], w0, false); w0 = __builtin_amdgcn_cvt_pk_fp8_f32(v0[2], v0[3], w0, true);
                    w1 = __builtin_amdgcn_cvt_pk_fp8_f32(v1[0], v1[1], w1, false); w1 = __builtin_amdgcn_cvt_pk_fp8_f32(v1[2], v1[3], w1, true);
                    if (bj == 0) { w.x = (unsigned)w0; w.y = (unsigned)w1; } else { w.z = (unsigned)w0; w.w = (unsigned)w1; } }
                *(u32x4*)rowp = w; }
    }
};
struct EpiNull {
    static constexpr int PERM = 1; static constexpr bool CARRY = false;
    float* D;
    __device__ __forceinline__ void operator()(f32x4 (&acc)[2][2][4][2], const pg8::Unit& u, int wr, int wc, int fr, int fq) const {
        f32x4 s = (f32x4){0.f, 0.f, 0.f, 0.f};
#pragma unroll
        for (int ai = 0; ai < 2; ++ai)
#pragma unroll
            for (int bj = 0; bj < 2; ++bj)
#pragma unroll
                for (int m = 0; m < 4; ++m)
#pragma unroll
                    for (int n = 0; n < 2; ++n) s += acc[ai][bj][m][n];
        *(f32x4*)(D + ((size_t)(u.pm * 64 + u.pn) * 512 + wr * 256 + wc * 64 + fq * 16 + fr) * 4) = s;
    }
};
struct EpiDq {
    static constexpr int PERM = 2; static constexpr bool CARRY = false;
    bf16_t* DQ; const float* RSS; const float* CS; float wsc;
    __device__ __forceinline__ void operator()(f32x4 (&acc)[2][2][4][2], const pg8::Unit& u, int wr, int wc, int fr, int fq) const {
        asm volatile("" : "+v"(fr), "+v"(fq));
        const int row0 = u.pm * 256 + wr * 64 + fr, col0 = u.pn * 256 + wc * 64 + 16 * fq;
#pragma unroll
        for (int ai = 0; ai < 2; ++ai)
#pragma unroll
            for (int m = 0; m < 4; ++m) { const int row = row0 + ai * 128 + m * 16;
                const f32x4 r0 = *(const f32x4*)(RSS + (size_t)row * 16), r1 = *(const f32x4*)(RSS + (size_t)row * 16 + 4), r2 = *(const f32x4*)(RSS + (size_t)row * 16 + 8);
                const float ss = ((r0[0] + r0[1]) + (r0[2] + r0[3])) + ((r1[0] + r1[1]) + (r1[2] + r1[3])) + ((r2[0] + r2[1]) + (r2[2] + r2[3]));
                const float rs = __builtin_amdgcn_rsqf(ss * (1.0f / 768.0f) + RMS_EPS) * wsc;
                bf16_t* rowp = DQ + (size_t)row * 1536 + col0;
#pragma unroll
                for (int bj = 0; bj < 2; ++bj) { f32x4 v[2];
#pragma unroll
                    for (int n = 0; n < 2; ++n) { v[n] = acc[ai][bj][m][n] * rs; const int c = col0 + bj * 8 + 4 * n, w = c % 192;
                        if (w >= 128) { const f32x4 cs = *(const f32x4*)(CS + (size_t)row * 64 + (w - 128));
                            const f32x4 t = v[n]; v[n][0] = t[0] * cs[0] - t[1] * cs[1]; v[n][1] = t[0] * cs[1] + t[1] * cs[0]; v[n][2] = t[2] * cs[2] - t[3] * cs[3]; v[n][3] = t[2] * cs[3] + t[3] * cs[2]; } }
                    u32x4 w4; w4.x = cvt_pk_bf16(v[0][0], v[0][1]); w4.y = cvt_pk_bf16(v[0][2], v[0][3]); w4.z = cvt_pk_bf16(v[1][0], v[1][1]); w4.w = cvt_pk_bf16(v[1][2], v[1][3]);
                    *(u32x4*)(rowp + bj * 8) = w4; }
                asm volatile("" ::: "memory"); }
    }
};
struct EpiDkv {
    static constexpr int PERM = 2; static constexpr bool CARRY = false;
    unsigned char* D8; const float* RSS; float wsc;
    __device__ __forceinline__ void operator()(f32x4 (&acc)[2][2][4][2], const pg8::Unit& u, int wr, int wc, int fr, int fq) const {
        asm volatile("" : "+v"(fr), "+v"(fq));
        const int row0 = u.pm * 256 + wr * 64 + fr, col0 = u.pn * 256 + wc * 64 + 16 * fq;
        f32x4 r3v[2][4];
#pragma unroll
        for (int ai = 0; ai < 2; ++ai)
#pragma unroll
            for (int m = 0; m < 4; ++m) r3v[ai][m] = *(const f32x4*)(RSS + (size_t)(row0 + ai * 128 + m * 16) * 16 + 12);
#pragma unroll
        for (int ai = 0; ai < 2; ++ai)
#pragma unroll
            for (int m = 0; m < 4; ++m) { const int row = row0 + ai * 128 + m * 16;
                const f32x4 r3 = r3v[ai][m];
                const float rs = __builtin_amdgcn_rsqf(((r3[0] + r3[1]) + (r3[2] + r3[3])) * (1.0f / 256.0f) + RMS_EPS) * wsc;
                u32x4 w4;
#pragma unroll
                for (int bj = 0; bj < 2; ++bj) { const f32x4 v0 = acc[ai][bj][m][0] * rs, v1 = acc[ai][bj][m][1] * rs; int w0 = 0, w1 = 0;
                    w0 = __builtin_amdgcn_cvt_pk_fp8_f32(v0[0], v0[1], w0, false); w0 = __builtin_amdgcn_cvt_pk_fp8_f32(v0[2], v0[3], w0, true);
                    w1 = __builtin_amdgcn_cvt_pk_fp8_f32(v1[0], v1[1], w1, false); w1 = __builtin_amdgcn_cvt_pk_fp8_f32(v1[2], v1[3], w1, true);
                    if (bj == 0) { w4.x = (unsigned)w0; w4.y = (unsigned)w1; } else { w4.z = (unsigned)w0; w4.w = (unsigned)w1; } }
                *(u32x4*)(D8 + (size_t)row * D8W + col0) = w4;
                asm volatile("" ::: "memory"); }
    }
};
struct EpiMerge {
    static constexpr int PERM = 2; static constexpr bool CARRY = true;
    const unsigned char* G; unsigned char* MRG;
    __device__ __forceinline__ void operator()(f32x4 (&acc)[2][2][4][2], const pg8::Unit& u, int wr, int wc, int fr, int fq) const {
        asm volatile("" : "+v"(fr), "+v"(fq));
        const int row0 = u.pm * 256 + wr * 64 + fr, col0 = u.pn * 256 + wc * 64 + 16 * fq, z = u.z;
        const float fin = 0.001953125f * 16.0f;
        u32x4 ga[2][4], gb[2][4];
        const unsigned char* gta = G + ((((size_t)u.pm * 64 + z * 16 + u.pn) * 8 + (wr * 4 + wc)) * 8) * 1024 + (fq * 16 + fr) * 16;
        const unsigned char* gtb = gta + (z < 3 ? (size_t)16 * 8 * 8 * 1024 : 0);
#define MG_LOAD(ai_, m_) do { ga[ai_][m_] = *(const u32x4*)(gta + ((ai_) * 4 + (m_)) * 1024); \
            gb[ai_][m_] = *(const u32x4*)(gtb + ((ai_) * 4 + (m_)) * 1024); } while (0)
#pragma unroll
        for (int m = 0; m < 4; ++m) MG_LOAD(0, m);
#pragma unroll
        for (int ai = 0; ai < 2; ++ai) {
#pragma unroll
            for (int m = 0; m < 4; ++m) { const size_t row = (size_t)(row0 + ai * 128 + m * 16); u32x4 wo;
                if (ai == 0) MG_LOAD(1, m);
#pragma unroll
                for (int bj = 0; bj < 2; ++bj) { const unsigned ax = bj ? ga[ai][m].z : ga[ai][m].x, ay = bj ? ga[ai][m].w : ga[ai][m].y, bx = bj ? gb[ai][m].z : gb[ai][m].x, by = bj ? gb[ai][m].w : gb[ai][m].y;
                    float fa[8], fb[8];
                    { const f32x2 t0 = __builtin_amdgcn_cvt_pk_f32_fp8((int)ax, false), t1 = __builtin_amdgcn_cvt_pk_f32_fp8((int)ax, true), t2 = __builtin_amdgcn_cvt_pk_f32_fp8((int)ay, false), t3 = __builtin_amdgcn_cvt_pk_f32_fp8((int)ay, true);
                      fa[0] = t0[0]; fa[1] = t0[1]; fa[2] = t1[0]; fa[3] = t1[1]; fa[4] = t2[0]; fa[5] = t2[1]; fa[6] = t3[0]; fa[7] = t3[1]; }
                    { const f32x2 t0 = __builtin_amdgcn_cvt_pk_f32_fp8((int)bx, false), t1 = __builtin_amdgcn_cvt_pk_f32_fp8((int)bx, true), t2 = __builtin_amdgcn_cvt_pk_f32_fp8((int)by, false), t3 = __builtin_amdgcn_cvt_pk_f32_fp8((int)by, true);
                      fb[0] = t0[0]; fb[1] = t0[1]; fb[2] = t1[0]; fb[3] = t1[1]; fb[4] = t2[0]; fb[5] = t2[1]; fb[6] = t3[0]; fb[7] = t3[1]; }
                    float f[8];
#pragma unroll
                    for (int e = 0; e < 8; ++e) { const float ra = __builtin_amdgcn_rcpf(1.0f + __builtin_amdgcn_exp2f(fa[e]));
                        f[e] = (z < 3) ? ra * (1.0f + __builtin_amdgcn_exp2f(fb[e])) : ra * fin; }
                    f32x4 v0 = acc[ai][bj][m][0], v1 = acc[ai][bj][m][1];
                    v0[0] *= f[0]; v0[1] *= f[1]; v0[2] *= f[2]; v0[3] *= f[3]; v1[0] *= f[4]; v1[1] *= f[5]; v1[2] *= f[6]; v1[3] *= f[7];
                    if (z < 3) { acc[ai][bj][m][0] = v0; acc[ai][bj][m][1] = v1; }
                    else { int w0 = 0, w1 = 0;
                        w0 = __builtin_amdgcn_cvt_pk_fp8_f32(v0[0], v0[1], w0, false); w0 = __builtin_amdgcn_cvt_pk_fp8_f32(v0[2], v0[3], w0, true);
                        w1 = __builtin_amdgcn_cvt_pk_fp8_f32(v1[0], v1[1], w1, false); w1 = __builtin_amdgcn_cvt_pk_fp8_f32(v1[2], v1[3], w1, true);
                        if (bj == 0) { wo.x = (unsigned)w0; wo.y = (unsigned)w1; } else { wo.z = (unsigned)w0; wo.w = (unsigned)w1; } } }
                if (z == 3) *(u32x4*)(MRG + row * DM + col0) = wo; }
            asm volatile("" ::: "memory"); }
#undef MG_LOAD
    }
};
struct EpiOut {
    static constexpr int PERM = 2; static constexpr bool CARRY = false;
    const bf16_t* XBr; bf16_t* R;
    __device__ __forceinline__ void operator()(f32x4 (&acc)[2][2][4][2], const pg8::Unit& u, int wr, int wc, int fr, int fq) const {
        asm volatile("" : "+v"(fr), "+v"(fq));
        const int row0 = u.pm * 256 + wr * 64 + fr, col0 = u.pn * 256 + wc * 64 + 16 * fq;
        u32x4 xw[2][4][2];
#pragma unroll
        for (int ai = 0; ai < 2; ++ai)
#pragma unroll
            for (int m = 0; m < 4; ++m) { const size_t off = (size_t)(row0 + ai * 128 + m * 16) * DM + col0;
#pragma unroll
                for (int bj = 0; bj < 2; ++bj) xw[ai][m][bj] = *(const u32x4*)(XBr + off + bj * 8); }
#pragma unroll
        for (int ai = 0; ai < 2; ++ai) {
#pragma unroll
            for (int m = 0; m < 4; ++m) { const size_t off = (size_t)(row0 + ai * 128 + m * 16) * DM + col0;
#pragma unroll
                for (int bj = 0; bj < 2; ++bj) { const u32x4 w = xw[ai][m][bj];
                    const f32x4 x0 = (f32x4){__uint_as_float(w.x << 16), __uint_as_float(w.x & 0xffff0000u), __uint_as_float(w.y << 16), __uint_as_float(w.y & 0xffff0000u)};
                    const f32x4 x1 = (f32x4){__uint_as_float(w.z << 16), __uint_as_float(w.z & 0xffff0000u), __uint_as_float(w.w << 16), __uint_as_float(w.w & 0xffff0000u)};
                    const f32x4 r0 = x0 * DN_ALPHA + acc[ai][bj][m][0] * 0.00048828125f, r1 = x1 * DN_ALPHA + acc[ai][bj][m][1] * 0.00048828125f;
                    u32x4 w4; w4.x = cvt_pk_bf16(r0[0], r0[1]); w4.y = cvt_pk_bf16(r0[2], r0[3]); w4.z = cvt_pk_bf16(r1[0], r1[1]); w4.w = cvt_pk_bf16(r1[2], r1[3]);
                    *(u32x4*)(R + off + bj * 8) = w4; } }
            asm volatile("" ::: "memory"); }
    }
};

__device__ __forceinline__ void ln_phase(const bf16_t* R, const float* gain, const float* bias, float* OUTF, bf16_t* XB, unsigned char* X8, unsigned char* X4) {
    const int tid_ = ptid(), lane = tid_ & 63, wave = tid_ >> 6;
    const int gw = blockIdx.x * NWAVES + wave, NGW = gridDim.x * NWAVES;
    for (int row = gw; row < MTOK; row += NGW) {
        const u32x4* rp = (const u32x4*)(R + (size_t)row * DM) + lane;
        float v[8][8]; float s = 0.f;
#pragma unroll
        for (int j = 0; j < 8; ++j) { const u32x4 w = rp[64 * j];
            v[j][0] = __uint_as_float(w.x << 16); v[j][1] = __uint_as_float(w.x & 0xffff0000u); v[j][2] = __uint_as_float(w.y << 16); v[j][3] = __uint_as_float(w.y & 0xffff0000u);
            v[j][4] = __uint_as_float(w.z << 16); v[j][5] = __uint_as_float(w.z & 0xffff0000u); v[j][6] = __uint_as_float(w.w << 16); v[j][7] = __uint_as_float(w.w & 0xffff0000u);
#pragma unroll
            for (int e = 0; e < 8; ++e) s += v[j][e]; }
        const float mean = wave_sum(s) * (1.0f / DM); float q = 0.f;
#pragma unroll
        for (int j = 0; j < 8; ++j)
#pragma unroll
            for (int e = 0; e < 8; ++e) { v[j][e] -= mean; q += v[j][e] * v[j][e]; }
        const float rstd = __builtin_amdgcn_rsqf(wave_sum(q) * (1.0f / DM) + LN_EPS);
#pragma unroll
        for (int j = 0; j < 8; ++j) { const int c8 = (lane + 64 * j) * 8;
            const f32x4 g0 = *(const f32x4*)(gain + c8), g1 = *(const f32x4*)(gain + c8 + 4), b0 = *(const f32x4*)(bias + c8), b1 = *(const f32x4*)(bias + c8 + 4);
            const f32x4 o0 = (f32x4){v[j][0], v[j][1], v[j][2], v[j][3]} * rstd * g0 + b0, o1 = (f32x4){v[j][4], v[j][5], v[j][6], v[j][7]} * rstd * g1 + b1;
            if (OUTF) { *(f32x4*)(OUTF + (size_t)row * DM + c8) = o0; *(f32x4*)(OUTF + (size_t)row * DM + c8 + 4) = o1; }
            if (XB) { u32x4 w; w.x = cvt_pk_bf16(o0[0], o0[1]); w.y = cvt_pk_bf16(o0[2], o0[3]); w.z = cvt_pk_bf16(o1[0], o1[1]); w.w = cvt_pk_bf16(o1[2], o1[3]); *(u32x4*)(XB + (size_t)row * DM + c8) = w;
                int w0 = 0, w1 = 0; w0 = __builtin_amdgcn_cvt_pk_fp8_f32(o0[0], o0[1], w0, false); w0 = __builtin_amdgcn_cvt_pk_fp8_f32(o0[2], o0[3], w0, true);
                w1 = __builtin_amdgcn_cvt_pk_fp8_f32(o1[0], o1[1], w1, false); w1 = __builtin_amdgcn_cvt_pk_fp8_f32(o1[2], o1[3], w1, true);
                *(u32x2*)(X8 + (size_t)row * DM + c8) = (u32x2){(unsigned)w0, (unsigned)w1};
                *(unsigned*)(X4 + (((size_t)row * DM + c8) >> 1)) = pack_fp4x8(o0[0] * FP4_XS, o0[1] * FP4_XS, o0[2] * FP4_XS, o0[3] * FP4_XS, o1[0] * FP4_XS, o1[1] * FP4_XS, o1[2] * FP4_XS, o1[3] * FP4_XS); } }
    }
}
__device__ __forceinline__ void cumsum_phase(const float* SM, const float* f_bias, float* CUM) {
    if ((int)blockIdx.x < (int)gridDim.x - BATCH) return;
    const int tid_ = ptid(), b = (int)blockIdx.x - ((int)gridDim.x - BATCH), h = tid_ >> 6, lane = tid_ & 63;
    const float fb = f_bias[h];
    const float* src = SM + ((size_t)b * SEQ + lane * 64) * 256 + SMC_BF + h;
    float run = 0.f; float vals[64];
#pragma unroll
    for (int j = 0; j < 64; ++j) { const float xv = src[(size_t)j * 256] + fb; const float ls = fminf(xv, 0.f) - log1pf(__expf(-fabsf(xv))); run += ls; vals[j] = run; }
    float incl = run;
#pragma unroll
    for (int o = 1; o < 64; o <<= 1) { const float t = __shfl_up(incl, o); if (lane >= o) incl += t; }
    const float offs = incl - run;
    float* dst = CUM + ((size_t)b * 8 + h) * SEQ + lane * 64;
#pragma unroll
    for (int j = 0; j < 64; j += 4) *(f32x4*)(dst + j) = (f32x4){(vals[j] + offs) * LOG2E, (vals[j + 1] + offs) * LOG2E, (vals[j + 2] + offs) * LOG2E, (vals[j + 3] + offs) * LOG2E};
}
__device__ __forceinline__ void krope_phase(const float* SM, const float* CS, unsigned char* D8) {
    const size_t gt = (size_t)blockIdx.x * NTHREADS + ptid(), GT = (size_t)gridDim.x * NTHREADS;
    for (size_t i = gt; i < (size_t)MTOK * 32; i += GT) {
        const size_t row = i >> 5; const int p = (int)(i & 31);
        const f32x2 t = *(const f32x2*)(SM + row * 256 + SMC_DKR + 2 * p), cs = *(const f32x2*)(CS + row * 64 + 2 * p);
        { int w = 0; w = __builtin_amdgcn_cvt_pk_fp8_f32(t[0] * cs[0] - t[1] * cs[1], t[0] * cs[1] + t[1] * cs[0], w, false); *(unsigned short*)(D8 + row * D8W + 2048 + 2 * p) = (unsigned short)w; }
    }
}

__device__ __forceinline__ int wave_count7(unsigned c) { int t = 0;
#pragma unroll
    for (int b = 0; b < 7; ++b) t += __builtin_popcountll(__ballot((c >> b) & 1u)) << b;
    return t; }
__device__ __forceinline__ unsigned f2ord(float f) { const unsigned u = __float_as_uint(f); return u ^ ((u >> 31) ? 0xffffffffu : 0x80000000u); }
template <int DBG = 0>
__device__ __forceinline__ void indexer_unit(LAS unsigned char* lds, const bf16_t* P, const float* SM, float* SC, unsigned long long* MASK, int b, int qb) {
    constexpr int QSTR = 2064 + 256;
    constexpr int L_IQ = 0, L_STG = 32 * QSTR;
    const int tid = ptid(), wid = __builtin_amdgcn_readfirstlane(tid >> 6), lane = tid & 63, r32 = lane & 31, hi = lane >> 5;
    const int t0 = qb * 32; const size_t row0 = (size_t)b * SEQ + t0;
#pragma unroll
    for (int i = 0; i < 8; ++i) { const int ci = tid + 512 * i, r = ci >> 7, cc = ci & 127;
        const bf16x8 v = *(const bf16x8*)(P + (row0 + r) * INP + PC_AIQ + cc * 8);
        *(LAS bf16x8*)(lds + L_IQ + r * QSTR + cc * 16) = v; }
    float w[16];
    { const float* wp = SM + (row0 + r32) * 256 + SMC_AIW;
#pragma unroll
      for (int j = 0; j < 4; ++j) { const f32x4 v = *(const f32x4*)(wp + 4 * j); w[4 * j] = v[0] * 0.03125f; w[4 * j + 1] = v[1] * 0.03125f; w[4 * j + 2] = v[2] * 0.03125f; w[4 * j + 3] = v[3] * 0.03125f; } }
    __syncthreads();
    { const int r = tid >> 4, d0 = (tid & 15) * 4;
      const float* wp = SM + (row0 + r) * 256 + SMC_AIW; float qb4[4] = {0.f, 0.f, 0.f, 0.f};
#pragma unroll
      for (int h = 0; h < 16; ++h) { const float wh = wp[h] * 0.03125f; const u32x2 q2 = *(const LAS u32x2*)(lds + L_IQ + r * QSTR + (h * 64 + d0) * 2);
          qb4[0] = fmaf(wh, __uint_as_float(q2.x << 16), qb4[0]); qb4[1] = fmaf(wh, __uint_as_float(q2.x & 0xffff0000u), qb4[1]);
          qb4[2] = fmaf(wh, __uint_as_float(q2.y << 16), qb4[2]); qb4[3] = fmaf(wh, __uint_as_float(q2.y & 0xffff0000u), qb4[3]); }
      u32x2 hi2, lo2; hi2.x = cvt_pk_bf16(qb4[0], qb4[1]); hi2.y = cvt_pk_bf16(qb4[2], qb4[3]);
      lo2.x = cvt_pk_bf16(qb4[0] - __uint_as_float(hi2.x << 16), qb4[1] - __uint_as_float(hi2.x & 0xffff0000u)); lo2.y = cvt_pk_bf16(qb4[2] - __uint_as_float(hi2.y << 16), qb4[3] - __uint_as_float(hi2.y & 0xffff0000u));
      *(LAS u32x2*)(lds + L_IQ + r * QSTR + (1024 + d0) * 2) = hi2; *(LAS u32x2*)(lds + L_IQ + r * QSTR + (1088 + d0) * 2) = lo2; }
    __syncthreads();
    LAS float* stg = (LAS float*)(lds + L_STG + wid * 4608);
    const int nkt = qb + 1;
    bf16x8 kfn[4];
    if (wid < nkt) { const bf16_t* kp = P + ((size_t)b * SEQ + wid * 32 + r32) * INP + PC_AIK + 8 * hi;
#pragma unroll
      for (int st = 0; st < 4; ++st) kfn[st] = *(const bf16x8*)(kp + 16 * st); }
    for (int kt = wid; kt < (DBG == 2 ? 0 : nkt); kt += NWAVES) {
        const int s0 = kt * 32;
        int qoff = L_IQ + r32 * QSTR + hi * 16; asm volatile("" : "+v"(qoff));
        bf16x8 kf[4];
#pragma unroll
        for (int st = 0; st < 4; ++st) kf[st] = kfn[st];
        if (kt + NWAVES < nkt) { const bf16_t* kp = P + ((size_t)b * SEQ + s0 + NWAVES * 32 + r32) * INP + PC_AIK + 8 * hi;
#pragma unroll
          for (int st = 0; st < 4; ++st) kfn[st] = *(const bf16x8*)(kp + 16 * st); }
        f32x16 sc;
#pragma unroll
        for (int r = 0; r < 16; ++r) sc[r] = 0.f;
#pragma unroll
        for (int st = 0; st < 8; ++st) { const bf16x8 qf = *(const LAS bf16x8*)(lds + qoff + (1024 + 16 * st) * 2);
            sc = __builtin_amdgcn_mfma_f32_32x32x16_bf16(kf[st & 3], qf, sc, 0, 0, 0); }
        f32x16 accA, accB;
#define IDX_MM(dst, h_) do { _Pragma("unroll") for (int r = 0; r < 16; ++r) dst[r] = 0.f; \
            _Pragma("unroll") for (int st = 0; st < 4; ++st) { const bf16x8 qf = *(const LAS bf16x8*)(lds + qoff + ((h_) * 64 + 16 * st) * 2); dst = __builtin_amdgcn_mfma_f32_32x32x16_bf16(kf[st], qf, dst, 0, 0, 0); } } while (0)
#define IDX_FMA(src, h_) do { asm volatile("s_nop 15" ::: ); \
            _Pragma("unroll") for (int r = 0; r < 16; ++r) asm volatile("v_fma_f32 %0, %1, |%2|, %0" : "+v"(sc[r]) : "v"(w[h_]), "v"(src[r])); } while (0)
        IDX_MM(accA, 0);
#pragma unroll
        for (int h = 0; h < 16; h += 2) {
            IDX_MM(accB, h + 1);
            __builtin_amdgcn_sched_barrier(0);
            IDX_FMA(accA, h);
            __builtin_amdgcn_sched_barrier(0);
            if (h + 2 < 16) IDX_MM(accA, h + 2);
            __builtin_amdgcn_sched_barrier(0);
            if (h + 2 >= 16) asm volatile("s_nop 15" ::: );
            IDX_FMA(accB, h + 1);
            __builtin_amdgcn_sched_barrier(0);
        }
#undef IDX_MM
#undef IDX_FMA
#pragma unroll
        for (int g = 0; g < 4; ++g) *(LAS f32x4*)(stg + r32 * 36 + 8 * g + 4 * hi) = (f32x4){sc[4 * g], sc[4 * g + 1], sc[4 * g + 2], sc[4 * g + 3]};
        LDS_WAIT();
#pragma unroll
        for (int i = 0; i < 16; ++i) { const float v = stg[(2 * i + hi) * 36 + r32]; SC[(row0 + 2 * i + hi) * SEQ + s0 + r32] = v; }
        LDS_WAIT();
    }
    VM_WAIT();
    __syncthreads();
#define IDX_LOADROW(dst, qi_) do { int ln_ = lane; asm volatile("" : "+v"(ln_)); const float* sr_ = SC + (row0 + wid * 4 + (qi_)) * SEQ + ln_; \
        _Pragma("unroll") for (int j = 0; j < 64; ++j) dst[j] = __float_as_uint(sr_[64 * j]); } while (0)
    auto process = [&](unsigned (&key)[64], const int qi) __attribute__((always_inline)) {
        const int t = t0 + wid * 4 + qi, n = t + 1;
        int ln = lane; asm volatile("" : "+v"(ln));
#pragma unroll
        for (int j = 0; j < 64; ++j) asm volatile("" : "+v"(key[j]));
#pragma unroll
        for (int j = 0; j < 64; ++j) key[j] = (ln < n - 64 * j) ? f2ord(__uint_as_float(key[j])) : 0u;
        unsigned T = 0u; int need = 0;
        const int ng = (n + 511) >> 9;
        if (n > 256) {
            bool exact = false;
#pragma unroll 1
            for (int bit = 31; bit >= 0; --bit) {
                const unsigned cand = T | (1u << bit); int cnt = 0;
#pragma unroll
                for (int g = 0; g < 8; ++g) { if (g < ng) {
#pragma unroll
                    for (int jj = 0; jj < 8; ++jj) cnt += __builtin_popcountll(__ballot(key[8 * g + jj] >= cand)); }
                    __builtin_amdgcn_sched_barrier(0); }
                if (cnt == 256) { T = cand - 1u; exact = true; break; }
                if (cnt > 256) T = cand;
            }
            if (!exact) {
                int cgt = 0;
#pragma unroll
                for (int g = 0; g < 8; ++g) { if (g < ng) {
#pragma unroll
                    for (int jj = 0; jj < 8; ++jj) cgt += __builtin_popcountll(__ballot(key[8 * g + jj] > T)); }
                    __builtin_amdgcn_sched_barrier(0); }
                need = 256 - cgt;
            }
        }
        int mwlo = 0, mwhi = 0, run = 0; int ln2 = ln; asm volatile("" : "+v"(ln2));
#pragma unroll
        for (int g = 0; g < 8; ++g) { if (g < ng) {
#pragma unroll
            for (int jj = 0; jj < 8; ++jj) { const int j = 8 * g + jj;
                const bool eq = key[j] == T;
                const unsigned long long eqm = __ballot(eq);
                const int rank = run + (int)__builtin_amdgcn_mbcnt_hi((unsigned)(eqm >> 32), __builtin_amdgcn_mbcnt_lo((unsigned)eqm, 0u));
                const unsigned long long sel = __ballot(key[j] > T || (eq && rank < need));
                run += __builtin_popcountll(eqm);
                mwlo = (ln2 == j) ? (int)(unsigned)sel : mwlo; mwhi = (ln2 == j) ? (int)(unsigned)(sel >> 32) : mwhi;
                __builtin_amdgcn_sched_barrier(0); } }
        }
        MASK[(row0 + wid * 4 + qi) * 64 + lane] = ((unsigned long long)(unsigned)mwhi << 32) | (unsigned)mwlo;
    };
    if (DBG != 1) {
        unsigned ka[64], kb[64];
        IDX_LOADROW(ka, 0);
#pragma unroll 1
        for (int pr = 0; pr < 2; ++pr) {
            IDX_LOADROW(kb, 2 * pr + 1);
            process(ka, 2 * pr);
            if (pr == 0) IDX_LOADROW(ka, 2);
            process(kb, 2 * pr + 1);
        }
    }
#undef IDX_LOADROW
    __syncthreads();
}
template <int DBG = 0>
__device__ __forceinline__ void indexer_phase(LAS unsigned char* lds, const Args& a) {
    const bf16_t* P = (const bf16_t*)(a.ws + WS_P); const float* SM = (const float*)(a.ws + WS_SM); float* SC = (float*)(a.ws + WS_SC); unsigned long long* MASK = (unsigned long long*)(a.ws + WS_MASK);
    for (int p = blockIdx.x; p < 256; p += gridDim.x) { const int b = p >> 6, q = p & 63;
#pragma unroll 1
        for (int k = 0; k < 2; ++k) indexer_unit<DBG>(lds, P, SM, SC, MASK, b, k == 0 ? 127 - q : q); }
}

template <int OFF> __device__ __forceinline__ s16x4 tr_read(int vb) { s16x4 r; asm volatile("ds_read_b64_tr_b16 %0, %1 offset:%2" : "=&v"(r) : "v"(vb), "i"(OFF) : "memory"); return r; }
using pg8::v8i_t; using pg8::cat8;
__device__ __forceinline__ u32x2 bf8_to_fp8(bf16x8 v) { const u32x4 w = __builtin_bit_cast(u32x4, v); int a = 0, b = 0;
    a = __builtin_amdgcn_cvt_pk_fp8_f32(__uint_as_float(w.x << 16), __uint_as_float(w.x & 0xffff0000u), a, false); a = __builtin_amdgcn_cvt_pk_fp8_f32(__uint_as_float(w.y << 16), __uint_as_float(w.y & 0xffff0000u), a, true);
    b = __builtin_amdgcn_cvt_pk_fp8_f32(__uint_as_float(w.z << 16), __uint_as_float(w.z & 0xffff0000u), b, false); b = __builtin_amdgcn_cvt_pk_fp8_f32(__uint_as_float(w.w << 16), __uint_as_float(w.w & 0xffff0000u), b, true);
    return (u32x2){(unsigned)a, (unsigned)b}; }
#ifndef ATT_PV8_MASK
#define ATT_PV8_MASK 0xB
#endif
#ifndef ATT_Q8_MASK
#define ATT_Q8_MASK 0xF
#endif
template <int VAR, int DBG = 0>
__device__ __forceinline__ void attn_unit(LAS unsigned char* lds, const Args& a, int layer, int b, int hidx, int qblk, unsigned* qh, volatile LAS unsigned* bw) {
    constexpr int DQK = (VAR == 2) ? 64 : (VAR == 3 ? 192 : 128), DV = (VAR == 2) ? 64 : 128;
    constexpr bool Q8 = ((ATT_Q8_MASK >> VAR) & 1) != 0;
    constexpr bool PV8 = Q8 && ((ATT_PV8_MASK >> VAR) & 1) != 0 && DV == 128;
    constexpr bool KV8S = PV8 && VAR != 2;
    constexpr int KSTR = Q8 ? DQK + 16 : DQK * 2 + 16, VSTR = PV8 ? DV + 32 : DV * 2 + 64;
    constexpr int KCH = DQK / 8, VCH = DV / 8, KPT = DQK / 64, VPT = DV / 64, NST = DQK / 16, ND0 = DV / 32;
    constexpr int LK = 0, LV = 2 * 64 * KSTR, LCK = LV + 2 * 64 * VSTR;
    constexpr float THR = 8.0f;
    const int tid = ptid(), wid = __builtin_amdgcn_readfirstlane(tid >> 6), lane = tid & 63, r32 = lane & 31, hi = lane >> 5;
    const bf16_t* P = (const bf16_t*)(a.ws + WS_P);
    int head, q0u, tq0w, kt_lo, kt_hi, kt_last_w;
    if constexpr (VAR == 0) { head = hidx * 4 + (wid >> 1); q0u = qblk * 64; tq0w = q0u + 32 * (wid & 1); kt_lo = 0; kt_hi = qblk; kt_last_w = qblk; }
    else if constexpr (VAR == 2) { head = hidx * 8 + wid; q0u = qblk * 32; tq0w = q0u; kt_lo = (q0u > 127 ? q0u - 127 : 0) >> 6; kt_hi = (q0u + 31) >> 6; kt_last_w = kt_hi; }
    else { head = hidx; q0u = qblk * 256; tq0w = q0u + 32 * wid; kt_lo = 0; kt_hi = 4 * qblk + 3; kt_last_w = 4 * qblk + (wid >> 1); }
    const int tq = tq0w + r32; const size_t rowq = (size_t)b * SEQ + tq;
    const bf16_t* qp;
    if constexpr (VAR == 0) qp = P + rowq * INP + PC_AQ + head * 128;
    else if constexpr (VAR == 1) qp = P + rowq * INP + PC_BQ + head * 128;
    else if constexpr (VAR == 2) qp = P + rowq * INP + PC_CQ + head * 64;
    else qp = (const bf16_t*)(a.ws + WS_DQ) + rowq * 1536 + head * 192;
    bf16x8 qf[Q8 ? 1 : NST]; v8i_t q8[Q8 ? NST / 4 : 1];
    if constexpr (Q8) {
#pragma unroll
        for (int s4 = 0; s4 < NST / 4; ++s4) { const bf16_t* q4 = qp + 64 * s4 + 32 * hi;
            const u32x2 c0 = bf8_to_fp8(*(const bf16x8*)(q4)), c1 = bf8_to_fp8(*(const bf16x8*)(q4 + 8)), c2 = bf8_to_fp8(*(const bf16x8*)(q4 + 16)), c3 = bf8_to_fp8(*(const bf16x8*)(q4 + 24));
            q8[s4] = (v8i_t){(int)c0.x, (int)c0.y, (int)c1.x, (int)c1.y, (int)c2.x, (int)c2.y, (int)c3.x, (int)c3.y}; }
    } else {
#pragma unroll
        for (int st = 0; st < NST; ++st) qf[st] = *(const bf16x8*)(qp + 16 * st + 8 * hi); }
    const bf16_t *kb, *vb_, *kb2 = nullptr; int ldk;
    if constexpr (VAR == 0) { kb = P + PC_AK + hidx * 128; vb_ = P + PC_AV + hidx * 128; ldk = INP; }
    else if constexpr (VAR == 1) { kb = P + PC_BK + head * 128; vb_ = P + PC_BV + head * 128; ldk = INP; }
    else if constexpr (VAR == 2) { kb = P + PC_CK + hidx * 64; vb_ = P + PC_CV + hidx * 64; ldk = INP; }
    else { kb = (const bf16_t*)(a.ws + WS_DKV) + head * 256; vb_ = kb + 128; kb2 = (const bf16_t*)(a.ws + WS_DKR); ldk = 2048; }
    const size_t brow = (size_t)b * SEQ;
    unsigned gk[KPT], lk[KPT], gv[VPT], lv[VPT]; bool krope[KPT];
#pragma unroll
    for (int i = 0; i < KPT; ++i) { const int ci = tid + 512 * i, kr = ci / KCH, kc = ci % KCH; krope[i] = (VAR == 3) && kc >= 16;
        gk[i] = krope[i] ? (unsigned)(kr * 64 + (kc - 16) * 8) * 2u : (unsigned)(kr * ldk + kc * 8) * 2u; lk[i] = (unsigned)(LK + kr * KSTR + kc * (Q8 ? 8 : 16)); }
#pragma unroll
    for (int i = 0; i < VPT; ++i) { const int ci = tid + 512 * i, vr = ci / VCH, vc = ci % VCH; gv[i] = (unsigned)(vr * ldk + vc * 8) * 2u; const int vrp = PV8 ? ((vr & ~15) | (vr & 3) | ((vr & 8) >> 1) | ((vr & 4) << 1)) : vr; lv[i] = (unsigned)(LV + vrp * VSTR + vc * (PV8 ? 8 : 16)); }
    const int r8_ = tid >> 3, c8_ = tid & 7, r8p_ = (r8_ & ~15) | (r8_ & 3) | ((r8_ & 8) >> 1) | ((r8_ & 4) << 1);
    constexpr int W8 = (VAR == 3) ? D8W : KV8W, VOFF8 = (VAR == 0) ? 256 : (VAR == 1 ? 1024 : 128);
    const unsigned char* kv8p = a.ws + (VAR == 3 ? WS_D8 : WS_KV8) + (VAR == 0 ? hidx * 128 : (VAR == 1 ? 512 + head * 128 : head * 256)) + (size_t)r8_ * W8 + c8_ * 16;
    const unsigned char* kr8p = a.ws + WS_D8 + 2048 + (size_t)(tid >> 2) * D8W + (tid & 3) * 16; const unsigned lkr8 = (unsigned)(LK + (tid >> 2) * KSTR + 128 + (tid & 3) * 16); u32x4 kr8 = (u32x4){0u, 0u, 0u, 0u};
    const unsigned lk8 = (unsigned)(LK + r8_ * KSTR + c8_ * 16), lv8 = (unsigned)(LV + r8p_ * VSTR + c8_ * 16); u32x4 ks8 = (u32x4){0u, 0u, 0u, 0u}, vs8 = (u32x4){0u, 0u, 0u, 0u};
    bf16x8 ks[1][KPT], vs[1][VPT]; float ckv[1] = {0.f}; unsigned long long mnx[1] = {0ull};
    const float* cum = (const float*)(a.ws + WS_CUM) + ((size_t)b * 8 + head) * SEQ;
    float cref = 0.f; if constexpr (VAR == 1) cref = cum[q0u];
    const unsigned long long* mrow = (const unsigned long long*)(a.ws + WS_MASK) + rowq * 64;
#define AT_ISSUE(kt_, S_) do { const int k0_ = (kt_) * 64; \
        const char* kt_base_ = (const char*)(kb + (brow + k0_) * ldk); const char* vt_base_ = (const char*)(vb_ + (brow + k0_) * ldk); \
        const char* k2_base_ = (VAR == 3) ? (const char*)(kb2 + (brow + k0_) * 64) : kt_base_; \
        if constexpr (KV8S) { ks8 = *(const u32x4*)(kv8p + (brow + k0_) * W8); vs8 = *(const u32x4*)(kv8p + (brow + k0_) * W8 + VOFF8); \
            if (VAR == 3 && tid < 256) kr8 = *(const u32x4*)(kr8p + (brow + k0_) * D8W); } \
        else { _Pragma("unroll") for (int i = 0; i < KPT; ++i) ks[S_][i] = *(const bf16x8*)((krope[i] ? k2_base_ : kt_base_) + gk[i]); \
               _Pragma("unroll") for (int i = 0; i < VPT; ++i) vs[S_][i] = *(const bf16x8*)(vt_base_ + gv[i]); } \
        if (VAR == 1 && tid < 64) ckv[S_] = cum[k0_ + tid]; \
        if (VAR == 0) mnx[S_] = mrow[(kt_)]; } while (0)
#define AT_WRITE(buf_, S_) do { \
        if constexpr (KV8S) { *(LAS u32x4*)(lds + (buf_) * 64 * KSTR + lk8) = ks8; *(LAS u32x4*)(lds + (buf_) * 64 * VSTR + lv8) = vs8; \
            if (VAR == 3 && tid < 256) *(LAS u32x4*)(lds + (buf_) * 64 * KSTR + lkr8) = kr8; } else { \
        _Pragma("unroll") for (int i = 0; i < KPT; ++i) { if constexpr (Q8) *(LAS u32x2*)(lds + (buf_) * 64 * KSTR + lk[i]) = bf8_to_fp8(ks[S_][i]); else *(LAS bf16x8*)(lds + (buf_) * 64 * KSTR + lk[i]) = ks[S_][i]; } \
        _Pragma("unroll") for (int i = 0; i < VPT; ++i) { if constexpr (PV8) *(LAS u32x2*)(lds + (buf_) * 64 * VSTR + lv[i]) = bf8_to_fp8(vs[S_][i]); else *(LAS bf16x8*)(lds + (buf_) * 64 * VSTR + lv[i]) = vs[S_][i]; } } \
        if (VAR == 1 && tid < 64) *(LAS float*)(lds + LCK + (buf_) * 256 + tid * 4) = cref - ckv[S_]; } while (0)
    f32x16 o[ND0];
#pragma unroll
    for (int d = 0; d < ND0; ++d)
#pragma unroll
        for (int r = 0; r < 16; ++r) o[d][r] = 0.f;
    constexpr bool MF = (VAR != 1);
    float m = MF ? -65536.0f : -1e30f, l = 0.f;
    float slope2 = 0.f;
    if constexpr (VAR == 0) slope2 = __builtin_amdgcn_exp2f(-(float)(head + 1)) * LOG2E;
    if constexpr (VAR == 2) slope2 = __builtin_amdgcn_exp2f(-0.5f * (float)(head + 1)) * LOG2E;
    const int g4 = lane >> 4, i16 = lane & 15;
    const int kq_off = r32 * KSTR + hi * (Q8 ? 32 : 16);
    const int vrd0 = (int)(uintptr_t)(lds + LV) + (4 * (g4 >> 1) + (i16 >> 2)) * VSTR + (16 * (g4 & 1) + 4 * (i16 & 3)) * 2;
    const int vrd8 = (int)(uintptr_t)(lds + LV) + (8 * (g4 >> 1) + (i16 >> 1)) * VSTR + 16 * (g4 & 1) + 8 * (i16 & 1);
    AT_ISSUE(kt_lo, 0); unsigned long long mcur = 0ull; if constexpr (VAR == 0) mcur = mnx[0];
    AT_WRITE(0, 0);
    if (DBG != 4 && kt_lo < kt_hi) AT_ISSUE(kt_lo + 1, 0);
    __syncthreads();
    bf16x8 pb[4]; v8i_t p8 = (v8i_t){0, 0, 0, 0, 0, 0, 0, 0};
#define AT_PV(D0, vrd) do { \
                const s16x4 l0 = tr_read<0 * 16 * VSTR + (D0) * 64>(vrd), h0 = tr_read<0 * 16 * VSTR + 8 * VSTR + (D0) * 64>(vrd); \
                const s16x4 l1 = tr_read<1 * 16 * VSTR + (D0) * 64>(vrd), h1 = tr_read<1 * 16 * VSTR + 8 * VSTR + (D0) * 64>(vrd); \
                const s16x4 l2 = tr_read<2 * 16 * VSTR + (D0) * 64>(vrd), h2 = tr_read<2 * 16 * VSTR + 8 * VSTR + (D0) * 64>(vrd); \
                const s16x4 l3 = tr_read<3 * 16 * VSTR + (D0) * 64>(vrd), h3 = tr_read<3 * 16 * VSTR + 8 * VSTR + (D0) * 64>(vrd); \
                asm volatile("s_waitcnt lgkmcnt(0)" ::: "memory"); __builtin_amdgcn_sched_barrier(0); \
                o[D0] = __builtin_amdgcn_mfma_f32_32x32x16_bf16((bf16x8){l0[0], l0[1], l0[2], l0[3], h0[0], h0[1], h0[2], h0[3]}, pb[0], o[D0], 0, 0, 0); \
                o[D0] = __builtin_amdgcn_mfma_f32_32x32x16_bf16((bf16x8){l1[0], l1[1], l1[2], l1[3], h1[0], h1[1], h1[2], h1[3]}, pb[1], o[D0], 0, 0, 0); \
                o[D0] = __builtin_amdgcn_mfma_f32_32x32x16_bf16((bf16x8){l2[0], l2[1], l2[2], l2[3], h2[0], h2[1], h2[2], h2[3]}, pb[2], o[D0], 0, 0, 0); \
                o[D0] = __builtin_amdgcn_mfma_f32_32x32x16_bf16((bf16x8){l3[0], l3[1], l3[2], l3[3], h3[0], h3[1], h3[2], h3[3]}, pb[3], o[D0], 0, 0, 0); } while (0)
#define AT_PV8(D0, vrd) do { \
                u32x2 t0_, t1_, t2_, t3_; \
                asm volatile("ds_read_b64_tr_b8 %0, %1 offset:%2" : "=&v"(t0_) : "v"(vrd), "i"(0 * 16 * VSTR + (D0) * 32) : "memory"); \
                asm volatile("ds_read_b64_tr_b8 %0, %1 offset:%2" : "=&v"(t1_) : "v"(vrd), "i"(1 * 16 * VSTR + (D0) * 32) : "memory"); \
                asm volatile("ds_read_b64_tr_b8 %0, %1 offset:%2" : "=&v"(t2_) : "v"(vrd), "i"(2 * 16 * VSTR + (D0) * 32) : "memory"); \
                asm volatile("ds_read_b64_tr_b8 %0, %1 offset:%2" : "=&v"(t3_) : "v"(vrd), "i"(3 * 16 * VSTR + (D0) * 32) : "memory"); \
                asm volatile("s_waitcnt lgkmcnt(0)" : "+v"(t0_), "+v"(t1_), "+v"(t2_), "+v"(t3_) :: "memory"); __builtin_amdgcn_sched_barrier(0); \
                { const v8i_t va_ = (v8i_t){(int)t0_.x, (int)t0_.y, (int)t1_.x, (int)t1_.y, (int)t2_.x, (int)t2_.y, (int)t3_.x, (int)t3_.y}; \
                  asm volatile("v_mfma_f32_32x32x64_f8f6f4 %0, %1, %2, %0" : "+v"(o[D0]) : "v"(va_), "v"(p8)); } } while (0)
#define AT_PV_ALL(vbuf_) do { if constexpr (PV8) { const int vrd_ = vrd8 + (vbuf_) * 64 * VSTR; asm volatile("s_nop 1" ::: "memory"); AT_PV8(0, vrd_); AT_PV8(1, vrd_); AT_PV8(2, vrd_); AT_PV8(3, vrd_); } \
        else { const int vrd_ = vrd0 + (vbuf_) * 64 * VSTR; AT_PV(0, vrd_); AT_PV(1, vrd_); if constexpr (ND0 == 4) { AT_PV(2, vrd_); AT_PV(3, vrd_); } } } while (0)
    for (int kt2 = kt_lo; kt2 <= kt_hi; kt2 += 2) {
#pragma unroll
    for (int hs = 0; hs < 2; ++hs) {
        const int kt = kt2 + hs; if (kt > kt_hi) break;
        const int buf = hs, k0 = kt * 64;
        if (kt <= kt_last_w && !(DBG == 6 && wid >= 4)) {
            f32x16 p[2];
            const int dq = tq - k0 - 4 * hi;
            if constexpr (VAR == 0 || VAR == 2) { const float base = -slope2 * (float)dq - m;
#pragma unroll
                for (int sub = 0; sub < 2; ++sub)
#pragma unroll
                    for (int r = 0; r < 16; ++r) p[sub][r] = fmaf(slope2, (float)(32 * sub + (r & 3) + 8 * (r >> 2)), base); }
            else if constexpr (VAR == 1) { const LAS float* ck = (const LAS float*)(lds + LCK + buf * 256);
#pragma unroll
                for (int sub = 0; sub < 2; ++sub)
#pragma unroll
                    for (int g = 0; g < 4; ++g) { const f32x4 c4 = *(const LAS f32x4*)(ck + 32 * sub + 8 * g + 4 * hi);
                        p[sub][4 * g] = c4[0]; p[sub][4 * g + 1] = c4[1]; p[sub][4 * g + 2] = c4[2]; p[sub][4 * g + 3] = c4[3]; } }
            else {
#pragma unroll
                for (int sub = 0; sub < 2; ++sub)
#pragma unroll
                    for (int r = 0; r < 16; ++r) p[sub][r] = -m; }
            const LAS unsigned char* kbuf = lds + LK + buf * 64 * KSTR + kq_off;
            if constexpr (Q8) {
                asm volatile("s_nop 1" ::: "memory");
#pragma unroll
                for (int s4 = 0; s4 < NST / 4; ++s4) {
                    const v8i_t ka = cat8(*(const LAS bf16x8*)(kbuf + s4 * 64), *(const LAS bf16x8*)(kbuf + s4 * 64 + 16));
                    const v8i_t kb8 = cat8(*(const LAS bf16x8*)(kbuf + 32 * KSTR + s4 * 64), *(const LAS bf16x8*)(kbuf + 32 * KSTR + s4 * 64 + 16));
                    if (DBG != 3) { asm volatile("v_mfma_f32_32x32x64_f8f6f4 %0, %1, %2, %0" : "+v"(p[0]) : "v"(ka), "v"(q8[s4]));
                                    asm volatile("v_mfma_f32_32x32x64_f8f6f4 %0, %1, %2, %0" : "+v"(p[1]) : "v"(kb8), "v"(q8[s4])); } }
                asm volatile("s_nop 15\n\ts_nop 7" : "+v"(p[0]), "+v"(p[1]) :: "memory");
            } else {
            constexpr int GS = (VAR == 3) ? 1 : 2, NG = NST / GS;
            bf16x8 kfa[2 * GS], kfb[2 * GS];
#define AT_LDK(dst, g_) do { _Pragma("unroll") for (int e = 0; e < GS; ++e) { dst[2 * e] = *(const LAS bf16x8*)(kbuf + (GS * (g_) + e) * 32); dst[2 * e + 1] = *(const LAS bf16x8*)(kbuf + 32 * KSTR + (GS * (g_) + e) * 32); } } while (0)
#define AT_MMK(src, g_) do { _Pragma("unroll") for (int e = 0; e < GS; ++e) { p[0] = __builtin_amdgcn_mfma_f32_32x32x16_bf16(src[2 * e], qf[GS * (g_) + e], p[0], 0, 0, 0); \
                                 p[1] = __builtin_amdgcn_mfma_f32_32x32x16_bf16(src[2 * e + 1], qf[GS * (g_) + e], p[1], 0, 0, 0); } } while (0)
            AT_LDK(kfa, 0);
#pragma unroll
            for (int g = 0; g < NG; g += 2) {
                if (g + 1 < NG) AT_LDK(kfb, g + 1);
                __builtin_amdgcn_sched_barrier(0);
                if (DBG != 3) AT_MMK(kfa, g);
                if (g + 1 < NG) { if (g + 2 < NG) AT_LDK(kfa, g + 2);
                    __builtin_amdgcn_sched_barrier(0);
                    if (DBG != 3) AT_MMK(kfb, g + 1); }
            }
#undef AT_LDK
#undef AT_MMK
            }
            if constexpr (VAR == 0) {
#pragma unroll
                for (int sub = 0; sub < 2; ++sub) { const unsigned wb = (unsigned)(mcur >> (32 * sub)) >> (4 * hi);
#pragma unroll
                    for (int r = 0; r < 16; ++r) p[sub][r] = ((wb >> ((r & 3) + 8 * (r >> 2))) & 1u) ? p[sub][r] : -INFINITY; }
            } else if constexpr (VAR == 2) {
#pragma unroll
                for (int sub = 0; sub < 2; ++sub)
#pragma unroll
                    for (int r = 0; r < 16; ++r) p[sub][r] = ((unsigned)(dq - (32 * sub + (r & 3) + 8 * (r >> 2))) <= 127u) ? p[sub][r] : -INFINITY;
            } else {
                if (k0 + 63 > tq0w) {
#pragma unroll
                    for (int sub = 0; sub < 2; ++sub)
#pragma unroll
                        for (int r = 0; r < 16; ++r) p[sub][r] = ((32 * sub + (r & 3) + 8 * (r >> 2)) <= dq) ? p[sub][r] : -INFINITY; }
            }
            if constexpr (DBG != 2) {
            asm volatile("s_nop 15\n\ts_nop 7" ::: "memory");
            float pm;
            { float ma, mb_;
              asm volatile("v_max3_f32 %0, %1, %2, %3" : "=v"(ma) : "v"(p[0][0]), "v"(p[0][1]), "v"(p[1][0]));
              asm volatile("v_max3_f32 %0, %1, %2, %3" : "=v"(mb_) : "v"(p[0][2]), "v"(p[0][3]), "v"(p[1][1]));
              asm volatile("v_max3_f32 %0, %1, %2, %3" : "+v"(ma) : "v"(ma), "v"(p[1][2]), "v"(p[1][3]));
#pragma unroll
              for (int r = 4; r < 16; r += 4) {
                  asm volatile("v_max3_f32 %0, %1, %2, %3" : "+v"(ma) : "v"(ma), "v"(p[0][r]), "v"(p[0][r + 1]));
                  asm volatile("v_max3_f32 %0, %1, %2, %3" : "+v"(mb_) : "v"(mb_), "v"(p[0][r + 2]), "v"(p[0][r + 3]));
                  asm volatile("v_max3_f32 %0, %1, %2, %3" : "+v"(ma) : "v"(ma), "v"(p[1][r]), "v"(p[1][r + 1]));
                  asm volatile("v_max3_f32 %0, %1, %2, %3" : "+v"(mb_) : "v"(mb_), "v"(p[1][r + 2]), "v"(p[1][r + 3])); }
              asm volatile("v_max_f32 %0, %1, %2" : "=v"(pm) : "v"(ma), "v"(mb_)); }
            { auto rr = __builtin_amdgcn_permlane32_swap(__float_as_uint(pm), __float_as_uint(pm), false, false); pm = fmaxf(__uint_as_float(rr[0]), __uint_as_float(rr[1])); }
            if constexpr (MF) {
                if (!__all(pm <= THR)) {
                    const float dm = fmaxf(pm, 0.f), alpha = __builtin_amdgcn_exp2f(-dm); m += dm; l *= alpha;
#pragma unroll
                    for (int d = 0; d < ND0; ++d)
#pragma unroll
                        for (int r = 0; r < 16; ++r) o[d][r] *= alpha;
#pragma unroll
                    for (int sub = 0; sub < 2; ++sub)
#pragma unroll
                        for (int r = 0; r < 16; ++r) p[sub][r] -= dm;
                }
            } else if (!__all(pm - m <= THR)) {
                const float mn = fmaxf(m, pm), alpha = __builtin_amdgcn_exp2f(m - mn); m = mn; l *= alpha;
#pragma unroll
                for (int d = 0; d < ND0; ++d)
#pragma unroll
                    for (int r = 0; r < 16; ++r) o[d][r] *= alpha;
            }
#pragma unroll
            for (int sub = 0; sub < 2; ++sub)
#pragma unroll
                for (int r = 0; r < 16; ++r) p[sub][r] = __builtin_amdgcn_exp2f(MF ? p[sub][r] : p[sub][r] - m);
            __builtin_amdgcn_sched_barrier(0);
            { float s0 = p[0][0], s1 = p[0][1], s2 = p[1][0], s3 = p[1][1];
#pragma unroll
              for (int r = 2; r < 16; r += 2) { s0 += p[0][r]; s1 += p[0][r + 1]; s2 += p[1][r]; s3 += p[1][r + 1]; }
              l += (s0 + s1) + (s2 + s3); }
            }
            if constexpr (PV8) {
#pragma unroll
                for (int w = 0; w < 8; ++w) { const int sub = w >> 2, r4 = 4 * (w & 3); int t = 0;
                    t = __builtin_amdgcn_cvt_pk_fp8_f32(p[sub][r4], p[sub][r4 + 1], t, false); t = __builtin_amdgcn_cvt_pk_fp8_f32(p[sub][r4 + 2], p[sub][r4 + 3], t, true); p8[w] = t; }
            } else {
#pragma unroll
            for (int s = 0; s < 4; ++s) { const int sub = s >> 1, k8 = 8 * (s & 1);
                u32x4 wv; wv.x = cvt_pk_bf16(p[sub][k8], p[sub][k8 + 1]); wv.y = cvt_pk_bf16(p[sub][k8 + 2], p[sub][k8 + 3]); wv.z = cvt_pk_bf16(p[sub][k8 + 4], p[sub][k8 + 5]); wv.w = cvt_pk_bf16(p[sub][k8 + 6], p[sub][k8 + 7]);
                pb[s] = __builtin_bit_cast(bf16x8, wv); }
            }
        }
        if (DBG != 4 && kt < kt_hi) AT_WRITE(buf ^ 1, 0);
        if constexpr (VAR == 0) mcur = mnx[0];
        if (DBG != 4 && kt + 1 < kt_hi) AT_ISSUE(kt + 2, 0);
        if (kt <= kt_last_w && !(DBG == 6 && wid >= 4)) {
            if (DBG != 1) AT_PV_ALL(buf);
            if (DBG == 1) { _Pragma("unroll") for (int i = 0; i < 4; ++i) o[0][i] += __uint_as_float((unsigned)pb[i][0]); }
        }
        if (DBG != 5) __syncthreads();
    }
    }
#undef AT_PV_ALL
#undef AT_PV8
#undef AT_PV
#undef AT_ISSUE
#undef AT_WRITE
    if constexpr (PV8) asm volatile("s_nop 15\n\ts_nop 15" : "+v"(o[0]), "+v"(o[1]), "+v"(o[ND0 - 2]), "+v"(o[ND0 - 1]) :: "memory");
    unsigned nx = 0u; if (threadIdx.x == 0) nx = __hip_atomic_fetch_add(qh, 1u, RLX_AGENT);
    { auto rr = __builtin_amdgcn_permlane32_swap(__float_as_uint(l), __float_as_uint(l), false, false); l = __uint_as_float(rr[0]) + __uint_as_float(rr[1]); }
    if constexpr (VAR == 2) l += __builtin_amdgcn_exp2f(a.sinks[layer * 16 + head] * LOG2E - m);
    const float inv = 1.0f / l;
    int zc, bc;
    if constexpr (VAR == 0) { zc = PC_AZ + head * 128; bc = 0 + head * 128; }
    else if constexpr (VAR == 1) { zc = PC_BZ + head * 128; bc = 1024 + head * 128; }
    else if constexpr (VAR == 2) { zc = PC_CZ + head * 64; bc = 2048 + head * 64; }
    else { zc = PC_DZ + head * 128; bc = 3072 + head * 128; }
    const bf16_t* zp = P + rowq * INP + zc + 4 * hi; unsigned char* op = a.ws + (DBG ? WS_SC : WS_BR) + rowq * 4096 + bc + 4 * hi;
#pragma unroll
    for (int d = 0; d < ND0; ++d)
#pragma unroll
        for (int g = 0; g < 4; ++g) { const u32x2 zw = *(const u32x2*)(zp + 32 * d + 8 * g);
            const float z0 = __uint_as_float(zw.x << 16), z1 = __uint_as_float(zw.x & 0xffff0000u), z2 = __uint_as_float(zw.y << 16), z3 = __uint_as_float(zw.y & 0xffff0000u);
            const float v0 = o[d][4 * g] * inv * (z0 * fast_sigmoid(z0)), v1 = o[d][4 * g + 1] * inv * (z1 * fast_sigmoid(z1));
            const float v2 = o[d][4 * g + 2] * inv * (z2 * fast_sigmoid(z2)), v3 = o[d][4 * g + 3] * inv * (z3 * fast_sigmoid(z3));
            int w8 = 0; w8 = __builtin_amdgcn_cvt_pk_fp8_f32(v0 * 8.0f, v1 * 8.0f, w8, false); w8 = __builtin_amdgcn_cvt_pk_fp8_f32(v2 * 8.0f, v3 * 8.0f, w8, true); *(int*)(op + 32 * d + 8 * g) = w8; }
    if (threadIdx.x == 0) bw[0] = nx;
}
template <int VAR, int DBG = 0>
__device__ __forceinline__ void attn_queue(LAS unsigned char* lds, const Args& a, int layer) {
    constexpr int NUX = (VAR == 2) ? 128 : 64;
    unsigned* qbase = (unsigned*)(a.ws + WS_CTL) + CW_Q + 64 * 8 * (layer * 4 + VAR);
    layer &= 1;
    volatile LAS unsigned* bw = (volatile LAS unsigned*)(lds + MISC_OFF + 64);
    const int myx = (int)(xb_xcc_id() & 7u);
    for (int qi = 0; qi < 8; ++qi) {
        const int x = (myx + qi) & 7;
        unsigned* qh = qbase + 64 * x;
        if (threadIdx.x == 0) bw[0] = __hip_atomic_fetch_add(qh, 1u, RLX_AGENT);
        for (;;) {
            __syncthreads();
            const int idx = (int)bw[0];
            __syncthreads();
            if (idx >= NUX) break;
            int b, hidx, qblk;
            if constexpr (VAR == 0) { qblk = 63 - idx; b = x >> 1; hidx = x & 1; }
            else if constexpr (VAR == 2) { qblk = idx; b = x >> 1; hidx = x & 1; }
            else { const int pr = 4 * x + 2 * (idx >> 5) + (idx & 1); qblk = 15 - ((idx & 31) >> 1); b = pr >> 3; hidx = pr & 7; }
            attn_unit<VAR, DBG>(lds, a, layer, b, hidx, qblk, qh, bw);
        }
    }
}

constexpr int N_PHASES = 1 + 6 * DEPTH;
#ifndef DUP_PHASE
#define DUP_PHASE -1
#endif
__global__ void __launch_bounds__(NTHREADS, 2) mega_fwd(Args a) {
    extern __shared__ __attribute__((aligned(16))) unsigned char lds_raw[];
    LAS unsigned char* lds = (LAS unsigned char*)lds_raw;
    const int tid = threadIdx.x;
    for (int u = tid; u < (LDS_BYTES - LDSCTL_OFF) / 4; u += NTHREADS) ((LAS unsigned*)(lds + LDSCTL_OFF))[u] = 0u;
    __syncthreads();
    unsigned* ctl = (unsigned*)(a.ws + WS_CTL);
    const int lo = a.ph_lo, hi = a.ph_hi;
    const bool multi = (hi - lo) > 1;
    XcdBarrier bar; bar.bar = ctl + CW_BAR; bar.x = 0; bar.st = nullptr;
    if (multi) bar = xcd_barrier_post(ctl + CW_BAR, (volatile LAS unsigned*)(lds + MISC_OFF + 32));
#define IN(k) (lo <= (k) && (k) < hi)
#define SEAM(k) do { if (IN(k) && IN((k) + 1)) xcd_barrier(bar); } while (0)
    unsigned char* ws = a.ws;
    bf16_t* XB = (bf16_t*)(ws + WS_XB); bf16_t* P = (bf16_t*)(ws + WS_P); unsigned char* Gt = ws + WS_G;
    float* SM = (float*)(ws + WS_SM); float* RSS = (float*)(ws + WS_RSS); float* CS = (float*)(ws + WS_CS);
    unsigned char* W = ws + WS_W;

    if (IN(0)) { convert_weights(a, 0, lds); prologue_misc(a); }
    SEAM(0);
    for (int layer = 0; layer < DEPTH; ++layer) {
        const int pb = 1 + 6 * layer;
        if (IN(pb + 0)) {
            { pg8::Gemm g{(const bf16_t*)(ws + WS_X4), (const bf16_t*)(W + WO_WG8), DM / 4, DM / 4, DM / 4, 0, 0}; pg8::StaticOrder S; S.init(MTOK, NGATE, gridDim.x, blockIdx.x, 8);
              EpiGate E{Gt, -LOG2E / (FP4_XS * FP4_WS * 0.9761f)};
              pg8::gemm_phase<EpiGate, pg8::StaticOrder, true, false, true>(lds, g, S, E);
#if DUP_PHASE == 1001
              pg8::gemm_phase<EpiGate, pg8::StaticOrder, true, true>(lds, g, S, E);
#endif
#if DUP_PHASE == 1002
              { EpiNull E0{(float*)(ws + WS_SC)}; pg8::gemm_phase<EpiNull, pg8::StaticOrder, true, true>(lds, g, S, E0); }
#endif
              }
            { pg8::Gemm g{(const bf16_t*)(ws + WS_X8), (const bf16_t*)(W + WO_WIN8), DM / 2, DM / 2, DM / 2, 0, 0}; pg8::StaticOrder S; S.init(MTOK, NIN8, gridDim.x, blockIdx.x);
              EpiIn E{P, SM, RSS, 1, ws + WS_KV8, ws + WS_L8};
              pg8::gemm_phase<EpiIn, pg8::StaticOrder, true, true>(lds, g, S, E); }
            { pg8::Gemm g{(const bf16_t*)(ws + WS_X4), (const bf16_t*)(W + WO_WZ4), DM / 4, DM / 4, DM / 4, 0, 0}; pg8::StaticOrder S; S.init(MTOK, NINZ, gridDim.x, blockIdx.x, 8);
              EpiIn E{P, SM, RSS, 2, ws + WS_KV8, ws + WS_L8};
              pg8::gemm_phase<EpiIn, pg8::StaticOrder, true, false, true>(lds, g, S, E); }
            { pg8::Gemm g{XB, (const bf16_t*)(W + WO_WINB), DM, DM, DM, 0, 0}; pg8::StaticOrder S; S.init(MTOK, NINB, gridDim.x, (blockIdx.x + 64) % gridDim.x, 2);
              EpiIn E{P, SM, RSS, 0, ws + WS_KV8, ws + WS_L8};
              pg8::gemm_phase<EpiIn, pg8::StaticOrder>(lds, g, S, E); }
        }
        SEAM(pb + 0);
        if (IN(pb + 1)) {
            cumsum_phase(SM, a.f_bias + layer * 8, (float*)(ws + WS_CUM));
            krope_phase(SM, CS, ws + WS_D8);
            { pg8::Gemm g{(const bf16_t*)(ws + WS_L8), (const bf16_t*)(W + WO_DQUP), 384, 512, 384, 0, 0}; pg8::StaticOrder S; S.init(MTOK, 1536, gridDim.x, blockIdx.x);
              EpiDq E{(bf16_t*)(ws + WS_DQ), RSS, CS, 1.0f / DQ_WS};
              pg8::gemm_phase<EpiDq, pg8::StaticOrder, true, true>(lds, g, S, E); }
            { pg8::Gemm g{(const bf16_t*)(ws + WS_L8 + 768), (const bf16_t*)(W + WO_DKVUP), 128, 512, 128, 0, 0}; pg8::StaticOrder S; S.init(MTOK, 2048, gridDim.x, blockIdx.x);
              EpiDkv E{ws + WS_D8, RSS, 1.0f / DKV_WS};
              pg8::gemm_phase<EpiDkv, pg8::StaticOrder, true, true>(lds, g, S, E); }
            indexer_phase(lds, a);
#if DUP_PHASE == 1 || DUP_PHASE == 11
            { pg8::Gemm g{P + PC_DCQ, (const bf16_t*)(W + WO_DQUP), 768, INP, 768, 0, 0}; pg8::StaticOrder S; S.init(MTOK, 1536, gridDim.x, blockIdx.x);
              EpiDq E{(bf16_t*)(ws + WS_DQ), RSS, CS};
              pg8::gemm_phase<EpiDq, pg8::StaticOrder>(lds, g, S, E); }
            { pg8::Gemm g{P + PC_DCKV, (const bf16_t*)(W + WO_DKVUP), 256, INP, 256, 0, 0}; pg8::StaticOrder S; S.init(MTOK, 2048, gridDim.x, blockIdx.x);
              EpiDkv E{ws + WS_D8, RSS};
              pg8::gemm_phase<EpiDkv, pg8::StaticOrder>(lds, g, S, E); }
#endif
#if DUP_PHASE == 1 || DUP_PHASE == 12
            indexer_phase(lds, a);
#endif
        }
        SEAM(pb + 1);
        if (IN(pb + 2)) {
            attn_queue<3>(lds, a, layer);
            attn_queue<1>(lds, a, layer);
            attn_queue<0>(lds, a, layer);
            attn_queue<2>(lds, a, layer);
#if DUP_PHASE == 2 || DUP_PHASE == 23
            attn_queue<3>(lds, a, layer + 2);
#endif
#if DUP_PHASE == 2 || DUP_PHASE == 21
            attn_queue<1>(lds, a, layer + 2);
#endif
#if DUP_PHASE >= 210 && DUP_PHASE <= 219
            attn_queue<1, DUP_PHASE - 210>(lds, a, layer + 2);
#endif
#if DUP_PHASE == 2 || DUP_PHASE == 20
            attn_queue<0>(lds, a, layer + 2);
#endif
#if DUP_PHASE == 2 || DUP_PHASE == 22
            attn_queue<2>(lds, a, layer + 2);
#endif
        }
        SEAM(pb + 2);
        if (IN(pb + 3)) {
            pg8::Gemm g{(const bf16_t*)(ws + WS_BR), (const bf16_t*)(W + WO_WBR), 512, 2048, 512, (size_t)1024, (size_t)DM * 1024};
            pg8::ZOrder<4> S; S.init(MTOK, DM, gridDim.x, blockIdx.x);
            EpiMerge E{Gt, ws + WS_MRG};
            pg8::gemm_phase<EpiMerge, pg8::ZOrder<4>, true, true>(lds, g, S, E);
#if DUP_PHASE == 3
            pg8::gemm_phase<EpiMerge, pg8::ZOrder<4>, true, true>(lds, g, S, E);
#endif
        }
        SEAM(pb + 3);
        if (IN(pb + 4)) {
            pg8::Gemm g{(const bf16_t*)(ws + WS_MRG), (const bf16_t*)(W + WO_WOUT), DM / 2, DM / 2, DM / 2, 0, 0}; pg8::StaticOrder S; S.init(MTOK, DM, gridDim.x, blockIdx.x);
            EpiOut E{XB, (bf16_t*)(ws + WS_R)};
            pg8::gemm_phase<EpiOut, pg8::StaticOrder, true, true>(lds, g, S, E);
#if DUP_PHASE == 4
            pg8::gemm_phase<EpiOut, pg8::StaticOrder, true, true>(lds, g, S, E);
#endif
        }
        SEAM(pb + 4);
        if (IN(pb + 5)) {
            ln_phase((const bf16_t*)(ws + WS_R), a.ln_gain + layer * DM, a.ln_bias + layer * DM, layer + 1 < DEPTH ? nullptr : a.out, layer + 1 < DEPTH ? XB : nullptr, ws + WS_X8, ws + WS_X4);
            if (layer + 1 < DEPTH) convert_weights(a, layer + 1, lds);
#if DUP_PHASE == 5
            ln_phase((const bf16_t*)(ws + WS_R), a.ln_gain + layer * DM, a.ln_bias + layer * DM, layer + 1 < DEPTH ? nullptr : a.out, layer + 1 < DEPTH ? XB : nullptr, ws + WS_X8, ws + WS_X4);
            if (layer + 1 < DEPTH) convert_weights(a, layer + 1, lds);
#endif
        }
        if (layer + 1 < DEPTH) SEAM(pb + 5);
    }
#undef IN
#undef SEAM
}

#ifdef PROBE_KERNEL
__global__ void __launch_bounds__(NTHREADS, 2) probe_fwd(Args a) {
    extern __shared__ __attribute__((aligned(16))) unsigned char lds_raw[];
    LAS unsigned char* lds = (LAS unsigned char*)lds_raw;
    unsigned char* ws = a.ws; unsigned char* W = ws + WS_W;
#if PROBE_KERNEL == 1 || PROBE_KERNEL == 2 || PROBE_KERNEL == 4
    pg8::Gemm g{(const bf16_t*)(ws + WS_X8), (const bf16_t*)(W + WO_WG8), DM / 2, DM / 2, DM / 2, 0, 0}; pg8::StaticOrder S; S.init(MTOK, NGATE, gridDim.x, blockIdx.x);
#if PROBE_KERNEL == 1
    EpiGate E{ws + WS_G}; pg8::gemm_phase<EpiGate, pg8::StaticOrder, true, true>(lds, g, S, E);
#elif PROBE_KERNEL == 4
    EpiGate E{ws + WS_G}; pg8::gemm_phase<EpiGate, pg8::StaticOrder, false, true>(lds, g, S, E);
#else
    EpiNull E{(float*)(ws + WS_SC)}; pg8::gemm_phase<EpiNull, pg8::StaticOrder, true, true>(lds, g, S, E);
#endif
#endif
#if PROBE_KERNEL >= 10 && PROBE_KERNEL < 20
    attn_queue<1, PROBE_KERNEL - 10>(lds, a, 3);
#endif
#if PROBE_KERNEL == 20 || PROBE_KERNEL == 21
    { pg8::Gemm g{(const bf16_t*)(ws + WS_BR), (const bf16_t*)(W + WO_WBR), 512, 2048, 512, (size_t)1024, (size_t)DM * 1024}; pg8::ZOrder<4> S; S.init(MTOK, DM, gridDim.x, blockIdx.x);
#if PROBE_KERNEL == 20
      EpiMerge E{ws + WS_G, ws + WS_MRG}; pg8::gemm_phase<EpiMerge, pg8::ZOrder<4>, true, true>(lds, g, S, E);
#else
      EpiNull E{(float*)(ws + WS_SC)}; pg8::gemm_phase<EpiNull, pg8::ZOrder<4>, true, true>(lds, g, S, E);
#endif
    }
#endif
#if PROBE_KERNEL == 22
    { pg8::Gemm g{(const bf16_t*)(ws + WS_MRG), (const bf16_t*)(W + WO_WOUT), DM / 2, DM / 2, DM / 2, 0, 0}; pg8::StaticOrder S; S.init(MTOK, DM, gridDim.x, blockIdx.x);
      EpiOut E{(const bf16_t*)(ws + WS_XB), (bf16_t*)(ws + WS_SC)}; pg8::gemm_phase<EpiOut, pg8::StaticOrder, true, true>(lds, g, S, E); }
#endif
#if PROBE_KERNEL == 30
    convert_weights(a, 1, lds);
#endif
#if PROBE_KERNEL == 31
    ln_phase((const bf16_t*)(ws + WS_R), a.ln_gain + DM, a.ln_bias + DM, a.out, nullptr, ws + WS_X8);
#endif
#if PROBE_KERNEL == 32
    indexer_phase(lds, a);
#endif
#if PROBE_KERNEL == 33
    indexer_phase<1>(lds, a);
#endif
#if PROBE_KERNEL == 34
    indexer_phase<2>(lds, a);
#endif
#if PROBE_KERNEL == 3
    pg8::Gemm g{(const bf16_t*)(ws + WS_XB), (const bf16_t*)(W + WO_WG8), DM / 2, DM / 2, DM / 2, 0, 0}; pg8::StaticOrder S; S.init(MTOK, NGATE, gridDim.x, blockIdx.x);
    EpiNull E{(float*)(ws + WS_SC)}; pg8::gemm_phase<EpiNull, pg8::StaticOrder, true, false>(lds, g, S, E);
#endif
}
#endif

#ifndef MK_N_LAUNCHES
#define MK_N_LAUNCHES 1
#endif
extern "C" void kernel_launch(void* const* d_in, const int* in_sizes, int n_in, void* d_out, int out_size, void* d_ws, size_t ws_size, hipStream_t stream) {
    static int grid = 0;
    if (grid == 0) {
        if (n_in != 14 || in_sizes[0] != MTOK * DM || out_size != MTOK * DM || ws_size < WS_END) {
            fprintf(stderr, "kernel_launch: unexpected shapes / workspace: n_in %d in0 %d out %d ws %zu (need >= %zu)\n", n_in, n_in > 0 ? in_sizes[0] : -1, out_size, ws_size, (size_t)WS_END); grid = -1; return; }
        int dev = 0, cus = 0, per_cu = 0;
        if (hipGetDevice(&dev) != hipSuccess || hipDeviceGetAttribute(&cus, hipDeviceAttributeMultiprocessorCount, dev) != hipSuccess) { grid = -1; return; }
        if (hipFuncSetAttribute((const void*)mega_fwd, hipFuncAttributeMaxDynamicSharedMemorySize, LDS_BYTES) != hipSuccess) { fprintf(stderr, "kernel_launch: hipFuncSetAttribute failed\n"); grid = -1; return; }
        if (hipOccupancyMaxActiveBlocksPerMultiprocessor(&per_cu, (const void*)mega_fwd, NTHREADS, LDS_BYTES) != hipSuccess || per_cu < 1) {
            fprintf(stderr, "kernel_launch: occupancy query reports %d workgroups per CU\n", per_cu); }
        (void)hipGetLastError();
        grid = cus;
    }
    if (grid < 0) return;
    (void)hipMemsetAsync((char*)d_ws + WS_CTL, 0, CTL_ZERO_BYTES, stream);
    Args a{};
    a.x = (const float*)d_in[0]; a.pos = (const int*)d_in[1]; a.w_in = (const float*)d_in[2]; a.w_gate = (const float*)d_in[3]; a.w_branch = (const float*)d_in[4]; a.w_out = (const float*)d_in[5];
    a.dq_gain = (const float*)d_in[6]; a.dq_up = (const float*)d_in[7]; a.dkv_gain = (const float*)d_in[8]; a.dkv_up = (const float*)d_in[9]; a.f_bias = (const float*)d_in[10];
    a.sinks = (const float*)d_in[11]; a.ln_gain = (const float*)d_in[12]; a.ln_bias = (const float*)d_in[13];
    a.out = (float*)d_out; a.ws = (unsigned char*)d_ws;
#if MK_N_LAUNCHES == 1
    a.ph_lo = 0; a.ph_hi = N_PHASES;
    hipLaunchKernelGGL(mega_fwd, dim3(grid), dim3(NTHREADS), LDS_BYTES, stream, a);
#else
    for (int p = 0; p < N_PHASES; ++p) { a.ph_lo = p; a.ph_hi = p + 1; hipLaunchKernelGGL(mega_fwd, dim3(grid), dim3(NTHREADS), LDS_BYTES, stream, a); }
#endif
#ifdef PROBE_KERNEL
    { static int once = 0; if (!once) { (void)hipFuncSetAttribute((const void*)probe_fwd, hipFuncAttributeMaxDynamicSharedMemorySize, LDS_BYTES); once = 1; }
      hipLaunchKernelGGL(probe_fwd, dim3(grid), dim3(NTHREADS), LDS_BYTES, stream, a); }
#endif
    const hipError_t le = hipPeekAtLastError();
    if (le != hipSuccess) fprintf(stderr, "kernel_launch: launch failed: %s\n", hipGetErrorName(le));
}
```

```cpp
#include <hip/hip_runtime.h>
#include <cstdio>
#include <cstdint>

#define LAS __attribute__((address_space(3)))
#define GAS __attribute__((address_space(1)))
typedef unsigned short bf16_t;
typedef short bf16x8 __attribute__((ext_vector_type(8)));
typedef short s16x4 __attribute__((ext_vector_type(4)));
typedef float f32x4 __attribute__((ext_vector_type(4)));
typedef float f32x2 __attribute__((ext_vector_type(2)));
typedef float f32x16 __attribute__((ext_vector_type(16)));
typedef unsigned u32x4 __attribute__((ext_vector_type(4)));
typedef unsigned u32x2 __attribute__((ext_vector_type(2)));

typedef __bf16 bf16x2_t __attribute__((ext_vector_type(2)));
__device__ __forceinline__ unsigned cvt_pk_bf16(float lo, float hi) { const f32x2 v = {lo, hi}; const bf16x2_t b = __builtin_convertvector(v, bf16x2_t); return __builtin_bit_cast(unsigned, b); }
__device__ __forceinline__ int ptid() { int t = threadIdx.x; asm volatile("" : "+v"(t)); return t; }
__device__ __forceinline__ float bf2f(unsigned short b) { return __uint_as_float(((unsigned)b) << 16); }

namespace pg8 {
constexpr int BM = 256, BK = 64, HALF = 128, HTB = HALF * BK * 2  , STAGE_BYTES = 8 * HTB, NXCD = 8, WGM = 4;
__host__ __device__ __forceinline__ int lds_byte(int r, int c) { const int st = (r >> 4) * 2 + (c >> 5), rr = r & 15, cc = c & 31, ob = rr * 64 + cc * 2; return st * 1024 + (ob ^ (((ob >> 9) & 1) << 5)); }
__host__ __device__ __forceinline__ void stage_rc(int b, int& R, int& C) { const int st = b / 1024, sb = b % 1024, swz = sb ^ (((sb >> 9) & 1) << 5); R = (st >> 1) * 16 + swz / 64; C = (st & 1) * 32 + (swz % 64) / 2; }
__host__ __device__ __forceinline__ int perm32(int rho) { const int n = rho >> 4, i = rho & 15; return 8 * (i >> 2) + 4 * n + (i & 3); }

struct Unit { int pm, pn, z; };
struct Gemm { const bf16_t* A; const bf16_t* Bt; int K, lda, ldb; size_t zA, zB; };

__device__ __forceinline__ void tile_of(int L, int nM, int nN, int& pm, int& pn, int WGM = pg8::WGM) {
    const int nwg = nM * nN; int wgid = L; { const int q = nwg / NXCD, r = nwg % NXCD, xcd = wgid % NXCD, off = wgid / NXCD; wgid = (xcd < r ? xcd * (q + 1) : r * (q + 1) + (xcd - r) * q) + off; }
    const int nig = WGM * nN, gid = wgid / nig, fm = gid * WGM, gsz = (nM - fm) < WGM ? (nM - fm) : WGM;
    pm = fm + ((wgid % nig) % gsz); pn = (wgid % nig) / gsz;
}
struct StaticOrder {
    int nM, nN, nwg, G, c, wgm;
    __device__ void init(int M, int N, int G_, int c_, int wgm_ = WGM) { nM = M / BM; nN = N / BM; nwg = nM * nN; G = G_; c = c_; wgm = wgm_; }
    __device__ bool next(int i, Unit& u) const { const long L = (long)i * G + c; if (L >= nwg) return false; tile_of((int)L, nM, nN, u.pm, u.pn, wgm); u.z = 0; return true; }
};
template <int Z> struct ZOrder {
    int nM, nN, nwg, G, c;
    __device__ void init(int M, int N, int G_, int c_) { nM = M / BM; nN = N / BM; nwg = nM * nN; G = G_; c = c_; }
    __device__ bool next(int i, Unit& u) const { const long L = (long)(i / Z) * G + c; if (L >= nwg) return false; tile_of((int)L, nM, nN, u.pm, u.pn); u.z = i % Z; return true; }
};

typedef int v8i_t __attribute__((ext_vector_type(8)));
typedef int v4i_t __attribute__((ext_vector_type(4)));
__device__ __forceinline__ v8i_t cat8(bf16x8 lo, bf16x8 hi) { const v4i_t a = __builtin_bit_cast(v4i_t, lo), b = __builtin_bit_cast(v4i_t, hi); return __builtin_shufflevector(a, b, 0, 1, 2, 3, 4, 5, 6, 7); }
template <class Epi, class Sched, bool ALIGN_EPI = true, bool F8 = false, bool F4 = false>
__device__ __forceinline__ void gemm_phase(LAS unsigned char* lds, const Gemm g, const Sched& S, const Epi& E) {
    const int tid = ptid(), wid = __builtin_amdgcn_readfirstlane(tid >> 6), lane = tid & 63, wr = wid >> 2, wc = wid & 3, fr = lane & 15, fq = lane >> 4;
    const int K = g.K, nt = K / BK;
    unsigned voffA[2], voffB[2];
#pragma unroll
    for (int i = 0; i < 2; ++i) { int R, C; stage_rc(tid * 16 + i * 8192, R, C);
        const int Rb = (int)Epi::PERM == 2 ? (64 * (R >> 5) + 16 * ((R >> 2) & 3) + 4 * ((R >> 4) & 1) + (R & 3)) : ((int)Epi::PERM == 1 ? ((R & ~31) + perm32(R & 31)) : R);
        voffA[i] = (unsigned)(R * g.lda + C) * 2u; voffB[i] = (unsigned)(Rb * g.ldb + C) * 2u; }
    const size_t kstep = (size_t)(BK * 2);
    const size_t hstepA = (size_t)HALF * g.lda * 2, hstepB = (size_t)((int)Epi::PERM == 2 ? 8 : HALF) * g.ldb * 2;
    const size_t tstepA = 2 * hstepA, tstepB = (size_t)BM * g.ldb * 2;
    const unsigned ldsw = (unsigned)wid * 1024u;
    const int aoff = lds_byte(wr * 64 + fr, fq * 8), boff = lds_byte(wc * 32 + fr, fq * 8);
#define PG8_SA(b, h) (((b) * 2 + (h)) * HTB)
#define PG8_SB(b, h) ((4 + (b) * 2 + (h)) * HTB)
#define PG8_STAGE(bufoff, gbase, voff) do { _Pragma("unroll") for (int _i = 0; _i < 2; ++_i) \
        __builtin_amdgcn_global_load_lds((const unsigned*)((const char*)(gbase) + (voff)[_i]), (LAS unsigned*)(lds + (bufoff) + ldsw + _i * 8192), 16, 0, 0); } while (0)
#define PG8_LDA(dst, b, h) do { _Pragma("unroll") for (int m = 0; m < 4; ++m) { if constexpr (F8) dst##8[m] = cat8(*(const LAS bf16x8*)(lds + PG8_SA(b, h) + aoff + m * 2048), *(const LAS bf16x8*)(lds + PG8_SA(b, h) + aoff + m * 2048 + 1024)); \
        else { _Pragma("unroll") for (int k = 0; k < 2; ++k) dst[m][k] = *(const LAS bf16x8*)(lds + PG8_SA(b, h) + aoff + m * 2048 + k * 1024); } } } while (0)
#define PG8_LDB(dst, b, h) do { _Pragma("unroll") for (int n = 0; n < 2; ++n) { if constexpr (F8) dst##8[n] = cat8(*(const LAS bf16x8*)(lds + PG8_SB(b, h) + boff + n * 2048), *(const LAS bf16x8*)(lds + PG8_SB(b, h) + boff + n * 2048 + 1024)); \
        else { _Pragma("unroll") for (int k = 0; k < 2; ++k) dst[n][k] = *(const LAS bf16x8*)(lds + PG8_SB(b, h) + boff + n * 2048 + k * 1024); } } } while (0)
#define PG8_MMA(ai, bj, At, Bt) do { __builtin_amdgcn_s_setprio(1); _Pragma("unroll") for (int m = 0; m < 4; ++m) _Pragma("unroll") for (int n = 0; n < 2; ++n) { \
        if constexpr (F8) asm volatile("v_mfma_f32_16x16x128_f8f6f4 %0, %1, %2, %0" : "+v"(acc[ai][bj][m][n]) : "v"(Bt##8[n]), "v"(At##8[m]));   \
        else if constexpr (F4) { _Pragma("unroll") for (int k = 0; k < 2; ++k) asm volatile("v_mfma_f32_16x16x128_f8f6f4 %0, %1, %2, %0 cbsz:4 blgp:4" : "+v"(acc[ai][bj][m][n]) : "v"(Bt[n][k]), "v"(At[m][k])); } \
        else { _Pragma("unroll") for (int k = 0; k < 2; ++k) acc[ai][bj][m][n] = __builtin_amdgcn_mfma_f32_16x16x32_bf16(Bt[n][k], At[m][k], acc[ai][bj][m][n], 0, 0, 0); } } \
        __builtin_amdgcn_s_setprio(0); } while (0)
#define PG8_WAIT_V(n) asm volatile("s_waitcnt vmcnt(" #n ")" ::: "memory")
#define PG8_WAIT_L(n) asm volatile("s_waitcnt lgkmcnt(" #n ")" ::: "memory")
#define PG8_BAR __builtin_amdgcn_s_barrier()
#define PG8_SCHED __builtin_amdgcn_sched_barrier(0)
    Unit cur, nxt; int ui = 0;
    if (!S.next(0, cur)) return;
    f32x4 acc[2][2][4][2];
#pragma unroll
    for (int a = 0; a < 2; ++a)
#pragma unroll
        for (int b = 0; b < 2; ++b)
#pragma unroll
            for (int m = 0; m < 4; ++m)
#pragma unroll
                for (int n = 0; n < 2; ++n) acc[a][b][m][n] = (f32x4){0.f, 0.f, 0.f, 0.f};
    bf16x8 At[4][2], B0[2][2], B1[2][2]; v8i_t At8[4], B08[2], B18[2];
    const char* cA = (const char*)g.A + (size_t)cur.z * g.zA + (size_t)cur.pm * tstepA; const char* cB = (const char*)g.Bt + (size_t)cur.z * g.zB + (size_t)cur.pn * tstepB;
    PG8_STAGE(PG8_SB(0, 0), cB, voffB); PG8_STAGE(PG8_SB(0, 1), cB + hstepB, voffB); PG8_STAGE(PG8_SA(0, 0), cA, voffA); PG8_STAGE(PG8_SA(0, 1), cA + hstepA, voffA);
    if (wr == 1) PG8_BAR;
    PG8_WAIT_V(2); PG8_BAR;
    PG8_STAGE(PG8_SB(1, 0), cB + kstep, voffB); PG8_STAGE(PG8_SA(1, 0), cA + kstep, voffA); PG8_STAGE(PG8_SB(1, 1), cB + hstepB + kstep, voffB);
    PG8_WAIT_V(6); PG8_BAR;
    for (;;) {
        const bool has_next = S.next(ui + 1, nxt);
        const char* nA = has_next ? (const char*)g.A + (size_t)nxt.z * g.zA + (size_t)nxt.pm * tstepA : cA; const char* nB = has_next ? (const char*)g.Bt + (size_t)nxt.z * g.zB + (size_t)nxt.pn * tstepB : cB;
#pragma unroll 1
        for (int t = 0; t < nt; t += 2) {
            const bool last = (t == nt - 2);
            const char* a1 = cA + (size_t)(t + 1) * kstep;
            const char* a2 = last ? nA : cA + (size_t)(t + 2) * kstep; const char* b2 = last ? nB : cB + (size_t)(t + 2) * kstep;
            const char* a3 = a2 + kstep; const char* b3 = b2 + kstep;
            PG8_LDB(B0, 0, 0); PG8_LDB(B1, 0, 1); PG8_SCHED; PG8_LDA(At, 0, 0); PG8_STAGE(PG8_SA(1, 1), a1 + hstepA, voffA);
            PG8_WAIT_V(8); PG8_WAIT_L(0); PG8_BAR; PG8_MMA(0, 0, At, B0); PG8_MMA(0, 1, At, B1); PG8_BAR; PG8_SCHED;
            PG8_LDA(At, 0, 1); PG8_STAGE(PG8_SB(0, 0), b2, voffB); PG8_STAGE(PG8_SB(0, 1), b2 + hstepB, voffB); PG8_STAGE(PG8_SA(0, 0), a2, voffA);
            PG8_WAIT_V(8); PG8_WAIT_L(0); PG8_BAR; PG8_MMA(1, 0, At, B0); PG8_MMA(1, 1, At, B1); PG8_BAR; PG8_SCHED;
            PG8_LDB(B0, 1, 0); PG8_LDB(B1, 1, 1); PG8_SCHED; PG8_LDA(At, 1, 0); PG8_STAGE(PG8_SA(0, 1), a2 + hstepA, voffA);
            PG8_WAIT_V(8); PG8_WAIT_L(0); PG8_BAR; PG8_MMA(0, 0, At, B0); PG8_MMA(0, 1, At, B1); PG8_BAR; PG8_SCHED;
            PG8_LDA(At, 1, 1); PG8_STAGE(PG8_SB(1, 0), b3, voffB); PG8_STAGE(PG8_SB(1, 1), b3 + hstepB, voffB); PG8_STAGE(PG8_SA(1, 0), a3, voffA);
            PG8_WAIT_V(8); PG8_WAIT_L(0); PG8_BAR; PG8_MMA(1, 0, At, B0); PG8_MMA(1, 1, At, B1); PG8_BAR; PG8_SCHED;
        }
        if constexpr (ALIGN_EPI) { if (wr == 0) PG8_BAR; }
        if constexpr (F8 || F4) asm volatile("s_nop 15\n\ts_nop 15" ::: "memory");
        E(acc, cur, wr, wc, fr, fq);
        if (!has_next) break;
        if (!(Epi::CARRY && nxt.z != 0))
#pragma unroll
        for (int a = 0; a < 2; ++a)
#pragma unroll
            for (int b = 0; b < 2; ++b)
#pragma unroll
                for (int m = 0; m < 4; ++m)
#pragma unroll
                    for (int n = 0; n < 2; ++n) acc[a][b][m][n] = (f32x4){0.f, 0.f, 0.f, 0.f};
        cur = nxt; cA = nA; cB = nB; ++ui;
        if constexpr (ALIGN_EPI) { if (wr == 1) PG8_BAR; }
    }
    PG8_WAIT_V(0);
    if constexpr (!ALIGN_EPI) { if (wr == 0) PG8_BAR; }
    PG8_BAR;
#undef PG8_SA
#undef PG8_SB
#undef PG8_STAGE
#undef PG8_LDA
#undef PG8_LDB
#undef PG8_MMA
#undef PG8_WAIT_V
#undef PG8_WAIT_L
#undef PG8_BAR
#undef PG8_SCHED
}
}

constexpr int BATCH = 4, SEQ = 4096, DM = 4096, MTOK = BATCH * SEQ, DEPTH = 2;
constexpr int INW = 12184, INP = 12288, NGATE = 4 * DM, N1 = INP + NGATE;
constexpr float LOG2E = 1.4426950408889634f;
constexpr float RMS_EPS = 1e-6f, LN_EPS = 1e-5f;
constexpr float DN_ALPHA = 1.4142135623730951f;
constexpr int PC_AQ = 0, PC_AK = 1024, PC_AV = 1280, PC_AIQ = 1536, PC_AZ = 2560, PC_BQ = 3584, PC_BK = 4608, PC_BV = 5632, PC_BZ = 6656,
              PC_CQ = 7680, PC_CK = 8704, PC_CV = 8832, PC_CZ = 8960, PC_DCQ = 9984, PC_DCKV = 10752, PC_DZ = 11008,
              PC_AIK = 12032, PC_AIW = 12096, PC_BF = 12112, PC_DKR = 12120, PC_END = 12184;
constexpr int SC_AQ = 0, SC_AK = 1024, SC_AV = 1280, SC_AIQ = 1536, SC_AIK = 2560, SC_AIW = 2624, SC_AZ = 2640, SC_BQ = 3664, SC_BK = 4688, SC_BV = 5712,
              SC_BF = 6736, SC_BZ = 6744, SC_CQ = 7768, SC_CK = 8792, SC_CV = 8920, SC_CZ = 9048, SC_DCQ = 10072, SC_DCKV = 10840, SC_DKR = 11096, SC_DZ = 11160;
static_assert(SC_DZ + 1024 == INW, "w_in column partition");
constexpr int SMC_AIK = 0, SMC_AIW = 64, SMC_BF = 80, SMC_DKR = 88;

constexpr size_t MiB = 1u << 20;
constexpr size_t WS_CTL = 0, CTL_ZERO_BYTES = 1 * MiB;
constexpr size_t WS_W = 2 * MiB;
constexpr int NIN8 = 27 * 256, NINZ = 16 * 256, NINB = 5 * 256;
constexpr size_t WO_WIN8 = 0                                         , WO_WZ4 = WO_WIN8 + (size_t)NIN8 * DM  ,
                 WO_WINB = WO_WZ4 + (size_t)NINZ * (DM / 2)          ,
                 WO_WG8 = WO_WINB + (size_t)NINB * DM * 2            , WO_WBR = WO_WG8 + (size_t)NGATE * DM  ,
                 WO_WOUT = WO_WBR + (size_t)4 * DM * 1024            , WO_DQUP = WO_WOUT + (size_t)DM * DM,
                 WO_DKVUP = WO_DQUP + (size_t)1536 * 768 * 2, WO_END = WO_DKVUP + (size_t)2048 * 256 * 2;
static_assert(WO_END <= 292 * MiB, "weights region");
constexpr size_t WS_XB = 294 * MiB;
constexpr size_t WS_P = 422 * MiB;
constexpr size_t WS_MRGF = WS_P;
constexpr size_t WS_G = 806 * MiB;
constexpr size_t WS_R = WS_G;
constexpr size_t WS_SC = 1318 * MiB;
constexpr size_t WS_MRG = WS_SC;
constexpr size_t WS_BR = 1574 * MiB;
constexpr size_t WS_DQ = 1702 * MiB;
constexpr size_t WS_DKV = 1750 * MiB;
constexpr size_t WS_MASK = 1814 * MiB;
constexpr size_t WS_SM = 1822 * MiB;
constexpr size_t WS_CS = 1838 * MiB;
constexpr size_t WS_RSS = 1842 * MiB;
constexpr size_t WS_CUM = 1843 * MiB;
constexpr size_t WS_DKR = 1844 * MiB;
constexpr size_t WS_X8 = 1846 * MiB;
constexpr size_t WS_KV8 = 1096 * MiB;
constexpr int KV8W = 2560;
constexpr size_t WS_D8 = 1136 * MiB;
constexpr int D8W = 2112;
constexpr size_t WS_L8 = 1170 * MiB;
constexpr float DQ_WS = 64.0f, DKV_WS = 8.0f;
constexpr size_t WS_X4 = 1062 * MiB;
constexpr size_t WS_END = 1910 * MiB;
constexpr int CW_TMO = 0;
constexpr int CW_Q = 64;
constexpr int CW_BAR = 16384;

constexpr int RING_BYTES = 131072;
constexpr int LDSCTL_OFF = RING_BYTES, MISC_OFF = LDSCTL_OFF + 320;
constexpr int LDS_BYTES = 147456;
constexpr int NWAVES = 8, NTHREADS = 512;

#define RLX_AGENT __ATOMIC_RELAXED, __HIP_MEMORY_SCOPE_AGENT
#define LDS_WAIT() asm volatile("s_waitcnt lgkmcnt(0)" ::: "memory")
#define VM_WAIT() asm volatile("s_waitcnt vmcnt(0)" ::: "memory")

#define XB_TMO      128
#define XB_XCNT(j)  (256  + 64 * (j))
#define XB_XSUB(j)  (1280 + 64 * (j))
#define XB_XGEN(j)  (2304 + 64 * (j))
#define XB_TOP      3328
#define XB_TOPGEN   3392
#define XCD_BAR_WORDS 3456
#define XB_SPIN_CAP (1u << 23)
__device__ __forceinline__ unsigned xb_ld(unsigned* p)              { return __hip_atomic_load(p, __ATOMIC_RELAXED, __HIP_MEMORY_SCOPE_AGENT); }
__device__ __forceinline__ unsigned xb_add(unsigned* p, unsigned v) { return __hip_atomic_fetch_add(p, v, __ATOMIC_RELAXED, __HIP_MEMORY_SCOPE_AGENT); }
__device__ __forceinline__ unsigned xb_xcc_id() { return (unsigned)__builtin_amdgcn_s_getreg((3 << 11) | 20) & 0xFu; }
#define XB_SPIN(cond, bar) do { unsigned _sp = 0; while (cond) { __builtin_amdgcn_s_sleep(1); \
    if ((++_sp & 255u) == 0u) { if (xb_ld(&(bar)[XB_TMO])) break; if (_sp > XB_SPIN_CAP) { atomicAdd(&(bar)[XB_TMO], 1u); break; } } } } while (0)
struct XcdBarrier { unsigned* bar; unsigned x; volatile LAS unsigned* st; };
__device__ __forceinline__ XcdBarrier xcd_barrier_post(unsigned* bar, volatile LAS unsigned* st) {
    XcdBarrier b; b.bar = bar; b.x = xb_xcc_id(); b.st = st;
    if (threadIdx.x == 0) (void)xb_add(&bar[XB_XCNT(b.x)], 1u);
    return b;
}
__device__ __forceinline__ void xcd_barrier_complete(unsigned* bar, unsigned x, unsigned& nloc, unsigned& nx) {
    const unsigned G = gridDim.x * gridDim.y * gridDim.z;
    unsigned sum, cnt, mine, sp = 0u;
    for (;;) {
        sum = 0u; cnt = 0u; mine = 0u;
#pragma unroll
        for (unsigned j = 0; j < 16; ++j) { const unsigned c = xb_ld(&bar[XB_XCNT(j)]); sum += c; cnt += (c > 0u) ? 1u : 0u; mine = (j == x) ? c : mine; }
        if (sum == G) break;
        __builtin_amdgcn_s_sleep(1);
        if ((++sp & 255u) == 0u) { if (xb_ld(&bar[XB_TMO])) break; if (sp > XB_SPIN_CAP) { atomicAdd(&bar[XB_TMO], 1u); break; } }
    }
    nloc = mine > 0u ? mine : 1u; nx = cnt > 0u ? cnt : 1u;
}
__device__ __forceinline__ void xcd_barrier(const XcdBarrier& b) {
    asm volatile("s_waitcnt vmcnt(0)" ::: "memory");
    __syncthreads();
    if (threadIdx.x == 0) {
        unsigned* bar = b.bar;
        __builtin_amdgcn_s_waitcnt(0);
        unsigned nloc = b.st[0], nx = b.st[1];
        if (nloc == 0u) { xcd_barrier_complete(bar, b.x, nloc, nx); b.st[0] = nloc; b.st[1] = nx; }
        const unsigned old = xb_add(&bar[XB_XSUB(b.x)], 1u);
        const unsigned gen = old / nloc;
        if (old + 1u == (gen + 1u) * nloc) {
            __builtin_amdgcn_fence(__ATOMIC_RELEASE, "agent");
            asm volatile("s_waitcnt vmcnt(0)" ::: "memory");
            const unsigned og = xb_add(&bar[XB_TOP], 1u);
            const unsigned tg = og / nx;
            if (og + 1u == (tg + 1u) * nx) xb_add(&bar[XB_TOPGEN], 1u);
            else XB_SPIN(xb_ld(&bar[XB_TOPGEN]) == tg, bar);
            __builtin_amdgcn_fence(__ATOMIC_ACQUIRE, "agent");
            xb_add(&bar[XB_XGEN(b.x)], 1u);
            asm volatile("s_waitcnt vmcnt(0)" ::: "memory");
        } else {
            XB_SPIN(xb_ld(&bar[XB_XGEN(b.x)]) == gen, bar);
            __builtin_amdgcn_fence(__ATOMIC_ACQUIRE, "agent");
            asm volatile("s_waitcnt vmcnt(0)" ::: "memory");
        }
    }
    __syncthreads();
}

struct Args {
    const float* x; const int* pos; const float* w_in; const float* w_gate; const float* w_branch; const float* w_out;
    const float* dq_gain; const float* dq_up; const float* dkv_gain; const float* dkv_up; const float* f_bias; const float* sinks; const float* ln_gain; const float* ln_bias;
    float* out; unsigned char* ws; int ph_lo, ph_hi;
};

__device__ __forceinline__ float wave_sum(float v) {
#pragma unroll
    for (int o = 1; o < 64; o <<= 1) v += __shfl_xor(v, o);
    return v;
}
__device__ __forceinline__ unsigned pack_fp4x8(float a0, float a1, float a2, float a3, float a4, float a5, float a6, float a7) {
    unsigned w = 0u;
    w = __builtin_amdgcn_cvt_scalef32_pk_fp4_f32(w, a0, a1, 1.0f, 0); w = __builtin_amdgcn_cvt_scalef32_pk_fp4_f32(w, a2, a3, 1.0f, 1);
    w = __builtin_amdgcn_cvt_scalef32_pk_fp4_f32(w, a4, a5, 1.0f, 2); w = __builtin_amdgcn_cvt_scalef32_pk_fp4_f32(w, a6, a7, 1.0f, 3);
    return w; }
constexpr float FP4_XS = 2.0f, FP4_WS = 128.0f;
__device__ __forceinline__ float fast_sigmoid(float v) { return __builtin_amdgcn_rcpf(1.0f + __builtin_amdgcn_exp2f(-v * LOG2E)); }

__device__ __forceinline__ int in_src(int j, float& sc) {
    sc = 1.0f;
    if (j < PC_AK)   return SC_AQ + (j - PC_AQ);
    if (j < PC_AV)   return SC_AK + (j - PC_AK);
    if (j < PC_AIQ)  return SC_AV + (j - PC_AV);
    if (j < PC_AZ)   return SC_AIQ + (j - PC_AIQ);
    if (j < PC_BQ)   return SC_AZ + (j - PC_AZ);
    if (j < PC_BK)   return SC_BQ + (j - PC_BQ);
    if (j < PC_BV)   return SC_BK + (j - PC_BK);
    if (j < PC_BZ)   return SC_BV + (j - PC_BV);
    if (j < PC_CQ)   return SC_BZ + (j - PC_BZ);
    if (j < PC_CK)   return SC_CQ + (j - PC_CQ);
    if (j < PC_CV)   return SC_CK + (j - PC_CK);
    if (j < PC_CZ)   return SC_CV + (j - PC_CV);
    if (j < PC_DCQ)  return SC_CZ + (j - PC_CZ);
    if (j < PC_DCKV) return SC_DCQ + (j - PC_DCQ);
    if (j < PC_DZ)   return SC_DCKV + (j - PC_DCKV);
    if (j < PC_AIK)  return SC_DZ + (j - PC_DZ);
    if (j < PC_AIW)  return SC_AIK + (j - PC_AIK);
    if (j < PC_BF)   return SC_AIW + (j - PC_AIW);
    if (j < PC_DKR)  return SC_BF + (j - PC_BF);
    if (j < PC_END)  { const int p = j - PC_DKR; return SC_DKR + (p >> 1) + 32 * (p & 1); }
    return -1;
}
__host__ __device__ __forceinline__ int in8_tile(int i) { return i < 6 ? i : (i < 22 ? i + 4 : i + 8); }
__host__ __device__ __forceinline__ int inz_tile(int j) { return j < 4 ? 26 + j : 31 + j; }
struct CvtItem {
    const float* p;
    unsigned ld;
    const float* gain;
    float sc;
    unsigned char* dst;
    int K, n0, k0, f8;
};
__device__ __forceinline__ CvtItem cvt_decode(const Args& a, int layer, int it, int lane) {
    unsigned char* W = a.ws + WS_W;
    constexpr int I_IN8 = (NIN8 / 32) * (DM / 64), I_INZ = (NINZ / 32) * (DM / 64), I_INB = (NINB / 32) * (DM / 64), I_G = (NGATE / 32) * (DM / 64), I_BR = 4 * (DM / 32) * (1024 / 64), I_OUT = (DM / 32) * (DM / 64), I_DQ = (1536 / 32) * (768 / 64);
    CvtItem d; d.gain = nullptr; d.sc = 1.0f; d.f8 = 1; d.K = DM; d.ld = DM;
    const int ln = lane & 31; int r = it;
    if (r < I_IN8) { const int nb = r % (NIN8 / 32), kb = r / (NIN8 / 32); d.n0 = nb * 32; d.k0 = kb * 64;
        const int j = in8_tile(d.n0 >> 8) * 256 + (d.n0 & 255) + ln; float s_; const int c = in_src(j, s_);
        d.p = a.w_in + (size_t)layer * DM * INW + (c < 0 ? 0 : c); d.ld = INW; d.sc = c < 0 ? 0.f : 64.0f; d.dst = W + WO_WIN8; return d; }
    r -= I_IN8;
    if (r < I_INZ) { const int nb = r % (NINZ / 32), kb = r / (NINZ / 32); d.n0 = nb * 32; d.k0 = kb * 64;
        const int j = inz_tile(d.n0 >> 8) * 256 + (d.n0 & 255) + ln; float s_; const int c = in_src(j, s_);
        d.p = a.w_in + (size_t)layer * DM * INW + (c < 0 ? 0 : c); d.ld = INW; d.sc = c < 0 ? 0.f : FP4_WS; d.dst = W + WO_WZ4; d.f8 = 2; return d; }
    r -= I_INZ;
    if (r < I_INB) { const int nb = r % (NINB / 32), kb = r / (NINB / 32); d.n0 = nb * 32; d.k0 = kb * 64;
        const int j = d.n0 + ln + (d.n0 < 1024 ? 1536 : 12032 - 1024); float s_; const int c = in_src(j, s_);
        d.p = a.w_in + (size_t)layer * DM * INW + (c < 0 ? 0 : c); d.ld = INW; d.sc = c < 0 ? 0.f : 1.0f; d.dst = W + WO_WINB; d.f8 = 0; return d; }
    r -= I_INB;
    if (r < I_G) { const int nb = r % (NGATE / 32), kb = r / (NGATE / 32), g = nb / (DM / 32); d.n0 = (nb % (DM / 32)) * 32; d.k0 = kb * 64;
        d.p = a.w_gate + ((size_t)layer * 4 + g) * DM * DM + d.n0 + ln; d.sc = FP4_WS; d.dst = W + WO_WG8 + (size_t)g * DM * (DM / 2); d.f8 = 2; return d; }
    r -= I_G;
    if (r < I_BR) { const int n = r / ((DM / 32) * 16), q = r % ((DM / 32) * 16), nb = q % (DM / 32), kb = q / (DM / 32); d.n0 = nb * 32; d.k0 = kb * 64;
        d.p = a.w_branch + ((size_t)layer * 4 + n) * 1024 * DM + d.n0 + ln; d.sc = 64.0f; d.dst = W + WO_WBR + (size_t)n * DM * 1024; d.K = 1024; return d; }
    r -= I_BR;
    if (r < I_OUT) { const int nb = r % (DM / 32), kb = r / (DM / 32); d.n0 = nb * 32; d.k0 = kb * 64;
        d.p = a.w_out + (size_t)layer * DM * DM + d.n0 + ln; d.sc = 128.0f; d.dst = W + WO_WOUT; return d; }
    r -= I_OUT;
    if (r < I_DQ) { const int nb = r % 48, kb = r / 48; d.n0 = nb * 32; d.k0 = kb * 64;
        const int j = d.n0 + ln, h = j / 192, wv = j % 192; int c = wv; if (wv >= 128) { const int q = wv - 128; c = 128 + (q >> 1) + 32 * (q & 1); }
        d.p = a.dq_up + (size_t)layer * 768 * 1536 + h * 192 + c; d.ld = 1536; d.gain = a.dq_gain + layer * 768; d.sc = 0.07216878364870322f * LOG2E * DQ_WS; d.dst = W + WO_DQUP; d.K = 768; d.f8 = 1; return d; }
    r -= I_DQ;
    { const int nb = r % 64, kb = r / 64; d.n0 = nb * 32; d.k0 = kb * 64;
      d.p = a.dkv_up + (size_t)layer * 256 * 2048 + d.n0 + ln; d.ld = 2048; d.gain = a.dkv_gain + layer * 256; d.sc = DKV_WS; d.dst = W + WO_DKVUP; d.K = 256; d.f8 = 1; return d; }
}
__device__ __forceinline__ void cvt_load(const CvtItem& d, float (&v)[32], int lane) {
    const float* p = d.p + (size_t)(d.k0 + (lane >> 5)) * d.ld;
#pragma unroll
    for (int i = 0; i < 32; ++i) v[i] = p[(size_t)(2 * i) * d.ld];
}
__device__ __forceinline__ void cvt_finish(const CvtItem& d, const float (&v)[32], LAS float* scr, int lane) {
#pragma unroll
    for (int i = 0; i < 32; ++i) { const int kk = 2 * i + (lane >> 5); float x = v[i] * d.sc; if (d.gain) x *= d.gain[d.k0 + kk]; scr[kk * 33 + (lane & 31)] = x; }
    LDS_WAIT(); asm volatile("" ::: "memory");
    const int c = lane & 7;
#pragma unroll
    for (int j = 0; j < 4; ++j) { const int n = (lane >> 3) + 8 * j; const LAS float* s = scr + (8 * c) * 33 + n;
        if (d.f8 == 2) *(unsigned*)(d.dst + (((size_t)(d.n0 + n) * d.K + d.k0 + 8 * c) >> 1)) = pack_fp4x8(s[0], s[33], s[2 * 33], s[3 * 33], s[4 * 33], s[5 * 33], s[6 * 33], s[7 * 33]);
        else if (d.f8) { int w0 = 0, w1 = 0;
            w0 = __builtin_amdgcn_cvt_pk_fp8_f32(s[0], s[33], w0, false); w0 = __builtin_amdgcn_cvt_pk_fp8_f32(s[2 * 33], s[3 * 33], w0, true);
            w1 = __builtin_amdgcn_cvt_pk_fp8_f32(s[4 * 33], s[5 * 33], w1, false); w1 = __builtin_amdgcn_cvt_pk_fp8_f32(s[6 * 33], s[7 * 33], w1, true);
            *(u32x2*)(d.dst + (size_t)(d.n0 + n) * d.K + d.k0 + 8 * c) = (u32x2){(unsigned)w0, (unsigned)w1}; }
        else { u32x4 o; o.x = cvt_pk_bf16(s[0], s[33]); o.y = cvt_pk_bf16(s[2 * 33], s[3 * 33]); o.z = cvt_pk_bf16(s[4 * 33], s[5 * 33]); o.w = cvt_pk_bf16(s[6 * 33], s[7 * 33]);
            *(u32x4*)((bf16_t*)d.dst + (size_t)(d.n0 + n) * d.K + d.k0 + 8 * c) = o; } }
    LDS_WAIT(); asm volatile("" ::: "memory");
}
__device__ __forceinline__ void convert_weights(const Args& a, int layer, LAS unsigned char* lds) {
    const int tid = ptid(), lane = tid & 63, wave = tid >> 6;
    LAS float* scr = (LAS float*)(lds + wave * 8448);
    const int NGW = gridDim.x * NWAVES, gw = blockIdx.x * NWAVES + wave;
    constexpr int NITEMS = (NIN8 / 32) * (DM / 64) + (NINZ / 32) * (DM / 64) + (NINB / 32) * (DM / 64) + (NGATE / 32) * (DM / 64) + 4 * (DM / 32) * (1024 / 64) + (DM / 32) * (DM / 64) + (1536 / 32) * (768 / 64) + (2048 / 32) * (256 / 64);
    float va[32], vb[32]; CvtItem da, db;
    int it = gw;
    if (it < NITEMS) { da = cvt_decode(a, layer, it, lane); cvt_load(da, va, lane); }
    while (it < NITEMS) {
        const int itb = it + NGW;
        if (itb < NITEMS) { db = cvt_decode(a, layer, itb, lane); cvt_load(db, vb, lane); }
        cvt_finish(da, va, scr, lane);
        if (itb >= NITEMS) break;
        const int ita = itb + NGW;
        if (ita < NITEMS) { da = cvt_decode(a, layer, ita, lane); cvt_load(da, va, lane); }
        cvt_finish(db, vb, scr, lane);
        it = ita;
    }
    __syncthreads();
}
__device__ __forceinline__ void prologue_misc(const Args& a) {
    const size_t gt = (size_t)blockIdx.x * NTHREADS + ptid(), GT = (size_t)gridDim.x * NTHREADS;
    bf16_t* XB = (bf16_t*)(a.ws + WS_XB);
    constexpr size_t NCH = (size_t)MTOK * DM / 8;
    for (size_t i0 = gt; i0 < NCH; i0 += 4 * GT) {
        f32x4 v0[4], v1[4];
#pragma unroll
        for (int u = 0; u < 4; ++u) { const size_t i = i0 + u * GT; if (i < NCH) { v0[u] = *(const f32x4*)(a.x + i * 8); v1[u] = *(const f32x4*)(a.x + i * 8 + 4); } }
#pragma unroll
        for (int u = 0; u < 4; ++u) { const size_t i = i0 + u * GT; if (i < NCH) {
            u32x4 o; o.x = cvt_pk_bf16(v0[u][0], v0[u][1]); o.y = cvt_pk_bf16(v0[u][2], v0[u][3]); o.z = cvt_pk_bf16(v1[u][0], v1[u][1]); o.w = cvt_pk_bf16(v1[u][2], v1[u][3]);
            *(u32x4*)(XB + i * 8) = o;
            int w0 = 0, w1 = 0;
            w0 = __builtin_amdgcn_cvt_pk_fp8_f32(v0[u][0], v0[u][1], w0, false); w0 = __builtin_amdgcn_cvt_pk_fp8_f32(v0[u][2], v0[u][3], w0, true);
            w1 = __builtin_amdgcn_cvt_pk_fp8_f32(v1[u][0], v1[u][1], w1, false); w1 = __builtin_amdgcn_cvt_pk_fp8_f32(v1[u][2], v1[u][3], w1, true);
            *(u32x2*)(a.ws + WS_X8 + i * 8) = (u32x2){(unsigned)w0, (unsigned)w1};
            *(unsigned*)(a.ws + WS_X4 + i * 4) = pack_fp4x8(v0[u][0] * FP4_XS, v0[u][1] * FP4_XS, v0[u][2] * FP4_XS, v0[u][3] * FP4_XS, v1[u][0] * FP4_XS, v1[u][1] * FP4_XS, v1[u][2] * FP4_XS, v1[u][3] * FP4_XS); } }
    }
    f32x2* CS = (f32x2*)(a.ws + WS_CS);
    for (size_t i = gt; i < (size_t)MTOK * 32; i += GT) {
        const int row = (int)(i >> 5), fi = (int)(i & 31);
        const float invf = __builtin_amdgcn_exp2f(-(float)fi * (13.287712379549449f / 32.0f));
        const float ang = (float)a.pos[row] * invf;
        const double rev = (double)ang * 0.15915494309189535;
        const float fr = (float)(rev - floor(rev));
        CS[i] = (f32x2){__builtin_amdgcn_cosf(fr), __builtin_amdgcn_sinf(fr)};
    }
}

struct EpiIn {
    static constexpr int PERM = 2; static constexpr bool CARRY = false;
    bf16_t* P; float* SM; float* RSS; int f8; unsigned char* KV8; unsigned char* L8;
    template <int MODE>
    __device__ __forceinline__ void run(const f32x4 (&acc)[2][2][4][2], int pn, int row0, int cw, int wc, int fq, float sc) const {
        bf16_t* base = P + (size_t)pn * 256 + cw;
        unsigned char* k8b = (MODE == 3) ? L8 + (pn - 39) * 256 + cw : KV8 + (pn < 6 ? (pn - 4) * 256 : 512 + (pn - 18) * 256) + cw;
#pragma unroll
        for (int ai = 0; ai < 2; ++ai)
#pragma unroll
            for (int m = 0; m < 4; ++m) { const int row = row0 + ai * 128 + m * 16; bf16_t* rowp = base + (size_t)row * INP; float ss = 0.f;
                u32x4 k8w;
#pragma unroll
                for (int bj = 0; bj < 2; ++bj) { f32x4 v0 = acc[ai][bj][m][0] * sc, v1 = acc[ai][bj][m][1] * sc;
                    if constexpr (MODE == 3) ss += ((v0[0] * v0[0] + v0[1] * v0[1]) + (v0[2] * v0[2] + v0[3] * v0[3])) + ((v1[0] * v1[0] + v1[1] * v1[1]) + (v1[2] * v1[2] + v1[3] * v1[3]));
                    if constexpr (MODE == 4 || MODE == 3) { int w0 = 0, w1 = 0;
                        w0 = __builtin_amdgcn_cvt_pk_fp8_f32(v0[0], v0[1], w0, false); w0 = __builtin_amdgcn_cvt_pk_fp8_f32(v0[2], v0[3], w0, true);
                        w1 = __builtin_amdgcn_cvt_pk_fp8_f32(v1[0], v1[1], w1, false); w1 = __builtin_amdgcn_cvt_pk_fp8_f32(v1[2], v1[3], w1, true);
                        if (bj == 0) { k8w.x = (unsigned)w0; k8w.y = (unsigned)w1; } else { k8w.z = (unsigned)w0; k8w.w = (unsigned)w1; } continue; }
                    if constexpr (MODE == 1) {
#pragma unroll
                        for (int j = 0; j < 4; ++j) { v0[j] = v0[j] * fast_sigmoid(v0[j]); v1[j] = v1[j] * fast_sigmoid(v1[j]); } }
                    if constexpr (MODE == 2) { float* sp = SM + (size_t)row * 256 + cw + bj * 8; *(f32x4*)sp = v0; *(f32x4*)(sp + 4) = v1; }
                    u32x4 w; w.x = cvt_pk_bf16(v0[0], v0[1]); w.y = cvt_pk_bf16(v0[2], v0[3]); w.z = cvt_pk_bf16(v1[0], v1[1]); w.w = cvt_pk_bf16(v1[2], v1[3]);
                    *(u32x4*)(rowp + bj * 8) = w; }
                if constexpr (MODE == 4) *(u32x4*)(k8b + (size_t)row * KV8W) = k8w;
                if constexpr (MODE == 3) *(u32x4*)(k8b + (size_t)row * 1024) = k8w;
                if constexpr (MODE == 3) { ss += __shfl_xor(ss, 16); ss += __shfl_xor(ss, 32); if (fq == 0) RSS[(size_t)row * 16 + (pn - 39) * 4 + wc] = ss; }
                asm volatile("" ::: "memory"); }
    }
    __device__ __forceinline__ void operator()(f32x4 (&acc)[2][2][4][2], const pg8::Unit& u, int wr, int wc, int fr, int fq) const {
        asm volatile("" : "+v"(fr), "+v"(fq));
        const int pn = f8 == 1 ? in8_tile(u.pn) : (f8 == 2 ? inz_tile(u.pn) : (u.pn < 4 ? u.pn + 6 : 47)), row0 = u.pm * 256 + wr * 64 + fr, cw = wc * 64 + 16 * fq;
        const float qs = (pn < 4 || (pn >= 14 && pn < 18)) ? 0.08838834764831845f * LOG2E : ((pn >= 30 && pn < 34) ? 0.125f * LOG2E : 1.0f), sc = f8 == 1 ? qs * 0.015625f : (f8 == 2 ? 1.0f / (FP4_XS * FP4_WS * 0.9761f) : qs);
        if (pn == 47) run<2>(acc, pn, row0, cw, wc, fq, sc);
        else if (pn >= 39 && pn < 43) run<3>(acc, pn, row0, cw, wc, fq, sc);
        else if (pn == 4 || pn == 5 || (pn >= 18 && pn < 26)) run<4>(acc, pn, row0, cw, wc, fq, sc);
        else run<0>(acc, pn, row0, cw, wc, fq, sc);
    }
};
struct EpiGate {
    static constexpr int PERM = 2; static constexpr bool CARRY = false;
    unsigned char* G; float sc;
    __device__ __forceinline__ void operator()(f32x4 (&acc)[2][2][4][2], const pg8::Unit& u, int wr, int wc, int fr, int fq) const {
        asm volatile("" : "+v"(fr), "+v"(fq));
        unsigned char* base = G + ((((size_t)u.pm * 64 + u.pn) * 8 + (wr * 4 + wc)) * 8) * 1024 + (fq * 16 + fr) * 16;
#pragma unroll
        for (int ai = 0; ai < 2; ++ai)
#pragma unroll
            for (int m = 0; m < 4; ++m) { unsigned char* rowp = base + (ai * 4 + m) * 1024; u32x4 w;
#pragma unroll
                for (int bj = 0; bj < 2; ++bj) { const f32x4 v0 = acc[ai][bj][m][0] * sc, v1 = acc[ai][bj][m][1] * sc; int w0 = 0, w1 = 0;
                    w0 = __builtin_amdgcn_cvt_pk_fp8_f32(v0[0], v0[1], w0, false); w0 = __builtin_amdgcn_cvt_pk_fp8_f32(v0[2], v0[3], w0, true);
                    w1 = __builtin_amdgcn_cvt_pk_fp8_f32(v1[0], v1[1], w1, false); w1 = __builtin_amdgcn_cvt_pk_fp8_f32(v1[2], v1[3], w1, true);
                    if (bj == 0) { w.x = (unsigned)w0; w.y = (unsigned)w1; } else { w.z = (unsigned)w0; w.w = (unsigned)w1; } }
                *(u32x4*)rowp = w; }
    }
};
struct EpiNull {
    static constexpr int PERM = 1; static constexpr bool CARRY = false;
    float* D;
    __device__ __forceinline__ void operator()(f32x4 (&acc)[2][2][4][2], const pg8::Unit& u, int wr, int wc, int fr, int fq) const {
        f32x4 s = (f32x4){0.f, 0.f, 0.f, 0.f};
#pragma unroll
        for (int ai = 0; ai < 2; ++ai)
#pragma unroll
            for (int bj = 0; bj < 2; ++bj)
#pragma unroll
                for (int m = 0; m < 4; ++m)
#pragma unroll
                    for (int n = 0; n < 2; ++n) s += acc[ai][bj][m][n];
        *(f32x4*)(D + ((size_t)(u.pm * 64 + u.pn) * 512 + wr * 256 + wc * 64 + fq * 16 + fr) * 4) = s;
    }
};
struct EpiDq {
    static constexpr int PERM = 2; static constexpr bool CARRY = false;
    bf16_t* DQ; const float* RSS; const float* CS; float wsc;
    __device__ __forceinline__ void operator()(f32x4 (&acc)[2][2][4][2], const pg8::Unit& u, int wr, int wc, int fr, int fq) const {
        asm volatile("" : "+v"(fr), "+v"(fq));
        const int row0 = u.pm * 256 + wr * 64 + fr, col0 = u.pn * 256 + wc * 64 + 16 * fq;
#pragma unroll
        for (int ai = 0; ai < 2; ++ai)
#pragma unroll
            for (int m = 0; m < 4; ++m) { const int row = row0 + ai * 128 + m * 16;
                const f32x4 r0 = *(const f32x4*)(RSS + (size_t)row * 16), r1 = *(const f32x4*)(RSS + (size_t)row * 16 + 4), r2 = *(const f32x4*)(RSS + (size_t)row * 16 + 8);
                const float ss = ((r0[0] + r0[1]) + (r0[2] + r0[3])) + ((r1[0] + r1[1]) + (r1[2] + r1[3])) + ((r2[0] + r2[1]) + (r2[2] + r2[3]));
                const float rs = __builtin_amdgcn_rsqf(ss * (1.0f / 768.0f) + RMS_EPS) * wsc;
                bf16_t* rowp = DQ + (size_t)row * 1536 + col0;
#pragma unroll
                for (int bj = 0; bj < 2; ++bj) { f32x4 v[2];
#pragma unroll
                    for (int n = 0; n < 2; ++n) { v[n] = acc[ai][bj][m][n] * rs; const int c = col0 + bj * 8 + 4 * n, w = c % 192;
                        if (w >= 128) { const f32x4 cs = *(const f32x4*)(CS + (size_t)row * 64 + (w - 128));
                            const f32x4 t = v[n]; v[n][0] = t[0] * cs[0] - t[1] * cs[1]; v[n][1] = t[0] * cs[1] + t[1] * cs[0]; v[n][2] = t[2] * cs[2] - t[3] * cs[3]; v[n][3] = t[2] * cs[3] + t[3] * cs[2]; } }
                    u32x4 w4; w4.x = cvt_pk_bf16(v[0][0], v[0][1]); w4.y = cvt_pk_bf16(v[0][2], v[0][3]); w4.z = cvt_pk_bf16(v[1][0], v[1][1]); w4.w = cvt_pk_bf16(v[1][2], v[1][3]);
                    *(u32x4*)(rowp + bj * 8) = w4; }
                asm volatile("" ::: "memory"); }
    }
};
struct EpiDkv {
    static constexpr int PERM = 2; static constexpr bool CARRY = false;
    unsigned char* D8; const float* RSS; float wsc;
    __device__ __forceinline__ void operator()(f32x4 (&acc)[2][2][4][2], const pg8::Unit& u, int wr, int wc, int fr, int fq) const {
        asm volatile("" : "+v"(fr), "+v"(fq));
        const int row0 = u.pm * 256 + wr * 64 + fr, col0 = u.pn * 256 + wc * 64 + 16 * fq;
        f32x4 r3v[2][4];
#pragma unroll
        for (int ai = 0; ai < 2; ++ai)
#pragma unroll
            for (int m = 0; m < 4; ++m) r3v[ai][m] = *(const f32x4*)(RSS + (size_t)(row0 + ai * 128 + m * 16) * 16 + 12);
#pragma unroll
        for (int ai = 0; ai < 2; ++ai)
#pragma unroll
            for (int m = 0; m < 4; ++m) { const int row = row0 + ai * 128 + m * 16;
                const f32x4 r3 = r3v[ai][m];
                const float rs = __builtin_amdgcn_rsqf(((r3[0] + r3[1]) + (r3[2] + r3[3])) * (1.0f / 256.0f) + RMS_EPS) * wsc;
                u32x4 w4;
#pragma unroll
                for (int bj = 0; bj < 2; ++bj) { const f32x4 v0 = acc[ai][bj][m][0] * rs, v1 = acc[ai][bj][m][1] * rs; int w0 = 0, w1 = 0;
                    w0 = __builtin_amdgcn_cvt_pk_fp8_f32(v0[0], v0[1], w0, false); w0 = __builtin_amdgcn_cvt_pk_fp8_f32(v0[2], v0[3], w0, true);
                    w1 = __builtin_amdgcn_cvt_pk_fp8_f32(v1[0], v1[1], w1, false); w1 = __builtin_amdgcn_cvt_pk_fp8_f32(v1[2], v1[3], w1, true);
                    if (bj == 0) { w4.x = (unsigned)w0; w4.y = (unsigned)w1; } else { w4.z = (unsigned)w0; w4.w = (unsigned)w1; } }
                *(u32x4*)(D8 + (size_t)row * D8W + col0) = w4;
                asm volatile("" ::: "memory"); }
    }
};
struct EpiMerge {
    static constexpr int PERM = 2; static constexpr bool CARRY = true;
    const unsigned char* G; unsigned char* MRG;
    __device__ __forceinline__ void operator()(f32x4 (&acc)[2][2][4][2], const pg8::Unit& u, int wr, int wc, int fr, int fq) const {
        asm volatile("" : "+v"(fr), "+v"(fq));
        const int row0 = u.pm * 256 + wr * 64 + fr, col0 = u.pn * 256 + wc * 64 + 16 * fq, z = u.z;
        const float fin = 0.001953125f * 16.0f;
        u32x4 ga[2][4], gb[2][4];
        const unsigned char* gta = G + ((((size_t)u.pm * 64 + z * 16 + u.pn) * 8 + (wr * 4 + wc)) * 8) * 1024 + (fq * 16 + fr) * 16;
        const unsigned char* gtb = gta + (z < 3 ? (size_t)16 * 8 * 8 * 1024 : 0);
#define MG_LOAD(ai_, m_) do { ga[ai_][m_] = *(const u32x4*)(gta + ((ai_) * 4 + (m_)) * 1024); \
            gb[ai_][m_] = *(const u32x4*)(gtb + ((ai_) * 4 + (m_)) * 1024); } while (0)
#pragma unroll
        for (int m = 0; m < 4; ++m) MG_LOAD(0, m);
#pragma unroll
        for (int ai = 0; ai < 2; ++ai) {
#pragma unroll
            for (int m = 0; m < 4; ++m) { const size_t row = (size_t)(row0 + ai * 128 + m * 16); u32x4 wo;
                if (ai == 0) MG_LOAD(1, m);
#pragma unroll
                for (int bj = 0; bj < 2; ++bj) { const unsigned ax = bj ? ga[ai][m].z : ga[ai][m].x, ay = bj ? ga[ai][m].w : ga[ai][m].y, bx = bj ? gb[ai][m].z : gb[ai][m].x, by = bj ? gb[ai][m].w : gb[ai][m].y;
                    float fa[8], fb[8];
                    { const f32x2 t0 = __builtin_amdgcn_cvt_pk_f32_fp8((int)ax, false), t1 = __builtin_amdgcn_cvt_pk_f32_fp8((int)ax, true), t2 = __builtin_amdgcn_cvt_pk_f32_fp8((int)ay, false), t3 = __builtin_amdgcn_cvt_pk_f32_fp8((int)ay, true);
                      fa[0] = t0[0]; fa[1] = t0[1]; fa[2] = t1[0]; fa[3] = t1[1]; fa[4] = t2[0]; fa[5] = t2[1]; fa[6] = t3[0]; fa[7] = t3[1]; }
                    { const f32x2 t0 = __builtin_amdgcn_cvt_pk_f32_fp8((int)bx, false), t1 = __builtin_amdgcn_cvt_pk_f32_fp8((int)bx, true), t2 = __builtin_amdgcn_cvt_pk_f32_fp8((int)by, false), t3 = __builtin_amdgcn_cvt_pk_f32_fp8((int)by, true);
                      fb[0] = t0[0]; fb[1] = t0[1]; fb[2] = t1[0]; fb[3] = t1[1]; fb[4] = t2[0]; fb[5] = t2[1]; fb[6] = t3[0]; fb[7] = t3[1]; }
                    float f[8];
#pragma unroll
                    for (int e = 0; e < 8; ++e) { const float ra = __builtin_amdgcn_rcpf(1.0f + __builtin_amdgcn_exp2f(fa[e]));
                        f[e] = (z < 3) ? ra * (1.0f + __builtin_amdgcn_exp2f(fb[e])) : ra * fin; }
                    f32x4 v0 = acc[ai][bj][m][0], v1 = acc[ai][bj][m][1];
                    v0[0] *= f[0]; v0[1] *= f[1]; v0[2] *= f[2]; v0[3] *= f[3]; v1[0] *= f[4]; v1[1] *= f[5]; v1[2] *= f[6]; v1[3] *= f[7];
                    if (z < 3) { acc[ai][bj][m][0] = v0; acc[ai][bj][m][1] = v1; }
                    else { int w0 = 0, w1 = 0;
                        w0 = __builtin_amdgcn_cvt_pk_fp8_f32(v0[0], v0[1], w0, false); w0 = __builtin_amdgcn_cvt_pk_fp8_f32(v0[2], v0[3], w0, true);
                        w1 = __builtin_amdgcn_cvt_pk_fp8_f32(v1[0], v1[1], w1, false); w1 = __builtin_amdgcn_cvt_pk_fp8_f32(v1[2], v1[3], w1, true);
                        if (bj == 0) { wo.x = (unsigned)w0; wo.y = (unsigned)w1; } else { wo.z = (unsigned)w0; wo.w = (unsigned)w1; } } }
                if (z == 3) *(u32x4*)(MRG + row * DM + col0) = wo; }
            asm volatile("" ::: "memory"); }
#undef MG_LOAD
    }
};
struct EpiOut {
    static constexpr int PERM = 2; static constexpr bool CARRY = false;
    const bf16_t* XBr; bf16_t* R;
    __device__ __forceinline__ void operator()(f32x4 (&acc)[2][2][4][2], const pg8::Unit& u, int wr, int wc, int fr, int fq) const {
        asm volatile("" : "+v"(fr), "+v"(fq));
        const int row0 = u.pm * 256 + wr * 64 + fr, col0 = u.pn * 256 + wc * 64 + 16 * fq;
        u32x4 xw[2][4][2];
#pragma unroll
        for (int ai = 0; ai < 2; ++ai)
#pragma unroll
            for (int m = 0; m < 4; ++m) { const size_t off = (size_t)(row0 + ai * 128 + m * 16) * DM + col0;
#pragma unroll
                for (int bj = 0; bj < 2; ++bj) xw[ai][m][bj] = *(const u32x4*)(XBr + off + bj * 8); }
#pragma unroll
        for (int ai = 0; ai < 2; ++ai) {
#pragma unroll
            for (int m = 0; m < 4; ++m) { const size_t off = (size_t)(row0 + ai * 128 + m * 16) * DM + col0;
#pragma unroll
                for (int bj = 0; bj < 2; ++bj) { const u32x4 w = xw[ai][m][bj];
                    const f32x4 x0 = (f32x4){__uint_as_float(w.x << 16), __uint_as_float(w.x & 0xffff0000u), __uint_as_float(w.y << 16), __uint_as_float(w.y & 0xffff0000u)};
                    const f32x4 x1 = (f32x4){__uint_as_float(w.z << 16), __uint_as_float(w.z & 0xffff0000u), __uint_as_float(w.w << 16), __uint_as_float(w.w & 0xffff0000u)};
                    const f32x4 r0 = x0 * DN_ALPHA + acc[ai][bj][m][0] * 0.00048828125f, r1 = x1 * DN_ALPHA + acc[ai][bj][m][1] * 0.00048828125f;
                    u32x4 w4; w4.x = cvt_pk_bf16(r0[0], r0[1]); w4.y = cvt_pk_bf16(r0[2], r0[3]); w4.z = cvt_pk_bf16(r1[0], r1[1]); w4.w = cvt_pk_bf16(r1[2], r1[3]);
                    *(u32x4*)(R + off + bj * 8) = w4; } }
            asm volatile("" ::: "memory"); }
    }
};

__device__ __forceinline__ void ln_phase(const bf16_t* R, const float* gain, const float* bias, float* OUTF, bf16_t* XB, unsigned char* X8, unsigned char* X4) {
    const int tid_ = ptid(), lane = tid_ & 63, wave = tid_ >> 6;
    const int gw = blockIdx.x * NWAVES + wave, NGW = gridDim.x * NWAVES;
    for (int row = gw; row < MTOK; row += NGW) {
        const u32x4* rp = (const u32x4*)(R + (size_t)row * DM) + lane;
        float v[8][8]; float s = 0.f;
#pragma unroll
        for (int j = 0; j < 8; ++j) { const u32x4 w = rp[64 * j];
            v[j][0] = __uint_as_float(w.x << 16); v[j][1] = __uint_as_float(w.x & 0xffff0000u); v[j][2] = __uint_as_float(w.y << 16); v[j][3] = __uint_as_float(w.y & 0xffff0000u);
            v[j][4] = __uint_as_float(w.z << 16); v[j][5] = __uint_as_float(w.z & 0xffff0000u); v[j][6] = __uint_as_float(w.w << 16); v[j][7] = __uint_as_float(w.w & 0xffff0000u);
#pragma unroll
            for (int e = 0; e < 8; ++e) s += v[j][e]; }
        const float mean = wave_sum(s) * (1.0f / DM); float q = 0.f;
#pragma unroll
        for (int j = 0; j < 8; ++j)
#pragma unroll
            for (int e = 0; e < 8; ++e) { v[j][e] -= mean; q += v[j][e] * v[j][e]; }
        const float rstd = __builtin_amdgcn_rsqf(wave_sum(q) * (1.0f / DM) + LN_EPS);
#pragma unroll
        for (int j = 0; j < 8; ++j) { const int c8 = (lane + 64 * j) * 8;
            const f32x4 g0 = *(const f32x4*)(gain + c8), g1 = *(const f32x4*)(gain + c8 + 4), b0 = *(const f32x4*)(bias + c8), b1 = *(const f32x4*)(bias + c8 + 4);
            const f32x4 o0 = (f32x4){v[j][0], v[j][1], v[j][2], v[j][3]} * rstd * g0 + b0, o1 = (f32x4){v[j][4], v[j][5], v[j][6], v[j][7]} * rstd * g1 + b1;
            if (OUTF) { *(f32x4*)(OUTF + (size_t)row * DM + c8) = o0; *(f32x4*)(OUTF + (size_t)row * DM + c8 + 4) = o1; }
            if (XB) { u32x4 w; w.x = cvt_pk_bf16(o0[0], o0[1]); w.y = cvt_pk_bf16(o0[2], o0[3]); w.z = cvt_pk_bf16(o1[0], o1[1]); w.w = cvt_pk_bf16(o1[2], o1[3]); *(u32x4*)(XB + (size_t)row * DM + c8) = w;
                int w0 = 0, w1 = 0; w0 = __builtin_amdgcn_cvt_pk_fp8_f32(o0[0], o0[1], w0, false); w0 = __builtin_amdgcn_cvt_pk_fp8_f32(o0[2], o0[3], w0, true);
                w1 = __builtin_amdgcn_cvt_pk_fp8_f32(o1[0], o1[1], w1, false); w1 = __builtin_amdgcn_cvt_pk_fp8_f32(o1[2], o1[3], w1, true);
                *(u32x2*)(X8 + (size_t)row * DM + c8) = (u32x2){(unsigned)w0, (unsigned)w1};
                *(unsigned*)(X4 + (((size_t)row * DM + c8) >> 1)) = pack_fp4x8(o0[0] * FP4_XS, o0[1] * FP4_XS, o0[2] * FP4_XS, o0[3] * FP4_XS, o1[0] * FP4_XS, o1[1] * FP4_XS, o1[2] * FP4_XS, o1[3] * FP4_XS); } }
    }
}
__device__ __forceinline__ void cumsum_phase(const float* SM, const float* f_bias, float* CUM) {
    if ((int)blockIdx.x < (int)gridDim.x - BATCH) return;
    const int tid_ = ptid(), b = (int)blockIdx.x - ((int)gridDim.x - BATCH), h = tid_ >> 6, lane = tid_ & 63;
    const float fb = f_bias[h];
    const float* src = SM + ((size_t)b * SEQ + lane * 64) * 256 + SMC_BF + h;
    float run = 0.f; float vals[64];
#pragma unroll
    for (int j = 0; j < 64; ++j) { const float xv = src[(size_t)j * 256] + fb; const float ls = fminf(xv, 0.f) - log1pf(__expf(-fabsf(xv))); run += ls; vals[j] = run; }
    float incl = run;
#pragma unroll
    for (int o = 1; o < 64; o <<= 1) { const float t = __shfl_up(incl, o); if (lane >= o) incl += t; }
    const float offs = incl - run;
    float* dst = CUM + ((size_t)b * 8 + h) * SEQ + lane * 64;
#pragma unroll
    for (int j = 0; j < 64; j += 4) *(f32x4*)(dst + j) = (f32x4){(vals[j] + offs) * LOG2E, (vals[j + 1] + offs) * LOG2E, (vals[j + 2] + offs) * LOG2E, (vals[j + 3] + offs) * LOG2E};
}
__device__ __forceinline__ void krope_phase(const float* SM, const float* CS, unsigned char* D8) {
    const size_t gt = (size_t)blockIdx.x * NTHREADS + ptid(), GT = (size_t)gridDim.x * NTHREADS;
    for (size_t i = gt; i < (size_t)MTOK * 32; i += GT) {
        const size_t row = i >> 5; const int p = (int)(i & 31);
        const f32x2 t = *(const f32x2*)(SM + row * 256 + SMC_DKR + 2 * p), cs = *(const f32x2*)(CS + row * 64 + 2 * p);
        { int w = 0; w = __builtin_amdgcn_cvt_pk_fp8_f32(t[0] * cs[0] - t[1] * cs[1], t[0] * cs[1] + t[1] * cs[0], w, false); *(unsigned short*)(D8 + row * D8W + 2048 + 2 * p) = (unsigned short)w; }
    }
}

__device__ __forceinline__ int wave_count7(unsigned c) { int t = 0;
#pragma unroll
    for (int b = 0; b < 7; ++b) t += __builtin_popcountll(__ballot((c >> b) & 1u)) << b;
    return t; }
__device__ __forceinline__ unsigned f2ord(float f) { const unsigned u = __float_as_uint(f); return u ^ ((u >> 31) ? 0xffffffffu : 0x80000000u); }
template <int DBG = 0>
__device__ __forceinline__ void indexer_unit(LAS unsigned char* lds, const bf16_t* P, const float* SM, float* SC, unsigned long long* MASK, int b, int qb) {
    constexpr int QSTR = 2064 + 256;
    constexpr int L_IQ = 0, L_STG = 32 * QSTR;
    const int tid = ptid(), wid = __builtin_amdgcn_readfirstlane(tid >> 6), lane = tid & 63, r32 = lane & 31, hi = lane >> 5;
    const int t0 = qb * 32; const size_t row0 = (size_t)b * SEQ + t0;
#pragma unroll
    for (int i = 0; i < 8; ++i) { const int ci = tid + 512 * i, r = ci >> 7, cc = ci & 127;
        const bf16x8 v = *(const bf16x8*)(P + (row0 + r) * INP + PC_AIQ + cc * 8);
        *(LAS bf16x8*)(lds + L_IQ + r * QSTR + cc * 16) = v; }
    float w[16];
    { const float* wp = SM + (row0 + r32) * 256 + SMC_AIW;
#pragma unroll
      for (int j = 0; j < 4; ++j) { const f32x4 v = *(const f32x4*)(wp + 4 * j); w[4 * j] = v[0] * 0.03125f; w[4 * j + 1] = v[1] * 0.03125f; w[4 * j + 2] = v[2] * 0.03125f; w[4 * j + 3] = v[3] * 0.03125f; } }
    __syncthreads();
    { const int r = tid >> 4, d0 = (tid & 15) * 4;
      const float* wp = SM + (row0 + r) * 256 + SMC_AIW; float qb4[4] = {0.f, 0.f, 0.f, 0.f};
#pragma unroll
      for (int h = 0; h < 16; ++h) { const float wh = wp[h] * 0.03125f; const u32x2 q2 = *(const LAS u32x2*)(lds + L_IQ + r * QSTR + (h * 64 + d0) * 2);
          qb4[0] = fmaf(wh, __uint_as_float(q2.x << 16), qb4[0]); qb4[1] = fmaf(wh, __uint_as_float(q2.x & 0xffff0000u), qb4[1]);
          qb4[2] = fmaf(wh, __uint_as_float(q2.y << 16), qb4[2]); qb4[3] = fmaf(wh, __uint_as_float(q2.y & 0xffff0000u), qb4[3]); }
      u32x2 hi2, lo2; hi2.x = cvt_pk_bf16(qb4[0], qb4[1]); hi2.y = cvt_pk_bf16(qb4[2], qb4[3]);
      lo2.x = cvt_pk_bf16(qb4[0] - __uint_as_float(hi2.x << 16), qb4[1] - __uint_as_float(hi2.x & 0xffff0000u)); lo2.y = cvt_pk_bf16(qb4[2] - __uint_as_float(hi2.y << 16), qb4[3] - __uint_as_float(hi2.y & 0xffff0000u));
      *(LAS u32x2*)(lds + L_IQ + r * QSTR + (1024 + d0) * 2) = hi2; *(LAS u32x2*)(lds + L_IQ + r * QSTR + (1088 + d0) * 2) = lo2; }
    __syncthreads();
    LAS float* stg = (LAS float*)(lds + L_STG + wid * 4608);
    const int nkt = qb + 1;
    bf16x8 kfn[4];
    if (wid < nkt) { const bf16_t* kp = P + ((size_t)b * SEQ + wid * 32 + r32) * INP + PC_AIK + 8 * hi;
#pragma unroll
      for (int st = 0; st < 4; ++st) kfn[st] = *(const bf16x8*)(kp + 16 * st); }
    for (int kt = wid; kt < (DBG == 2 ? 0 : nkt); kt += NWAVES) {
        const int s0 = kt * 32;
        int qoff = L_IQ + r32 * QSTR + hi * 16; asm volatile("" : "+v"(qoff));
        bf16x8 kf[4];
#pragma unroll
        for (int st = 0; st < 4; ++st) kf[st] = kfn[st];
        if (kt + NWAVES < nkt) { const bf16_t* kp = P + ((size_t)b * SEQ + s0 + NWAVES * 32 + r32) * INP + PC_AIK + 8 * hi;
#pragma unroll
          for (int st = 0; st < 4; ++st) kfn[st] = *(const bf16x8*)(kp + 16 * st); }
        f32x16 sc;
#pragma unroll
        for (int r = 0; r < 16; ++r) sc[r] = 0.f;
#pragma unroll
        for (int st = 0; st < 8; ++st) { const bf16x8 qf = *(const LAS bf16x8*)(lds + qoff + (1024 + 16 * st) * 2);
            sc = __builtin_amdgcn_mfma_f32_32x32x16_bf16(kf[st & 3], qf, sc, 0, 0, 0); }
        f32x16 accA, accB;
#define IDX_MM(dst, h_) do { _Pragma("unroll") for (int r = 0; r < 16; ++r) dst[r] = 0.f; \
            _Pragma("unroll") for (int st = 0; st < 4; ++st) { const bf16x8 qf = *(const LAS bf16x8*)(lds + qoff + ((h_) * 64 + 16 * st) * 2); dst = __builtin_amdgcn_mfma_f32_32x32x16_bf16(kf[st], qf, dst, 0, 0, 0); } } while (0)
#define IDX_FMA(src, h_) do { asm volatile("s_nop 15" ::: ); \
            _Pragma("unroll") for (int r = 0; r < 16; ++r) asm volatile("v_fma_f32 %0, %1, |%2|, %0" : "+v"(sc[r]) : "v"(w[h_]), "v"(src[r])); } while (0)
        IDX_MM(accA, 0);
#pragma unroll
        for (int h = 0; h < 16; h += 2) {
            IDX_MM(accB, h + 1);
            __builtin_amdgcn_sched_barrier(0);
            IDX_FMA(accA, h);
            __builtin_amdgcn_sched_barrier(0);
            if (h + 2 < 16) IDX_MM(accA, h + 2);
            __builtin_amdgcn_sched_barrier(0);
            if (h + 2 >= 16) asm volatile("s_nop 15" ::: );
            IDX_FMA(accB, h + 1);
            __builtin_amdgcn_sched_barrier(0);
        }
#undef IDX_MM
#undef IDX_FMA
#pragma unroll
        for (int g = 0; g < 4; ++g) *(LAS f32x4*)(stg + r32 * 36 + 8 * g + 4 * hi) = (f32x4){sc[4 * g], sc[4 * g + 1], sc[4 * g + 2], sc[4 * g + 3]};
        LDS_WAIT();
#pragma unroll
        for (int i = 0; i < 16; ++i) { const float v = stg[(2 * i + hi) * 36 + r32]; SC[(row0 + 2 * i + hi) * SEQ + s0 + r32] = v; }
        LDS_WAIT();
    }
    VM_WAIT();
    __syncthreads();
#define IDX_LOADROW(dst, qi_) do { int ln_ = lane; asm volatile("" : "+v"(ln_)); const float* sr_ = SC + (row0 + wid * 4 + (qi_)) * SEQ + ln_; \
        _Pragma("unroll") for (int j = 0; j < 64; ++j) dst[j] = __float_as_uint(sr_[64 * j]); } while (0)
    auto process = [&](unsigned (&key)[64], const int qi) __attribute__((always_inline)) {
        const int t = t0 + wid * 4 + qi, n = t + 1;
        int ln = lane; asm volatile("" : "+v"(ln));
#pragma unroll
        for (int j = 0; j < 64; ++j) asm volatile("" : "+v"(key[j]));
#pragma unroll
        for (int j = 0; j < 64; ++j) key[j] = (ln < n - 64 * j) ? f2ord(__uint_as_float(key[j])) : 0u;
        unsigned T = 0u; int need = 0;
        const int ng = (n + 511) >> 9;
        if (n > 256) {
            bool exact = false;
#pragma unroll 1
            for (int bit = 31; bit >= 0; --bit) {
                const unsigned cand = T | (1u << bit); int cnt = 0;
#pragma unroll
                for (int g = 0; g < 8; ++g) { if (g < ng) {
#pragma unroll
                    for (int jj = 0; jj < 8; ++jj) cnt += __builtin_popcountll(__ballot(key[8 * g + jj] >= cand)); }
                    __builtin_amdgcn_sched_barrier(0); }
                if (cnt == 256) { T = cand - 1u; exact = true; break; }
                if (cnt > 256) T = cand;
            }
            if (!exact) {
                int cgt = 0;
#pragma unroll
                for (int g = 0; g < 8; ++g) { if (g < ng) {
#pragma unroll
                    for (int jj = 0; jj < 8; ++jj) cgt += __builtin_popcountll(__ballot(key[8 * g + jj] > T)); }
                    __builtin_amdgcn_sched_barrier(0); }
                need = 256 - cgt;
            }
        }
        int mwlo = 0, mwhi = 0, run = 0; int ln2 = ln; asm volatile("" : "+v"(ln2));
#pragma unroll
        for (int g = 0; g < 8; ++g) { if (g < ng) {
#pragma unroll
            for (int jj = 0; jj < 8; ++jj) { const int j = 8 * g + jj;
                const bool eq = key[j] == T;
                const unsigned long long eqm = __ballot(eq);
                const int rank = run + (int)__builtin_amdgcn_mbcnt_hi((unsigned)(eqm >> 32), __builtin_amdgcn_mbcnt_lo((unsigned)eqm, 0u));
                const unsigned long long sel = __ballot(key[j] > T || (eq && rank < need));
                run += __builtin_popcountll(eqm);
                mwlo = (ln2 == j) ? (int)(unsigned)sel : mwlo; mwhi = (ln2 == j) ? (int)(unsigned)(sel >> 32) : mwhi;
                __builtin_amdgcn_sched_barrier(0); } }
        }
        MASK[(row0 + wid * 4 + qi) * 64 + lane] = ((unsigned long long)(unsigned)mwhi << 32) | (unsigned)mwlo;
    };
    if (DBG != 1) {
        unsigned ka[64], kb[64];
        IDX_LOADROW(ka, 0);
#pragma unroll 1
        for (int pr = 0; pr < 2; ++pr) {
            IDX_LOADROW(kb, 2 * pr + 1);
            process(ka, 2 * pr);
            if (pr == 0) IDX_LOADROW(ka, 2);
            process(kb, 2 * pr + 1);
        }
    }
#undef IDX_LOADROW
    __syncthreads();
}
template <int DBG = 0>
__device__ __forceinline__ void indexer_phase(LAS unsigned char* lds, const Args& a) {
    const bf16_t* P = (const bf16_t*)(a.ws + WS_P); const float* SM = (const float*)(a.ws + WS_SM); float* SC = (float*)(a.ws + WS_SC); unsigned long long* MASK = (unsigned long long*)(a.ws + WS_MASK);
    for (int p = blockIdx.x; p < 256; p += gridDim.x) { const int b = p >> 6, q = p & 63;
#pragma unroll 1
        for (int k = 0; k < 2; ++k) indexer_unit<DBG>(lds, P, SM, SC, MASK, b, k == 0 ? 127 - q : q); }
}

template <int OFF> __device__ __forceinline__ s16x4 tr_read(int vb) { s16x4 r; asm volatile("ds_read_b64_tr_b16 %0, %1 offset:%2" : "=&v"(r) : "v"(vb), "i"(OFF) : "memory"); return r; }
using pg8::v8i_t; using pg8::cat8;
__device__ __forceinline__ u32x2 bf8_to_fp8(bf16x8 v) { const u32x4 w = __builtin_bit_cast(u32x4, v); int a = 0, b = 0;
    a = __builtin_amdgcn_cvt_pk_fp8_f32(__uint_as_float(w.x << 16), __uint_as_float(w.x & 0xffff0000u), a, false); a = __builtin_amdgcn_cvt_pk_fp8_f32(__uint_as_float(w.y << 16), __uint_as_float(w.y & 0xffff0000u), a, true);
    b = __builtin_amdgcn_cvt_pk_fp8_f32(__uint_as_float(w.z << 16), __uint_as_float(w.z & 0xffff0000u), b, false); b = __builtin_amdgcn_cvt_pk_fp8_f32(__uint_as_float(w.w << 16), __uint_as_float(w.w & 0xffff0000u), b, true);
    return (u32x2){(unsigned)a, (unsigned)b}; }
#ifndef ATT_PV8_MASK
#define ATT_PV8_MASK 0xB
#endif
#ifndef ATT_Q8_MASK
#define ATT_Q8_MASK 0xF
#endif
template <int VAR, int DBG = 0>
__device__ __forceinline__ void attn_unit(LAS unsigned char* lds, const Args& a, int layer, int b, int hidx, int qblk, unsigned* qh, volatile LAS unsigned* bw) {
    constexpr int DQK = (VAR == 2) ? 64 : (VAR == 3 ? 192 : 128), DV = (VAR == 2) ? 64 : 128;
    constexpr bool Q8 = ((ATT_Q8_MASK >> VAR) & 1) != 0;
    constexpr bool PV8 = Q8 && ((ATT_PV8_MASK >> VAR) & 1) != 0 && DV == 128;
    constexpr bool KV8S = PV8 && VAR != 2;
    constexpr int KSTR = Q8 ? DQK + 16 : DQK * 2 + 16, VSTR = PV8 ? DV + 32 : DV * 2 + 64;
    constexpr int KCH = DQK / 8, VCH = DV / 8, KPT = DQK / 64, VPT = DV / 64, NST = DQK / 16, ND0 = DV / 32;
    constexpr int LK = 0, LV = 2 * 64 * KSTR, LCK = LV + 2 * 64 * VSTR;
    constexpr float THR = 8.0f;
    const int tid = ptid(), wid = __builtin_amdgcn_readfirstlane(tid >> 6), lane = tid & 63, r32 = lane & 31, hi = lane >> 5;
    const bf16_t* P = (const bf16_t*)(a.ws + WS_P);
    int head, q0u, tq0w, kt_lo, kt_hi, kt_last_w;
    if constexpr (VAR == 0) { head = hidx * 4 + (wid >> 1); q0u = qblk * 64; tq0w = q0u + 32 * (wid & 1); kt_lo = 0; kt_hi = qblk; kt_last_w = qblk; }
    else if constexpr (VAR == 2) { head = hidx * 8 + wid; q0u = qblk * 32; tq0w = q0u; kt_lo = (q0u > 127 ? q0u - 127 : 0) >> 6; kt_hi = (q0u + 31) >> 6; kt_last_w = kt_hi; }
    else { head = hidx; q0u = qblk * 256; tq0w = q0u + 32 * wid; kt_lo = 0; kt_hi = 4 * qblk + 3; kt_last_w = 4 * qblk + (wid >> 1); }
    const int tq = tq0w + r32; const size_t rowq = (size_t)b * SEQ + tq;
    const bf16_t* qp;
    if constexpr (VAR == 0) qp = P + rowq * INP + PC_AQ + head * 128;
    else if constexpr (VAR == 1) qp = P + rowq * INP + PC_BQ + head * 128;
    else if constexpr (VAR == 2) qp = P + rowq * INP + PC_CQ + head * 64;
    else qp = (const bf16_t*)(a.ws + WS_DQ) + rowq * 1536 + head * 192;
    bf16x8 qf[Q8 ? 1 : NST]; v8i_t q8[Q8 ? NST / 4 : 1];
    if constexpr (Q8) {
#pragma unroll
        for (int s4 = 0; s4 < NST / 4; ++s4) { const bf16_t* q4 = qp + 64 * s4 + 32 * hi;
            const u32x2 c0 = bf8_to_fp8(*(const bf16x8*)(q4)), c1 = bf8_to_fp8(*(const bf16x8*)(q4 + 8)), c2 = bf8_to_fp8(*(const bf16x8*)(q4 + 16)), c3 = bf8_to_fp8(*(const bf16x8*)(q4 + 24));
            q8[s4] = (v8i_t){(int)c0.x, (int)c0.y, (int)c1.x, (int)c1.y, (int)c2.x, (int)c2.y, (int)c3.x, (int)c3.y}; }
    } else {
#pragma unroll
        for (int st = 0; st < NST; ++st) qf[st] = *(const bf16x8*)(qp + 16 * st + 8 * hi); }
    const bf16_t *kb, *vb_, *kb2 = nullptr; int ldk;
    if constexpr (VAR == 0) { kb = P + PC_AK + hidx * 128; vb_ = P + PC_AV + hidx * 128; ldk = INP; }
    else if constexpr (VAR == 1) { kb = P + PC_BK + head * 128; vb_ = P + PC_BV + head * 128; ldk = INP; }
    else if constexpr (VAR == 2) { kb = P + PC_CK + hidx * 64; vb_ = P + PC_CV + hidx * 64; ldk = INP; }
    else { kb = (const bf16_t*)(a.ws + WS_DKV) + head * 256; vb_ = kb + 128; kb2 = (const bf16_t*)(a.ws + WS_DKR); ldk = 2048; }
    const size_t brow = (size_t)b * SEQ;
    unsigned gk[KPT], lk[KPT], gv[VPT], lv[VPT]; bool krope[KPT];
#pragma unroll
    for (int i = 0; i < KPT; ++i) { const int ci = tid + 512 * i, kr = ci / KCH, kc = ci % KCH; krope[i] = (VAR == 3) && kc >= 16;
        gk[i] = krope[i] ? (unsigned)(kr * 64 + (kc - 16) * 8) * 2u : (unsigned)(kr * ldk + kc * 8) * 2u; lk[i] = (unsigned)(LK + kr * KSTR + kc * (Q8 ? 8 : 16)); }
#pragma unroll
    for (int i = 0; i < VPT; ++i) { const int ci = tid + 512 * i, vr = ci / VCH, vc = ci % VCH; gv[i] = (unsigned)(vr * ldk + vc * 8) * 2u; const int vrp = PV8 ? ((vr & ~15) | (vr & 3) | ((vr & 8) >> 1) | ((vr & 4) << 1)) : vr; lv[i] = (unsigned)(LV + vrp * VSTR + vc * (PV8 ? 8 : 16)); }
    const int r8_ = tid >> 3, c8_ = tid & 7, r8p_ = (r8_ & ~15) | (r8_ & 3) | ((r8_ & 8) >> 1) | ((r8_ & 4) << 1);
    constexpr int W8 = (VAR == 3) ? D8W : KV8W, VOFF8 = (VAR == 0) ? 256 : (VAR == 1 ? 1024 : 128);
    const unsigned char* kv8p = a.ws + (VAR == 3 ? WS_D8 : WS_KV8) + (VAR == 0 ? hidx * 128 : (VAR == 1 ? 512 + head * 128 : head * 256)) + (size_t)r8_ * W8 + c8_ * 16;
    const unsigned char* kr8p = a.ws + WS_D8 + 2048 + (size_t)(tid >> 2) * D8W + (tid & 3) * 16; const unsigned lkr8 = (unsigned)(LK + (tid >> 2) * KSTR + 128 + (tid & 3) * 16); u32x4 kr8 = (u32x4){0u, 0u, 0u, 0u};
    const unsigned lk8 = (unsigned)(LK + r8_ * KSTR + c8_ * 16), lv8 = (unsigned)(LV + r8p_ * VSTR + c8_ * 16); u32x4 ks8 = (u32x4){0u, 0u, 0u, 0u}, vs8 = (u32x4){0u, 0u, 0u, 0u};
    bf16x8 ks[1][KPT], vs[1][VPT]; float ckv[1] = {0.f}; unsigned long long mnx[1] = {0ull};
    const float* cum = (const float*)(a.ws + WS_CUM) + ((size_t)b * 8 + head) * SEQ;
    float cref = 0.f; if constexpr (VAR == 1) cref = cum[q0u];
    const unsigned long long* mrow = (const unsigned long long*)(a.ws + WS_MASK) + rowq * 64;
#define AT_ISSUE(kt_, S_) do { const int k0_ = (kt_) * 64; \
        const char* kt_base_ = (const char*)(kb + (brow + k0_) * ldk); const char* vt_base_ = (const char*)(vb_ + (brow + k0_) * ldk); \
        const char* k2_base_ = (VAR == 3) ? (const char*)(kb2 + (brow + k0_) * 64) : kt_base_; \
        if constexpr (KV8S) { ks8 = *(const u32x4*)(kv8p + (brow + k0_) * W8); vs8 = *(const u32x4*)(kv8p + (brow + k0_) * W8 + VOFF8); \
            if (VAR == 3 && tid < 256) kr8 = *(const u32x4*)(kr8p + (brow + k0_) * D8W); } \
        else { _Pragma("unroll") for (int i = 0; i < KPT; ++i) ks[S_][i] = *(const bf16x8*)((krope[i] ? k2_base_ : kt_base_) + gk[i]); \
               _Pragma("unroll") for (int i = 0; i < VPT; ++i) vs[S_][i] = *(const bf16x8*)(vt_base_ + gv[i]); } \
        if (VAR == 1 && tid < 64) ckv[S_] = cum[k0_ + tid]; \
        if (VAR == 0) mnx[S_] = mrow[(kt_)]; } while (0)
#define AT_WRITE(buf_, S_) do { \
        if constexpr (KV8S) { *(LAS u32x4*)(lds + (buf_) * 64 * KSTR + lk8) = ks8; *(LAS u32x4*)(lds + (buf_) * 64 * VSTR + lv8) = vs8; \
            if (VAR == 3 && tid < 256) *(LAS u32x4*)(lds + (buf_) * 64 * KSTR + lkr8) = kr8; } else { \
        _Pragma("unroll") for (int i = 0; i < KPT; ++i) { if constexpr (Q8) *(LAS u32x2*)(lds + (buf_) * 64 * KSTR + lk[i]) = bf8_to_fp8(ks[S_][i]); else *(LAS bf16x8*)(lds + (buf_) * 64 * KSTR + lk[i]) = ks[S_][i]; } \
        _Pragma("unroll") for (int i = 0; i < VPT; ++i) { if constexpr (PV8) *(LAS u32x2*)(lds + (buf_) * 64 * VSTR + lv[i]) = bf8_to_fp8(vs[S_][i]); else *(LAS bf16x8*)(lds + (buf_) * 64 * VSTR + lv[i]) = vs[S_][i]; } } \
        if (VAR == 1 && tid < 64) *(LAS float*)(lds + LCK + (buf_) * 256 + tid * 4) = cref - ckv[S_]; } while (0)
    f32x16 o[ND0];
#pragma unroll
    for (int d = 0; d < ND0; ++d)
#pragma unroll
        for (int r = 0; r < 16; ++r) o[d][r] = 0.f;
    constexpr bool MF = (VAR != 1);
    float m = MF ? -65536.0f : -1e30f, l = 0.f;
    float slope2 = 0.f;
    if constexpr (VAR == 0) slope2 = __builtin_amdgcn_exp2f(-(float)(head + 1)) * LOG2E;
    if constexpr (VAR == 2) slope2 = __builtin_amdgcn_exp2f(-0.5f * (float)(head + 1)) * LOG2E;
    const int g4 = lane >> 4, i16 = lane & 15;
    const int kq_off = r32 * KSTR + hi * (Q8 ? 32 : 16);
    const int vrd0 = (int)(uintptr_t)(lds + LV) + (4 * (g4 >> 1) + (i16 >> 2)) * VSTR + (16 * (g4 & 1) + 4 * (i16 & 3)) * 2;
    const int vrd8 = (int)(uintptr_t)(lds + LV) + (8 * (g4 >> 1) + (i16 >> 1)) * VSTR + 16 * (g4 & 1) + 8 * (i16 & 1);
    AT_ISSUE(kt_lo, 0); unsigned long long mcur = 0ull; if constexpr (VAR == 0) mcur = mnx[0];
    AT_WRITE(0, 0);
    if (DBG != 4 && kt_lo < kt_hi) AT_ISSUE(kt_lo + 1, 0);
    __syncthreads();
    bf16x8 pb[4]; v8i_t p8 = (v8i_t){0, 0, 0, 0, 0, 0, 0, 0};
#define AT_PV(D0, vrd) do { \
                const s16x4 l0 = tr_read<0 * 16 * VSTR + (D0) * 64>(vrd), h0 = tr_read<0 * 16 * VSTR + 8 * VSTR + (D0) * 64>(vrd); \
                const s16x4 l1 = tr_read<1 * 16 * VSTR + (D0) * 64>(vrd), h1 = tr_read<1 * 16 * VSTR + 8 * VSTR + (D0) * 64>(vrd); \
                const s16x4 l2 = tr_read<2 * 16 * VSTR + (D0) * 64>(vrd), h2 = tr_read<2 * 16 * VSTR + 8 * VSTR + (D0) * 64>(vrd); \
                const s16x4 l3 = tr_read<3 * 16 * VSTR + (D0) * 64>(vrd), h3 = tr_read<3 * 16 * VSTR + 8 * VSTR + (D0) * 64>(vrd); \
                asm volatile("s_waitcnt lgkmcnt(0)" ::: "memory"); __builtin_amdgcn_sched_barrier(0); \
                o[D0] = __builtin_amdgcn_mfma_f32_32x32x16_bf16((bf16x8){l0[0], l0[1], l0[2], l0[3], h0[0], h0[1], h0[2], h0[3]}, pb[0], o[D0], 0, 0, 0); \
                o[D0] = __builtin_amdgcn_mfma_f32_32x32x16_bf16((bf16x8){l1[0], l1[1], l1[2], l1[3], h1[0], h1[1], h1[2], h1[3]}, pb[1], o[D0], 0, 0, 0); \
                o[D0] = __builtin_amdgcn_mfma_f32_32x32x16_bf16((bf16x8){l2[0], l2[1], l2[2], l2[3], h2[0], h2[1], h2[2], h2[3]}, pb[2], o[D0], 0, 0, 0); \
                o[D0] = __builtin_amdgcn_mfma_f32_32x32x16_bf16((bf16x8){l3[0], l3[1], l3[2], l3[3], h3[0], h3[1], h3[2], h3[3]}, pb[3], o[D0], 0, 0, 0); } while (0)
#define AT_PV8(D0, vrd) do { \
                u32x2 t0_, t1_, t2_, t3_; \
                asm volatile("ds_read_b64_tr_b8 %0, %1 offset:%2" : "=&v"(t0_) : "v"(vrd), "i"(0 * 16 * VSTR + (D0) * 32) : "memory"); \
                asm volatile("ds_read_b64_tr_b8 %0, %1 offset:%2" : "=&v"(t1_) : "v"(vrd), "i"(1 * 16 * VSTR + (D0) * 32) : "memory"); \
                asm volatile("ds_read_b64_tr_b8 %0, %1 offset:%2" : "=&v"(t2_) : "v"(vrd), "i"(2 * 16 * VSTR + (D0) * 32) : "memory"); \
                asm volatile("ds_read_b64_tr_b8 %0, %1 offset:%2" : "=&v"(t3_) : "v"(vrd), "i"(3 * 16 * VSTR + (D0) * 32) : "memory"); \
                asm volatile("s_waitcnt lgkmcnt(0)" : "+v"(t0_), "+v"(t1_), "+v"(t2_), "+v"(t3_) :: "memory"); __builtin_amdgcn_sched_barrier(0); \
                { const v8i_t va_ = (v8i_t){(int)t0_.x, (int)t0_.y, (int)t1_.x, (int)t1_.y, (int)t2_.x, (int)t2_.y, (int)t3_.x, (int)t3_.y}; \
                  asm volatile("v_mfma_f32_32x32x64_f8f6f4 %0, %1, %2, %0" : "+v"(o[D0]) : "v"(va_), "v"(p8)); } } while (0)
#define AT_PV_ALL(vbuf_) do { if constexpr (PV8) { const int vrd_ = vrd8 + (vbuf_) * 64 * VSTR; asm volatile("s_nop 1" ::: "memory"); AT_PV8(0, vrd_); AT_PV8(1, vrd_); AT_PV8(2, vrd_); AT_PV8(3, vrd_); } \
        else { const int vrd_ = vrd0 + (vbuf_) * 64 * VSTR; AT_PV(0, vrd_); AT_PV(1, vrd_); if constexpr (ND0 == 4) { AT_PV(2, vrd_); AT_PV(3, vrd_); } } } while (0)
    for (int kt2 = kt_lo; kt2 <= kt_hi; kt2 += 2) {
#pragma unroll
    for (int hs = 0; hs < 2; ++hs) {
        const int kt = kt2 + hs; if (kt > kt_hi) break;
        const int buf = hs, k0 = kt * 64;
        if (kt <= kt_last_w && !(DBG == 6 && wid >= 4)) {
            f32x16 p[2];
            const int dq = tq - k0 - 4 * hi;
            if constexpr (VAR == 0 || VAR == 2) { const float base = -slope2 * (float)dq - m;
#pragma unroll
                for (int sub = 0; sub < 2; ++sub)
#pragma unroll
                    for (int r = 0; r < 16; ++r) p[sub][r] = fmaf(slope2, (float)(32 * sub + (r & 3) + 8 * (r >> 2)), base); }
            else if constexpr (VAR == 1) { const LAS float* ck = (const LAS float*)(lds + LCK + buf * 256);
#pragma unroll
                for (int sub = 0; sub < 2; ++sub)
#pragma unroll
                    for (int g = 0; g < 4; ++g) { const f32x4 c4 = *(const LAS f32x4*)(ck + 32 * sub + 8 * g + 4 * hi);
                        p[sub][4 * g] = c4[0]; p[sub][4 * g + 1] = c4[1]; p[sub][4 * g + 2] = c4[2]; p[sub][4 * g + 3] = c4[3]; } }
            else {
#pragma unroll
                for (int sub = 0; sub < 2; ++sub)
#pragma unroll
                    for (int r = 0; r < 16; ++r) p[sub][r] = -m; }
            const LAS unsigned char* kbuf = lds + LK + buf * 64 * KSTR + kq_off;
            if constexpr (Q8) {
                asm volatile("s_nop 1" ::: "memory");
#pragma unroll
                for (int s4 = 0; s4 < NST / 4; ++s4) {
                    const v8i_t ka = cat8(*(const LAS bf16x8*)(kbuf + s4 * 64), *(const LAS bf16x8*)(kbuf + s4 * 64 + 16));
                    const v8i_t kb8 = cat8(*(const LAS bf16x8*)(kbuf + 32 * KSTR + s4 * 64), *(const LAS bf16x8*)(kbuf + 32 * KSTR + s4 * 64 + 16));
                    if (DBG != 3) { asm volatile("v_mfma_f32_32x32x64_f8f6f4 %0, %1, %2, %0" : "+v"(p[0]) : "v"(ka), "v"(q8[s4]));
                                    asm volatile("v_mfma_f32_32x32x64_f8f6f4 %0, %1, %2, %0" : "+v"(p[1]) : "v"(kb8), "v"(q8[s4])); } }
                asm volatile("s_nop 15\n\ts_nop 7" : "+v"(p[0]), "+v"(p[1]) :: "memory");
            } else {
            constexpr int GS = (VAR == 3) ? 1 : 2, NG = NST / GS;
            bf16x8 kfa[2 * GS], kfb[2 * GS];
#define AT_LDK(dst, g_) do { _Pragma("unroll") for (int e = 0; e < GS; ++e) { dst[2 * e] = *(const LAS bf16x8*)(kbuf + (GS * (g_) + e) * 32); dst[2 * e + 1] = *(const LAS bf16x8*)(kbuf + 32 * KSTR + (GS * (g_) + e) * 32); } } while (0)
#define AT_MMK(src, g_) do { _Pragma("unroll") for (int e = 0; e < GS; ++e) { p[0] = __builtin_amdgcn_mfma_f32_32x32x16_bf16(src[2 * e], qf[GS * (g_) + e], p[0], 0, 0, 0); \
                                 p[1] = __builtin_amdgcn_mfma_f32_32x32x16_bf16(src[2 * e + 1], qf[GS * (g_) + e], p[1], 0, 0, 0); } } while (0)
            AT_LDK(kfa, 0);
#pragma unroll
            for (int g = 0; g < NG; g += 2) {
                if (g + 1 < NG) AT_LDK(kfb, g + 1);
                __builtin_amdgcn_sched_barrier(0);
                if (DBG != 3) AT_MMK(kfa, g);
                if (g + 1 < NG) { if (g + 2 < NG) AT_LDK(kfa, g + 2);
                    __builtin_amdgcn_sched_barrier(0);
                    if (DBG != 3) AT_MMK(kfb, g + 1); }
            }
#undef AT_LDK
#undef AT_MMK
            }
            if constexpr (VAR == 0) {
#pragma unroll
                for (int sub = 0; sub < 2; ++sub) { const unsigned wb = (unsigned)(mcur >> (32 * sub)) >> (4 * hi);
#pragma unroll
                    for (int r = 0; r < 16; ++r) p[sub][r] = ((wb >> ((r & 3) + 8 * (r >> 2))) & 1u) ? p[sub][r] : -INFINITY; }
            } else if constexpr (VAR == 2) {
#pragma unroll
                for (int sub = 0; sub < 2; ++sub)
#pragma unroll
                    for (int r = 0; r < 16; ++r) p[sub][r] = ((unsigned)(dq - (32 * sub + (r & 3) + 8 * (r >> 2))) <= 127u) ? p[sub][r] : -INFINITY;
            } else {
                if (k0 + 63 > tq0w) {
#pragma unroll
                    for (int sub = 0; sub < 2; ++sub)
#pragma unroll
                        for (int r = 0; r < 16; ++r) p[sub][r] = ((32 * sub + (r & 3) + 8 * (r >> 2)) <= dq) ? p[sub][r] : -INFINITY; }
            }
            if constexpr (DBG != 2) {
            asm volatile("s_nop 15\n\ts_nop 7" ::: "memory");
            float pm;
            { float ma, mb_;
              asm volatile("v_max3_f32 %0, %1, %2, %3" : "=v"(ma) : "v"(p[0][0]), "v"(p[0][1]), "v"(p[1][0]));
              asm volatile("v_max3_f32 %0, %1, %2, %3" : "=v"(mb_) : "v"(p[0][2]), "v"(p[0][3]), "v"(p[1][1]));
              asm volatile("v_max3_f32 %0, %1, %2, %3" : "+v"(ma) : "v"(ma), "v"(p[1][2]), "v"(p[1][3]));
#pragma unroll
              for (int r = 4; r < 16; r += 4) {
                  asm volatile("v_max3_f32 %0, %1, %2, %3" : "+v"(ma) : "v"(ma), "v"(p[0][r]), "v"(p[0][r + 1]));
                  asm volatile("v_max3_f32 %0, %1, %2, %3" : "+v"(mb_) : "v"(mb_), "v"(p[0][r + 2]), "v"(p[0][r + 3]));
                  asm volatile("v_max3_f32 %0, %1, %2, %3" : "+v"(ma) : "v"(ma), "v"(p[1][r]), "v"(p[1][r + 1]));
                  asm volatile("v_max3_f32 %0, %1, %2, %3" : "+v"(mb_) : "v"(mb_), "v"(p[1][r + 2]), "v"(p[1][r + 3])); }
              asm volatile("v_max_f32 %0, %1, %2" : "=v"(pm) : "v"(ma), "v"(mb_)); }
            { auto rr = __builtin_amdgcn_permlane32_swap(__float_as_uint(pm), __float_as_uint(pm), false, false); pm = fmaxf(__uint_as_float(rr[0]), __uint_as_float(rr[1])); }
            if constexpr (MF) {
                if (!__all(pm <= THR)) {
                    const float dm = fmaxf(pm, 0.f), alpha = __builtin_amdgcn_exp2f(-dm); m += dm; l *= alpha;
#pragma unroll
                    for (int d = 0; d < ND0; ++d)
#pragma unroll
                        for (int r = 0; r < 16; ++r) o[d][r] *= alpha;
#pragma unroll
                    for (int sub = 0; sub < 2; ++sub)
#pragma unroll
                        for (int r = 0; r < 16; ++r) p[sub][r] -= dm;
                }
            } else if (!__all(pm - m <= THR)) {
                const float mn = fmaxf(m, pm), alpha = __builtin_amdgcn_exp2f(m - mn); m = mn; l *= alpha;
#pragma unroll
                for (int d = 0; d < ND0; ++d)
#pragma unroll
                    for (int r = 0; r < 16; ++r) o[d][r] *= alpha;
            }
#pragma unroll
            for (int sub = 0; sub < 2; ++sub)
#pragma unroll
                for (int r = 0; r < 16; ++r) p[sub][r] = __builtin_amdgcn_exp2f(MF ? p[sub][r] : p[sub][r] - m);
            __builtin_amdgcn_sched_barrier(0);
            { float s0 = p[0][0], s1 = p[0][1], s2 = p[1][0], s3 = p[1][1];
#pragma unroll
              for (int r = 2; r < 16; r += 2) { s0 += p[0][r]; s1 += p[0][r + 1]; s2 += p[1][r]; s3 += p[1][r + 1]; }
              l += (s0 + s1) + (s2 + s3); }
            }
            if constexpr (PV8) {
#pragma unroll
                for (int w = 0; w < 8; ++w) { const int sub = w >> 2, r4 = 4 * (w & 3); int t = 0;
                    t = __builtin_amdgcn_cvt_pk_fp8_f32(p[sub][r4], p[sub][r4 + 1], t, false); t = __builtin_amdgcn_cvt_pk_fp8_f32(p[sub][r4 + 2], p[sub][r4 + 3], t, true); p8[w] = t; }
            } else {
#pragma unroll
            for (int s = 0; s < 4; ++s) { const int sub = s >> 1, k8 = 8 * (s & 1);
                u32x4 wv; wv.x = cvt_pk_bf16(p[sub][k8], p[sub][k8 + 1]); wv.y = cvt_pk_bf16(p[sub][k8 + 2], p[sub][k8 + 3]); wv.z = cvt_pk_bf16(p[sub][k8 + 4], p[sub][k8 + 5]); wv.w = cvt_pk_bf16(p[sub][k8 + 6], p[sub][k8 + 7]);
                pb[s] = __builtin_bit_cast(bf16x8, wv); }
            }
        }
        if (DBG != 4 && kt < kt_hi) AT_WRITE(buf ^ 1, 0);
        if constexpr (VAR == 0) mcur = mnx[0];
        if (DBG != 4 && kt + 1 < kt_hi) AT_ISSUE(kt + 2, 0);
        if (kt <= kt_last_w && !(DBG == 6 && wid >= 4)) {
            if (DBG != 1) AT_PV_ALL(buf);
            if (DBG == 1) { _Pragma("unroll") for (int i = 0; i < 4; ++i) o[0][i] += __uint_as_float((unsigned)pb[i][0]); }
        }
        if (DBG != 5) __syncthreads();
    }
    }
#undef AT_PV_ALL
#undef AT_PV8
#undef AT_PV
#undef AT_ISSUE
#undef AT_WRITE
    if constexpr (PV8) asm volatile("s_nop 15\n\ts_nop 15" : "+v"(o[0]), "+v"(o[1]), "+v"(o[ND0 - 2]), "+v"(o[ND0 - 1]) :: "memory");
    unsigned nx = 0u; if (threadIdx.x == 0) nx = __hip_atomic_fetch_add(qh, 1u, RLX_AGENT);
    { auto rr = __builtin_amdgcn_permlane32_swap(__float_as_uint(l), __float_as_uint(l), false, false); l = __uint_as_float(rr[0]) + __uint_as_float(rr[1]); }
    if constexpr (VAR == 2) l += __builtin_amdgcn_exp2f(a.sinks[layer * 16 + head] * LOG2E - m);
    const float inv = 1.0f / l;
    int zc, bc;
    if constexpr (VAR == 0) { zc = PC_AZ + head * 128; bc = 0 + head * 128; }
    else if constexpr (VAR == 1) { zc = PC_BZ + head * 128; bc = 1024 + head * 128; }
    else if constexpr (VAR == 2) { zc = PC_CZ + head * 64; bc = 2048 + head * 64; }
    else { zc = PC_DZ + head * 128; bc = 3072 + head * 128; }
    const bf16_t* zp = P + rowq * INP + zc + 16 * hi; unsigned char* op = a.ws + (DBG ? WS_SC : WS_BR) + rowq * 4096 + bc + 16 * hi;
#pragma unroll
    for (int d = 0; d < ND0; ++d) {
#pragma unroll
        for (int jj = 0; jj < 8; ++jj) { const int r0 = jj, r1 = 8 + jj;
            const auto sw = __builtin_amdgcn_permlane32_swap(__float_as_uint(o[d][r0]), __float_as_uint(o[d][r1]), false, false);
            o[d][r0] = __uint_as_float(sw[0]); o[d][r1] = __uint_as_float(sw[1]); }
        const u32x4 za = *(const u32x4*)(zp + 32 * d), zb = *(const u32x4*)(zp + 32 * d + 8);
        const unsigned zw[8] = {za.x, za.y, za.z, za.w, zb.x, zb.y, zb.z, zb.w};
        u32x4 wo;
#pragma unroll
        for (int q4 = 0; q4 < 4; ++q4) { const int rb = (q4 & 1) * 8 + (q4 >> 1) * 4;
            const float z0 = __uint_as_float(zw[2 * q4] << 16), z1 = __uint_as_float(zw[2 * q4] & 0xffff0000u), z2 = __uint_as_float(zw[2 * q4 + 1] << 16), z3 = __uint_as_float(zw[2 * q4 + 1] & 0xffff0000u);
            const float v0 = o[d][rb] * inv * (z0 * fast_sigmoid(z0)), v1 = o[d][rb + 1] * inv * (z1 * fast_sigmoid(z1));
            const float v2 = o[d][rb + 2] * inv * (z2 * fast_sigmoid(z2)), v3 = o[d][rb + 3] * inv * (z3 * fast_sigmoid(z3));
            int w8 = 0; w8 = __builtin_amdgcn_cvt_pk_fp8_f32(v0 * 8.0f, v1 * 8.0f, w8, false); w8 = __builtin_amdgcn_cvt_pk_fp8_f32(v2 * 8.0f, v3 * 8.0f, w8, true);
            if (q4 == 0) wo.x = (unsigned)w8; else if (q4 == 1) wo.y = (unsigned)w8; else if (q4 == 2) wo.z = (unsigned)w8; else wo.w = (unsigned)w8; }
        *(u32x4*)(op + 32 * d) = wo; }
    if (threadIdx.x == 0) bw[0] = nx;
}
template <int VAR, int DBG = 0>
__device__ __forceinline__ void attn_queue(LAS unsigned char* lds, const Args& a, int layer) {
    constexpr int NUX = (VAR == 2) ? 128 : 64;
    unsigned* qbase = (unsigned*)(a.ws + WS_CTL) + CW_Q + 64 * 8 * (layer * 4 + VAR);
    layer &= 1;
    volatile LAS unsigned* bw = (volatile LAS unsigned*)(lds + MISC_OFF + 64);
    const int myx = (int)(xb_xcc_id() & 7u);
    for (int qi = 0; qi < 8; ++qi) {
        const int x = (myx + qi) & 7;
        unsigned* qh = qbase + 64 * x;
        if (threadIdx.x == 0) bw[0] = __hip_atomic_fetch_add(qh, 1u, RLX_AGENT);
        for (;;) {
            __syncthreads();
            const int idx = (int)bw[0];
            __syncthreads();
            if (idx >= NUX) break;
            int b, hidx, qblk;
            if constexpr (VAR == 0) { qblk = 63 - idx; b = x >> 1; hidx = x & 1; }
            else if constexpr (VAR == 2) { qblk = idx; b = x >> 1; hidx = x & 1; }
            else { const int pr = 4 * x + 2 * (idx >> 5) + (idx & 1); qblk = 15 - ((idx & 31) >> 1); b = pr >> 3; hidx = pr & 7; }
            attn_unit<VAR, DBG>(lds, a, layer, b, hidx, qblk, qh, bw);
        }
    }
}

constexpr int N_PHASES = 1 + 6 * DEPTH;
#ifndef DUP_PHASE
#define DUP_PHASE -1
#endif
__global__ void __launch_bounds__(NTHREADS, 2) mega_fwd(Args a) {
    extern __shared__ __attribute__((aligned(16))) unsigned char lds_raw[];
    LAS unsigned char* lds = (LAS unsigned char*)lds_raw;
    const int tid = threadIdx.x;
    for (int u = tid; u < (LDS_BYTES - LDSCTL_OFF) / 4; u += NTHREADS) ((LAS unsigned*)(lds + LDSCTL_OFF))[u] = 0u;
    __syncthreads();
    unsigned* ctl = (unsigned*)(a.ws + WS_CTL);
    const int lo = a.ph_lo, hi = a.ph_hi;
    const bool multi = (hi - lo) > 1;
    XcdBarrier bar; bar.bar = ctl + CW_BAR; bar.x = 0; bar.st = nullptr;
    if (multi) bar = xcd_barrier_post(ctl + CW_BAR, (volatile LAS unsigned*)(lds + MISC_OFF + 32));
#define IN(k) (lo <= (k) && (k) < hi)
#define SEAM(k) do { if (IN(k) && IN((k) + 1)) xcd_barrier(bar); } while (0)
    unsigned char* ws = a.ws;
    bf16_t* XB = (bf16_t*)(ws + WS_XB); bf16_t* P = (bf16_t*)(ws + WS_P); unsigned char* Gt = ws + WS_G;
    float* SM = (float*)(ws + WS_SM); float* RSS = (float*)(ws + WS_RSS); float* CS = (float*)(ws + WS_CS);
    unsigned char* W = ws + WS_W;

    if (IN(0)) { convert_weights(a, 0, lds); prologue_misc(a); }
    SEAM(0);
    for (int layer = 0; layer < DEPTH; ++layer) {
        const int pb = 1 + 6 * layer;
        if (IN(pb + 0)) {
            { pg8::Gemm g{(const bf16_t*)(ws + WS_X4), (const bf16_t*)(W + WO_WG8), DM / 4, DM / 4, DM / 4, 0, 0}; pg8::StaticOrder S; S.init(MTOK, NGATE, gridDim.x, blockIdx.x, 8);
              EpiGate E{Gt, -LOG2E / (FP4_XS * FP4_WS * 0.9761f)};
              pg8::gemm_phase<EpiGate, pg8::StaticOrder, true, false, true>(lds, g, S, E);
#if DUP_PHASE == 1001
              pg8::gemm_phase<EpiGate, pg8::StaticOrder, true, true>(lds, g, S, E);
#endif
#if DUP_PHASE == 1002
              { EpiNull E0{(float*)(ws + WS_SC)}; pg8::gemm_phase<EpiNull, pg8::StaticOrder, true, true>(lds, g, S, E0); }
#endif
              }
            { pg8::Gemm g{(const bf16_t*)(ws + WS_X8), (const bf16_t*)(W + WO_WIN8), DM / 2, DM / 2, DM / 2, 0, 0}; pg8::StaticOrder S; S.init(MTOK, NIN8, gridDim.x, blockIdx.x);
              EpiIn E{P, SM, RSS, 1, ws + WS_KV8, ws + WS_L8};
              pg8::gemm_phase<EpiIn, pg8::StaticOrder, true, true>(lds, g, S, E); }
            { pg8::Gemm g{(const bf16_t*)(ws + WS_X4), (const bf16_t*)(W + WO_WZ4), DM / 4, DM / 4, DM / 4, 0, 0}; pg8::StaticOrder S; S.init(MTOK, NINZ, gridDim.x, blockIdx.x, 8);
              EpiIn E{P, SM, RSS, 2, ws + WS_KV8, ws + WS_L8};
              pg8::gemm_phase<EpiIn, pg8::StaticOrder, true, false, true>(lds, g, S, E); }
            { pg8::Gemm g{XB, (const bf16_t*)(W + WO_WINB), DM, DM, DM, 0, 0}; pg8::StaticOrder S; S.init(MTOK, NINB, gridDim.x, (blockIdx.x + 64) % gridDim.x, 2);
              EpiIn E{P, SM, RSS, 0, ws + WS_KV8, ws + WS_L8};
              pg8::gemm_phase<EpiIn, pg8::StaticOrder>(lds, g, S, E); }
        }
        SEAM(pb + 0);
        if (IN(pb + 1)) {
            cumsum_phase(SM, a.f_bias + layer * 8, (float*)(ws + WS_CUM));
            krope_phase(SM, CS, ws + WS_D8);
            { pg8::Gemm g{(const bf16_t*)(ws + WS_L8), (const bf16_t*)(W + WO_DQUP), 384, 512, 384, 0, 0}; pg8::StaticOrder S; S.init(MTOK, 1536, gridDim.x, blockIdx.x);
              EpiDq E{(bf16_t*)(ws + WS_DQ), RSS, CS, 1.0f / DQ_WS};
              pg8::gemm_phase<EpiDq, pg8::StaticOrder, true, true>(lds, g, S, E); }
            { pg8::Gemm g{(const bf16_t*)(ws + WS_L8 + 768), (const bf16_t*)(W + WO_DKVUP), 128, 512, 128, 0, 0}; pg8::StaticOrder S; S.init(MTOK, 2048, gridDim.x, blockIdx.x);
              EpiDkv E{ws + WS_D8, RSS, 1.0f / DKV_WS};
              pg8::gemm_phase<EpiDkv, pg8::StaticOrder, true, true>(lds, g, S, E); }
            indexer_phase(lds, a);
#if DUP_PHASE == 1 || DUP_PHASE == 11
            { pg8::Gemm g{P + PC_DCQ, (const bf16_t*)(W + WO_DQUP), 768, INP, 768, 0, 0}; pg8::StaticOrder S; S.init(MTOK, 1536, gridDim.x, blockIdx.x);
              EpiDq E{(bf16_t*)(ws + WS_DQ), RSS, CS};
              pg8::gemm_phase<EpiDq, pg8::StaticOrder>(lds, g, S, E); }
            { pg8::Gemm g{P + PC_DCKV, (const bf16_t*)(W + WO_DKVUP), 256, INP, 256, 0, 0}; pg8::StaticOrder S; S.init(MTOK, 2048, gridDim.x, blockIdx.x);
              EpiDkv E{ws + WS_D8, RSS};
              pg8::gemm_phase<EpiDkv, pg8::StaticOrder>(lds, g, S, E); }
#endif
#if DUP_PHASE == 1 || DUP_PHASE == 12
            indexer_phase(lds, a);
#endif
        }
        SEAM(pb + 1);
        if (IN(pb + 2)) {
            attn_queue<3>(lds, a, layer);
            attn_queue<1>(lds, a, layer);
            attn_queue<0>(lds, a, layer);
            attn_queue<2>(lds, a, layer);
#if DUP_PHASE == 2 || DUP_PHASE == 23
            attn_queue<3>(lds, a, layer + 2);
#endif
#if DUP_PHASE == 2 || DUP_PHASE == 21
            attn_queue<1>(lds, a, layer + 2);
#endif
#if DUP_PHASE >= 210 && DUP_PHASE <= 219
            attn_queue<1, DUP_PHASE - 210>(lds, a, layer + 2);
#endif
#if DUP_PHASE == 2 || DUP_PHASE == 20
            attn_queue<0>(lds, a, layer + 2);
#endif
#if DUP_PHASE == 2 || DUP_PHASE == 22
            attn_queue<2>(lds, a, layer + 2);
#endif
        }
        SEAM(pb + 2);
        if (IN(pb + 3)) {
            pg8::Gemm g{(const bf16_t*)(ws + WS_BR), (const bf16_t*)(W + WO_WBR), 512, 2048, 512, (size_t)1024, (size_t)DM * 1024};
            pg8::ZOrder<4> S; S.init(MTOK, DM, gridDim.x, blockIdx.x);
            EpiMerge E{Gt, ws + WS_MRG};
            pg8::gemm_phase<EpiMerge, pg8::ZOrder<4>, true, true>(lds, g, S, E);
#if DUP_PHASE == 3
            pg8::gemm_phase<EpiMerge, pg8::ZOrder<4>, true, true>(lds, g, S, E);
#endif
        }
        SEAM(pb + 3);
        if (IN(pb + 4)) {
            pg8::Gemm g{(const bf16_t*)(ws + WS_MRG), (const bf16_t*)(W + WO_WOUT), DM / 2, DM / 2, DM / 2, 0, 0}; pg8::StaticOrder S; S.init(MTOK, DM, gridDim.x, blockIdx.x);
            EpiOut E{XB, (bf16_t*)(ws + WS_R)};
            pg8::gemm_phase<EpiOut, pg8::StaticOrder, true, true>(lds, g, S, E);
#if DUP_PHASE == 4
            pg8::gemm_phase<EpiOut, pg8::StaticOrder, true, true>(lds, g, S, E);
#endif
        }
        SEAM(pb + 4);
        if (IN(pb + 5)) {
            ln_phase((const bf16_t*)(ws + WS_R), a.ln_gain + layer * DM, a.ln_bias + layer * DM, layer + 1 < DEPTH ? nullptr : a.out, layer + 1 < DEPTH ? XB : nullptr, ws + WS_X8, ws + WS_X4);
            if (layer + 1 < DEPTH) convert_weights(a, layer + 1, lds);
#if DUP_PHASE == 5
            ln_phase((const bf16_t*)(ws + WS_R), a.ln_gain + layer * DM, a.ln_bias + layer * DM, layer + 1 < DEPTH ? nullptr : a.out, layer + 1 < DEPTH ? XB : nullptr, ws + WS_X8, ws + WS_X4);
            if (layer + 1 < DEPTH) convert_weights(a, layer + 1, lds);
#endif
        }
        if (layer + 1 < DEPTH) SEAM(pb + 5);
    }
#undef IN
#undef SEAM
}

#ifdef PROBE_KERNEL
__global__ void __launch_bounds__(NTHREADS, 2) probe_fwd(Args a) {
    extern __shared__ __attribute__((aligned(16))) unsigned char lds_raw[];
    LAS unsigned char* lds = (LAS unsigned char*)lds_raw;
    unsigned char* ws = a.ws; unsigned char* W = ws + WS_W;
#if PROBE_KERNEL == 1 || PROBE_KERNEL == 2 || PROBE_KERNEL == 4
    pg8::Gemm g{(const bf16_t*)(ws + WS_X8), (const bf16_t*)(W + WO_WG8), DM / 2, DM / 2, DM / 2, 0, 0}; pg8::StaticOrder S; S.init(MTOK, NGATE, gridDim.x, blockIdx.x);
#if PROBE_KERNEL == 1
    EpiGate E{ws + WS_G}; pg8::gemm_phase<EpiGate, pg8::StaticOrder, true, true>(lds, g, S, E);
#elif PROBE_KERNEL == 4
    EpiGate E{ws + WS_G}; pg8::gemm_phase<EpiGate, pg8::StaticOrder, false, true>(lds, g, S, E);
#else
    EpiNull E{(float*)(ws + WS_SC)}; pg8::gemm_phase<EpiNull, pg8::StaticOrder, true, true>(lds, g, S, E);
#endif
#endif
#if PROBE_KERNEL >= 10 && PROBE_KERNEL < 20
    attn_queue<1, PROBE_KERNEL - 10>(lds, a, 3);
#endif
#if PROBE_KERNEL == 20 || PROBE_KERNEL == 21
    { pg8::Gemm g{(const bf16_t*)(ws + WS_BR), (const bf16_t*)(W + WO_WBR), 512, 2048, 512, (size_t)1024, (size_t)DM * 1024}; pg8::ZOrder<4> S; S.init(MTOK, DM, gridDim.x, blockIdx.x);
#if PROBE_KERNEL == 20
      EpiMerge E{ws + WS_G, ws + WS_MRG}; pg8::gemm_phase<EpiMerge, pg8::ZOrder<4>, true, true>(lds, g, S, E);
#else
      EpiNull E{(float*)(ws + WS_SC)}; pg8::gemm_phase<EpiNull, pg8::ZOrder<4>, true, true>(lds, g, S, E);
#endif
    }
#endif
#if PROBE_KERNEL == 22
    { pg8::Gemm g{(const bf16_t*)(ws + WS_MRG), (const bf16_t*)(W + WO_WOUT), DM / 2, DM / 2, DM / 2, 0, 0}; pg8::StaticOrder S; S.init(MTOK, DM, gridDim.x, blockIdx.x);
      EpiOut E{(const bf16_t*)(ws + WS_XB), (bf16_t*)(ws + WS_SC)}; pg8::gemm_phase<EpiOut, pg8::StaticOrder, true, true>(lds, g, S, E); }
#endif
#if PROBE_KERNEL == 30
    convert_weights(a, 1, lds);
#endif
#if PROBE_KERNEL == 31
    ln_phase((const bf16_t*)(ws + WS_R), a.ln_gain + DM, a.ln_bias + DM, a.out, nullptr, ws + WS_X8);
#endif
#if PROBE_KERNEL == 32
    indexer_phase(lds, a);
#endif
#if PROBE_KERNEL == 33
    indexer_phase<1>(lds, a);
#endif
#if PROBE_KERNEL == 34
    indexer_phase<2>(lds, a);
#endif
#if PROBE_KERNEL == 3
    pg8::Gemm g{(const bf16_t*)(ws + WS_XB), (const bf16_t*)(W + WO_WG8), DM / 2, DM / 2, DM / 2, 0, 0}; pg8::StaticOrder S; S.init(MTOK, NGATE, gridDim.x, blockIdx.x);
    EpiNull E{(float*)(ws + WS_SC)}; pg8::gemm_phase<EpiNull, pg8::StaticOrder, true, false>(lds, g, S, E);
#endif
}
#endif

#ifndef MK_N_LAUNCHES
#define MK_N_LAUNCHES 1
#endif
extern "C" void kernel_launch(void* const* d_in, const int* in_sizes, int n_in, void* d_out, int out_size, void* d_ws, size_t ws_size, hipStream_t stream) {
    static int grid = 0;
    if (grid == 0) {
        if (n_in != 14 || in_sizes[0] != MTOK * DM || out_size != MTOK * DM || ws_size < WS_END) {
            fprintf(stderr, "kernel_launch: unexpected shapes / workspace: n_in %d in0 %d out %d ws %zu (need >= %zu)\n", n_in, n_in > 0 ? in_sizes[0] : -1, out_size, ws_size, (size_t)WS_END); grid = -1; return; }
        int dev = 0, cus = 0, per_cu = 0;
        if (hipGetDevice(&dev) != hipSuccess || hipDeviceGetAttribute(&cus, hipDeviceAttributeMultiprocessorCount, dev) != hipSuccess) { grid = -1; return; }
        if (hipFuncSetAttribute((const void*)mega_fwd, hipFuncAttributeMaxDynamicSharedMemorySize, LDS_BYTES) != hipSuccess) { fprintf(stderr, "kernel_launch: hipFuncSetAttribute failed\n"); grid = -1; return; }
        if (hipOccupancyMaxActiveBlocksPerMultiprocessor(&per_cu, (const void*)mega_fwd, NTHREADS, LDS_BYTES) != hipSuccess || per_cu < 1) {
            fprintf(stderr, "kernel_launch: occupancy query reports %d workgroups per CU\n", per_cu); }
        (void)hipGetLastError();
        grid = cus;
    }
    if (grid < 0) return;
    (void)hipMemsetAsync((char*)d_ws + WS_CTL, 0, CTL_ZERO_BYTES, stream);
    Args a{};
    a.x = (const float*)d_in[0]; a.pos = (const int*)d_in[1]; a.w_in = (const float*)d_in[2]; a.w_gate = (const float*)d_in[3]; a.w_branch = (const float*)d_in[4]; a.w_out = (const float*)d_in[5];
    a.dq_gain = (const float*)d_in[6]; a.dq_up = (const float*)d_in[7]; a.dkv_gain = (const float*)d_in[8]; a.dkv_up = (const float*)d_in[9]; a.f_bias = (const float*)d_in[10];
    a.sinks = (const float*)d_in[11]; a.ln_gain = (const float*)d_in[12]; a.ln_bias = (const float*)d_in[13];
    a.out = (float*)d_out; a.ws = (unsigned char*)d_ws;
#if MK_N_LAUNCHES == 1
    a.ph_lo = 0; a.ph_hi = N_PHASES;
    hipLaunchKernelGGL(mega_fwd, dim3(grid), dim3(NTHREADS), LDS_BYTES, stream, a);
#else
    for (int p = 0; p < N_PHASES; ++p) { a.ph_lo = p; a.ph_hi = p + 1; hipLaunchKernelGGL(mega_fwd, dim3(grid), dim3(NTHREADS), LDS_BYTES, stream, a); }
#endif
#ifdef PROBE_KERNEL
    { static int once = 0; if (!once) { (void)hipFuncSetAttribute((const void*)probe_fwd, hipFuncAttributeMaxDynamicSharedMemorySize, LDS_BYTES); once = 1; }
      hipLaunchKernelGGL(probe_fwd, dim3(grid), dim3(NTHREADS), LDS_BYTES, stream, a); }
#endif
    const hipError_t le = hipPeekAtLastError();
    if (le != hipSuccess) fprintf(stderr, "kernel_launch: launch failed: %s\n", hipGetErrorName(le));
}
```

```cpp
#include <hip/hip_runtime.h>
#include <cstdio>
#include <cstdint>

#define LAS __attribute__((address_space(3)))
#define GAS __attribute__((address_space(1)))
typedef unsigned short bf16_t;
typedef short bf16x8 __attribute__((ext_vector_type(8)));
typedef short s16x4 __attribute__((ext_vector_type(4)));
typedef float f32x4 __attribute__((ext_vector_type(4)));
typedef float f32x2 __attribute__((ext_vector_type(2)));
typedef float f32x16 __attribute__((ext_vector_type(16)));
typedef unsigned u32x4 __attribute__((ext_vector_type(4)));
typedef unsigned u32x2 __attribute__((ext_vector_type(2)));

typedef __bf16 bf16x2_t __attribute__((ext_vector_type(2)));
__device__ __forceinline__ unsigned cvt_pk_bf16(float lo, float hi) { const f32x2 v = {lo, hi}; const bf16x2_t b = __builtin_convertvector(v, bf16x2_t); return __builtin_bit_cast(unsigned, b); }
__device__ __forceinline__ int ptid() { int t = threadIdx.x; asm volatile("" : "+v"(t)); return t; }
__device__ __forceinline__ float bf2f(unsigned short b) { return __uint_as_float(((unsigned)b) << 16); }

namespace pg8 {
constexpr int BM = 256, BK = 64, HALF = 128, HTB = HALF * BK * 2  , STAGE_BYTES = 8 * HTB, NXCD = 8, WGM = 4;
__host__ __device__ __forceinline__ int lds_byte(int r, int c) { const int st = (r >> 4) * 2 + (c >> 5), rr = r & 15, cc = c & 31, ob = rr * 64 + cc * 2; return st * 1024 + (ob ^ (((ob >> 9) & 1) << 5)); }
__host__ __device__ __forceinline__ void stage_rc(int b, int& R, int& C) { const int st = b / 1024, sb = b % 1024, swz = sb ^ (((sb >> 9) & 1) << 5); R = (st >> 1) * 16 + swz / 64; C = (st & 1) * 32 + (swz % 64) / 2; }
__host__ __device__ __forceinline__ int perm32(int rho) { const int n = rho >> 4, i = rho & 15; return 8 * (i >> 2) + 4 * n + (i & 3); }

struct Unit { int pm, pn, z; };
struct Gemm { const bf16_t* A; const bf16_t* Bt; int K, lda, ldb; size_t zA, zB; };

__device__ __forceinline__ void tile_of(int L, int nM, int nN, int& pm, int& pn, int WGM = pg8::WGM) {
    const int nwg = nM * nN; int wgid = L; { const int q = nwg / NXCD, r = nwg % NXCD, xcd = wgid % NXCD, off = wgid / NXCD; wgid = (xcd < r ? xcd * (q + 1) : r * (q + 1) + (xcd - r) * q) + off; }
    const int nig = WGM * nN, gid = wgid / nig, fm = gid * WGM, gsz = (nM - fm) < WGM ? (nM - fm) : WGM;
    pm = fm + ((wgid % nig) % gsz); pn = (wgid % nig) / gsz;
}
struct StaticOrder {
    int nM, nN, nwg, G, c, wgm;
    __device__ void init(int M, int N, int G_, int c_, int wgm_ = WGM) { nM = M / BM; nN = N / BM; nwg = nM * nN; G = G_; c = c_; wgm = wgm_; }
    __device__ bool next(int i, Unit& u) const { const long L = (long)i * G + c; if (L >= nwg) return false; tile_of((int)L, nM, nN, u.pm, u.pn, wgm); u.z = 0; return true; }
};
template <int Z> struct ZOrder {
    int nM, nN, nwg, G, c;
    __device__ void init(int M, int N, int G_, int c_) { nM = M / BM; nN = N / BM; nwg = nM * nN; G = G_; c = c_; }
    __device__ bool next(int i, Unit& u) const { const long L = (long)(i / Z) * G + c; if (L >= nwg) return false; tile_of((int)L, nM, nN, u.pm, u.pn); u.z = i % Z; return true; }
};

typedef int v8i_t __attribute__((ext_vector_type(8)));
typedef int v4i_t __attribute__((ext_vector_type(4)));
__device__ __forceinline__ v8i_t cat8(bf16x8 lo, bf16x8 hi) { const v4i_t a = __builtin_bit_cast(v4i_t, lo), b = __builtin_bit_cast(v4i_t, hi); return __builtin_shufflevector(a, b, 0, 1, 2, 3, 4, 5, 6, 7); }
template <class Epi, class Sched, bool ALIGN_EPI = true, bool F8 = false, bool F4 = false>
__device__ __forceinline__ void gemm_phase(LAS unsigned char* lds, const Gemm g, const Sched& S, const Epi& E) {
    const int tid = ptid(), wid = __builtin_amdgcn_readfirstlane(tid >> 6), lane = tid & 63, wr = wid >> 2, wc = wid & 3, fr = lane & 15, fq = lane >> 4;
    const int K = g.K, nt = K / BK;
    unsigned voffA[2], voffB[2];
#pragma unroll
    for (int i = 0; i < 2; ++i) { int R, C; stage_rc(tid * 16 + i * 8192, R, C);
        const int Rb = (int)Epi::PERM == 2 ? (64 * (R >> 5) + 16 * ((R >> 2) & 3) + 4 * ((R >> 4) & 1) + (R & 3)) : ((int)Epi::PERM == 1 ? ((R & ~31) + perm32(R & 31)) : R);
        voffA[i] = (unsigned)(R * g.lda + C) * 2u; voffB[i] = (unsigned)(Rb * g.ldb + C) * 2u; }
    const size_t kstep = (size_t)(BK * 2);
    const size_t hstepA = (size_t)HALF * g.lda * 2, hstepB = (size_t)((int)Epi::PERM == 2 ? 8 : HALF) * g.ldb * 2;
    const size_t tstepA = 2 * hstepA, tstepB = (size_t)BM * g.ldb * 2;
    const unsigned ldsw = (unsigned)wid * 1024u;
    const int aoff = lds_byte(wr * 64 + fr, fq * 8), boff = lds_byte(wc * 32 + fr, fq * 8);
#define PG8_SA(b, h) (((b) * 2 + (h)) * HTB)
#define PG8_SB(b, h) ((4 + (b) * 2 + (h)) * HTB)
#define PG8_STAGE(bufoff, gbase, voff) do { _Pragma("unroll") for (int _i = 0; _i < 2; ++_i) \
        __builtin_amdgcn_global_load_lds((const unsigned*)((const char*)(gbase) + (voff)[_i]), (LAS unsigned*)(lds + (bufoff) + ldsw + _i * 8192), 16, 0, 0); } while (0)
#define PG8_LDA(dst, b, h) do { _Pragma("unroll") for (int m = 0; m < 4; ++m) { if constexpr (F8) dst##8[m] = cat8(*(const LAS bf16x8*)(lds + PG8_SA(b, h) + aoff + m * 2048), *(const LAS bf16x8*)(lds + PG8_SA(b, h) + aoff + m * 2048 + 1024)); \
        else { _Pragma("unroll") for (int k = 0; k < 2; ++k) dst[m][k] = *(const LAS bf16x8*)(lds + PG8_SA(b, h) + aoff + m * 2048 + k * 1024); } } } while (0)
#define PG8_LDB(dst, b, h) do { _Pragma("unroll") for (int n = 0; n < 2; ++n) { if constexpr (F8) dst##8[n] = cat8(*(const LAS bf16x8*)(lds + PG8_SB(b, h) + boff + n * 2048), *(const LAS bf16x8*)(lds + PG8_SB(b, h) + boff + n * 2048 + 1024)); \
        else { _Pragma("unroll") for (int k = 0; k < 2; ++k) dst[n][k] = *(const LAS bf16x8*)(lds + PG8_SB(b, h) + boff + n * 2048 + k * 1024); } } } while (0)
#define PG8_MMA(ai, bj, At, Bt) do { __builtin_amdgcn_s_setprio(1); _Pragma("unroll") for (int m = 0; m < 4; ++m) _Pragma("unroll") for (int n = 0; n < 2; ++n) { \
        if constexpr (F8) asm volatile("v_mfma_f32_16x16x128_f8f6f4 %0, %1, %2, %0" : "+v"(acc[ai][bj][m][n]) : "v"(Bt##8[n]), "v"(At##8[m]));   \
        else if constexpr (F4) { _Pragma("unroll") for (int k = 0; k < 2; ++k) asm volatile("v_mfma_f32_16x16x128_f8f6f4 %0, %1, %2, %0 cbsz:4 blgp:4" : "+v"(acc[ai][bj][m][n]) : "v"(Bt[n][k]), "v"(At[m][k])); } \
        else { _Pragma("unroll") for (int k = 0; k < 2; ++k) acc[ai][bj][m][n] = __builtin_amdgcn_mfma_f32_16x16x32_bf16(Bt[n][k], At[m][k], acc[ai][bj][m][n], 0, 0, 0); } } \
        __builtin_amdgcn_s_setprio(0); } while (0)
#define PG8_WAIT_V(n) asm volatile("s_waitcnt vmcnt(" #n ")" ::: "memory")
#define PG8_WAIT_L(n) asm volatile("s_waitcnt lgkmcnt(" #n ")" ::: "memory")
#define PG8_BAR __builtin_amdgcn_s_barrier()
#define PG8_SCHED __builtin_amdgcn_sched_barrier(0)
    Unit cur, nxt; int ui = 0;
    if (!S.next(0, cur)) return;
    f32x4 acc[2][2][4][2];
#pragma unroll
    for (int a = 0; a < 2; ++a)
#pragma unroll
        for (int b = 0; b < 2; ++b)
#pragma unroll
            for (int m = 0; m < 4; ++m)
#pragma unroll
                for (int n = 0; n < 2; ++n) acc[a][b][m][n] = (f32x4){0.f, 0.f, 0.f, 0.f};
    bf16x8 At[4][2], B0[2][2], B1[2][2]; v8i_t At8[4], B08[2], B18[2];
    const char* cA = (const char*)g.A + (size_t)cur.z * g.zA + (size_t)cur.pm * tstepA; const char* cB = (const char*)g.Bt + (size_t)cur.z * g.zB + (size_t)cur.pn * tstepB;
    PG8_STAGE(PG8_SB(0, 0), cB, voffB); PG8_STAGE(PG8_SB(0, 1), cB + hstepB, voffB); PG8_STAGE(PG8_SA(0, 0), cA, voffA); PG8_STAGE(PG8_SA(0, 1), cA + hstepA, voffA);
    if (wr == 1) PG8_BAR;
    PG8_WAIT_V(2); PG8_BAR;
    PG8_STAGE(PG8_SB(1, 0), cB + kstep, voffB); PG8_STAGE(PG8_SA(1, 0), cA + kstep, voffA); PG8_STAGE(PG8_SB(1, 1), cB + hstepB + kstep, voffB);
    PG8_WAIT_V(6); PG8_BAR;
    for (;;) {
        const bool has_next = S.next(ui + 1, nxt);
        const char* nA = has_next ? (const char*)g.A + (size_t)nxt.z * g.zA + (size_t)nxt.pm * tstepA : cA; const char* nB = has_next ? (const char*)g.Bt + (size_t)nxt.z * g.zB + (size_t)nxt.pn * tstepB : cB;
#pragma unroll 1
        for (int t = 0; t < nt; t += 2) {
            const bool last = (t == nt - 2);
            const char* a1 = cA + (size_t)(t + 1) * kstep;
            const char* a2 = last ? nA : cA + (size_t)(t + 2) * kstep; const char* b2 = last ? nB : cB + (size_t)(t + 2) * kstep;
            const char* a3 = a2 + kstep; const char* b3 = b2 + kstep;
            PG8_LDB(B0, 0, 0); PG8_LDB(B1, 0, 1); PG8_SCHED; PG8_LDA(At, 0, 0); PG8_STAGE(PG8_SA(1, 1), a1 + hstepA, voffA);
            PG8_WAIT_V(8); PG8_WAIT_L(0); PG8_BAR; PG8_MMA(0, 0, At, B0); PG8_MMA(0, 1, At, B1); PG8_BAR; PG8_SCHED;
            PG8_LDA(At, 0, 1); PG8_STAGE(PG8_SB(0, 0), b2, voffB); PG8_STAGE(PG8_SB(0, 1), b2 + hstepB, voffB); PG8_STAGE(PG8_SA(0, 0), a2, voffA);
            PG8_WAIT_V(8); PG8_WAIT_L(0); PG8_BAR; PG8_MMA(1, 0, At, B0); PG8_MMA(1, 1, At, B1); PG8_BAR; PG8_SCHED;
            PG8_LDB(B0, 1, 0); PG8_LDB(B1, 1, 1); PG8_SCHED; PG8_LDA(At, 1, 0); PG8_STAGE(PG8_SA(0, 1), a2 + hstepA, voffA);
            PG8_WAIT_V(8); PG8_WAIT_L(0); PG8_BAR; PG8_MMA(0, 0, At, B0); PG8_MMA(0, 1, At, B1); PG8_BAR; PG8_SCHED;
            PG8_LDA(At, 1, 1); PG8_STAGE(PG8_SB(1, 0), b3, voffB); PG8_STAGE(PG8_SB(1, 1), b3 + hstepB, voffB); PG8_STAGE(PG8_SA(1, 0), a3, voffA);
            PG8_WAIT_V(8); PG8_WAIT_L(0); PG8_BAR; PG8_MMA(1, 0, At, B0); PG8_MMA(1, 1, At, B1); PG8_BAR; PG8_SCHED;
        }
        if constexpr (ALIGN_EPI) { if (wr == 0) PG8_BAR; }
        if constexpr (F8 || F4) asm volatile("s_nop 15\n\ts_nop 15" ::: "memory");
        E(acc, cur, wr, wc, fr, fq);
        if (!has_next) break;
        if (!(Epi::CARRY && nxt.z != 0))
#pragma unroll
        for (int a = 0; a < 2; ++a)
#pragma unroll
            for (int b = 0; b < 2; ++b)
#pragma unroll
                for (int m = 0; m < 4; ++m)
#pragma unroll
                    for (int n = 0; n < 2; ++n) acc[a][b][m][n] = (f32x4){0.f, 0.f, 0.f, 0.f};
        cur = nxt; cA = nA; cB = nB; ++ui;
        if constexpr (ALIGN_EPI) { if (wr == 1) PG8_BAR; }
    }
    PG8_WAIT_V(0);
    if constexpr (!ALIGN_EPI) { if (wr == 0) PG8_BAR; }
    PG8_BAR;
#undef PG8_SA
#undef PG8_SB
#undef PG8_STAGE
#undef PG8_LDA
#undef PG8_LDB
#undef PG8_MMA
#undef PG8_WAIT_V
#undef PG8_WAIT_L
#undef PG8_BAR
#undef PG8_SCHED
}
}

constexpr int BATCH = 4, SEQ = 4096, DM = 4096, MTOK = BATCH * SEQ, DEPTH = 2;
constexpr int INW = 12184, INP = 12288, NGATE = 4 * DM, N1 = INP + NGATE;
constexpr float LOG2E = 1.4426950408889634f;
constexpr float RMS_EPS = 1e-6f, LN_EPS = 1e-5f;
constexpr float DN_ALPHA = 1.4142135623730951f;
constexpr int PC_AQ = 0, PC_AK = 1024, PC_AV = 1280, PC_AIQ = 1536, PC_AZ = 2560, PC_BQ = 3584, PC_BK = 4608, PC_BV = 5632, PC_BZ = 6656,
              PC_CQ = 7680, PC_CK = 8704, PC_CV = 8832, PC_CZ = 8960, PC_DCQ = 9984, PC_DCKV = 10752, PC_DZ = 11008,
              PC_AIK = 12032, PC_AIW = 12096, PC_BF = 12112, PC_DKR = 12120, PC_END = 12184;
constexpr int SC_AQ = 0, SC_AK = 1024, SC_AV = 1280, SC_AIQ = 1536, SC_AIK = 2560, SC_AIW = 2624, SC_AZ = 2640, SC_BQ = 3664, SC_BK = 4688, SC_BV = 5712,
              SC_BF = 6736, SC_BZ = 6744, SC_CQ = 7768, SC_CK = 8792, SC_CV = 8920, SC_CZ = 9048, SC_DCQ = 10072, SC_DCKV = 10840, SC_DKR = 11096, SC_DZ = 11160;
static_assert(SC_DZ + 1024 == INW, "w_in column partition");
constexpr int SMC_AIK = 0, SMC_AIW = 64, SMC_BF = 80, SMC_DKR = 88;

constexpr size_t MiB = 1u << 20;
constexpr size_t WS_CTL = 0, CTL_ZERO_BYTES = 1 * MiB;
constexpr size_t WS_W = 2 * MiB;
constexpr int NIN8 = 27 * 256, NINZ = 16 * 256, NINB = 5 * 256;
constexpr size_t WO_WIN8 = 0                                         , WO_WZ4 = WO_WIN8 + (size_t)NIN8 * DM  ,
                 WO_WINB = WO_WZ4 + (size_t)NINZ * (DM / 2)          ,
                 WO_WG8 = WO_WINB + (size_t)NINB * DM * 2            , WO_WBR = WO_WG8 + (size_t)NGATE * DM  ,
                 WO_WOUT = WO_WBR + (size_t)4 * DM * 1024            , WO_DQUP = WO_WOUT + (size_t)DM * DM,
                 WO_DKVUP = WO_DQUP + (size_t)1536 * 768 * 2, WO_END = WO_DKVUP + (size_t)2048 * 256 * 2;
static_assert(WO_END <= 292 * MiB, "weights region");
constexpr size_t WS_XB = 294 * MiB;
constexpr size_t WS_P = 422 * MiB;
constexpr size_t WS_MRGF = WS_P;
constexpr size_t WS_G = 806 * MiB;
constexpr size_t WS_R = WS_G;
constexpr size_t WS_SC = 1318 * MiB;
constexpr size_t WS_MRG = WS_SC;
constexpr size_t WS_BR = 1574 * MiB;
constexpr size_t WS_DQ = 1702 * MiB;
constexpr size_t WS_DKV = 1750 * MiB;
constexpr size_t WS_MASK = 1814 * MiB;
constexpr size_t WS_SM = 1822 * MiB;
constexpr size_t WS_CS = 1838 * MiB;
constexpr size_t WS_RSS = 1842 * MiB;
constexpr size_t WS_CUM = 1843 * MiB;
constexpr size_t WS_DKR = 1844 * MiB;
constexpr size_t WS_X8 = 1846 * MiB;
constexpr size_t WS_KV8 = 1096 * MiB;
constexpr int KV8W = 2560;
constexpr size_t WS_D8 = 1136 * MiB;
constexpr int D8W = 2112;
constexpr size_t WS_L8 = 1170 * MiB;
constexpr float DQ_WS = 64.0f, DKV_WS = 8.0f;
constexpr size_t WS_Z8 = 1188 * MiB;
constexpr size_t WS_X4 = 1062 * MiB;
constexpr size_t WS_END = 1910 * MiB;
constexpr int CW_TMO = 0;
constexpr int CW_Q = 64;
constexpr int CW_BAR = 16384;

constexpr int RING_BYTES = 131072;
constexpr int LDSCTL_OFF = RING_BYTES, MISC_OFF = LDSCTL_OFF + 320;
constexpr int LDS_BYTES = 147456;
constexpr int NWAVES = 8, NTHREADS = 512;

#define RLX_AGENT __ATOMIC_RELAXED, __HIP_MEMORY_SCOPE_AGENT
#define LDS_WAIT() asm volatile("s_waitcnt lgkmcnt(0)" ::: "memory")
#define VM_WAIT() asm volatile("s_waitcnt vmcnt(0)" ::: "memory")

#define XB_TMO      128
#define XB_XCNT(j)  (256  + 64 * (j))
#define XB_XSUB(j)  (1280 + 64 * (j))
#define XB_XGEN(j)  (2304 + 64 * (j))
#define XB_TOP      3328
#define XB_TOPGEN   3392
#define XCD_BAR_WORDS 3456
#define XB_SPIN_CAP (1u << 23)
__device__ __forceinline__ unsigned xb_ld(unsigned* p)              { return __hip_atomic_load(p, __ATOMIC_RELAXED, __HIP_MEMORY_SCOPE_AGENT); }
__device__ __forceinline__ unsigned xb_add(unsigned* p, unsigned v) { return __hip_atomic_fetch_add(p, v, __ATOMIC_RELAXED, __HIP_MEMORY_SCOPE_AGENT); }
__device__ __forceinline__ unsigned xb_xcc_id() { return (unsigned)__builtin_amdgcn_s_getreg((3 << 11) | 20) & 0xFu; }
#define XB_SPIN(cond, bar) do { unsigned _sp = 0; while (cond) { __builtin_amdgcn_s_sleep(1); \
    if ((++_sp & 255u) == 0u) { if (xb_ld(&(bar)[XB_TMO])) break; if (_sp > XB_SPIN_CAP) { atomicAdd(&(bar)[XB_TMO], 1u); break; } } } } while (0)
struct XcdBarrier { unsigned* bar; unsigned x; volatile LAS unsigned* st; };
__device__ __forceinline__ XcdBarrier xcd_barrier_post(unsigned* bar, volatile LAS unsigned* st) {
    XcdBarrier b; b.bar = bar; b.x = xb_xcc_id(); b.st = st;
    if (threadIdx.x == 0) (void)xb_add(&bar[XB_XCNT(b.x)], 1u);
    return b;
}
__device__ __forceinline__ void xcd_barrier_complete(unsigned* bar, unsigned x, unsigned& nloc, unsigned& nx) {
    const unsigned G = gridDim.x * gridDim.y * gridDim.z;
    unsigned sum, cnt, mine, sp = 0u;
    for (;;) {
        sum = 0u; cnt = 0u; mine = 0u;
#pragma unroll
        for (unsigned j = 0; j < 16; ++j) { const unsigned c = xb_ld(&bar[XB_XCNT(j)]); sum += c; cnt += (c > 0u) ? 1u : 0u; mine = (j == x) ? c : mine; }
        if (sum == G) break;
        __builtin_amdgcn_s_sleep(1);
        if ((++sp & 255u) == 0u) { if (xb_ld(&bar[XB_TMO])) break; if (sp > XB_SPIN_CAP) { atomicAdd(&bar[XB_TMO], 1u); break; } }
    }
    nloc = mine > 0u ? mine : 1u; nx = cnt > 0u ? cnt : 1u;
}
__device__ __forceinline__ void xcd_barrier(const XcdBarrier& b) {
    asm volatile("s_waitcnt vmcnt(0)" ::: "memory");
    __syncthreads();
    if (threadIdx.x == 0) {
        unsigned* bar = b.bar;
        __builtin_amdgcn_s_waitcnt(0);
        unsigned nloc = b.st[0], nx = b.st[1];
        if (nloc == 0u) { xcd_barrier_complete(bar, b.x, nloc, nx); b.st[0] = nloc; b.st[1] = nx; }
        const unsigned old = xb_add(&bar[XB_XSUB(b.x)], 1u);
        const unsigned gen = old / nloc;
        if (old + 1u == (gen + 1u) * nloc) {
            __builtin_amdgcn_fence(__ATOMIC_RELEASE, "agent");
            asm volatile("s_waitcnt vmcnt(0)" ::: "memory");
            const unsigned og = xb_add(&bar[XB_TOP], 1u);
            const unsigned tg = og / nx;
            if (og + 1u == (tg + 1u) * nx) xb_add(&bar[XB_TOPGEN], 1u);
            else XB_SPIN(xb_ld(&bar[XB_TOPGEN]) == tg, bar);
            __builtin_amdgcn_fence(__ATOMIC_ACQUIRE, "agent");
            xb_add(&bar[XB_XGEN(b.x)], 1u);
            asm volatile("s_waitcnt vmcnt(0)" ::: "memory");
        } else {
            XB_SPIN(xb_ld(&bar[XB_XGEN(b.x)]) == gen, bar);
            __builtin_amdgcn_fence(__ATOMIC_ACQUIRE, "agent");
            asm volatile("s_waitcnt vmcnt(0)" ::: "memory");
        }
    }
    __syncthreads();
}

struct Args {
    const float* x; const int* pos; const float* w_in; const float* w_gate; const float* w_branch; const float* w_out;
    const float* dq_gain; const float* dq_up; const float* dkv_gain; const float* dkv_up; const float* f_bias; const float* sinks; const float* ln_gain; const float* ln_bias;
    float* out; unsigned char* ws; int ph_lo, ph_hi;
};

__device__ __forceinline__ float wave_sum(float v) {
#pragma unroll
    for (int o = 1; o < 64; o <<= 1) v += __shfl_xor(v, o);
    return v;
}
__device__ __forceinline__ unsigned pack_fp4x8(float a0, float a1, float a2, float a3, float a4, float a5, float a6, float a7) {
    unsigned w = 0u;
    w = __builtin_amdgcn_cvt_scalef32_pk_fp4_f32(w, a0, a1, 1.0f, 0); w = __builtin_amdgcn_cvt_scalef32_pk_fp4_f32(w, a2, a3, 1.0f, 1);
    w = __builtin_amdgcn_cvt_scalef32_pk_fp4_f32(w, a4, a5, 1.0f, 2); w = __builtin_amdgcn_cvt_scalef32_pk_fp4_f32(w, a6, a7, 1.0f, 3);
    return w; }
constexpr float FP4_XS = 2.0f, FP4_WS = 128.0f;
__device__ __forceinline__ float fast_sigmoid(float v) { return __builtin_amdgcn_rcpf(1.0f + __builtin_amdgcn_exp2f(-v * LOG2E)); }

__device__ __forceinline__ int in_src(int j, float& sc) {
    sc = 1.0f;
    if (j < PC_AK)   return SC_AQ + (j - PC_AQ);
    if (j < PC_AV)   return SC_AK + (j - PC_AK);
    if (j < PC_AIQ)  return SC_AV + (j - PC_AV);
    if (j < PC_AZ)   return SC_AIQ + (j - PC_AIQ);
    if (j < PC_BQ)   return SC_AZ + (j - PC_AZ);
    if (j < PC_BK)   return SC_BQ + (j - PC_BQ);
    if (j < PC_BV)   return SC_BK + (j - PC_BK);
    if (j < PC_BZ)   return SC_BV + (j - PC_BV);
    if (j < PC_CQ)   return SC_BZ + (j - PC_BZ);
    if (j < PC_CK)   return SC_CQ + (j - PC_CQ);
    if (j < PC_CV)   return SC_CK + (j - PC_CK);
    if (j < PC_CZ)   return SC_CV + (j - PC_CV);
    if (j < PC_DCQ)  return SC_CZ + (j - PC_CZ);
    if (j < PC_DCKV) return SC_DCQ + (j - PC_DCQ);
    if (j < PC_DZ)   return SC_DCKV + (j - PC_DCKV);
    if (j < PC_AIK)  return SC_DZ + (j - PC_DZ);
    if (j < PC_AIW)  return SC_AIK + (j - PC_AIK);
    if (j < PC_BF)   return SC_AIW + (j - PC_AIW);
    if (j < PC_DKR)  return SC_BF + (j - PC_BF);
    if (j < PC_END)  { const int p = j - PC_DKR; return SC_DKR + (p >> 1) + 32 * (p & 1); }
    return -1;
}
__host__ __device__ __forceinline__ int in8_tile(int i) { return i < 6 ? i : (i < 22 ? i + 4 : i + 8); }
__host__ __device__ __forceinline__ int inz_tile(int j) { return j < 4 ? 26 + j : 31 + j; }
struct CvtItem {
    const float* p;
    unsigned ld;
    const float* gain;
    float sc;
    unsigned char* dst;
    int K, n0, k0, f8;
};
__device__ __forceinline__ CvtItem cvt_decode(const Args& a, int layer, int it, int lane) {
    unsigned char* W = a.ws + WS_W;
    constexpr int I_IN8 = (NIN8 / 32) * (DM / 64), I_INZ = (NINZ / 32) * (DM / 64), I_INB = (NINB / 32) * (DM / 64), I_G = (NGATE / 32) * (DM / 64), I_BR = 4 * (DM / 32) * (1024 / 64), I_OUT = (DM / 32) * (DM / 64), I_DQ = (1536 / 32) * (768 / 64);
    CvtItem d; d.gain = nullptr; d.sc = 1.0f; d.f8 = 1; d.K = DM; d.ld = DM;
    const int ln = lane & 31; int r = it;
    if (r < I_IN8) { const int nb = r % (NIN8 / 32), kb = r / (NIN8 / 32); d.n0 = nb * 32; d.k0 = kb * 64;
        const int j = in8_tile(d.n0 >> 8) * 256 + (d.n0 & 255) + ln; float s_; const int c = in_src(j, s_);
        d.p = a.w_in + (size_t)layer * DM * INW + (c < 0 ? 0 : c); d.ld = INW; d.sc = c < 0 ? 0.f : 64.0f; d.dst = W + WO_WIN8; return d; }
    r -= I_IN8;
    if (r < I_INZ) { const int nb = r % (NINZ / 32), kb = r / (NINZ / 32); d.n0 = nb * 32; d.k0 = kb * 64;
        const int j = inz_tile(d.n0 >> 8) * 256 + (d.n0 & 255) + ln; float s_; const int c = in_src(j, s_);
        d.p = a.w_in + (size_t)layer * DM * INW + (c < 0 ? 0 : c); d.ld = INW; d.sc = c < 0 ? 0.f : FP4_WS; d.dst = W + WO_WZ4; d.f8 = 2; return d; }
    r -= I_INZ;
    if (r < I_INB) { const int nb = r % (NINB / 32), kb = r / (NINB / 32); d.n0 = nb * 32; d.k0 = kb * 64;
        const int j = d.n0 + ln + (d.n0 < 1024 ? 1536 : 12032 - 1024); float s_; const int c = in_src(j, s_);
        d.p = a.w_in + (size_t)layer * DM * INW + (c < 0 ? 0 : c); d.ld = INW; d.sc = c < 0 ? 0.f : 1.0f; d.dst = W + WO_WINB; d.f8 = 0; return d; }
    r -= I_INB;
    if (r < I_G) { const int nb = r % (NGATE / 32), kb = r / (NGATE / 32), g = nb / (DM / 32); d.n0 = (nb % (DM / 32)) * 32; d.k0 = kb * 64;
        d.p = a.w_gate + ((size_t)layer * 4 + g) * DM * DM + d.n0 + ln; d.sc = FP4_WS; d.dst = W + WO_WG8 + (size_t)g * DM * (DM / 2); d.f8 = 2; return d; }
    r -= I_G;
    if (r < I_BR) { const int n = r / ((DM / 32) * 16), q = r % ((DM / 32) * 16), nb = q % (DM / 32), kb = q / (DM / 32); d.n0 = nb * 32; d.k0 = kb * 64;
        d.p = a.w_branch + ((size_t)layer * 4 + n) * 1024 * DM + d.n0 + ln; d.sc = 64.0f; d.dst = W + WO_WBR + (size_t)n * DM * 1024; d.K = 1024; return d; }
    r -= I_BR;
    if (r < I_OUT) { const int nb = r % (DM / 32), kb = r / (DM / 32); d.n0 = nb * 32; d.k0 = kb * 64;
        d.p = a.w_out + (size_t)layer * DM * DM + d.n0 + ln; d.sc = 128.0f; d.dst = W + WO_WOUT; return d; }
    r -= I_OUT;
    if (r < I_DQ) { const int nb = r % 48, kb = r / 48; d.n0 = nb * 32; d.k0 = kb * 64;
        const int j = d.n0 + ln, h = j / 192, wv = j % 192; int c = wv; if (wv >= 128) { const int q = wv - 128; c = 128 + (q >> 1) + 32 * (q & 1); }
        d.p = a.dq_up + (size_t)layer * 768 * 1536 + h * 192 + c; d.ld = 1536; d.gain = a.dq_gain + layer * 768; d.sc = 0.07216878364870322f * LOG2E * DQ_WS; d.dst = W + WO_DQUP; d.K = 768; d.f8 = 1; return d; }
    r -= I_DQ;
    { const int nb = r % 64, kb = r / 64; d.n0 = nb * 32; d.k0 = kb * 64;
      d.p = a.dkv_up + (size_t)layer * 256 * 2048 + d.n0 + ln; d.ld = 2048; d.gain = a.dkv_gain + layer * 256; d.sc = DKV_WS; d.dst = W + WO_DKVUP; d.K = 256; d.f8 = 1; return d; }
}
__device__ __forceinline__ void cvt_load(const CvtItem& d, float (&v)[32], int lane) {
    const float* p = d.p + (size_t)(d.k0 + (lane >> 5)) * d.ld;
#pragma unroll
    for (int i = 0; i < 32; ++i) v[i] = p[(size_t)(2 * i) * d.ld];
}
__device__ __forceinline__ void cvt_finish(const CvtItem& d, const float (&v)[32], LAS float* scr, int lane) {
#pragma unroll
    for (int i = 0; i < 32; ++i) { const int kk = 2 * i + (lane >> 5); float x = v[i] * d.sc; if (d.gain) x *= d.gain[d.k0 + kk]; scr[kk * 33 + (lane & 31)] = x; }
    LDS_WAIT(); asm volatile("" ::: "memory");
    const int c = lane & 7;
#pragma unroll
    for (int j = 0; j < 4; ++j) { const int n = (lane >> 3) + 8 * j; const LAS float* s = scr + (8 * c) * 33 + n;
        if (d.f8 == 2) *(unsigned*)(d.dst + (((size_t)(d.n0 + n) * d.K + d.k0 + 8 * c) >> 1)) = pack_fp4x8(s[0], s[33], s[2 * 33], s[3 * 33], s[4 * 33], s[5 * 33], s[6 * 33], s[7 * 33]);
        else if (d.f8) { int w0 = 0, w1 = 0;
            w0 = __builtin_amdgcn_cvt_pk_fp8_f32(s[0], s[33], w0, false); w0 = __builtin_amdgcn_cvt_pk_fp8_f32(s[2 * 33], s[3 * 33], w0, true);
            w1 = __builtin_amdgcn_cvt_pk_fp8_f32(s[4 * 33], s[5 * 33], w1, false); w1 = __builtin_amdgcn_cvt_pk_fp8_f32(s[6 * 33], s[7 * 33], w1, true);
            *(u32x2*)(d.dst + (size_t)(d.n0 + n) * d.K + d.k0 + 8 * c) = (u32x2){(unsigned)w0, (unsigned)w1}; }
        else { u32x4 o; o.x = cvt_pk_bf16(s[0], s[33]); o.y = cvt_pk_bf16(s[2 * 33], s[3 * 33]); o.z = cvt_pk_bf16(s[4 * 33], s[5 * 33]); o.w = cvt_pk_bf16(s[6 * 33], s[7 * 33]);
            *(u32x4*)((bf16_t*)d.dst + (size_t)(d.n0 + n) * d.K + d.k0 + 8 * c) = o; } }
    LDS_WAIT(); asm volatile("" ::: "memory");
}
__device__ __forceinline__ void convert_weights(const Args& a, int layer, LAS unsigned char* lds) {
    const int tid = ptid(), lane = tid & 63, wave = tid >> 6;
    LAS float* scr = (LAS float*)(lds + wave * 8448);
    const int NGW = gridDim.x * NWAVES, gw = blockIdx.x * NWAVES + wave;
    constexpr int NITEMS = (NIN8 / 32) * (DM / 64) + (NINZ / 32) * (DM / 64) + (NINB / 32) * (DM / 64) + (NGATE / 32) * (DM / 64) + 4 * (DM / 32) * (1024 / 64) + (DM / 32) * (DM / 64) + (1536 / 32) * (768 / 64) + (2048 / 32) * (256 / 64);
    float va[32], vb[32]; CvtItem da, db;
    int it = gw;
    if (it < NITEMS) { da = cvt_decode(a, layer, it, lane); cvt_load(da, va, lane); }
    while (it < NITEMS) {
        const int itb = it + NGW;
        if (itb < NITEMS) { db = cvt_decode(a, layer, itb, lane); cvt_load(db, vb, lane); }
        cvt_finish(da, va, scr, lane);
        if (itb >= NITEMS) break;
        const int ita = itb + NGW;
        if (ita < NITEMS) { da = cvt_decode(a, layer, ita, lane); cvt_load(da, va, lane); }
        cvt_finish(db, vb, scr, lane);
        it = ita;
    }
    __syncthreads();
}
__device__ __forceinline__ void prologue_misc(const Args& a) {
    const size_t gt = (size_t)blockIdx.x * NTHREADS + ptid(), GT = (size_t)gridDim.x * NTHREADS;
    bf16_t* XB = (bf16_t*)(a.ws + WS_XB);
    constexpr size_t NCH = (size_t)MTOK * DM / 8;
    for (size_t i0 = gt; i0 < NCH; i0 += 4 * GT) {
        f32x4 v0[4], v1[4];
#pragma unroll
        for (int u = 0; u < 4; ++u) { const size_t i = i0 + u * GT; if (i < NCH) { v0[u] = *(const f32x4*)(a.x + i * 8); v1[u] = *(const f32x4*)(a.x + i * 8 + 4); } }
#pragma unroll
        for (int u = 0; u < 4; ++u) { const size_t i = i0 + u * GT; if (i < NCH) {
            u32x4 o; o.x = cvt_pk_bf16(v0[u][0], v0[u][1]); o.y = cvt_pk_bf16(v0[u][2], v0[u][3]); o.z = cvt_pk_bf16(v1[u][0], v1[u][1]); o.w = cvt_pk_bf16(v1[u][2], v1[u][3]);
            *(u32x4*)(XB + i * 8) = o;
            int w0 = 0, w1 = 0;
            w0 = __builtin_amdgcn_cvt_pk_fp8_f32(v0[u][0], v0[u][1], w0, false); w0 = __builtin_amdgcn_cvt_pk_fp8_f32(v0[u][2], v0[u][3], w0, true);
            w1 = __builtin_amdgcn_cvt_pk_fp8_f32(v1[u][0], v1[u][1], w1, false); w1 = __builtin_amdgcn_cvt_pk_fp8_f32(v1[u][2], v1[u][3], w1, true);
            *(u32x2*)(a.ws + WS_X8 + i * 8) = (u32x2){(unsigned)w0, (unsigned)w1};
            *(unsigned*)(a.ws + WS_X4 + i * 4) = pack_fp4x8(v0[u][0] * FP4_XS, v0[u][1] * FP4_XS, v0[u][2] * FP4_XS, v0[u][3] * FP4_XS, v1[u][0] * FP4_XS, v1[u][1] * FP4_XS, v1[u][2] * FP4_XS, v1[u][3] * FP4_XS); } }
    }
    f32x2* CS = (f32x2*)(a.ws + WS_CS);
    for (size_t i = gt; i < (size_t)MTOK * 32; i += GT) {
        const int row = (int)(i >> 5), fi = (int)(i & 31);
        const float invf = __builtin_amdgcn_exp2f(-(float)fi * (13.287712379549449f / 32.0f));
        const float ang = (float)a.pos[row] * invf;
        const double rev = (double)ang * 0.15915494309189535;
        const float fr = (float)(rev - floor(rev));
        CS[i] = (f32x2){__builtin_amdgcn_cosf(fr), __builtin_amdgcn_sinf(fr)};
    }
}

struct EpiIn {
    static constexpr int PERM = 2; static constexpr bool CARRY = false;
    bf16_t* P; float* SM; float* RSS; int f8; unsigned char* KV8; unsigned char* L8; unsigned char* Z8;
    template <int MODE>
    __device__ __forceinline__ void run(const f32x4 (&acc)[2][2][4][2], int pn, int row0, int cw, int wc, int fq, float sc) const {
        bf16_t* base = P + (size_t)pn * 256 + cw;
        unsigned char* k8b = (MODE == 5) ? Z8 + (pn < 14 ? (pn - 10) * 256 : (pn < 30 ? 1024 + (pn - 26) * 256 : (pn < 39 ? 2048 + (pn - 35) * 256 : 3072 + (pn - 43) * 256))) + cw
                           : (MODE == 3) ? L8 + (pn - 39) * 256 + cw : KV8 + (pn < 6 ? (pn - 4) * 256 : 512 + (pn - 18) * 256) + cw;
#pragma unroll
        for (int ai = 0; ai < 2; ++ai)
#pragma unroll
            for (int m = 0; m < 4; ++m) { const int row = row0 + ai * 128 + m * 16; bf16_t* rowp = base + (size_t)row * INP; float ss = 0.f;
                u32x4 k8w;
#pragma unroll
                for (int bj = 0; bj < 2; ++bj) { f32x4 v0 = acc[ai][bj][m][0] * sc, v1 = acc[ai][bj][m][1] * sc;
                    if constexpr (MODE == 3) ss += ((v0[0] * v0[0] + v0[1] * v0[1]) + (v0[2] * v0[2] + v0[3] * v0[3])) + ((v1[0] * v1[0] + v1[1] * v1[1]) + (v1[2] * v1[2] + v1[3] * v1[3]));
                    if constexpr (MODE == 4 || MODE == 3 || MODE == 5) { int w0 = 0, w1 = 0;
                        w0 = __builtin_amdgcn_cvt_pk_fp8_f32(v0[0], v0[1], w0, false); w0 = __builtin_amdgcn_cvt_pk_fp8_f32(v0[2], v0[3], w0, true);
                        w1 = __builtin_amdgcn_cvt_pk_fp8_f32(v1[0], v1[1], w1, false); w1 = __builtin_amdgcn_cvt_pk_fp8_f32(v1[2], v1[3], w1, true);
                        if (bj == 0) { k8w.x = (unsigned)w0; k8w.y = (unsigned)w1; } else { k8w.z = (unsigned)w0; k8w.w = (unsigned)w1; } continue; }
                    if constexpr (MODE == 1) {
#pragma unroll
                        for (int j = 0; j < 4; ++j) { v0[j] = v0[j] * fast_sigmoid(v0[j]); v1[j] = v1[j] * fast_sigmoid(v1[j]); } }
                    if constexpr (MODE == 2) { float* sp = SM + (size_t)row * 256 + cw + bj * 8; *(f32x4*)sp = v0; *(f32x4*)(sp + 4) = v1; }
                    u32x4 w; w.x = cvt_pk_bf16(v0[0], v0[1]); w.y = cvt_pk_bf16(v0[2], v0[3]); w.z = cvt_pk_bf16(v1[0], v1[1]); w.w = cvt_pk_bf16(v1[2], v1[3]);
                    *(u32x4*)(rowp + bj * 8) = w; }
                if constexpr (MODE == 4) *(u32x4*)(k8b + (size_t)row * KV8W) = k8w;
                if constexpr (MODE == 3) *(u32x4*)(k8b + (size_t)row * 1024) = k8w;
                if constexpr (MODE == 5) *(u32x4*)(k8b + (size_t)row * 4096) = k8w;
                if constexpr (MODE == 3) { ss += __shfl_xor(ss, 16); ss += __shfl_xor(ss, 32); if (fq == 0) RSS[(size_t)row * 16 + (pn - 39) * 4 + wc] = ss; }
                asm volatile("" ::: "memory"); }
    }
    __device__ __forceinline__ void operator()(f32x4 (&acc)[2][2][4][2], const pg8::Unit& u, int wr, int wc, int fr, int fq) const {
        asm volatile("" : "+v"(fr), "+v"(fq));
        const int pn = f8 == 1 ? in8_tile(u.pn) : (f8 == 2 ? inz_tile(u.pn) : (u.pn < 4 ? u.pn + 6 : 47)), row0 = u.pm * 256 + wr * 64 + fr, cw = wc * 64 + 16 * fq;
        const float qs = (pn < 4 || (pn >= 14 && pn < 18)) ? 0.08838834764831845f * LOG2E : ((pn >= 30 && pn < 34) ? 0.125f * LOG2E : 1.0f), sc = f8 == 1 ? qs * 0.015625f : (f8 == 2 ? 1.0f / (FP4_XS * FP4_WS * 0.9761f) : qs);
        if (pn == 47) run<2>(acc, pn, row0, cw, wc, fq, sc);
        else if (pn >= 39 && pn < 43) run<3>(acc, pn, row0, cw, wc, fq, sc);
        else if (pn == 4 || pn == 5 || (pn >= 18 && pn < 26)) run<4>(acc, pn, row0, cw, wc, fq, sc);
        else if ((pn >= 10 && pn < 14) || (pn >= 26 && pn < 30) || (pn >= 35 && pn < 39) || (pn >= 43 && pn < 47)) run<5>(acc, pn, row0, cw, wc, fq, sc);
        else run<0>(acc, pn, row0, cw, wc, fq, sc);
    }
};
struct EpiGate {
    static constexpr int PERM = 2; static constexpr bool CARRY = false;
    unsigned char* G; float sc;
    __device__ __forceinline__ void operator()(f32x4 (&acc)[2][2][4][2], const pg8::Unit& u, int wr, int wc, int fr, int fq) const {
        asm volatile("" : "+v"(fr), "+v"(fq));
        unsigned char* base = G + ((((size_t)u.pm * 64 + u.pn) * 8 + (wr * 4 + wc)) * 8) * 1024 + (fq * 16 + fr) * 16;
#pragma unroll
        for (int ai = 0; ai < 2; ++ai)
#pragma unroll
            for (int m = 0; m < 4; ++m) { unsigned char* rowp = base + (ai * 4 + m) * 1024; u32x4 w;
#pragma unroll
                for (int bj = 0; bj < 2; ++bj) { const f32x4 v0 = acc[ai][bj][m][0] * sc, v1 = acc[ai][bj][m][1] * sc; int w0 = 0, w1 = 0;
                    w0 = __builtin_amdgcn_cvt_pk_fp8_f32(v0[0], v0[1], w0, false); w0 = __builtin_amdgcn_cvt_pk_fp8_f32(v0[2], v0[3], w0, true);
                    w1 = __builtin_amdgcn_cvt_pk_fp8_f32(v1[0], v1[1], w1, false); w1 = __builtin_amdgcn_cvt_pk_fp8_f32(v1[2], v1[3], w1, true);
                    if (bj == 0) { w.x = (unsigned)w0; w.y = (unsigned)w1; } else { w.z = (unsigned)w0; w.w = (unsigned)w1; } }
                *(u32x4*)rowp = w; }
    }
};
struct EpiNull {
    static constexpr int PERM = 1; static constexpr bool CARRY = false;
    float* D;
    __device__ __forceinline__ void operator()(f32x4 (&acc)[2][2][4][2], const pg8::Unit& u, int wr, int wc, int fr, int fq) const {
        f32x4 s = (f32x4){0.f, 0.f, 0.f, 0.f};
#pragma unroll
        for (int ai = 0; ai < 2; ++ai)
#pragma unroll
            for (int bj = 0; bj < 2; ++bj)
#pragma unroll
                for (int m = 0; m < 4; ++m)
#pragma unroll
                    for (int n = 0; n < 2; ++n) s += acc[ai][bj][m][n];
        *(f32x4*)(D + ((size_t)(u.pm * 64 + u.pn) * 512 + wr * 256 + wc * 64 + fq * 16 + fr) * 4) = s;
    }
};
struct EpiDq {
    static constexpr int PERM = 2; static constexpr bool CARRY = false;
    bf16_t* DQ; const float* RSS; const float* CS; float wsc;
    __device__ __forceinline__ void operator()(f32x4 (&acc)[2][2][4][2], const pg8::Unit& u, int wr, int wc, int fr, int fq) const {
        asm volatile("" : "+v"(fr), "+v"(fq));
        const int row0 = u.pm * 256 + wr * 64 + fr, col0 = u.pn * 256 + wc * 64 + 16 * fq;
#pragma unroll
        for (int ai = 0; ai < 2; ++ai)
#pragma unroll
            for (int m = 0; m < 4; ++m) { const int row = row0 + ai * 128 + m * 16;
                const f32x4 r0 = *(const f32x4*)(RSS + (size_t)row * 16), r1 = *(const f32x4*)(RSS + (size_t)row * 16 + 4), r2 = *(const f32x4*)(RSS + (size_t)row * 16 + 8);
                const float ss = ((r0[0] + r0[1]) + (r0[2] + r0[3])) + ((r1[0] + r1[1]) + (r1[2] + r1[3])) + ((r2[0] + r2[1]) + (r2[2] + r2[3]));
                const float rs = __builtin_amdgcn_rsqf(ss * (1.0f / 768.0f) + RMS_EPS) * wsc;
                bf16_t* rowp = DQ + (size_t)row * 1536 + col0;
#pragma unroll
                for (int bj = 0; bj < 2; ++bj) { f32x4 v[2];
#pragma unroll
                    for (int n = 0; n < 2; ++n) { v[n] = acc[ai][bj][m][n] * rs; const int c = col0 + bj * 8 + 4 * n, w = c % 192;
                        if (w >= 128) { const f32x4 cs = *(const f32x4*)(CS + (size_t)row * 64 + (w - 128));
                            const f32x4 t = v[n]; v[n][0] = t[0] * cs[0] - t[1] * cs[1]; v[n][1] = t[0] * cs[1] + t[1] * cs[0]; v[n][2] = t[2] * cs[2] - t[3] * cs[3]; v[n][3] = t[2] * cs[3] + t[3] * cs[2]; } }
                    u32x4 w4; w4.x = cvt_pk_bf16(v[0][0], v[0][1]); w4.y = cvt_pk_bf16(v[0][2], v[0][3]); w4.z = cvt_pk_bf16(v[1][0], v[1][1]); w4.w = cvt_pk_bf16(v[1][2], v[1][3]);
                    *(u32x4*)(rowp + bj * 8) = w4; }
                asm volatile("" ::: "memory"); }
    }
};
struct EpiDkv {
    static constexpr int PERM = 2; static constexpr bool CARRY = false;
    unsigned char* D8; const float* RSS; float wsc;
    __device__ __forceinline__ void operator()(f32x4 (&acc)[2][2][4][2], const pg8::Unit& u, int wr, int wc, int fr, int fq) const {
        asm volatile("" : "+v"(fr), "+v"(fq));
        const int row0 = u.pm * 256 + wr * 64 + fr, col0 = u.pn * 256 + wc * 64 + 16 * fq;
        f32x4 r3v[2][4];
#pragma unroll
        for (int ai = 0; ai < 2; ++ai)
#pragma unroll
            for (int m = 0; m < 4; ++m) r3v[ai][m] = *(const f32x4*)(RSS + (size_t)(row0 + ai * 128 + m * 16) * 16 + 12);
#pragma unroll
        for (int ai = 0; ai < 2; ++ai)
#pragma unroll
            for (int m = 0; m < 4; ++m) { const int row = row0 + ai * 128 + m * 16;
                const f32x4 r3 = r3v[ai][m];
                const float rs = __builtin_amdgcn_rsqf(((r3[0] + r3[1]) + (r3[2] + r3[3])) * (1.0f / 256.0f) + RMS_EPS) * wsc;
                u32x4 w4;
#pragma unroll
                for (int bj = 0; bj < 2; ++bj) { const f32x4 v0 = acc[ai][bj][m][0] * rs, v1 = acc[ai][bj][m][1] * rs; int w0 = 0, w1 = 0;
                    w0 = __builtin_amdgcn_cvt_pk_fp8_f32(v0[0], v0[1], w0, false); w0 = __builtin_amdgcn_cvt_pk_fp8_f32(v0[2], v0[3], w0, true);
                    w1 = __builtin_amdgcn_cvt_pk_fp8_f32(v1[0], v1[1], w1, false); w1 = __builtin_amdgcn_cvt_pk_fp8_f32(v1[2], v1[3], w1, true);
                    if (bj == 0) { w4.x = (unsigned)w0; w4.y = (unsigned)w1; } else { w4.z = (unsigned)w0; w4.w = (unsigned)w1; } }
                *(u32x4*)(D8 + (size_t)row * D8W + col0) = w4;
                asm volatile("" ::: "memory"); }
    }
};
struct EpiMerge {
    static constexpr int PERM = 2; static constexpr bool CARRY = true;
    const unsigned char* G; unsigned char* MRG;
    __device__ __forceinline__ void operator()(f32x4 (&acc)[2][2][4][2], const pg8::Unit& u, int wr, int wc, int fr, int fq) const {
        asm volatile("" : "+v"(fr), "+v"(fq));
        const int row0 = u.pm * 256 + wr * 64 + fr, col0 = u.pn * 256 + wc * 64 + 16 * fq, z = u.z;
        const float fin = 0.001953125f * 16.0f;
        u32x4 ga[2][4], gb[2][4];
        const unsigned char* gta = G + ((((size_t)u.pm * 64 + z * 16 + u.pn) * 8 + (wr * 4 + wc)) * 8) * 1024 + (fq * 16 + fr) * 16;
        const unsigned char* gtb = gta + (z < 3 ? (size_t)16 * 8 * 8 * 1024 : 0);
#define MG_LOAD(ai_, m_) do { ga[ai_][m_] = *(const u32x4*)(gta + ((ai_) * 4 + (m_)) * 1024); \
            gb[ai_][m_] = *(const u32x4*)(gtb + ((ai_) * 4 + (m_)) * 1024); } while (0)
#pragma unroll
        for (int m = 0; m < 4; ++m) MG_LOAD(0, m);
#pragma unroll
        for (int ai = 0; ai < 2; ++ai) {
#pragma unroll
            for (int m = 0; m < 4; ++m) { const size_t row = (size_t)(row0 + ai * 128 + m * 16); u32x4 wo;
                if (ai == 0) MG_LOAD(1, m);
#pragma unroll
                for (int bj = 0; bj < 2; ++bj) { const unsigned ax = bj ? ga[ai][m].z : ga[ai][m].x, ay = bj ? ga[ai][m].w : ga[ai][m].y, bx = bj ? gb[ai][m].z : gb[ai][m].x, by = bj ? gb[ai][m].w : gb[ai][m].y;
                    float fa[8], fb[8];
                    { const f32x2 t0 = __builtin_amdgcn_cvt_pk_f32_fp8((int)ax, false), t1 = __builtin_amdgcn_cvt_pk_f32_fp8((int)ax, true), t2 = __builtin_amdgcn_cvt_pk_f32_fp8((int)ay, false), t3 = __builtin_amdgcn_cvt_pk_f32_fp8((int)ay, true);
                      fa[0] = t0[0]; fa[1] = t0[1]; fa[2] = t1[0]; fa[3] = t1[1]; fa[4] = t2[0]; fa[5] = t2[1]; fa[6] = t3[0]; fa[7] = t3[1]; }
                    { const f32x2 t0 = __builtin_amdgcn_cvt_pk_f32_fp8((int)bx, false), t1 = __builtin_amdgcn_cvt_pk_f32_fp8((int)bx, true), t2 = __builtin_amdgcn_cvt_pk_f32_fp8((int)by, false), t3 = __builtin_amdgcn_cvt_pk_f32_fp8((int)by, true);
                      fb[0] = t0[0]; fb[1] = t0[1]; fb[2] = t1[0]; fb[3] = t1[1]; fb[4] = t2[0]; fb[5] = t2[1]; fb[6] = t3[0]; fb[7] = t3[1]; }
                    float f[8];
#pragma unroll
                    for (int e = 0; e < 8; ++e) { const float ra = __builtin_amdgcn_rcpf(1.0f + __builtin_amdgcn_exp2f(fa[e]));
                        f[e] = (z < 3) ? ra * (1.0f + __builtin_amdgcn_exp2f(fb[e])) : ra * fin; }
                    f32x4 v0 = acc[ai][bj][m][0], v1 = acc[ai][bj][m][1];
                    v0[0] *= f[0]; v0[1] *= f[1]; v0[2] *= f[2]; v0[3] *= f[3]; v1[0] *= f[4]; v1[1] *= f[5]; v1[2] *= f[6]; v1[3] *= f[7];
                    if (z < 3) { acc[ai][bj][m][0] = v0; acc[ai][bj][m][1] = v1; }
                    else { int w0 = 0, w1 = 0;
                        w0 = __builtin_amdgcn_cvt_pk_fp8_f32(v0[0], v0[1], w0, false); w0 = __builtin_amdgcn_cvt_pk_fp8_f32(v0[2], v0[3], w0, true);
                        w1 = __builtin_amdgcn_cvt_pk_fp8_f32(v1[0], v1[1], w1, false); w1 = __builtin_amdgcn_cvt_pk_fp8_f32(v1[2], v1[3], w1, true);
                        if (bj == 0) { wo.x = (unsigned)w0; wo.y = (unsigned)w1; } else { wo.z = (unsigned)w0; wo.w = (unsigned)w1; } } }
                if (z == 3) *(u32x4*)(MRG + row * DM + col0) = wo; }
            asm volatile("" ::: "memory"); }
#undef MG_LOAD
    }
};
struct EpiOut {
    static constexpr int PERM = 2; static constexpr bool CARRY = false;
    const bf16_t* XBr; bf16_t* R;
    __device__ __forceinline__ void operator()(f32x4 (&acc)[2][2][4][2], const pg8::Unit& u, int wr, int wc, int fr, int fq) const {
        asm volatile("" : "+v"(fr), "+v"(fq));
        const int row0 = u.pm * 256 + wr * 64 + fr, col0 = u.pn * 256 + wc * 64 + 16 * fq;
        u32x4 xw[2][4][2];
#pragma unroll
        for (int ai = 0; ai < 2; ++ai)
#pragma unroll
            for (int m = 0; m < 4; ++m) { const size_t off = (size_t)(row0 + ai * 128 + m * 16) * DM + col0;
#pragma unroll
                for (int bj = 0; bj < 2; ++bj) xw[ai][m][bj] = *(const u32x4*)(XBr + off + bj * 8); }
#pragma unroll
        for (int ai = 0; ai < 2; ++ai) {
#pragma unroll
            for (int m = 0; m < 4; ++m) { const size_t off = (size_t)(row0 + ai * 128 + m * 16) * DM + col0;
#pragma unroll
                for (int bj = 0; bj < 2; ++bj) { const u32x4 w = xw[ai][m][bj];
                    const f32x4 x0 = (f32x4){__uint_as_float(w.x << 16), __uint_as_float(w.x & 0xffff0000u), __uint_as_float(w.y << 16), __uint_as_float(w.y & 0xffff0000u)};
                    const f32x4 x1 = (f32x4){__uint_as_float(w.z << 16), __uint_as_float(w.z & 0xffff0000u), __uint_as_float(w.w << 16), __uint_as_float(w.w & 0xffff0000u)};
                    const f32x4 r0 = x0 * DN_ALPHA + acc[ai][bj][m][0] * 0.00048828125f, r1 = x1 * DN_ALPHA + acc[ai][bj][m][1] * 0.00048828125f;
                    u32x4 w4; w4.x = cvt_pk_bf16(r0[0], r0[1]); w4.y = cvt_pk_bf16(r0[2], r0[3]); w4.z = cvt_pk_bf16(r1[0], r1[1]); w4.w = cvt_pk_bf16(r1[2], r1[3]);
                    *(u32x4*)(R + off + bj * 8) = w4; } }
            asm volatile("" ::: "memory"); }
    }
};

__device__ __forceinline__ void ln_phase(const bf16_t* R, const float* gain, const float* bias, float* OUTF, bf16_t* XB, unsigned char* X8, unsigned char* X4) {
    const int tid_ = ptid(), lane = tid_ & 63, wave = tid_ >> 6;
    const int gw = blockIdx.x * NWAVES + wave, NGW = gridDim.x * NWAVES;
    for (int row = gw; row < MTOK; row += NGW) {
        const u32x4* rp = (const u32x4*)(R + (size_t)row * DM) + lane;
        float v[8][8]; float s = 0.f;
#pragma unroll
        for (int j = 0; j < 8; ++j) { const u32x4 w = rp[64 * j];
            v[j][0] = __uint_as_float(w.x << 16); v[j][1] = __uint_as_float(w.x & 0xffff0000u); v[j][2] = __uint_as_float(w.y << 16); v[j][3] = __uint_as_float(w.y & 0xffff0000u);
            v[j][4] = __uint_as_float(w.z << 16); v[j][5] = __uint_as_float(w.z & 0xffff0000u); v[j][6] = __uint_as_float(w.w << 16); v[j][7] = __uint_as_float(w.w & 0xffff0000u);
#pragma unroll
            for (int e = 0; e < 8; ++e) s += v[j][e]; }
        const float mean = wave_sum(s) * (1.0f / DM); float q = 0.f;
#pragma unroll
        for (int j = 0; j < 8; ++j)
#pragma unroll
            for (int e = 0; e < 8; ++e) { v[j][e] -= mean; q += v[j][e] * v[j][e]; }
        const float rstd = __builtin_amdgcn_rsqf(wave_sum(q) * (1.0f / DM) + LN_EPS);
#pragma unroll
        for (int j = 0; j < 8; ++j) { const int c8 = (lane + 64 * j) * 8;
            const f32x4 g0 = *(const f32x4*)(gain + c8), g1 = *(const f32x4*)(gain + c8 + 4), b0 = *(const f32x4*)(bias + c8), b1 = *(const f32x4*)(bias + c8 + 4);
            const f32x4 o0 = (f32x4){v[j][0], v[j][1], v[j][2], v[j][3]} * rstd * g0 + b0, o1 = (f32x4){v[j][4], v[j][5], v[j][6], v[j][7]} * rstd * g1 + b1;
            if (OUTF) { *(f32x4*)(OUTF + (size_t)row * DM + c8) = o0; *(f32x4*)(OUTF + (size_t)row * DM + c8 + 4) = o1; }
            if (XB) { u32x4 w; w.x = cvt_pk_bf16(o0[0], o0[1]); w.y = cvt_pk_bf16(o0[2], o0[3]); w.z = cvt_pk_bf16(o1[0], o1[1]); w.w = cvt_pk_bf16(o1[2], o1[3]); *(u32x4*)(XB + (size_t)row * DM + c8) = w;
                int w0 = 0, w1 = 0; w0 = __builtin_amdgcn_cvt_pk_fp8_f32(o0[0], o0[1], w0, false); w0 = __builtin_amdgcn_cvt_pk_fp8_f32(o0[2], o0[3], w0, true);
                w1 = __builtin_amdgcn_cvt_pk_fp8_f32(o1[0], o1[1], w1, false); w1 = __builtin_amdgcn_cvt_pk_fp8_f32(o1[2], o1[3], w1, true);
                *(u32x2*)(X8 + (size_t)row * DM + c8) = (u32x2){(unsigned)w0, (unsigned)w1};
                *(unsigned*)(X4 + (((size_t)row * DM + c8) >> 1)) = pack_fp4x8(o0[0] * FP4_XS, o0[1] * FP4_XS, o0[2] * FP4_XS, o0[3] * FP4_XS, o1[0] * FP4_XS, o1[1] * FP4_XS, o1[2] * FP4_XS, o1[3] * FP4_XS); } }
    }
}
__device__ __forceinline__ void cumsum_phase(const float* SM, const float* f_bias, float* CUM) {
    if ((int)blockIdx.x < (int)gridDim.x - BATCH) return;
    const int tid_ = ptid(), b = (int)blockIdx.x - ((int)gridDim.x - BATCH), h = tid_ >> 6, lane = tid_ & 63;
    const float fb = f_bias[h];
    const float* src = SM + ((size_t)b * SEQ + lane * 64) * 256 + SMC_BF + h;
    float run = 0.f; float vals[64];
#pragma unroll
    for (int j = 0; j < 64; ++j) { const float xv = src[(size_t)j * 256] + fb; const float ls = fminf(xv, 0.f) - log1pf(__expf(-fabsf(xv))); run += ls; vals[j] = run; }
    float incl = run;
#pragma unroll
    for (int o = 1; o < 64; o <<= 1) { const float t = __shfl_up(incl, o); if (lane >= o) incl += t; }
    const float offs = incl - run;
    float* dst = CUM + ((size_t)b * 8 + h) * SEQ + lane * 64;
#pragma unroll
    for (int j = 0; j < 64; j += 4) *(f32x4*)(dst + j) = (f32x4){(vals[j] + offs) * LOG2E, (vals[j + 1] + offs) * LOG2E, (vals[j + 2] + offs) * LOG2E, (vals[j + 3] + offs) * LOG2E};
}
__device__ __forceinline__ void krope_phase(const float* SM, const float* CS, unsigned char* D8) {
    const size_t gt = (size_t)blockIdx.x * NTHREADS + ptid(), GT = (size_t)gridDim.x * NTHREADS;
    for (size_t i = gt; i < (size_t)MTOK * 32; i += GT) {
        const size_t row = i >> 5; const int p = (int)(i & 31);
        const f32x2 t = *(const f32x2*)(SM + row * 256 + SMC_DKR + 2 * p), cs = *(const f32x2*)(CS + row * 64 + 2 * p);
        { int w = 0; w = __builtin_amdgcn_cvt_pk_fp8_f32(t[0] * cs[0] - t[1] * cs[1], t[0] * cs[1] + t[1] * cs[0], w, false); *(unsigned short*)(D8 + row * D8W + 2048 + 2 * p) = (unsigned short)w; }
    }
}

__device__ __forceinline__ int wave_count7(unsigned c) { int t = 0;
#pragma unroll
    for (int b = 0; b < 7; ++b) t += __builtin_popcountll(__ballot((c >> b) & 1u)) << b;
    return t; }
__device__ __forceinline__ unsigned f2ord(float f) { const unsigned u = __float_as_uint(f); return u ^ ((u >> 31) ? 0xffffffffu : 0x80000000u); }
template <int DBG = 0>
__device__ __forceinline__ void indexer_unit(LAS unsigned char* lds, const bf16_t* P, const float* SM, float* SC, unsigned long long* MASK, int b, int qb) {
    constexpr int QSTR = 2064 + 256;
    constexpr int L_IQ = 0, L_STG = 32 * QSTR;
    const int tid = ptid(), wid = __builtin_amdgcn_readfirstlane(tid >> 6), lane = tid & 63, r32 = lane & 31, hi = lane >> 5;
    const int t0 = qb * 32; const size_t row0 = (size_t)b * SEQ + t0;
#pragma unroll
    for (int i = 0; i < 8; ++i) { const int ci = tid + 512 * i, r = ci >> 7, cc = ci & 127;
        const bf16x8 v = *(const bf16x8*)(P + (row0 + r) * INP + PC_AIQ + cc * 8);
        *(LAS bf16x8*)(lds + L_IQ + r * QSTR + cc * 16) = v; }
    float w[16];
    { const float* wp = SM + (row0 + r32) * 256 + SMC_AIW;
#pragma unroll
      for (int j = 0; j < 4; ++j) { const f32x4 v = *(const f32x4*)(wp + 4 * j); w[4 * j] = v[0] * 0.03125f; w[4 * j + 1] = v[1] * 0.03125f; w[4 * j + 2] = v[2] * 0.03125f; w[4 * j + 3] = v[3] * 0.03125f; } }
    __syncthreads();
    { const int r = tid >> 4, d0 = (tid & 15) * 4;
      const float* wp = SM + (row0 + r) * 256 + SMC_AIW; float qb4[4] = {0.f, 0.f, 0.f, 0.f};
#pragma unroll
      for (int h = 0; h < 16; ++h) { const float wh = wp[h] * 0.03125f; const u32x2 q2 = *(const LAS u32x2*)(lds + L_IQ + r * QSTR + (h * 64 + d0) * 2);
          qb4[0] = fmaf(wh, __uint_as_float(q2.x << 16), qb4[0]); qb4[1] = fmaf(wh, __uint_as_float(q2.x & 0xffff0000u), qb4[1]);
          qb4[2] = fmaf(wh, __uint_as_float(q2.y << 16), qb4[2]); qb4[3] = fmaf(wh, __uint_as_float(q2.y & 0xffff0000u), qb4[3]); }
      u32x2 hi2, lo2; hi2.x = cvt_pk_bf16(qb4[0], qb4[1]); hi2.y = cvt_pk_bf16(qb4[2], qb4[3]);
      lo2.x = cvt_pk_bf16(qb4[0] - __uint_as_float(hi2.x << 16), qb4[1] - __uint_as_float(hi2.x & 0xffff0000u)); lo2.y = cvt_pk_bf16(qb4[2] - __uint_as_float(hi2.y << 16), qb4[3] - __uint_as_float(hi2.y & 0xffff0000u));
      *(LAS u32x2*)(lds + L_IQ + r * QSTR + (1024 + d0) * 2) = hi2; *(LAS u32x2*)(lds + L_IQ + r * QSTR + (1088 + d0) * 2) = lo2; }
    __syncthreads();
    LAS float* stg = (LAS float*)(lds + L_STG + wid * 4608);
    const int nkt = qb + 1;
    bf16x8 kfn[4];
    if (wid < nkt) { const bf16_t* kp = P + ((size_t)b * SEQ + wid * 32 + r32) * INP + PC_AIK + 8 * hi;
#pragma unroll
      for (int st = 0; st < 4; ++st) kfn[st] = *(const bf16x8*)(kp + 16 * st); }
    for (int kt = wid; kt < (DBG == 2 ? 0 : nkt); kt += NWAVES) {
        const int s0 = kt * 32;
        int qoff = L_IQ + r32 * QSTR + hi * 16; asm volatile("" : "+v"(qoff));
        bf16x8 kf[4];
#pragma unroll
        for (int st = 0; st < 4; ++st) kf[st] = kfn[st];
        if (kt + NWAVES < nkt) { const bf16_t* kp = P + ((size_t)b * SEQ + s0 + NWAVES * 32 + r32) * INP + PC_AIK + 8 * hi;
#pragma unroll
          for (int st = 0; st < 4; ++st) kfn[st] = *(const bf16x8*)(kp + 16 * st); }
        f32x16 sc;
#pragma unroll
        for (int r = 0; r < 16; ++r) sc[r] = 0.f;
#pragma unroll
        for (int st = 0; st < 8; ++st) { const bf16x8 qf = *(const LAS bf16x8*)(lds + qoff + (1024 + 16 * st) * 2);
            sc = __builtin_amdgcn_mfma_f32_32x32x16_bf16(kf[st & 3], qf, sc, 0, 0, 0); }
        f32x16 accA, accB;
#define IDX_MM(dst, h_) do { _Pragma("unroll") for (int r = 0; r < 16; ++r) dst[r] = 0.f; \
            _Pragma("unroll") for (int st = 0; st < 4; ++st) { const bf16x8 qf = *(const LAS bf16x8*)(lds + qoff + ((h_) * 64 + 16 * st) * 2); dst = __builtin_amdgcn_mfma_f32_32x32x16_bf16(kf[st], qf, dst, 0, 0, 0); } } while (0)
#define IDX_FMA(src, h_) do { asm volatile("s_nop 15" ::: ); \
            _Pragma("unroll") for (int r = 0; r < 16; ++r) asm volatile("v_fma_f32 %0, %1, |%2|, %0" : "+v"(sc[r]) : "v"(w[h_]), "v"(src[r])); } while (0)
        IDX_MM(accA, 0);
#pragma unroll
        for (int h = 0; h < 16; h += 2) {
            IDX_MM(accB, h + 1);
            __builtin_amdgcn_sched_barrier(0);
            IDX_FMA(accA, h);
            __builtin_amdgcn_sched_barrier(0);
            if (h + 2 < 16) IDX_MM(accA, h + 2);
            __builtin_amdgcn_sched_barrier(0);
            if (h + 2 >= 16) asm volatile("s_nop 15" ::: );
            IDX_FMA(accB, h + 1);
            __builtin_amdgcn_sched_barrier(0);
        }
#undef IDX_MM
#undef IDX_FMA
#pragma unroll
        for (int g = 0; g < 4; ++g) *(LAS f32x4*)(stg + r32 * 36 + 8 * g + 4 * hi) = (f32x4){sc[4 * g], sc[4 * g + 1], sc[4 * g + 2], sc[4 * g + 3]};
        LDS_WAIT();
#pragma unroll
        for (int i = 0; i < 16; ++i) { const float v = stg[(2 * i + hi) * 36 + r32]; SC[(row0 + 2 * i + hi) * SEQ + s0 + r32] = v; }
        LDS_WAIT();
    }
    VM_WAIT();
    __syncthreads();
#define IDX_LOADROW(dst, qi_) do { int ln_ = lane; asm volatile("" : "+v"(ln_)); const float* sr_ = SC + (row0 + wid * 4 + (qi_)) * SEQ + ln_; \
        _Pragma("unroll") for (int j = 0; j < 64; ++j) dst[j] = __float_as_uint(sr_[64 * j]); } while (0)
    auto process = [&](unsigned (&key)[64], const int qi) __attribute__((always_inline)) {
        const int t = t0 + wid * 4 + qi, n = t + 1;
        int ln = lane; asm volatile("" : "+v"(ln));
#pragma unroll
        for (int j = 0; j < 64; ++j) asm volatile("" : "+v"(key[j]));
#pragma unroll
        for (int j = 0; j < 64; ++j) key[j] = (ln < n - 64 * j) ? f2ord(__uint_as_float(key[j])) : 0u;
        unsigned T = 0u; int need = 0;
        const int ng = (n + 511) >> 9;
        if (n > 256) {
            bool exact = false;
#pragma unroll 1
            for (int bit = 31; bit >= 0; --bit) {
                const unsigned cand = T | (1u << bit); int cnt = 0;
#pragma unroll
                for (int g = 0; g < 8; ++g) { if (g < ng) {
#pragma unroll
                    for (int jj = 0; jj < 8; ++jj) cnt += __builtin_popcountll(__ballot(key[8 * g + jj] >= cand)); }
                    __builtin_amdgcn_sched_barrier(0); }
                if (cnt == 256) { T = cand - 1u; exact = true; break; }
                if (cnt > 256) T = cand;
            }
            if (!exact) {
                int cgt = 0;
#pragma unroll
                for (int g = 0; g < 8; ++g) { if (g < ng) {
#pragma unroll
                    for (int jj = 0; jj < 8; ++jj) cgt += __builtin_popcountll(__ballot(key[8 * g + jj] > T)); }
                    __builtin_amdgcn_sched_barrier(0); }
                need = 256 - cgt;
            }
        }
        int mwlo = 0, mwhi = 0, run = 0; int ln2 = ln; asm volatile("" : "+v"(ln2));
#pragma unroll
        for (int g = 0; g < 8; ++g) { if (g < ng) {
#pragma unroll
            for (int jj = 0; jj < 8; ++jj) { const int j = 8 * g + jj;
                const bool eq = key[j] == T;
                const unsigned long long eqm = __ballot(eq);
                const int rank = run + (int)__builtin_amdgcn_mbcnt_hi((unsigned)(eqm >> 32), __builtin_amdgcn_mbcnt_lo((unsigned)eqm, 0u));
                const unsigned long long sel = __ballot(key[j] > T || (eq && rank < need));
                run += __builtin_popcountll(eqm);
                mwlo = (ln2 == j) ? (int)(unsigned)sel : mwlo; mwhi = (ln2 == j) ? (int)(unsigned)(sel >> 32) : mwhi;
                __builtin_amdgcn_sched_barrier(0); } }
        }
        MASK[(row0 + wid * 4 + qi) * 64 + lane] = ((unsigned long long)(unsigned)mwhi << 32) | (unsigned)mwlo;
    };
    if (DBG != 1) {
        unsigned ka[64], kb[64];
        IDX_LOADROW(ka, 0);
#pragma unroll 1
        for (int pr = 0; pr < 2; ++pr) {
            IDX_LOADROW(kb, 2 * pr + 1);
            process(ka, 2 * pr);
            if (pr == 0) IDX_LOADROW(ka, 2);
            process(kb, 2 * pr + 1);
        }
    }
#undef IDX_LOADROW
    __syncthreads();
}
template <int DBG = 0>
__device__ __forceinline__ void indexer_phase(LAS unsigned char* lds, const Args& a) {
    const bf16_t* P = (const bf16_t*)(a.ws + WS_P); const float* SM = (const float*)(a.ws + WS_SM); float* SC = (float*)(a.ws + WS_SC); unsigned long long* MASK = (unsigned long long*)(a.ws + WS_MASK);
    for (int p = blockIdx.x; p < 256; p += gridDim.x) { const int b = p >> 6, q = p & 63;
#pragma unroll 1
        for (int k = 0; k < 2; ++k) indexer_unit<DBG>(lds, P, SM, SC, MASK, b, k == 0 ? 127 - q : q); }
}

template <int OFF> __device__ __forceinline__ s16x4 tr_read(int vb) { s16x4 r; asm volatile("ds_read_b64_tr_b16 %0, %1 offset:%2" : "=&v"(r) : "v"(vb), "i"(OFF) : "memory"); return r; }
using pg8::v8i_t; using pg8::cat8;
__device__ __forceinline__ u32x2 bf8_to_fp8(bf16x8 v) { const u32x4 w = __builtin_bit_cast(u32x4, v); int a = 0, b = 0;
    a = __builtin_amdgcn_cvt_pk_fp8_f32(__uint_as_float(w.x << 16), __uint_as_float(w.x & 0xffff0000u), a, false); a = __builtin_amdgcn_cvt_pk_fp8_f32(__uint_as_float(w.y << 16), __uint_as_float(w.y & 0xffff0000u), a, true);
    b = __builtin_amdgcn_cvt_pk_fp8_f32(__uint_as_float(w.z << 16), __uint_as_float(w.z & 0xffff0000u), b, false); b = __builtin_amdgcn_cvt_pk_fp8_f32(__uint_as_float(w.w << 16), __uint_as_float(w.w & 0xffff0000u), b, true);
    return (u32x2){(unsigned)a, (unsigned)b}; }
#ifndef ATT_PV8_MASK
#define ATT_PV8_MASK 0xB
#endif
#ifndef ATT_Q8_MASK
#define ATT_Q8_MASK 0xF
#endif
template <int VAR, int DBG = 0>
__device__ __forceinline__ void attn_unit(LAS unsigned char* lds, const Args& a, int layer, int b, int hidx, int qblk, unsigned* qh, volatile LAS unsigned* bw) {
    constexpr int DQK = (VAR == 2) ? 64 : (VAR == 3 ? 192 : 128), DV = (VAR == 2) ? 64 : 128;
    constexpr bool Q8 = ((ATT_Q8_MASK >> VAR) & 1) != 0;
    constexpr bool PV8 = Q8 && ((ATT_PV8_MASK >> VAR) & 1) != 0 && DV == 128;
    constexpr bool KV8S = PV8 && VAR != 2;
    constexpr int KSTR = Q8 ? DQK + 16 : DQK * 2 + 16, VSTR = PV8 ? DV + 32 : DV * 2 + 64;
    constexpr int KCH = DQK / 8, VCH = DV / 8, KPT = DQK / 64, VPT = DV / 64, NST = DQK / 16, ND0 = DV / 32;
    constexpr int LK = 0, LV = 2 * 64 * KSTR, LCK = LV + 2 * 64 * VSTR;
    constexpr float THR = 8.0f;
    const int tid = ptid(), wid = __builtin_amdgcn_readfirstlane(tid >> 6), lane = tid & 63, r32 = lane & 31, hi = lane >> 5;
    const bf16_t* P = (const bf16_t*)(a.ws + WS_P);
    int head, q0u, tq0w, kt_lo, kt_hi, kt_last_w;
    if constexpr (VAR == 0) { head = hidx * 4 + (wid >> 1); q0u = qblk * 64; tq0w = q0u + 32 * (wid & 1); kt_lo = 0; kt_hi = qblk; kt_last_w = qblk; }
    else if constexpr (VAR == 2) { head = hidx * 8 + wid; q0u = qblk * 32; tq0w = q0u; kt_lo = (q0u > 127 ? q0u - 127 : 0) >> 6; kt_hi = (q0u + 31) >> 6; kt_last_w = kt_hi; }
    else { head = hidx; q0u = qblk * 256; tq0w = q0u + 32 * wid; kt_lo = 0; kt_hi = 4 * qblk + 3; kt_last_w = 4 * qblk + (wid >> 1); }
    const int tq = tq0w + r32; const size_t rowq = (size_t)b * SEQ + tq;
    const bf16_t* qp;
    if constexpr (VAR == 0) qp = P + rowq * INP + PC_AQ + head * 128;
    else if constexpr (VAR == 1) qp = P + rowq * INP + PC_BQ + head * 128;
    else if constexpr (VAR == 2) qp = P + rowq * INP + PC_CQ + head * 64;
    else qp = (const bf16_t*)(a.ws + WS_DQ) + rowq * 1536 + head * 192;
    bf16x8 qf[Q8 ? 1 : NST]; v8i_t q8[Q8 ? NST / 4 : 1];
    if constexpr (Q8) {
#pragma unroll
        for (int s4 = 0; s4 < NST / 4; ++s4) { const bf16_t* q4 = qp + 64 * s4 + 32 * hi;
            const u32x2 c0 = bf8_to_fp8(*(const bf16x8*)(q4)), c1 = bf8_to_fp8(*(const bf16x8*)(q4 + 8)), c2 = bf8_to_fp8(*(const bf16x8*)(q4 + 16)), c3 = bf8_to_fp8(*(const bf16x8*)(q4 + 24));
            q8[s4] = (v8i_t){(int)c0.x, (int)c0.y, (int)c1.x, (int)c1.y, (int)c2.x, (int)c2.y, (int)c3.x, (int)c3.y}; }
    } else {
#pragma unroll
        for (int st = 0; st < NST; ++st) qf[st] = *(const bf16x8*)(qp + 16 * st + 8 * hi); }
    const bf16_t *kb, *vb_, *kb2 = nullptr; int ldk;
    if constexpr (VAR == 0) { kb = P + PC_AK + hidx * 128; vb_ = P + PC_AV + hidx * 128; ldk = INP; }
    else if constexpr (VAR == 1) { kb = P + PC_BK + head * 128; vb_ = P + PC_BV + head * 128; ldk = INP; }
    else if constexpr (VAR == 2) { kb = P + PC_CK + hidx * 64; vb_ = P + PC_CV + hidx * 64; ldk = INP; }
    else { kb = (const bf16_t*)(a.ws + WS_DKV) + head * 256; vb_ = kb + 128; kb2 = (const bf16_t*)(a.ws + WS_DKR); ldk = 2048; }
    const size_t brow = (size_t)b * SEQ;
    unsigned gk[KPT], lk[KPT], gv[VPT], lv[VPT]; bool krope[KPT];
#pragma unroll
    for (int i = 0; i < KPT; ++i) { const int ci = tid + 512 * i, kr = ci / KCH, kc = ci % KCH; krope[i] = (VAR == 3) && kc >= 16;
        gk[i] = krope[i] ? (unsigned)(kr * 64 + (kc - 16) * 8) * 2u : (unsigned)(kr * ldk + kc * 8) * 2u; lk[i] = (unsigned)(LK + kr * KSTR + kc * (Q8 ? 8 : 16)); }
#pragma unroll
    for (int i = 0; i < VPT; ++i) { const int ci = tid + 512 * i, vr = ci / VCH, vc = ci % VCH; gv[i] = (unsigned)(vr * ldk + vc * 8) * 2u; const int vrp = PV8 ? ((vr & ~15) | (vr & 3) | ((vr & 8) >> 1) | ((vr & 4) << 1)) : vr; lv[i] = (unsigned)(LV + vrp * VSTR + vc * (PV8 ? 8 : 16)); }
    const int r8_ = tid >> 3, c8_ = tid & 7, r8p_ = (r8_ & ~15) | (r8_ & 3) | ((r8_ & 8) >> 1) | ((r8_ & 4) << 1);
    constexpr int W8 = (VAR == 3) ? D8W : KV8W, VOFF8 = (VAR == 0) ? 256 : (VAR == 1 ? 1024 : 128);
    const unsigned char* kv8p = a.ws + (VAR == 3 ? WS_D8 : WS_KV8) + (VAR == 0 ? hidx * 128 : (VAR == 1 ? 512 + head * 128 : head * 256)) + (size_t)r8_ * W8 + c8_ * 16;
    const unsigned char* kr8p = a.ws + WS_D8 + 2048 + (size_t)(tid >> 2) * D8W + (tid & 3) * 16; const unsigned lkr8 = (unsigned)(LK + (tid >> 2) * KSTR + 128 + (tid & 3) * 16); u32x4 kr8 = (u32x4){0u, 0u, 0u, 0u};
    const unsigned lk8 = (unsigned)(LK + r8_ * KSTR + c8_ * 16), lv8 = (unsigned)(LV + r8p_ * VSTR + c8_ * 16); u32x4 ks8 = (u32x4){0u, 0u, 0u, 0u}, vs8 = (u32x4){0u, 0u, 0u, 0u};
    bf16x8 ks[1][KPT], vs[1][VPT]; float ckv[1] = {0.f}; unsigned long long mnx[1] = {0ull};
    const float* cum = (const float*)(a.ws + WS_CUM) + ((size_t)b * 8 + head) * SEQ;
    float cref = 0.f; if constexpr (VAR == 1) cref = cum[q0u];
    const unsigned long long* mrow = (const unsigned long long*)(a.ws + WS_MASK) + rowq * 64;
#define AT_ISSUE(kt_, S_) do { const int k0_ = (kt_) * 64; \
        const char* kt_base_ = (const char*)(kb + (brow + k0_) * ldk); const char* vt_base_ = (const char*)(vb_ + (brow + k0_) * ldk); \
        const char* k2_base_ = (VAR == 3) ? (const char*)(kb2 + (brow + k0_) * 64) : kt_base_; \
        if constexpr (KV8S) { ks8 = *(const u32x4*)(kv8p + (brow + k0_) * W8); vs8 = *(const u32x4*)(kv8p + (brow + k0_) * W8 + VOFF8); \
            if (VAR == 3 && tid < 256) kr8 = *(const u32x4*)(kr8p + (brow + k0_) * D8W); } \
        else { _Pragma("unroll") for (int i = 0; i < KPT; ++i) ks[S_][i] = *(const bf16x8*)((krope[i] ? k2_base_ : kt_base_) + gk[i]); \
               _Pragma("unroll") for (int i = 0; i < VPT; ++i) vs[S_][i] = *(const bf16x8*)(vt_base_ + gv[i]); } \
        if (VAR == 1 && tid < 64) ckv[S_] = cum[k0_ + tid]; \
        if (VAR == 0) mnx[S_] = mrow[(kt_)]; } while (0)
#define AT_WRITE(buf_, S_) do { \
        if constexpr (KV8S) { *(LAS u32x4*)(lds + (buf_) * 64 * KSTR + lk8) = ks8; *(LAS u32x4*)(lds + (buf_) * 64 * VSTR + lv8) = vs8; \
            if (VAR == 3 && tid < 256) *(LAS u32x4*)(lds + (buf_) * 64 * KSTR + lkr8) = kr8; } else { \
        _Pragma("unroll") for (int i = 0; i < KPT; ++i) { if constexpr (Q8) *(LAS u32x2*)(lds + (buf_) * 64 * KSTR + lk[i]) = bf8_to_fp8(ks[S_][i]); else *(LAS bf16x8*)(lds + (buf_) * 64 * KSTR + lk[i]) = ks[S_][i]; } \
        _Pragma("unroll") for (int i = 0; i < VPT; ++i) { if constexpr (PV8) *(LAS u32x2*)(lds + (buf_) * 64 * VSTR + lv[i]) = bf8_to_fp8(vs[S_][i]); else *(LAS bf16x8*)(lds + (buf_) * 64 * VSTR + lv[i]) = vs[S_][i]; } } \
        if (VAR == 1 && tid < 64) *(LAS float*)(lds + LCK + (buf_) * 256 + tid * 4) = cref - ckv[S_]; } while (0)
    f32x16 o[ND0];
#pragma unroll
    for (int d = 0; d < ND0; ++d)
#pragma unroll
        for (int r = 0; r < 16; ++r) o[d][r] = 0.f;
    constexpr bool MF = (VAR != 1);
    float m = MF ? -65536.0f : -1e30f, l = 0.f;
    float slope2 = 0.f;
    if constexpr (VAR == 0) slope2 = __builtin_amdgcn_exp2f(-(float)(head + 1)) * LOG2E;
    if constexpr (VAR == 2) slope2 = __builtin_amdgcn_exp2f(-0.5f * (float)(head + 1)) * LOG2E;
    const int g4 = lane >> 4, i16 = lane & 15;
    const int kq_off = r32 * KSTR + hi * (Q8 ? 32 : 16);
    const int vrd0 = (int)(uintptr_t)(lds + LV) + (4 * (g4 >> 1) + (i16 >> 2)) * VSTR + (16 * (g4 & 1) + 4 * (i16 & 3)) * 2;
    const int vrd8 = (int)(uintptr_t)(lds + LV) + (8 * (g4 >> 1) + (i16 >> 1)) * VSTR + 16 * (g4 & 1) + 8 * (i16 & 1);
    AT_ISSUE(kt_lo, 0); unsigned long long mcur = 0ull; if constexpr (VAR == 0) mcur = mnx[0];
    AT_WRITE(0, 0);
    if (DBG != 4 && kt_lo < kt_hi) AT_ISSUE(kt_lo + 1, 0);
    __syncthreads();
    bf16x8 pb[4]; v8i_t p8 = (v8i_t){0, 0, 0, 0, 0, 0, 0, 0};
#define AT_PV(D0, vrd) do { \
                const s16x4 l0 = tr_read<0 * 16 * VSTR + (D0) * 64>(vrd), h0 = tr_read<0 * 16 * VSTR + 8 * VSTR + (D0) * 64>(vrd); \
                const s16x4 l1 = tr_read<1 * 16 * VSTR + (D0) * 64>(vrd), h1 = tr_read<1 * 16 * VSTR + 8 * VSTR + (D0) * 64>(vrd); \
                const s16x4 l2 = tr_read<2 * 16 * VSTR + (D0) * 64>(vrd), h2 = tr_read<2 * 16 * VSTR + 8 * VSTR + (D0) * 64>(vrd); \
                const s16x4 l3 = tr_read<3 * 16 * VSTR + (D0) * 64>(vrd), h3 = tr_read<3 * 16 * VSTR + 8 * VSTR + (D0) * 64>(vrd); \
                asm volatile("s_waitcnt lgkmcnt(0)" ::: "memory"); __builtin_amdgcn_sched_barrier(0); \
                o[D0] = __builtin_amdgcn_mfma_f32_32x32x16_bf16((bf16x8){l0[0], l0[1], l0[2], l0[3], h0[0], h0[1], h0[2], h0[3]}, pb[0], o[D0], 0, 0, 0); \
                o[D0] = __builtin_amdgcn_mfma_f32_32x32x16_bf16((bf16x8){l1[0], l1[1], l1[2], l1[3], h1[0], h1[1], h1[2], h1[3]}, pb[1], o[D0], 0, 0, 0); \
                o[D0] = __builtin_amdgcn_mfma_f32_32x32x16_bf16((bf16x8){l2[0], l2[1], l2[2], l2[3], h2[0], h2[1], h2[2], h2[3]}, pb[2], o[D0], 0, 0, 0); \
                o[D0] = __builtin_amdgcn_mfma_f32_32x32x16_bf16((bf16x8){l3[0], l3[1], l3[2], l3[3], h3[0], h3[1], h3[2], h3[3]}, pb[3], o[D0], 0, 0, 0); } while (0)
#define AT_PV8(D0, vrd) do { \
                u32x2 t0_, t1_, t2_, t3_; \
                asm volatile("ds_read_b64_tr_b8 %0, %1 offset:%2" : "=&v"(t0_) : "v"(vrd), "i"(0 * 16 * VSTR + (D0) * 32) : "memory"); \
                asm volatile("ds_read_b64_tr_b8 %0, %1 offset:%2" : "=&v"(t1_) : "v"(vrd), "i"(1 * 16 * VSTR + (D0) * 32) : "memory"); \
                asm volatile("ds_read_b64_tr_b8 %0, %1 offset:%2" : "=&v"(t2_) : "v"(vrd), "i"(2 * 16 * VSTR + (D0) * 32) : "memory"); \
                asm volatile("ds_read_b64_tr_b8 %0, %1 offset:%2" : "=&v"(t3_) : "v"(vrd), "i"(3 * 16 * VSTR + (D0) * 32) : "memory"); \
                asm volatile("s_waitcnt lgkmcnt(0)" : "+v"(t0_), "+v"(t1_), "+v"(t2_), "+v"(t3_) :: "memory"); __builtin_amdgcn_sched_barrier(0); \
                { const v8i_t va_ = (v8i_t){(int)t0_.x, (int)t0_.y, (int)t1_.x, (int)t1_.y, (int)t2_.x, (int)t2_.y, (int)t3_.x, (int)t3_.y}; \
                  asm volatile("v_mfma_f32_32x32x64_f8f6f4 %0, %1, %2, %0" : "+v"(o[D0]) : "v"(va_), "v"(p8)); } } while (0)
#define AT_PV_ALL(vbuf_) do { if constexpr (PV8) { const int vrd_ = vrd8 + (vbuf_) * 64 * VSTR; asm volatile("s_nop 1" ::: "memory"); AT_PV8(0, vrd_); AT_PV8(1, vrd_); AT_PV8(2, vrd_); AT_PV8(3, vrd_); } \
        else { const int vrd_ = vrd0 + (vbuf_) * 64 * VSTR; AT_PV(0, vrd_); AT_PV(1, vrd_); if constexpr (ND0 == 4) { AT_PV(2, vrd_); AT_PV(3, vrd_); } } } while (0)
    for (int kt2 = kt_lo; kt2 <= kt_hi; kt2 += 2) {
#pragma unroll
    for (int hs = 0; hs < 2; ++hs) {
        const int kt = kt2 + hs; if (kt > kt_hi) break;
        const int buf = hs, k0 = kt * 64;
        if (kt <= kt_last_w && !(DBG == 6 && wid >= 4)) {
            f32x16 p[2];
            const int dq = tq - k0 - 4 * hi;
            if constexpr (VAR == 0 || VAR == 2) { const float base = -slope2 * (float)dq - m;
#pragma unroll
                for (int sub = 0; sub < 2; ++sub)
#pragma unroll
                    for (int r = 0; r < 16; ++r) p[sub][r] = fmaf(slope2, (float)(32 * sub + (r & 3) + 8 * (r >> 2)), base); }
            else if constexpr (VAR == 1) { const LAS float* ck = (const LAS float*)(lds + LCK + buf * 256);
#pragma unroll
                for (int sub = 0; sub < 2; ++sub)
#pragma unroll
                    for (int g = 0; g < 4; ++g) { const f32x4 c4 = *(const LAS f32x4*)(ck + 32 * sub + 8 * g + 4 * hi);
                        p[sub][4 * g] = c4[0]; p[sub][4 * g + 1] = c4[1]; p[sub][4 * g + 2] = c4[2]; p[sub][4 * g + 3] = c4[3]; } }
            else {
#pragma unroll
                for (int sub = 0; sub < 2; ++sub)
#pragma unroll
                    for (int r = 0; r < 16; ++r) p[sub][r] = -m; }
            const LAS unsigned char* kbuf = lds + LK + buf * 64 * KSTR + kq_off;
            if constexpr (Q8) {
                asm volatile("s_nop 1" ::: "memory");
#pragma unroll
                for (int s4 = 0; s4 < NST / 4; ++s4) {
                    const v8i_t ka = cat8(*(const LAS bf16x8*)(kbuf + s4 * 64), *(const LAS bf16x8*)(kbuf + s4 * 64 + 16));
                    const v8i_t kb8 = cat8(*(const LAS bf16x8*)(kbuf + 32 * KSTR + s4 * 64), *(const LAS bf16x8*)(kbuf + 32 * KSTR + s4 * 64 + 16));
                    if (DBG != 3) { asm volatile("v_mfma_f32_32x32x64_f8f6f4 %0, %1, %2, %0" : "+v"(p[0]) : "v"(ka), "v"(q8[s4]));
                                    asm volatile("v_mfma_f32_32x32x64_f8f6f4 %0, %1, %2, %0" : "+v"(p[1]) : "v"(kb8), "v"(q8[s4])); } }
                asm volatile("s_nop 15\n\ts_nop 7" : "+v"(p[0]), "+v"(p[1]) :: "memory");
            } else {
            constexpr int GS = (VAR == 3) ? 1 : 2, NG = NST / GS;
            bf16x8 kfa[2 * GS], kfb[2 * GS];
#define AT_LDK(dst, g_) do { _Pragma("unroll") for (int e = 0; e < GS; ++e) { dst[2 * e] = *(const LAS bf16x8*)(kbuf + (GS * (g_) + e) * 32); dst[2 * e + 1] = *(const LAS bf16x8*)(kbuf + 32 * KSTR + (GS * (g_) + e) * 32); } } while (0)
#define AT_MMK(src, g_) do { _Pragma("unroll") for (int e = 0; e < GS; ++e) { p[0] = __builtin_amdgcn_mfma_f32_32x32x16_bf16(src[2 * e], qf[GS * (g_) + e], p[0], 0, 0, 0); \
                                 p[1] = __builtin_amdgcn_mfma_f32_32x32x16_bf16(src[2 * e + 1], qf[GS * (g_) + e], p[1], 0, 0, 0); } } while (0)
            AT_LDK(kfa, 0);
#pragma unroll
            for (int g = 0; g < NG; g += 2) {
                if (g + 1 < NG) AT_LDK(kfb, g + 1);
                __builtin_amdgcn_sched_barrier(0);
                if (DBG != 3) AT_MMK(kfa, g);
                if (g + 1 < NG) { if (g + 2 < NG) AT_LDK(kfa, g + 2);
                    __builtin_amdgcn_sched_barrier(0);
                    if (DBG != 3) AT_MMK(kfb, g + 1); }
            }
#undef AT_LDK
#undef AT_MMK
            }
            if constexpr (VAR == 0) {
#pragma unroll
                for (int sub = 0; sub < 2; ++sub) { const unsigned wb = (unsigned)(mcur >> (32 * sub)) >> (4 * hi);
#pragma unroll
                    for (int r = 0; r < 16; ++r) p[sub][r] = ((wb >> ((r & 3) + 8 * (r >> 2))) & 1u) ? p[sub][r] : -INFINITY; }
            } else if constexpr (VAR == 2) {
#pragma unroll
                for (int sub = 0; sub < 2; ++sub)
#pragma unroll
                    for (int r = 0; r < 16; ++r) p[sub][r] = ((unsigned)(dq - (32 * sub + (r & 3) + 8 * (r >> 2))) <= 127u) ? p[sub][r] : -INFINITY;
            } else {
                if (k0 + 63 > tq0w) {
#pragma unroll
                    for (int sub = 0; sub < 2; ++sub)
#pragma unroll
                        for (int r = 0; r < 16; ++r) p[sub][r] = ((32 * sub + (r & 3) + 8 * (r >> 2)) <= dq) ? p[sub][r] : -INFINITY; }
            }
            if constexpr (DBG != 2) {
            asm volatile("s_nop 15\n\ts_nop 7" ::: "memory");
            float pm;
            { float ma, mb_;
              asm volatile("v_max3_f32 %0, %1, %2, %3" : "=v"(ma) : "v"(p[0][0]), "v"(p[0][1]), "v"(p[1][0]));
              asm volatile("v_max3_f32 %0, %1, %2, %3" : "=v"(mb_) : "v"(p[0][2]), "v"(p[0][3]), "v"(p[1][1]));
              asm volatile("v_max3_f32 %0, %1, %2, %3" : "+v"(ma) : "v"(ma), "v"(p[1][2]), "v"(p[1][3]));
#pragma unroll
              for (int r = 4; r < 16; r += 4) {
                  asm volatile("v_max3_f32 %0, %1, %2, %3" : "+v"(ma) : "v"(ma), "v"(p[0][r]), "v"(p[0][r + 1]));
                  asm volatile("v_max3_f32 %0, %1, %2, %3" : "+v"(mb_) : "v"(mb_), "v"(p[0][r + 2]), "v"(p[0][r + 3]));
                  asm volatile("v_max3_f32 %0, %1, %2, %3" : "+v"(ma) : "v"(ma), "v"(p[1][r]), "v"(p[1][r + 1]));
                  asm volatile("v_max3_f32 %0, %1, %2, %3" : "+v"(mb_) : "v"(mb_), "v"(p[1][r + 2]), "v"(p[1][r + 3])); }
              asm volatile("v_max_f32 %0, %1, %2" : "=v"(pm) : "v"(ma), "v"(mb_)); }
            { auto rr = __builtin_amdgcn_permlane32_swap(__float_as_uint(pm), __float_as_uint(pm), false, false); pm = fmaxf(__uint_as_float(rr[0]), __uint_as_float(rr[1])); }
            if constexpr (MF) {
                if (!__all(pm <= THR)) {
                    const float dm = fmaxf(pm, 0.f), alpha = __builtin_amdgcn_exp2f(-dm); m += dm; l *= alpha;
#pragma unroll
                    for (int d = 0; d < ND0; ++d)
#pragma unroll
                        for (int r = 0; r < 16; ++r) o[d][r] *= alpha;
#pragma unroll
                    for (int sub = 0; sub < 2; ++sub)
#pragma unroll
                        for (int r = 0; r < 16; ++r) p[sub][r] -= dm;
                }
            } else if (!__all(pm - m <= THR)) {
                const float mn = fmaxf(m, pm), alpha = __builtin_amdgcn_exp2f(m - mn); m = mn; l *= alpha;
#pragma unroll
                for (int d = 0; d < ND0; ++d)
#pragma unroll
                    for (int r = 0; r < 16; ++r) o[d][r] *= alpha;
            }
#pragma unroll
            for (int sub = 0; sub < 2; ++sub)
#pragma unroll
                for (int r = 0; r < 16; ++r) p[sub][r] = __builtin_amdgcn_exp2f(MF ? p[sub][r] : p[sub][r] - m);
            __builtin_amdgcn_sched_barrier(0);
            { float s0 = p[0][0], s1 = p[0][1], s2 = p[1][0], s3 = p[1][1];
#pragma unroll
              for (int r = 2; r < 16; r += 2) { s0 += p[0][r]; s1 += p[0][r + 1]; s2 += p[1][r]; s3 += p[1][r + 1]; }
              l += (s0 + s1) + (s2 + s3); }
            }
            if constexpr (PV8) {
#pragma unroll
                for (int w = 0; w < 8; ++w) { const int sub = w >> 2, r4 = 4 * (w & 3); int t = 0;
                    t = __builtin_amdgcn_cvt_pk_fp8_f32(p[sub][r4], p[sub][r4 + 1], t, false); t = __builtin_amdgcn_cvt_pk_fp8_f32(p[sub][r4 + 2], p[sub][r4 + 3], t, true); p8[w] = t; }
            } else {
#pragma unroll
            for (int s = 0; s < 4; ++s) { const int sub = s >> 1, k8 = 8 * (s & 1);
                u32x4 wv; wv.x = cvt_pk_bf16(p[sub][k8], p[sub][k8 + 1]); wv.y = cvt_pk_bf16(p[sub][k8 + 2], p[sub][k8 + 3]); wv.z = cvt_pk_bf16(p[sub][k8 + 4], p[sub][k8 + 5]); wv.w = cvt_pk_bf16(p[sub][k8 + 6], p[sub][k8 + 7]);
                pb[s] = __builtin_bit_cast(bf16x8, wv); }
            }
        }
        if (DBG != 4 && kt < kt_hi) AT_WRITE(buf ^ 1, 0);
        if constexpr (VAR == 0) mcur = mnx[0];
        if (DBG != 4 && kt + 1 < kt_hi) AT_ISSUE(kt + 2, 0);
        if (kt <= kt_last_w && !(DBG == 6 && wid >= 4)) {
            if (DBG != 1) AT_PV_ALL(buf);
            if (DBG == 1) { _Pragma("unroll") for (int i = 0; i < 4; ++i) o[0][i] += __uint_as_float((unsigned)pb[i][0]); }
        }
        if (DBG != 5) __syncthreads();
    }
    }
#undef AT_PV_ALL
#undef AT_PV8
#undef AT_PV
#undef AT_ISSUE
#undef AT_WRITE
    if constexpr (PV8) asm volatile("s_nop 15\n\ts_nop 15" : "+v"(o[0]), "+v"(o[1]), "+v"(o[ND0 - 2]), "+v"(o[ND0 - 1]) :: "memory");
    unsigned nx = 0u; if (threadIdx.x == 0) nx = __hip_atomic_fetch_add(qh, 1u, RLX_AGENT);
    { auto rr = __builtin_amdgcn_permlane32_swap(__float_as_uint(l), __float_as_uint(l), false, false); l = __uint_as_float(rr[0]) + __uint_as_float(rr[1]); }
    if constexpr (VAR == 2) l += __builtin_amdgcn_exp2f(a.sinks[layer * 16 + head] * LOG2E - m);
    const float inv = 1.0f / l;
    int zc, bc;
    if constexpr (VAR == 0) { zc = PC_AZ + head * 128; bc = 0 + head * 128; }
    else if constexpr (VAR == 1) { zc = PC_BZ + head * 128; bc = 1024 + head * 128; }
    else if constexpr (VAR == 2) { zc = PC_CZ + head * 64; bc = 2048 + head * 64; }
    else { zc = PC_DZ + head * 128; bc = 3072 + head * 128; }
    const unsigned char* zp = a.ws + WS_Z8 + rowq * 4096 + bc + 16 * hi; (void)zc; unsigned char* op = a.ws + (DBG ? WS_SC : WS_BR) + rowq * 4096 + bc + 16 * hi;
#pragma unroll
    for (int d = 0; d < ND0; ++d) {
#pragma unroll
        for (int jj = 0; jj < 8; ++jj) { const int r0 = jj, r1 = 8 + jj;
            const auto sw = __builtin_amdgcn_permlane32_swap(__float_as_uint(o[d][r0]), __float_as_uint(o[d][r1]), false, false);
            o[d][r0] = __uint_as_float(sw[0]); o[d][r1] = __uint_as_float(sw[1]); }
        const u32x4 za = *(const u32x4*)(zp + 32 * d);
        const unsigned zw[4] = {za.x, za.y, za.z, za.w};
        u32x4 wo;
#pragma unroll
        for (int q4 = 0; q4 < 4; ++q4) { const int rb = (q4 & 1) * 8 + (q4 >> 1) * 4;
            const f32x2 zl = __builtin_amdgcn_cvt_pk_f32_fp8((int)zw[q4], false), zh = __builtin_amdgcn_cvt_pk_f32_fp8((int)zw[q4], true); const float z0 = zl[0], z1 = zl[1], z2 = zh[0], z3 = zh[1];
            const float v0 = o[d][rb] * inv * (z0 * fast_sigmoid(z0)), v1 = o[d][rb + 1] * inv * (z1 * fast_sigmoid(z1));
            const float v2 = o[d][rb + 2] * inv * (z2 * fast_sigmoid(z2)), v3 = o[d][rb + 3] * inv * (z3 * fast_sigmoid(z3));
            int w8 = 0; w8 = __builtin_amdgcn_cvt_pk_fp8_f32(v0 * 8.0f, v1 * 8.0f, w8, false); w8 = __builtin_amdgcn_cvt_pk_fp8_f32(v2 * 8.0f, v3 * 8.0f, w8, true);
            if (q4 == 0) wo.x = (unsigned)w8; else if (q4 == 1) wo.y = (unsigned)w8; else if (q4 == 2) wo.z = (unsigned)w8; else wo.w = (unsigned)w8; }
        *(u32x4*)(op + 32 * d) = wo; }
    if (threadIdx.x == 0) bw[0] = nx;
}
template <int VAR, int DBG = 0>
__device__ __forceinline__ void attn_queue(LAS unsigned char* lds, const Args& a, int layer) {
    constexpr int NUX = (VAR == 2) ? 128 : 64;
    unsigned* qbase = (unsigned*)(a.ws + WS_CTL) + CW_Q + 64 * 8 * (layer * 4 + VAR);
    layer &= 1;
    volatile LAS unsigned* bw = (volatile LAS unsigned*)(lds + MISC_OFF + 64);
    const int myx = (int)(xb_xcc_id() & 7u);
    for (int qi = 0; qi < 8; ++qi) {
        const int x = (myx + qi) & 7;
        unsigned* qh = qbase + 64 * x;
        if (threadIdx.x == 0) bw[0] = __hip_atomic_fetch_add(qh, 1u, RLX_AGENT);
        for (;;) {
            __syncthreads();
            const int idx = (int)bw[0];
            __syncthreads();
            if (idx >= NUX) break;
            int b, hidx, qblk;
            if constexpr (VAR == 0) { qblk = 63 - idx; b = x >> 1; hidx = x & 1; }
            else if constexpr (VAR == 2) { qblk = idx; b = x >> 1; hidx = x & 1; }
            else { const int pr = 4 * x + 2 * (idx >> 5) + (idx & 1); qblk = 15 - ((idx & 31) >> 1); b = pr >> 3; hidx = pr & 7; }
            attn_unit<VAR, DBG>(lds, a, layer, b, hidx, qblk, qh, bw);
        }
    }
}

constexpr int N_PHASES = 1 + 6 * DEPTH;
#ifndef DUP_PHASE
#define DUP_PHASE -1
#endif
__global__ void __launch_bounds__(NTHREADS, 2) mega_fwd(Args a) {
    extern __shared__ __attribute__((aligned(16))) unsigned char lds_raw[];
    LAS unsigned char* lds = (LAS unsigned char*)lds_raw;
    const int tid = threadIdx.x;
    for (int u = tid; u < (LDS_BYTES - LDSCTL_OFF) / 4; u += NTHREADS) ((LAS unsigned*)(lds + LDSCTL_OFF))[u] = 0u;
    __syncthreads();
    unsigned* ctl = (unsigned*)(a.ws + WS_CTL);
    const int lo = a.ph_lo, hi = a.ph_hi;
    const bool multi = (hi - lo) > 1;
    XcdBarrier bar; bar.bar = ctl + CW_BAR; bar.x = 0; bar.st = nullptr;
    if (multi) bar = xcd_barrier_post(ctl + CW_BAR, (volatile LAS unsigned*)(lds + MISC_OFF + 32));
#define IN(k) (lo <= (k) && (k) < hi)
#define SEAM(k) do { if (IN(k) && IN((k) + 1)) xcd_barrier(bar); } while (0)
    unsigned char* ws = a.ws;
    bf16_t* XB = (bf16_t*)(ws + WS_XB); bf16_t* P = (bf16_t*)(ws + WS_P); unsigned char* Gt = ws + WS_G;
    float* SM = (float*)(ws + WS_SM); float* RSS = (float*)(ws + WS_RSS); float* CS = (float*)(ws + WS_CS);
    unsigned char* W = ws + WS_W;

    if (IN(0)) { convert_weights(a, 0, lds); prologue_misc(a); }
    SEAM(0);
    for (int layer = 0; layer < DEPTH; ++layer) {
        const int pb = 1 + 6 * layer;
        if (IN(pb + 0)) {
            { pg8::Gemm g{(const bf16_t*)(ws + WS_X4), (const bf16_t*)(W + WO_WG8), DM / 4, DM / 4, DM / 4, 0, 0}; pg8::StaticOrder S; S.init(MTOK, NGATE, gridDim.x, blockIdx.x, 8);
              EpiGate E{Gt, -LOG2E / (FP4_XS * FP4_WS * 0.9761f)};
              pg8::gemm_phase<EpiGate, pg8::StaticOrder, true, false, true>(lds, g, S, E);
#if DUP_PHASE == 1001
              pg8::gemm_phase<EpiGate, pg8::StaticOrder, true, true>(lds, g, S, E);
#endif
#if DUP_PHASE == 1002
              { EpiNull E0{(float*)(ws + WS_SC)}; pg8::gemm_phase<EpiNull, pg8::StaticOrder, true, true>(lds, g, S, E0); }
#endif
              }
            { pg8::Gemm g{(const bf16_t*)(ws + WS_X8), (const bf16_t*)(W + WO_WIN8), DM / 2, DM / 2, DM / 2, 0, 0}; pg8::StaticOrder S; S.init(MTOK, NIN8, gridDim.x, blockIdx.x);
              EpiIn E{P, SM, RSS, 1, ws + WS_KV8, ws + WS_L8, ws + WS_Z8};
              pg8::gemm_phase<EpiIn, pg8::StaticOrder, true, true>(lds, g, S, E); }
            { pg8::Gemm g{(const bf16_t*)(ws + WS_X4), (const bf16_t*)(W + WO_WZ4), DM / 4, DM / 4, DM / 4, 0, 0}; pg8::StaticOrder S; S.init(MTOK, NINZ, gridDim.x, blockIdx.x, 8);
              EpiIn E{P, SM, RSS, 2, ws + WS_KV8, ws + WS_L8, ws + WS_Z8};
              pg8::gemm_phase<EpiIn, pg8::StaticOrder, true, false, true>(lds, g, S, E); }
            { pg8::Gemm g{XB, (const bf16_t*)(W + WO_WINB), DM, DM, DM, 0, 0}; pg8::StaticOrder S; S.init(MTOK, NINB, gridDim.x, (blockIdx.x + 64) % gridDim.x, 2);
              EpiIn E{P, SM, RSS, 0, ws + WS_KV8, ws + WS_L8, ws + WS_Z8};
              pg8::gemm_phase<EpiIn, pg8::StaticOrder>(lds, g, S, E); }
        }
        SEAM(pb + 0);
        if (IN(pb + 1)) {
            cumsum_phase(SM, a.f_bias + layer * 8, (float*)(ws + WS_CUM));
            krope_phase(SM, CS, ws + WS_D8);
            { pg8::Gemm g{(const bf16_t*)(ws + WS_L8), (const bf16_t*)(W + WO_DQUP), 384, 512, 384, 0, 0}; pg8::StaticOrder S; S.init(MTOK, 1536, gridDim.x, blockIdx.x);
              EpiDq E{(bf16_t*)(ws + WS_DQ), RSS, CS, 1.0f / DQ_WS};
              pg8::gemm_phase<EpiDq, pg8::StaticOrder, true, true>(lds, g, S, E); }
            { pg8::Gemm g{(const bf16_t*)(ws + WS_L8 + 768), (const bf16_t*)(W + WO_DKVUP), 128, 512, 128, 0, 0}; pg8::StaticOrder S; S.init(MTOK, 2048, gridDim.x, blockIdx.x);
              EpiDkv E{ws + WS_D8, RSS, 1.0f / DKV_WS};
              pg8::gemm_phase<EpiDkv, pg8::StaticOrder, true, true>(lds, g, S, E); }
            indexer_phase(lds, a);
#if DUP_PHASE == 1 || DUP_PHASE == 11
            { pg8::Gemm g{P + PC_DCQ, (const bf16_t*)(W + WO_DQUP), 768, INP, 768, 0, 0}; pg8::StaticOrder S; S.init(MTOK, 1536, gridDim.x, blockIdx.x);
              EpiDq E{(bf16_t*)(ws + WS_DQ), RSS, CS};
              pg8::gemm_phase<EpiDq, pg8::StaticOrder>(lds, g, S, E); }
            { pg8::Gemm g{P + PC_DCKV, (const bf16_t*)(W + WO_DKVUP), 256, INP, 256, 0, 0}; pg8::StaticOrder S; S.init(MTOK, 2048, gridDim.x, blockIdx.x);
              EpiDkv E{ws + WS_D8, RSS};
              pg8::gemm_phase<EpiDkv, pg8::StaticOrder>(lds, g, S, E); }
#endif
#if DUP_PHASE == 1 || DUP_PHASE == 12
            indexer_phase(lds, a);
#endif
        }
        SEAM(pb + 1);
        if (IN(pb + 2)) {
            attn_queue<3>(lds, a, layer);
            attn_queue<1>(lds, a, layer);
            attn_queue<0>(lds, a, layer);
            attn_queue<2>(lds, a, layer);
#if DUP_PHASE == 2 || DUP_PHASE == 23
            attn_queue<3>(lds, a, layer + 2);
#endif
#if DUP_PHASE == 2 || DUP_PHASE == 21
            attn_queue<1>(lds, a, layer + 2);
#endif
#if DUP_PHASE >= 210 && DUP_PHASE <= 219
            attn_queue<1, DUP_PHASE - 210>(lds, a, layer + 2);
#endif
#if DUP_PHASE == 2 || DUP_PHASE == 20
            attn_queue<0>(lds, a, layer + 2);
#endif
#if DUP_PHASE == 2 || DUP_PHASE == 22
            attn_queue<2>(lds, a, layer + 2);
#endif
        }
        SEAM(pb + 2);
        if (IN(pb + 3)) {
            pg8::Gemm g{(const bf16_t*)(ws + WS_BR), (const bf16_t*)(W + WO_WBR), 512, 2048, 512, (size_t)1024, (size_t)DM * 1024};
            pg8::ZOrder<4> S; S.init(MTOK, DM, gridDim.x, blockIdx.x);
            EpiMerge E{Gt, ws + WS_MRG};
            pg8::gemm_phase<EpiMerge, pg8::ZOrder<4>, true, true>(lds, g, S, E);
#if DUP_PHASE == 3
            pg8::gemm_phase<EpiMerge, pg8::ZOrder<4>, true, true>(lds, g, S, E);
#endif
        }
        SEAM(pb + 3);
        if (IN(pb + 4)) {
            pg8::Gemm g{(const bf16_t*)(ws + WS_MRG), (const bf16_t*)(W + WO_WOUT), DM / 2, DM / 2, DM / 2, 0, 0}; pg8::StaticOrder S; S.init(MTOK, DM, gridDim.x, blockIdx.x);
            EpiOut E{XB, (bf16_t*)(ws + WS_R)};
            pg8::gemm_phase<EpiOut, pg8::StaticOrder, true, true>(lds, g, S, E);
#if DUP_PHASE == 4
            pg8::gemm_phase<EpiOut, pg8::StaticOrder, true, true>(lds, g, S, E);
#endif
        }
        SEAM(pb + 4);
        if (IN(pb + 5)) {
            ln_phase((const bf16_t*)(ws + WS_R), a.ln_gain + layer * DM, a.ln_bias + layer * DM, layer + 1 < DEPTH ? nullptr : a.out, layer + 1 < DEPTH ? XB : nullptr, ws + WS_X8, ws + WS_X4);
            if (layer + 1 < DEPTH) convert_weights(a, layer + 1, lds);
#if DUP_PHASE == 5
            ln_phase((const bf16_t*)(ws + WS_R), a.ln_gain + layer * DM, a.ln_bias + layer * DM, layer + 1 < DEPTH ? nullptr : a.out, layer + 1 < DEPTH ? XB : nullptr, ws + WS_X8, ws + WS_X4);
            if (layer + 1 < DEPTH) convert_weights(a, layer + 1, lds);
#endif
        }
        if (layer + 1 < DEPTH) SEAM(pb + 5);
    }
#undef IN
#undef SEAM
}

#ifdef PROBE_KERNEL
__global__ void __launch_bounds__(NTHREADS, 2) probe_fwd(Args a) {
    extern __shared__ __attribute__((aligned(16))) unsigned char lds_raw[];
    LAS unsigned char* lds = (LAS unsigned char*)lds_raw;
    unsigned char* ws = a.ws; unsigned char* W = ws + WS_W;
#if PROBE_KERNEL == 1 || PROBE_KERNEL == 2 || PROBE_KERNEL == 4
    pg8::Gemm g{(const bf16_t*)(ws + WS_X8), (const bf16_t*)(W + WO_WG8), DM / 2, DM / 2, DM / 2, 0, 0}; pg8::StaticOrder S; S.init(MTOK, NGATE, gridDim.x, blockIdx.x);
#if PROBE_KERNEL == 1
    EpiGate E{ws + WS_G}; pg8::gemm_phase<EpiGate, pg8::StaticOrder, true, true>(lds, g, S, E);
#elif PROBE_KERNEL == 4
    EpiGate E{ws + WS_G}; pg8::gemm_phase<EpiGate, pg8::StaticOrder, false, true>(lds, g, S, E);
#else
    EpiNull E{(float*)(ws + WS_SC)}; pg8::gemm_phase<EpiNull, pg8::StaticOrder, true, true>(lds, g, S, E);
#endif
#endif
#if PROBE_KERNEL >= 10 && PROBE_KERNEL < 20
    attn_queue<1, PROBE_KERNEL - 10>(lds, a, 3);
#endif
#if PROBE_KERNEL == 20 || PROBE_KERNEL == 21
    { pg8::Gemm g{(const bf16_t*)(ws + WS_BR), (const bf16_t*)(W + WO_WBR), 512, 2048, 512, (size_t)1024, (size_t)DM * 1024}; pg8::ZOrder<4> S; S.init(MTOK, DM, gridDim.x, blockIdx.x);
#if PROBE_KERNEL == 20
      EpiMerge E{ws + WS_G, ws + WS_MRG}; pg8::gemm_phase<EpiMerge, pg8::ZOrder<4>, true, true>(lds, g, S, E);
#else
      EpiNull E{(float*)(ws + WS_SC)}; pg8::gemm_phase<EpiNull, pg8::ZOrder<4>, true, true>(lds, g, S, E);
#endif
    }
#endif
#if PROBE_KERNEL == 22
    { pg8::Gemm g{(const bf16_t*)(ws + WS_MRG), (const bf16_t*)(W + WO_WOUT), DM / 2, DM / 2, DM / 2, 0, 0}; pg8::StaticOrder S; S.init(MTOK, DM, gridDim.x, blockIdx.x);
      EpiOut E{(const bf16_t*)(ws + WS_XB), (bf16_t*)(ws + WS_SC)}; pg8::gemm_phase<EpiOut, pg8::StaticOrder, true, true>(lds, g, S, E); }
#endif
#if PROBE_KERNEL == 30
    convert_weights(a, 1, lds);
#endif
#if PROBE_KERNEL == 31
    ln_phase((const bf16_t*)(ws + WS_R), a.ln_gain + DM, a.ln_bias + DM, a.out, nullptr, ws + WS_X8);
#endif
#if PROBE_KERNEL == 32
    indexer_phase(lds, a);
#endif
#if PROBE_KERNEL == 33
    indexer_phase<1>(lds, a);
#endif
#if PROBE_KERNEL == 34
    indexer_phase<2>(lds, a);
#endif
#if PROBE_KERNEL == 3
    pg8::Gemm g{(const bf16_t*)(ws + WS_XB), (const bf16_t*)(W + WO_WG8), DM / 2, DM / 2, DM / 2, 0, 0}; pg8::StaticOrder S; S.init(MTOK, NGATE, gridDim.x, blockIdx.x);
    EpiNull E{(float*)(ws + WS_SC)}; pg8::gemm_phase<EpiNull, pg8::StaticOrder, true, false>(lds, g, S, E);
#endif
}
#endif

#ifndef MK_N_LAUNCHES
#define MK_N_LAUNCHES 1
#endif
extern "C" void kernel_launch(void* const* d_in, const int* in_sizes, int n_in, void* d_out, int out_size, void* d_ws, size_t ws_size, hipStream_t stream) {
    static int grid = 0;
    if (grid == 0) {
        if (n_in != 14 || in_sizes[0] != MTOK * DM || out_size != MTOK * DM || ws_size < WS_END) {
            fprintf(stderr, "kernel_launch: unexpected shapes / workspace: n_in %d in0 %d out %d ws %zu (need >= %zu)\n", n_in, n_in > 0 ? in_sizes[0] : -1, out_size, ws_size, (size_t)WS_END); grid = -1; return; }
        int dev = 0, cus = 0, per_cu = 0;
        if (hipGetDevice(&dev) != hipSuccess || hipDeviceGetAttribute(&cus, hipDeviceAttributeMultiprocessorCount, dev) != hipSuccess) { grid = -1; return; }
        if (hipFuncSetAttribute((const void*)mega_fwd, hipFuncAttributeMaxDynamicSharedMemorySize, LDS_BYTES) != hipSuccess) { fprintf(stderr, "kernel_launch: hipFuncSetAttribute failed\n"); grid = -1; return; }
        if (hipOccupancyMaxActiveBlocksPerMultiprocessor(&per_cu, (const void*)mega_fwd, NTHREADS, LDS_BYTES) != hipSuccess || per_cu < 1) {
            fprintf(stderr, "kernel_launch: occupancy query reports %d workgroups per CU\n", per_cu); }
        (void)hipGetLastError();
        grid = cus;
    }
    if (grid < 0) return;
    (void)hipMemsetAsync((char*)d_ws + WS_CTL, 0, CTL_ZERO_BYTES, stream);
    Args a{};
    a.x = (const float*)d_in[0]; a.pos = (const int*)d_in[1]; a.w_in = (const float*)d_in[2]; a.w_gate = (const float*)d_in[3]; a.w_branch = (const float*)d_in[4]; a.w_out = (const float*)d_in[5];
    a.dq_gain = (const float*)d_in[6]; a.dq_up = (const float*)d_in[7]; a.dkv_gain = (const float*)d_in[8]; a.dkv_up = (const float*)d_in[9]; a.f_bias = (const float*)d_in[10];
    a.sinks = (const float*)d_in[11]; a.ln_gain = (const float*)d_in[12]; a.ln_bias = (const float*)d_in[13];
    a.out = (float*)d_out; a.ws = (unsigned char*)d_ws;
#if MK_N_LAUNCHES == 1
    a.ph_lo = 0; a.ph_hi = N_PHASES;
    hipLaunchKernelGGL(mega_fwd, dim3(grid), dim3(NTHREADS), LDS_BYTES, stream, a);
#else
    for (int p = 0; p < N_PHASES; ++p) { a.ph_lo = p; a.ph_hi = p + 1; hipLaunchKernelGGL(mega_fwd, dim3(grid), dim3(NTHREADS), LDS_BYTES, stream, a); }
#endif
#ifdef PROBE_KERNEL
    { static int once = 0; if (!once) { (void)hipFuncSetAttribute((const void*)probe_fwd, hipFuncAttributeMaxDynamicSharedMemorySize, LDS_BYTES); once = 1; }
      hipLaunchKernelGGL(probe_fwd, dim3(grid), dim3(NTHREADS), LDS_BYTES, stream, a); }
#endif
    const hipError_t le = hipPeekAtLastError();
    if (le != hipSuccess) fprintf(stderr, "kernel_launch: launch failed: %s\n", hipGetErrorName(le));
}
```

```cpp
#include <hip/hip_runtime.h>
#include <cstdio>
#include <cstdint>

#define LAS __attribute__((address_space(3)))
#define GAS __attribute__((address_space(1)))
typedef unsigned short bf16_t;
typedef short bf16x8 __attribute__((ext_vector_type(8)));
typedef short s16x4 __attribute__((ext_vector_type(4)));
typedef float f32x4 __attribute__((ext_vector_type(4)));
typedef float f32x2 __attribute__((ext_vector_type(2)));
typedef float f32x16 __attribute__((ext_vector_type(16)));
typedef unsigned u32x4 __attribute__((ext_vector_type(4)));
typedef unsigned u32x2 __attribute__((ext_vector_type(2)));

typedef __bf16 bf16x2_t __attribute__((ext_vector_type(2)));
__device__ __forceinline__ unsigned cvt_pk_bf16(float lo, float hi) { const f32x2 v = {lo, hi}; const bf16x2_t b = __builtin_convertvector(v, bf16x2_t); return __builtin_bit_cast(unsigned, b); }
__device__ __forceinline__ int ptid() { int t = threadIdx.x; asm volatile("" : "+v"(t)); return t; }
__device__ __forceinline__ float bf2f(unsigned short b) { return __uint_as_float(((unsigned)b) << 16); }

namespace pg8 {
constexpr int BM = 256, BK = 64, HALF = 128, HTB = HALF * BK * 2  , STAGE_BYTES = 8 * HTB, NXCD = 8, WGM = 4;
__host__ __device__ __forceinline__ int lds_byte(int r, int c) { const int st = (r >> 4) * 2 + (c >> 5), rr = r & 15, cc = c & 31, ob = rr * 64 + cc * 2; return st * 1024 + (ob ^ (((ob >> 9) & 1) << 5)); }
__host__ __device__ __forceinline__ void stage_rc(int b, int& R, int& C) { const int st = b / 1024, sb = b % 1024, swz = sb ^ (((sb >> 9) & 1) << 5); R = (st >> 1) * 16 + swz / 64; C = (st & 1) * 32 + (swz % 64) / 2; }
__host__ __device__ __forceinline__ int perm32(int rho) { const int n = rho >> 4, i = rho & 15; return 8 * (i >> 2) + 4 * n + (i & 3); }

struct Unit { int pm, pn, z; };
struct Gemm { const bf16_t* A; const bf16_t* Bt; int K, lda, ldb; size_t zA, zB; };

__device__ __forceinline__ void tile_of(int L, int nM, int nN, int& pm, int& pn, int WGM = pg8::WGM) {
    const int nwg = nM * nN; int wgid = L; { const int q = nwg / NXCD, r = nwg % NXCD, xcd = wgid % NXCD, off = wgid / NXCD; wgid = (xcd < r ? xcd * (q + 1) : r * (q + 1) + (xcd - r) * q) + off; }
    const int nig = WGM * nN, gid = wgid / nig, fm = gid * WGM, gsz = (nM - fm) < WGM ? (nM - fm) : WGM;
    pm = fm + ((wgid % nig) % gsz); pn = (wgid % nig) / gsz;
}
struct StaticOrder {
    int nM, nN, nwg, G, c, wgm;
    __device__ void init(int M, int N, int G_, int c_, int wgm_ = WGM) { nM = M / BM; nN = N / BM; nwg = nM * nN; G = G_; c = c_; wgm = wgm_; }
    __device__ bool next(int i, Unit& u) const { const long L = (long)i * G + c; if (L >= nwg) return false; tile_of((int)L, nM, nN, u.pm, u.pn, wgm); u.z = 0; return true; }
};
template <int Z> struct ZOrder {
    int nM, nN, nwg, G, c;
    __device__ void init(int M, int N, int G_, int c_) { nM = M / BM; nN = N / BM; nwg = nM * nN; G = G_; c = c_; }
    __device__ bool next(int i, Unit& u) const { const long L = (long)(i / Z) * G + c; if (L >= nwg) return false; tile_of((int)L, nM, nN, u.pm, u.pn); u.z = i % Z; return true; }
};

typedef int v8i_t __attribute__((ext_vector_type(8)));
typedef int v4i_t __attribute__((ext_vector_type(4)));
__device__ __forceinline__ v8i_t cat8(bf16x8 lo, bf16x8 hi) { const v4i_t a = __builtin_bit_cast(v4i_t, lo), b = __builtin_bit_cast(v4i_t, hi); return __builtin_shufflevector(a, b, 0, 1, 2, 3, 4, 5, 6, 7); }
template <class Epi, class Sched, bool ALIGN_EPI = true, bool F8 = false, bool F4 = false>
__device__ __forceinline__ void gemm_phase(LAS unsigned char* lds, const Gemm g, const Sched& S, const Epi& E) {
    const int tid = ptid(), wid = __builtin_amdgcn_readfirstlane(tid >> 6), lane = tid & 63, wr = wid >> 2, wc = wid & 3, fr = lane & 15, fq = lane >> 4;
    const int K = g.K, nt = K / BK;
    unsigned voffA[2], voffB[2];
#pragma unroll
    for (int i = 0; i < 2; ++i) { int R, C; stage_rc(tid * 16 + i * 8192, R, C);
        const int Rb = (int)Epi::PERM == 2 ? (64 * (R >> 5) + 16 * ((R >> 2) & 3) + 4 * ((R >> 4) & 1) + (R & 3)) : ((int)Epi::PERM == 1 ? ((R & ~31) + perm32(R & 31)) : R);
        voffA[i] = (unsigned)(R * g.lda + C) * 2u; voffB[i] = (unsigned)(Rb * g.ldb + C) * 2u; }
    const size_t kstep = (size_t)(BK * 2);
    const size_t hstepA = (size_t)HALF * g.lda * 2, hstepB = (size_t)((int)Epi::PERM == 2 ? 8 : HALF) * g.ldb * 2;
    const size_t tstepA = 2 * hstepA, tstepB = (size_t)BM * g.ldb * 2;
    const unsigned ldsw = (unsigned)wid * 1024u;
    const int aoff = lds_byte(wr * 64 + fr, fq * 8), boff = lds_byte(wc * 32 + fr, fq * 8);
#define PG8_SA(b, h) (((b) * 2 + (h)) * HTB)
#define PG8_SB(b, h) ((4 + (b) * 2 + (h)) * HTB)
#define PG8_STAGE(bufoff, gbase, voff) do { _Pragma("unroll") for (int _i = 0; _i < 2; ++_i) \
        __builtin_amdgcn_global_load_lds((const unsigned*)((const char*)(gbase) + (voff)[_i]), (LAS unsigned*)(lds + (bufoff) + ldsw + _i * 8192), 16, 0, 0); } while (0)
#define PG8_LDA(dst, b, h) do { _Pragma("unroll") for (int m = 0; m < 4; ++m) { if constexpr (F8) dst##8[m] = cat8(*(const LAS bf16x8*)(lds + PG8_SA(b, h) + aoff + m * 2048), *(const LAS bf16x8*)(lds + PG8_SA(b, h) + aoff + m * 2048 + 1024)); \
        else { _Pragma("unroll") for (int k = 0; k < 2; ++k) dst[m][k] = *(const LAS bf16x8*)(lds + PG8_SA(b, h) + aoff + m * 2048 + k * 1024); } } } while (0)
#define PG8_LDB(dst, b, h) do { _Pragma("unroll") for (int n = 0; n < 2; ++n) { if constexpr (F8) dst##8[n] = cat8(*(const LAS bf16x8*)(lds + PG8_SB(b, h) + boff + n * 2048), *(const LAS bf16x8*)(lds + PG8_SB(b, h) + boff + n * 2048 + 1024)); \
        else { _Pragma("unroll") for (int k = 0; k < 2; ++k) dst[n][k] = *(const LAS bf16x8*)(lds + PG8_SB(b, h) + boff + n * 2048 + k * 1024); } } } while (0)
#define PG8_MMA(ai, bj, At, Bt) do { __builtin_amdgcn_s_setprio(1); _Pragma("unroll") for (int m = 0; m < 4; ++m) _Pragma("unroll") for (int n = 0; n < 2; ++n) { \
        if constexpr (F8) asm volatile("v_mfma_f32_16x16x128_f8f6f4 %0, %1, %2, %0" : "+v"(acc[ai][bj][m][n]) : "v"(Bt##8[n]), "v"(At##8[m]));   \
        else if constexpr (F4) { _Pragma("unroll") for (int k = 0; k < 2; ++k) asm volatile("v_mfma_f32_16x16x128_f8f6f4 %0, %1, %2, %0 cbsz:4 blgp:4" : "+v"(acc[ai][bj][m][n]) : "v"(Bt[n][k]), "v"(At[m][k])); } \
        else { _Pragma("unroll") for (int k = 0; k < 2; ++k) acc[ai][bj][m][n] = __builtin_amdgcn_mfma_f32_16x16x32_bf16(Bt[n][k], At[m][k], acc[ai][bj][m][n], 0, 0, 0); } } \
        __builtin_amdgcn_s_setprio(0); } while (0)
#define PG8_WAIT_V(n) asm volatile("s_waitcnt vmcnt(" #n ")" ::: "memory")
#define PG8_WAIT_L(n) asm volatile("s_waitcnt lgkmcnt(" #n ")" ::: "memory")
#define PG8_BAR __builtin_amdgcn_s_barrier()
#define PG8_SCHED __builtin_amdgcn_sched_barrier(0)
    Unit cur, nxt; int ui = 0;
    if (!S.next(0, cur)) return;
    f32x4 acc[2][2][4][2];
#pragma unroll
    for (int a = 0; a < 2; ++a)
#pragma unroll
        for (int b = 0; b < 2; ++b)
#pragma unroll
            for (int m = 0; m < 4; ++m)
#pragma unroll
                for (int n = 0; n < 2; ++n) acc[a][b][m][n] = (f32x4){0.f, 0.f, 0.f, 0.f};
    bf16x8 At[4][2], B0[2][2], B1[2][2]; v8i_t At8[4], B08[2], B18[2];
    const char* cA = (const char*)g.A + (size_t)cur.z * g.zA + (size_t)cur.pm * tstepA; const char* cB = (const char*)g.Bt + (size_t)cur.z * g.zB + (size_t)cur.pn * tstepB;
    PG8_STAGE(PG8_SB(0, 0), cB, voffB); PG8_STAGE(PG8_SB(0, 1), cB + hstepB, voffB); PG8_STAGE(PG8_SA(0, 0), cA, voffA); PG8_STAGE(PG8_SA(0, 1), cA + hstepA, voffA);
    if (wr == 1) PG8_BAR;
    PG8_WAIT_V(2); PG8_BAR;
    PG8_STAGE(PG8_SB(1, 0), cB + kstep, voffB); PG8_STAGE(PG8_SA(1, 0), cA + kstep, voffA); PG8_STAGE(PG8_SB(1, 1), cB + hstepB + kstep, voffB);
    PG8_WAIT_V(6); PG8_BAR;
    for (;;) {
        const bool has_next = S.next(ui + 1, nxt);
        const char* nA = has_next ? (const char*)g.A + (size_t)nxt.z * g.zA + (size_t)nxt.pm * tstepA : cA; const char* nB = has_next ? (const char*)g.Bt + (size_t)nxt.z * g.zB + (size_t)nxt.pn * tstepB : cB;
#pragma unroll 1
        for (int t = 0; t < nt; t += 2) {
            const bool last = (t == nt - 2);
            const char* a1 = cA + (size_t)(t + 1) * kstep;
            const char* a2 = last ? nA : cA + (size_t)(t + 2) * kstep; const char* b2 = last ? nB : cB + (size_t)(t + 2) * kstep;
            const char* a3 = a2 + kstep; const char* b3 = b2 + kstep;
            PG8_LDB(B0, 0, 0); PG8_LDB(B1, 0, 1); PG8_SCHED; PG8_LDA(At, 0, 0); PG8_STAGE(PG8_SA(1, 1), a1 + hstepA, voffA);
            PG8_WAIT_V(8); PG8_WAIT_L(0); PG8_BAR; PG8_MMA(0, 0, At, B0); PG8_MMA(0, 1, At, B1); PG8_BAR; PG8_SCHED;
            PG8_LDA(At, 0, 1); PG8_STAGE(PG8_SB(0, 0), b2, voffB); PG8_STAGE(PG8_SB(0, 1), b2 + hstepB, voffB); PG8_STAGE(PG8_SA(0, 0), a2, voffA);
            PG8_WAIT_V(8); PG8_WAIT_L(0); PG8_BAR; PG8_MMA(1, 0, At, B0); PG8_MMA(1, 1, At, B1); PG8_BAR; PG8_SCHED;
            PG8_LDB(B0, 1, 0); PG8_LDB(B1, 1, 1); PG8_SCHED; PG8_LDA(At, 1, 0); PG8_STAGE(PG8_SA(0, 1), a2 + hstepA, voffA);
            PG8_WAIT_V(8); PG8_WAIT_L(0); PG8_BAR; PG8_MMA(0, 0, At, B0); PG8_MMA(0, 1, At, B1); PG8_BAR; PG8_SCHED;
            PG8_LDA(At, 1, 1); PG8_STAGE(PG8_SB(1, 0), b3, voffB); PG8_STAGE(PG8_SB(1, 1), b3 + hstepB, voffB); PG8_STAGE(PG8_SA(1, 0), a3, voffA);
            PG8_WAIT_V(8); PG8_WAIT_L(0); PG8_BAR; PG8_MMA(1, 0, At, B0); PG8_MMA(1, 1, At, B1); PG8_BAR; PG8_SCHED;
        }
        if constexpr (ALIGN_EPI) { if (wr == 0) PG8_BAR; }
        if constexpr (F8 || F4) asm volatile("s_nop 15\n\ts_nop 15" ::: "memory");
        E(acc, cur, wr, wc, fr, fq);
        if (!has_next) break;
        if (!(Epi::CARRY && nxt.z != 0))
#pragma unroll
        for (int a = 0; a < 2; ++a)
#pragma unroll
            for (int b = 0; b < 2; ++b)
#pragma unroll
                for (int m = 0; m < 4; ++m)
#pragma unroll
                    for (int n = 0; n < 2; ++n) acc[a][b][m][n] = (f32x4){0.f, 0.f, 0.f, 0.f};
        cur = nxt; cA = nA; cB = nB; ++ui;
        if constexpr (ALIGN_EPI) { if (wr == 1) PG8_BAR; }
    }
    PG8_WAIT_V(0);
    if constexpr (!ALIGN_EPI) { if (wr == 0) PG8_BAR; }
    PG8_BAR;
#undef PG8_SA
#undef PG8_SB
#undef PG8_STAGE
#undef PG8_LDA
#undef PG8_LDB
#undef PG8_MMA
#undef PG8_WAIT_V
#undef PG8_WAIT_L
#undef PG8_BAR
#undef PG8_SCHED
}
}

constexpr int BATCH = 4, SEQ = 4096, DM = 4096, MTOK = BATCH * SEQ, DEPTH = 2;
constexpr int INW = 12184, INP = 12288, NGATE = 4 * DM, N1 = INP + NGATE;
constexpr float LOG2E = 1.4426950408889634f;
constexpr float RMS_EPS = 1e-6f, LN_EPS = 1e-5f;
constexpr float DN_ALPHA = 1.4142135623730951f;
constexpr int PC_AQ = 0, PC_AK = 1024, PC_AV = 1280, PC_AIQ = 1536, PC_AZ = 2560, PC_BQ = 3584, PC_BK = 4608, PC_BV = 5632, PC_BZ = 6656,
              PC_CQ = 7680, PC_CK = 8704, PC_CV = 8832, PC_CZ = 8960, PC_DCQ = 9984, PC_DCKV = 10752, PC_DZ = 11008,
              PC_AIK = 12032, PC_AIW = 12096, PC_BF = 12112, PC_DKR = 12120, PC_END = 12184;
constexpr int SC_AQ = 0, SC_AK = 1024, SC_AV = 1280, SC_AIQ = 1536, SC_AIK = 2560, SC_AIW = 2624, SC_AZ = 2640, SC_BQ = 3664, SC_BK = 4688, SC_BV = 5712,
              SC_BF = 6736, SC_BZ = 6744, SC_CQ = 7768, SC_CK = 8792, SC_CV = 8920, SC_CZ = 9048, SC_DCQ = 10072, SC_DCKV = 10840, SC_DKR = 11096, SC_DZ = 11160;
static_assert(SC_DZ + 1024 == INW, "w_in column partition");
constexpr int SMC_AIK = 0, SMC_AIW = 64, SMC_BF = 80, SMC_DKR = 88;

constexpr size_t MiB = 1u << 20;
constexpr size_t WS_CTL = 0, CTL_ZERO_BYTES = 1 * MiB;
constexpr size_t WS_W = 2 * MiB;
constexpr int NIN8 = 27 * 256, NINZ = 16 * 256, NINB = 5 * 256;
constexpr size_t WO_WIN8 = 0                                         , WO_WZ4 = WO_WIN8 + (size_t)NIN8 * DM  ,
                 WO_WINB = WO_WZ4 + (size_t)NINZ * (DM / 2)          ,
                 WO_WG8 = WO_WINB + (size_t)NINB * DM * 2            , WO_WBR = WO_WG8 + (size_t)NGATE * DM  ,
                 WO_WOUT = WO_WBR + (size_t)4 * DM * 1024            , WO_DQUP = WO_WOUT + (size_t)DM * DM,
                 WO_DKVUP = WO_DQUP + (size_t)1536 * 768 * 2, WO_END = WO_DKVUP + (size_t)2048 * 256 * 2;
static_assert(WO_END <= 292 * MiB, "weights region");
constexpr size_t WS_XB = 294 * MiB;
constexpr size_t WS_P = 422 * MiB;
constexpr size_t WS_MRGF = WS_P;
constexpr size_t WS_G = 806 * MiB;
constexpr size_t WS_R = WS_G;
constexpr size_t WS_SC = 1318 * MiB;
constexpr size_t WS_MRG = WS_SC;
constexpr size_t WS_BR = 1574 * MiB;
constexpr size_t WS_DQ = 1702 * MiB;
constexpr size_t WS_DKV = 1750 * MiB;
constexpr size_t WS_MASK = 1814 * MiB;
constexpr size_t WS_SM = 1822 * MiB;
constexpr size_t WS_CS = 1838 * MiB;
constexpr size_t WS_RSS = 1842 * MiB;
constexpr size_t WS_CUM = 1843 * MiB;
constexpr size_t WS_DKR = 1844 * MiB;
constexpr size_t WS_X8 = 1846 * MiB;
constexpr size_t WS_KV8 = 1096 * MiB;
constexpr int KV8W = 2560;
constexpr size_t WS_D8 = 1136 * MiB;
constexpr int D8W = 2112;
constexpr size_t WS_L8 = 1170 * MiB;
constexpr float DQ_WS = 64.0f, DKV_WS = 8.0f;
constexpr size_t WS_Z8 = 1188 * MiB;
constexpr size_t WS_Q8 = 1252 * MiB;
constexpr size_t WS_X4 = 1062 * MiB;
constexpr size_t WS_END = 1910 * MiB;
constexpr int CW_TMO = 0;
constexpr int CW_Q = 64;
constexpr int CW_BAR = 16384;

constexpr int RING_BYTES = 131072;
constexpr int LDSCTL_OFF = RING_BYTES, MISC_OFF = LDSCTL_OFF + 320;
constexpr int LDS_BYTES = 147456;
constexpr int NWAVES = 8, NTHREADS = 512;

#define RLX_AGENT __ATOMIC_RELAXED, __HIP_MEMORY_SCOPE_AGENT
#define LDS_WAIT() asm volatile("s_waitcnt lgkmcnt(0)" ::: "memory")
#define VM_WAIT() asm volatile("s_waitcnt vmcnt(0)" ::: "memory")

#define XB_TMO      128
#define XB_XCNT(j)  (256  + 64 * (j))
#define XB_XSUB(j)  (1280 + 64 * (j))
#define XB_XGEN(j)  (2304 + 64 * (j))
#define XB_TOP      3328
#define XB_TOPGEN   3392
#define XCD_BAR_WORDS 3456
#define XB_SPIN_CAP (1u << 23)
__device__ __forceinline__ unsigned xb_ld(unsigned* p)              { return __hip_atomic_load(p, __ATOMIC_RELAXED, __HIP_MEMORY_SCOPE_AGENT); }
__device__ __forceinline__ unsigned xb_add(unsigned* p, unsigned v) { return __hip_atomic_fetch_add(p, v, __ATOMIC_RELAXED, __HIP_MEMORY_SCOPE_AGENT); }
__device__ __forceinline__ unsigned xb_xcc_id() { return (unsigned)__builtin_amdgcn_s_getreg((3 << 11) | 20) & 0xFu; }
#define XB_SPIN(cond, bar) do { unsigned _sp = 0; while (cond) { __builtin_amdgcn_s_sleep(1); \
    if ((++_sp & 255u) == 0u) { if (xb_ld(&(bar)[XB_TMO])) break; if (_sp > XB_SPIN_CAP) { atomicAdd(&(bar)[XB_TMO], 1u); break; } } } } while (0)
struct XcdBarrier { unsigned* bar; unsigned x; volatile LAS unsigned* st; };
__device__ __forceinline__ XcdBarrier xcd_barrier_post(unsigned* bar, volatile LAS unsigned* st) {
    XcdBarrier b; b.bar = bar; b.x = xb_xcc_id(); b.st = st;
    if (threadIdx.x == 0) (void)xb_add(&bar[XB_XCNT(b.x)], 1u);
    return b;
}
__device__ __forceinline__ void xcd_barrier_complete(unsigned* bar, unsigned x, unsigned& nloc, unsigned& nx) {
    const unsigned G = gridDim.x * gridDim.y * gridDim.z;
    unsigned sum, cnt, mine, sp = 0u;
    for (;;) {
        sum = 0u; cnt = 0u; mine = 0u;
#pragma unroll
        for (unsigned j = 0; j < 16; ++j) { const unsigned c = xb_ld(&bar[XB_XCNT(j)]); sum += c; cnt += (c > 0u) ? 1u : 0u; mine = (j == x) ? c : mine; }
        if (sum == G) break;
        __builtin_amdgcn_s_sleep(1);
        if ((++sp & 255u) == 0u) { if (xb_ld(&bar[XB_TMO])) break; if (sp > XB_SPIN_CAP) { atomicAdd(&bar[XB_TMO], 1u); break; } }
    }
    nloc = mine > 0u ? mine : 1u; nx = cnt > 0u ? cnt : 1u;
}
__device__ __forceinline__ void xcd_barrier(const XcdBarrier& b) {
    asm volatile("s_waitcnt vmcnt(0)" ::: "memory");
    __syncthreads();
    if (threadIdx.x == 0) {
        unsigned* bar = b.bar;
        __builtin_amdgcn_s_waitcnt(0);
        unsigned nloc = b.st[0], nx = b.st[1];
        if (nloc == 0u) { xcd_barrier_complete(bar, b.x, nloc, nx); b.st[0] = nloc; b.st[1] = nx; }
        const unsigned old = xb_add(&bar[XB_XSUB(b.x)], 1u);
        const unsigned gen = old / nloc;
        if (old + 1u == (gen + 1u) * nloc) {
            __builtin_amdgcn_fence(__ATOMIC_RELEASE, "agent");
            asm volatile("s_waitcnt vmcnt(0)" ::: "memory");
            const unsigned og = xb_add(&bar[XB_TOP], 1u);
            const unsigned tg = og / nx;
            if (og + 1u == (tg + 1u) * nx) xb_add(&bar[XB_TOPGEN], 1u);
            else XB_SPIN(xb_ld(&bar[XB_TOPGEN]) == tg, bar);
            __builtin_amdgcn_fence(__ATOMIC_ACQUIRE, "agent");
            xb_add(&bar[XB_XGEN(b.x)], 1u);
            asm volatile("s_waitcnt vmcnt(0)" ::: "memory");
        } else {
            XB_SPIN(xb_ld(&bar[XB_XGEN(b.x)]) == gen, bar);
            __builtin_amdgcn_fence(__ATOMIC_ACQUIRE, "agent");
            asm volatile("s_waitcnt vmcnt(0)" ::: "memory");
        }
    }
    __syncthreads();
}

struct Args {
    const float* x; const int* pos; const float* w_in; const float* w_gate; const float* w_branch; const float* w_out;
    const float* dq_gain; const float* dq_up; const float* dkv_gain; const float* dkv_up; const float* f_bias; const float* sinks; const float* ln_gain; const float* ln_bias;
    float* out; unsigned char* ws; int ph_lo, ph_hi;
};

__device__ __forceinline__ float wave_sum(float v) {
#pragma unroll
    for (int o = 1; o < 64; o <<= 1) v += __shfl_xor(v, o);
    return v;
}
__device__ __forceinline__ unsigned pack_fp4x8(float a0, float a1, float a2, float a3, float a4, float a5, float a6, float a7) {
    unsigned w = 0u;
    w = __builtin_amdgcn_cvt_scalef32_pk_fp4_f32(w, a0, a1, 1.0f, 0); w = __builtin_amdgcn_cvt_scalef32_pk_fp4_f32(w, a2, a3, 1.0f, 1);
    w = __builtin_amdgcn_cvt_scalef32_pk_fp4_f32(w, a4, a5, 1.0f, 2); w = __builtin_amdgcn_cvt_scalef32_pk_fp4_f32(w, a6, a7, 1.0f, 3);
    return w; }
constexpr float FP4_XS = 2.0f, FP4_WS = 128.0f;
__device__ __forceinline__ float fast_sigmoid(float v) { return __builtin_amdgcn_rcpf(1.0f + __builtin_amdgcn_exp2f(-v * LOG2E)); }

__device__ __forceinline__ int in_src(int j, float& sc) {
    sc = 1.0f;
    if (j < PC_AK)   return SC_AQ + (j - PC_AQ);
    if (j < PC_AV)   return SC_AK + (j - PC_AK);
    if (j < PC_AIQ)  return SC_AV + (j - PC_AV);
    if (j < PC_AZ)   return SC_AIQ + (j - PC_AIQ);
    if (j < PC_BQ)   return SC_AZ + (j - PC_AZ);
    if (j < PC_BK)   return SC_BQ + (j - PC_BQ);
    if (j < PC_BV)   return SC_BK + (j - PC_BK);
    if (j < PC_BZ)   return SC_BV + (j - PC_BV);
    if (j < PC_CQ)   return SC_BZ + (j - PC_BZ);
    if (j < PC_CK)   return SC_CQ + (j - PC_CQ);
    if (j < PC_CV)   return SC_CK + (j - PC_CK);
    if (j < PC_CZ)   return SC_CV + (j - PC_CV);
    if (j < PC_DCQ)  return SC_CZ + (j - PC_CZ);
    if (j < PC_DCKV) return SC_DCQ + (j - PC_DCQ);
    if (j < PC_DZ)   return SC_DCKV + (j - PC_DCKV);
    if (j < PC_AIK)  return SC_DZ + (j - PC_DZ);
    if (j < PC_AIW)  return SC_AIK + (j - PC_AIK);
    if (j < PC_BF)   return SC_AIW + (j - PC_AIW);
    if (j < PC_DKR)  return SC_BF + (j - PC_BF);
    if (j < PC_END)  { const int p = j - PC_DKR; return SC_DKR + (p >> 1) + 32 * (p & 1); }
    return -1;
}
__host__ __device__ __forceinline__ int in8_tile(int i) { return i < 6 ? i : (i < 22 ? i + 4 : i + 8); }
__host__ __device__ __forceinline__ int inz_tile(int j) { return j < 4 ? 26 + j : 31 + j; }
struct CvtItem {
    const float* p;
    unsigned ld;
    const float* gain;
    float sc;
    unsigned char* dst;
    int K, n0, k0, f8;
};
__device__ __forceinline__ CvtItem cvt_decode(const Args& a, int layer, int it, int lane) {
    unsigned char* W = a.ws + WS_W;
    constexpr int I_IN8 = (NIN8 / 32) * (DM / 64), I_INZ = (NINZ / 32) * (DM / 64), I_INB = (NINB / 32) * (DM / 64), I_G = (NGATE / 32) * (DM / 64), I_BR = 4 * (DM / 32) * (1024 / 64), I_OUT = (DM / 32) * (DM / 64), I_DQ = (1536 / 32) * (768 / 64);
    CvtItem d; d.gain = nullptr; d.sc = 1.0f; d.f8 = 1; d.K = DM; d.ld = DM;
    const int ln = lane & 31; int r = it;
    if (r < I_IN8) { const int nb = r % (NIN8 / 32), kb = r / (NIN8 / 32); d.n0 = nb * 32; d.k0 = kb * 64;
        const int j = in8_tile(d.n0 >> 8) * 256 + (d.n0 & 255) + ln; float s_; const int c = in_src(j, s_);
        d.p = a.w_in + (size_t)layer * DM * INW + (c < 0 ? 0 : c); d.ld = INW; d.sc = c < 0 ? 0.f : 64.0f; d.dst = W + WO_WIN8; return d; }
    r -= I_IN8;
    if (r < I_INZ) { const int nb = r % (NINZ / 32), kb = r / (NINZ / 32); d.n0 = nb * 32; d.k0 = kb * 64;
        const int j = inz_tile(d.n0 >> 8) * 256 + (d.n0 & 255) + ln; float s_; const int c = in_src(j, s_);
        d.p = a.w_in + (size_t)layer * DM * INW + (c < 0 ? 0 : c); d.ld = INW; d.sc = c < 0 ? 0.f : FP4_WS; d.dst = W + WO_WZ4; d.f8 = 2; return d; }
    r -= I_INZ;
    if (r < I_INB) { const int nb = r % (NINB / 32), kb = r / (NINB / 32); d.n0 = nb * 32; d.k0 = kb * 64;
        const int j = d.n0 + ln + (d.n0 < 1024 ? 1536 : 12032 - 1024); float s_; const int c = in_src(j, s_);
        d.p = a.w_in + (size_t)layer * DM * INW + (c < 0 ? 0 : c); d.ld = INW; d.sc = c < 0 ? 0.f : 1.0f; d.dst = W + WO_WINB; d.f8 = 0; return d; }
    r -= I_INB;
    if (r < I_G) { const int nb = r % (NGATE / 32), kb = r / (NGATE / 32), g = nb / (DM / 32); d.n0 = (nb % (DM / 32)) * 32; d.k0 = kb * 64;
        d.p = a.w_gate + ((size_t)layer * 4 + g) * DM * DM + d.n0 + ln; d.sc = FP4_WS; d.dst = W + WO_WG8 + (size_t)g * DM * (DM / 2); d.f8 = 2; return d; }
    r -= I_G;
    if (r < I_BR) { const int n = r / ((DM / 32) * 16), q = r % ((DM / 32) * 16), nb = q % (DM / 32), kb = q / (DM / 32); d.n0 = nb * 32; d.k0 = kb * 64;
        d.p = a.w_branch + ((size_t)layer * 4 + n) * 1024 * DM + d.n0 + ln; d.sc = 64.0f; d.dst = W + WO_WBR + (size_t)n * DM * 1024; d.K = 1024; return d; }
    r -= I_BR;
    if (r < I_OUT) { const int nb = r % (DM / 32), kb = r / (DM / 32); d.n0 = nb * 32; d.k0 = kb * 64;
        d.p = a.w_out + (size_t)layer * DM * DM + d.n0 + ln; d.sc = 128.0f; d.dst = W + WO_WOUT; return d; }
    r -= I_OUT;
    if (r < I_DQ) { const int nb = r % 48, kb = r / 48; d.n0 = nb * 32; d.k0 = kb * 64;
        const int j = d.n0 + ln, h = j / 192, wv = j % 192; int c = wv; if (wv >= 128) { const int q = wv - 128; c = 128 + (q >> 1) + 32 * (q & 1); }
        d.p = a.dq_up + (size_t)layer * 768 * 1536 + h * 192 + c; d.ld = 1536; d.gain = a.dq_gain + layer * 768; d.sc = 0.07216878364870322f * LOG2E * DQ_WS; d.dst = W + WO_DQUP; d.K = 768; d.f8 = 1; return d; }
    r -= I_DQ;
    { const int nb = r % 64, kb = r / 64; d.n0 = nb * 32; d.k0 = kb * 64;
      d.p = a.dkv_up + (size_t)layer * 256 * 2048 + d.n0 + ln; d.ld = 2048; d.gain = a.dkv_gain + layer * 256; d.sc = DKV_WS; d.dst = W + WO_DKVUP; d.K = 256; d.f8 = 1; return d; }
}
__device__ __forceinline__ void cvt_load(const CvtItem& d, float (&v)[32], int lane) {
    const float* p = d.p + (size_t)(d.k0 + (lane >> 5)) * d.ld;
#pragma unroll
    for (int i = 0; i < 32; ++i) v[i] = p[(size_t)(2 * i) * d.ld];
}
__device__ __forceinline__ void cvt_finish(const CvtItem& d, const float (&v)[32], LAS float* scr, int lane) {
#pragma unroll
    for (int i = 0; i < 32; ++i) { const int kk = 2 * i + (lane >> 5); float x = v[i] * d.sc; if (d.gain) x *= d.gain[d.k0 + kk]; scr[kk * 33 + (lane & 31)] = x; }
    LDS_WAIT(); asm volatile("" ::: "memory");
    const int c = lane & 7;
#pragma unroll
    for (int j = 0; j < 4; ++j) { const int n = (lane >> 3) + 8 * j; const LAS float* s = scr + (8 * c) * 33 + n;
        if (d.f8 == 2) *(unsigned*)(d.dst + (((size_t)(d.n0 + n) * d.K + d.k0 + 8 * c) >> 1)) = pack_fp4x8(s[0], s[33], s[2 * 33], s[3 * 33], s[4 * 33], s[5 * 33], s[6 * 33], s[7 * 33]);
        else if (d.f8) { int w0 = 0, w1 = 0;
            w0 = __builtin_amdgcn_cvt_pk_fp8_f32(s[0], s[33], w0, false); w0 = __builtin_amdgcn_cvt_pk_fp8_f32(s[2 * 33], s[3 * 33], w0, true);
            w1 = __builtin_amdgcn_cvt_pk_fp8_f32(s[4 * 33], s[5 * 33], w1, false); w1 = __builtin_amdgcn_cvt_pk_fp8_f32(s[6 * 33], s[7 * 33], w1, true);
            *(u32x2*)(d.dst + (size_t)(d.n0 + n) * d.K + d.k0 + 8 * c) = (u32x2){(unsigned)w0, (unsigned)w1}; }
        else { u32x4 o; o.x = cvt_pk_bf16(s[0], s[33]); o.y = cvt_pk_bf16(s[2 * 33], s[3 * 33]); o.z = cvt_pk_bf16(s[4 * 33], s[5 * 33]); o.w = cvt_pk_bf16(s[6 * 33], s[7 * 33]);
            *(u32x4*)((bf16_t*)d.dst + (size_t)(d.n0 + n) * d.K + d.k0 + 8 * c) = o; } }
    LDS_WAIT(); asm volatile("" ::: "memory");
}
__device__ __forceinline__ void convert_weights(const Args& a, int layer, LAS unsigned char* lds) {
    const int tid = ptid(), lane = tid & 63, wave = tid >> 6;
    LAS float* scr = (LAS float*)(lds + wave * 8448);
    const int NGW = gridDim.x * NWAVES, gw = blockIdx.x * NWAVES + wave;
    constexpr int NITEMS = (NIN8 / 32) * (DM / 64) + (NINZ / 32) * (DM / 64) + (NINB / 32) * (DM / 64) + (NGATE / 32) * (DM / 64) + 4 * (DM / 32) * (1024 / 64) + (DM / 32) * (DM / 64) + (1536 / 32) * (768 / 64) + (2048 / 32) * (256 / 64);
    float va[32], vb[32]; CvtItem da, db;
    int it = gw;
    if (it < NITEMS) { da = cvt_decode(a, layer, it, lane); cvt_load(da, va, lane); }
    while (it < NITEMS) {
        const int itb = it + NGW;
        if (itb < NITEMS) { db = cvt_decode(a, layer, itb, lane); cvt_load(db, vb, lane); }
        cvt_finish(da, va, scr, lane);
        if (itb >= NITEMS) break;
        const int ita = itb + NGW;
        if (ita < NITEMS) { da = cvt_decode(a, layer, ita, lane); cvt_load(da, va, lane); }
        cvt_finish(db, vb, scr, lane);
        it = ita;
    }
    __syncthreads();
}
__device__ __forceinline__ void prologue_misc(const Args& a) {
    const size_t gt = (size_t)blockIdx.x * NTHREADS + ptid(), GT = (size_t)gridDim.x * NTHREADS;
    bf16_t* XB = (bf16_t*)(a.ws + WS_XB);
    constexpr size_t NCH = (size_t)MTOK * DM / 8;
    for (size_t i0 = gt; i0 < NCH; i0 += 4 * GT) {
        f32x4 v0[4], v1[4];
#pragma unroll
        for (int u = 0; u < 4; ++u) { const size_t i = i0 + u * GT; if (i < NCH) { v0[u] = *(const f32x4*)(a.x + i * 8); v1[u] = *(const f32x4*)(a.x + i * 8 + 4); } }
#pragma unroll
        for (int u = 0; u < 4; ++u) { const size_t i = i0 + u * GT; if (i < NCH) {
            u32x4 o; o.x = cvt_pk_bf16(v0[u][0], v0[u][1]); o.y = cvt_pk_bf16(v0[u][2], v0[u][3]); o.z = cvt_pk_bf16(v1[u][0], v1[u][1]); o.w = cvt_pk_bf16(v1[u][2], v1[u][3]);
            *(u32x4*)(XB + i * 8) = o;
            int w0 = 0, w1 = 0;
            w0 = __builtin_amdgcn_cvt_pk_fp8_f32(v0[u][0], v0[u][1], w0, false); w0 = __builtin_amdgcn_cvt_pk_fp8_f32(v0[u][2], v0[u][3], w0, true);
            w1 = __builtin_amdgcn_cvt_pk_fp8_f32(v1[u][0], v1[u][1], w1, false); w1 = __builtin_amdgcn_cvt_pk_fp8_f32(v1[u][2], v1[u][3], w1, true);
            *(u32x2*)(a.ws + WS_X8 + i * 8) = (u32x2){(unsigned)w0, (unsigned)w1};
            *(unsigned*)(a.ws + WS_X4 + i * 4) = pack_fp4x8(v0[u][0] * FP4_XS, v0[u][1] * FP4_XS, v0[u][2] * FP4_XS, v0[u][3] * FP4_XS, v1[u][0] * FP4_XS, v1[u][1] * FP4_XS, v1[u][2] * FP4_XS, v1[u][3] * FP4_XS); } }
    }
    f32x2* CS = (f32x2*)(a.ws + WS_CS);
    for (size_t i = gt; i < (size_t)MTOK * 32; i += GT) {
        const int row = (int)(i >> 5), fi = (int)(i & 31);
        const float invf = __builtin_amdgcn_exp2f(-(float)fi * (13.287712379549449f / 32.0f));
        const float ang = (float)a.pos[row] * invf;
        const double rev = (double)ang * 0.15915494309189535;
        const float fr = (float)(rev - floor(rev));
        CS[i] = (f32x2){__builtin_amdgcn_cosf(fr), __builtin_amdgcn_sinf(fr)};
    }
}

struct EpiIn {
    static constexpr int PERM = 2; static constexpr bool CARRY = false;
    bf16_t* P; float* SM; float* RSS; int f8; unsigned char* KV8; unsigned char* L8; unsigned char* Z8; unsigned char* Q8;
    template <int MODE>
    __device__ __forceinline__ void run(const f32x4 (&acc)[2][2][4][2], int pn, int row0, int cw, int wc, int fq, float sc) const {
        bf16_t* base = P + (size_t)pn * 256 + cw;
        unsigned char* k8b = (MODE == 6) ? Q8 + (pn < 4 ? pn * 256 : (pn < 18 ? 1024 + (pn - 14) * 256 : 2048 + (pn - 30) * 256)) + cw
                           : (MODE == 5) ? Z8 + (pn < 14 ? (pn - 10) * 256 : (pn < 30 ? 1024 + (pn - 26) * 256 : (pn < 39 ? 2048 + (pn - 35) * 256 : 3072 + (pn - 43) * 256))) + cw
                           : (MODE == 3) ? L8 + (pn - 39) * 256 + cw : KV8 + (pn < 6 ? (pn - 4) * 256 : 512 + (pn - 18) * 256) + cw;
#pragma unroll
        for (int ai = 0; ai < 2; ++ai)
#pragma unroll
            for (int m = 0; m < 4; ++m) { const int row = row0 + ai * 128 + m * 16; bf16_t* rowp = base + (size_t)row * INP; float ss = 0.f;
                u32x4 k8w;
#pragma unroll
                for (int bj = 0; bj < 2; ++bj) { f32x4 v0 = acc[ai][bj][m][0] * sc, v1 = acc[ai][bj][m][1] * sc;
                    if constexpr (MODE == 3) ss += ((v0[0] * v0[0] + v0[1] * v0[1]) + (v0[2] * v0[2] + v0[3] * v0[3])) + ((v1[0] * v1[0] + v1[1] * v1[1]) + (v1[2] * v1[2] + v1[3] * v1[3]));
                    if constexpr (MODE == 4 || MODE == 3 || MODE == 5 || MODE == 6) { int w0 = 0, w1 = 0;
                        w0 = __builtin_amdgcn_cvt_pk_fp8_f32(v0[0], v0[1], w0, false); w0 = __builtin_amdgcn_cvt_pk_fp8_f32(v0[2], v0[3], w0, true);
                        w1 = __builtin_amdgcn_cvt_pk_fp8_f32(v1[0], v1[1], w1, false); w1 = __builtin_amdgcn_cvt_pk_fp8_f32(v1[2], v1[3], w1, true);
                        if (bj == 0) { k8w.x = (unsigned)w0; k8w.y = (unsigned)w1; } else { k8w.z = (unsigned)w0; k8w.w = (unsigned)w1; } continue; }
                    if constexpr (MODE == 1) {
#pragma unroll
                        for (int j = 0; j < 4; ++j) { v0[j] = v0[j] * fast_sigmoid(v0[j]); v1[j] = v1[j] * fast_sigmoid(v1[j]); } }
                    if constexpr (MODE == 2) { float* sp = SM + (size_t)row * 256 + cw + bj * 8; *(f32x4*)sp = v0; *(f32x4*)(sp + 4) = v1; }
                    u32x4 w; w.x = cvt_pk_bf16(v0[0], v0[1]); w.y = cvt_pk_bf16(v0[2], v0[3]); w.z = cvt_pk_bf16(v1[0], v1[1]); w.w = cvt_pk_bf16(v1[2], v1[3]);
                    *(u32x4*)(rowp + bj * 8) = w; }
                if constexpr (MODE == 4) *(u32x4*)(k8b + (size_t)row * KV8W) = k8w;
                if constexpr (MODE == 3) *(u32x4*)(k8b + (size_t)row * 1024) = k8w;
                if constexpr (MODE == 5) *(u32x4*)(k8b + (size_t)row * 4096) = k8w;
                if constexpr (MODE == 6) *(u32x4*)(k8b + (size_t)row * 3072) = k8w;
                if constexpr (MODE == 3) { ss += __shfl_xor(ss, 16); ss += __shfl_xor(ss, 32); if (fq == 0) RSS[(size_t)row * 16 + (pn - 39) * 4 + wc] = ss; }
                asm volatile("" ::: "memory"); }
    }
    __device__ __forceinline__ void operator()(f32x4 (&acc)[2][2][4][2], const pg8::Unit& u, int wr, int wc, int fr, int fq) const {
        asm volatile("" : "+v"(fr), "+v"(fq));
        const int pn = f8 == 1 ? in8_tile(u.pn) : (f8 == 2 ? inz_tile(u.pn) : (u.pn < 4 ? u.pn + 6 : 47)), row0 = u.pm * 256 + wr * 64 + fr, cw = wc * 64 + 16 * fq;
        const float qs = (pn < 4 || (pn >= 14 && pn < 18)) ? 0.08838834764831845f * LOG2E : ((pn >= 30 && pn < 34) ? 0.125f * LOG2E : 1.0f), sc = f8 == 1 ? qs * 0.015625f : (f8 == 2 ? 1.0f / (FP4_XS * FP4_WS * 0.9761f) : qs);
        if (pn == 47) run<2>(acc, pn, row0, cw, wc, fq, sc);
        else if (pn >= 39 && pn < 43) run<3>(acc, pn, row0, cw, wc, fq, sc);
        else if (pn == 4 || pn == 5 || (pn >= 18 && pn < 26)) run<4>(acc, pn, row0, cw, wc, fq, sc);
        else if (pn < 4 || (pn >= 14 && pn < 18) || (pn >= 30 && pn < 34)) run<6>(acc, pn, row0, cw, wc, fq, sc);
        else if ((pn >= 10 && pn < 14) || (pn >= 26 && pn < 30) || (pn >= 35 && pn < 39) || (pn >= 43 && pn < 47)) run<5>(acc, pn, row0, cw, wc, fq, sc);
        else run<0>(acc, pn, row0, cw, wc, fq, sc);
    }
};
struct EpiGate {
    static constexpr int PERM = 2; static constexpr bool CARRY = false;
    unsigned char* G; float sc;
    __device__ __forceinline__ void operator()(f32x4 (&acc)[2][2][4][2], const pg8::Unit& u, int wr, int wc, int fr, int fq) const {
        asm volatile("" : "+v"(fr), "+v"(fq));
        unsigned char* base = G + ((((size_t)u.pm * 64 + u.pn) * 8 + (wr * 4 + wc)) * 8) * 1024 + (fq * 16 + fr) * 16;
#pragma unroll
        for (int ai = 0; ai < 2; ++ai)
#pragma unroll
            for (int m = 0; m < 4; ++m) { unsigned char* rowp = base + (ai * 4 + m) * 1024; u32x4 w;
#pragma unroll
                for (int bj = 0; bj < 2; ++bj) { const f32x4 v0 = acc[ai][bj][m][0] * sc, v1 = acc[ai][bj][m][1] * sc; int w0 = 0, w1 = 0;
                    w0 = __builtin_amdgcn_cvt_pk_fp8_f32(v0[0], v0[1], w0, false); w0 = __builtin_amdgcn_cvt_pk_fp8_f32(v0[2], v0[3], w0, true);
                    w1 = __builtin_amdgcn_cvt_pk_fp8_f32(v1[0], v1[1], w1, false); w1 = __builtin_amdgcn_cvt_pk_fp8_f32(v1[2], v1[3], w1, true);
                    if (bj == 0) { w.x = (unsigned)w0; w.y = (unsigned)w1; } else { w.z = (unsigned)w0; w.w = (unsigned)w1; } }
                *(u32x4*)rowp = w; }
    }
};
struct EpiNull {
    static constexpr int PERM = 1; static constexpr bool CARRY = false;
    float* D;
    __device__ __forceinline__ void operator()(f32x4 (&acc)[2][2][4][2], const pg8::Unit& u, int wr, int wc, int fr, int fq) const {
        f32x4 s = (f32x4){0.f, 0.f, 0.f, 0.f};
#pragma unroll
        for (int ai = 0; ai < 2; ++ai)
#pragma unroll
            for (int bj = 0; bj < 2; ++bj)
#pragma unroll
                for (int m = 0; m < 4; ++m)
#pragma unroll
                    for (int n = 0; n < 2; ++n) s += acc[ai][bj][m][n];
        *(f32x4*)(D + ((size_t)(u.pm * 64 + u.pn) * 512 + wr * 256 + wc * 64 + fq * 16 + fr) * 4) = s;
    }
};
struct EpiDq {
    static constexpr int PERM = 2; static constexpr bool CARRY = false;
    unsigned char* DQ; const float* RSS; const float* CS; float wsc;
    __device__ __forceinline__ void operator()(f32x4 (&acc)[2][2][4][2], const pg8::Unit& u, int wr, int wc, int fr, int fq) const {
        asm volatile("" : "+v"(fr), "+v"(fq));
        const int row0 = u.pm * 256 + wr * 64 + fr, col0 = u.pn * 256 + wc * 64 + 16 * fq;
#pragma unroll
        for (int ai = 0; ai < 2; ++ai)
#pragma unroll
            for (int m = 0; m < 4; ++m) { const int row = row0 + ai * 128 + m * 16;
                const f32x4 r0 = *(const f32x4*)(RSS + (size_t)row * 16), r1 = *(const f32x4*)(RSS + (size_t)row * 16 + 4), r2 = *(const f32x4*)(RSS + (size_t)row * 16 + 8);
                const float ss = ((r0[0] + r0[1]) + (r0[2] + r0[3])) + ((r1[0] + r1[1]) + (r1[2] + r1[3])) + ((r2[0] + r2[1]) + (r2[2] + r2[3]));
                const float rs = __builtin_amdgcn_rsqf(ss * (1.0f / 768.0f) + RMS_EPS) * wsc;
                unsigned char* rowp = DQ + (size_t)row * 1536 + col0; u32x4 q16;
#pragma unroll
                for (int bj = 0; bj < 2; ++bj) { f32x4 v[2];
#pragma unroll
                    for (int n = 0; n < 2; ++n) { v[n] = acc[ai][bj][m][n] * rs; const int c = col0 + bj * 8 + 4 * n, w = c % 192;
                        if (w >= 128) { const f32x4 cs = *(const f32x4*)(CS + (size_t)row * 64 + (w - 128));
                            const f32x4 t = v[n]; v[n][0] = t[0] * cs[0] - t[1] * cs[1]; v[n][1] = t[0] * cs[1] + t[1] * cs[0]; v[n][2] = t[2] * cs[2] - t[3] * cs[3]; v[n][3] = t[2] * cs[3] + t[3] * cs[2]; } }
                    int w0 = 0, w1 = 0;
                    w0 = __builtin_amdgcn_cvt_pk_fp8_f32(v[0][0], v[0][1], w0, false); w0 = __builtin_amdgcn_cvt_pk_fp8_f32(v[0][2], v[0][3], w0, true);
                    w1 = __builtin_amdgcn_cvt_pk_fp8_f32(v[1][0], v[1][1], w1, false); w1 = __builtin_amdgcn_cvt_pk_fp8_f32(v[1][2], v[1][3], w1, true);
                    if (bj == 0) { q16.x = (unsigned)w0; q16.y = (unsigned)w1; } else { q16.z = (unsigned)w0; q16.w = (unsigned)w1; } }
                *(u32x4*)rowp = q16;
                asm volatile("" ::: "memory"); }
    }
};
struct EpiDkv {
    static constexpr int PERM = 2; static constexpr bool CARRY = false;
    unsigned char* D8; const float* RSS; float wsc;
    __device__ __forceinline__ void operator()(f32x4 (&acc)[2][2][4][2], const pg8::Unit& u, int wr, int wc, int fr, int fq) const {
        asm volatile("" : "+v"(fr), "+v"(fq));
        const int row0 = u.pm * 256 + wr * 64 + fr, col0 = u.pn * 256 + wc * 64 + 16 * fq;
        f32x4 r3v[2][4];
#pragma unroll
        for (int ai = 0; ai < 2; ++ai)
#pragma unroll
            for (int m = 0; m < 4; ++m) r3v[ai][m] = *(const f32x4*)(RSS + (size_t)(row0 + ai * 128 + m * 16) * 16 + 12);
#pragma unroll
        for (int ai = 0; ai < 2; ++ai)
#pragma unroll
            for (int m = 0; m < 4; ++m) { const int row = row0 + ai * 128 + m * 16;
                const f32x4 r3 = r3v[ai][m];
                const float rs = __builtin_amdgcn_rsqf(((r3[0] + r3[1]) + (r3[2] + r3[3])) * (1.0f / 256.0f) + RMS_EPS) * wsc;
                u32x4 w4;
#pragma unroll
                for (int bj = 0; bj < 2; ++bj) { const f32x4 v0 = acc[ai][bj][m][0] * rs, v1 = acc[ai][bj][m][1] * rs; int w0 = 0, w1 = 0;
                    w0 = __builtin_amdgcn_cvt_pk_fp8_f32(v0[0], v0[1], w0, false); w0 = __builtin_amdgcn_cvt_pk_fp8_f32(v0[2], v0[3], w0, true);
                    w1 = __builtin_amdgcn_cvt_pk_fp8_f32(v1[0], v1[1], w1, false); w1 = __builtin_amdgcn_cvt_pk_fp8_f32(v1[2], v1[3], w1, true);
                    if (bj == 0) { w4.x = (unsigned)w0; w4.y = (unsigned)w1; } else { w4.z = (unsigned)w0; w4.w = (unsigned)w1; } }
                *(u32x4*)(D8 + (size_t)row * D8W + col0) = w4;
                asm volatile("" ::: "memory"); }
    }
};
struct EpiMerge {
    static constexpr int PERM = 2; static constexpr bool CARRY = true;
    const unsigned char* G; unsigned char* MRG;
    __device__ __forceinline__ void operator()(f32x4 (&acc)[2][2][4][2], const pg8::Unit& u, int wr, int wc, int fr, int fq) const {
        asm volatile("" : "+v"(fr), "+v"(fq));
        const int row0 = u.pm * 256 + wr * 64 + fr, col0 = u.pn * 256 + wc * 64 + 16 * fq, z = u.z;
        const float fin = 0.001953125f * 16.0f;
        u32x4 ga[2][4], gb[2][4];
        const unsigned char* gta = G + ((((size_t)u.pm * 64 + z * 16 + u.pn) * 8 + (wr * 4 + wc)) * 8) * 1024 + (fq * 16 + fr) * 16;
        const unsigned char* gtb = gta + (z < 3 ? (size_t)16 * 8 * 8 * 1024 : 0);
#define MG_LOAD(ai_, m_) do { ga[ai_][m_] = *(const u32x4*)(gta + ((ai_) * 4 + (m_)) * 1024); \
            gb[ai_][m_] = *(const u32x4*)(gtb + ((ai_) * 4 + (m_)) * 1024); } while (0)
#pragma unroll
        for (int m = 0; m < 4; ++m) MG_LOAD(0, m);
#pragma unroll
        for (int ai = 0; ai < 2; ++ai) {
#pragma unroll
            for (int m = 0; m < 4; ++m) { const size_t row = (size_t)(row0 + ai * 128 + m * 16); u32x4 wo;
                if (ai == 0) MG_LOAD(1, m);
#pragma unroll
                for (int bj = 0; bj < 2; ++bj) { const unsigned ax = bj ? ga[ai][m].z : ga[ai][m].x, ay = bj ? ga[ai][m].w : ga[ai][m].y, bx = bj ? gb[ai][m].z : gb[ai][m].x, by = bj ? gb[ai][m].w : gb[ai][m].y;
                    float fa[8], fb[8];
                    { const f32x2 t0 = __builtin_amdgcn_cvt_pk_f32_fp8((int)ax, false), t1 = __builtin_amdgcn_cvt_pk_f32_fp8((int)ax, true), t2 = __builtin_amdgcn_cvt_pk_f32_fp8((int)ay, false), t3 = __builtin_amdgcn_cvt_pk_f32_fp8((int)ay, true);
                      fa[0] = t0[0]; fa[1] = t0[1]; fa[2] = t1[0]; fa[3] = t1[1]; fa[4] = t2[0]; fa[5] = t2[1]; fa[6] = t3[0]; fa[7] = t3[1]; }
                    { const f32x2 t0 = __builtin_amdgcn_cvt_pk_f32_fp8((int)bx, false), t1 = __builtin_amdgcn_cvt_pk_f32_fp8((int)bx, true), t2 = __builtin_amdgcn_cvt_pk_f32_fp8((int)by, false), t3 = __builtin_amdgcn_cvt_pk_f32_fp8((int)by, true);
                      fb[0] = t0[0]; fb[1] = t0[1]; fb[2] = t1[0]; fb[3] = t1[1]; fb[4] = t2[0]; fb[5] = t2[1]; fb[6] = t3[0]; fb[7] = t3[1]; }
                    float f[8];
#pragma unroll
                    for (int e = 0; e < 8; ++e) { const float ra = __builtin_amdgcn_rcpf(1.0f + __builtin_amdgcn_exp2f(fa[e]));
                        f[e] = (z < 3) ? ra * (1.0f + __builtin_amdgcn_exp2f(fb[e])) : ra * fin; }
                    f32x4 v0 = acc[ai][bj][m][0], v1 = acc[ai][bj][m][1];
                    v0[0] *= f[0]; v0[1] *= f[1]; v0[2] *= f[2]; v0[3] *= f[3]; v1[0] *= f[4]; v1[1] *= f[5]; v1[2] *= f[6]; v1[3] *= f[7];
                    if (z < 3) { acc[ai][bj][m][0] = v0; acc[ai][bj][m][1] = v1; }
                    else { int w0 = 0, w1 = 0;
                        w0 = __builtin_amdgcn_cvt_pk_fp8_f32(v0[0], v0[1], w0, false); w0 = __builtin_amdgcn_cvt_pk_fp8_f32(v0[2], v0[3], w0, true);
                        w1 = __builtin_amdgcn_cvt_pk_fp8_f32(v1[0], v1[1], w1, false); w1 = __builtin_amdgcn_cvt_pk_fp8_f32(v1[2], v1[3], w1, true);
                        if (bj == 0) { wo.x = (unsigned)w0; wo.y = (unsigned)w1; } else { wo.z = (unsigned)w0; wo.w = (unsigned)w1; } } }
                if (z == 3) *(u32x4*)(MRG + row * DM + col0) = wo; }
            asm volatile("" ::: "memory"); }
#undef MG_LOAD
    }
};
struct EpiOut {
    static constexpr int PERM = 2; static constexpr bool CARRY = false;
    const bf16_t* XBr; bf16_t* R;
    __device__ __forceinline__ void operator()(f32x4 (&acc)[2][2][4][2], const pg8::Unit& u, int wr, int wc, int fr, int fq) const {
        asm volatile("" : "+v"(fr), "+v"(fq));
        const int row0 = u.pm * 256 + wr * 64 + fr, col0 = u.pn * 256 + wc * 64 + 16 * fq;
        u32x4 xw[2][4][2];
#pragma unroll
        for (int ai = 0; ai < 2; ++ai)
#pragma unroll
            for (int m = 0; m < 4; ++m) { const size_t off = (size_t)(row0 + ai * 128 + m * 16) * DM + col0;
#pragma unroll
                for (int bj = 0; bj < 2; ++bj) xw[ai][m][bj] = *(const u32x4*)(XBr + off + bj * 8); }
#pragma unroll
        for (int ai = 0; ai < 2; ++ai) {
#pragma unroll
            for (int m = 0; m < 4; ++m) { const size_t off = (size_t)(row0 + ai * 128 + m * 16) * DM + col0;
#pragma unroll
                for (int bj = 0; bj < 2; ++bj) { const u32x4 w = xw[ai][m][bj];
                    const f32x4 x0 = (f32x4){__uint_as_float(w.x << 16), __uint_as_float(w.x & 0xffff0000u), __uint_as_float(w.y << 16), __uint_as_float(w.y & 0xffff0000u)};
                    const f32x4 x1 = (f32x4){__uint_as_float(w.z << 16), __uint_as_float(w.z & 0xffff0000u), __uint_as_float(w.w << 16), __uint_as_float(w.w & 0xffff0000u)};
                    const f32x4 r0 = x0 * DN_ALPHA + acc[ai][bj][m][0] * 0.00048828125f, r1 = x1 * DN_ALPHA + acc[ai][bj][m][1] * 0.00048828125f;
                    u32x4 w4; w4.x = cvt_pk_bf16(r0[0], r0[1]); w4.y = cvt_pk_bf16(r0[2], r0[3]); w4.z = cvt_pk_bf16(r1[0], r1[1]); w4.w = cvt_pk_bf16(r1[2], r1[3]);
                    *(u32x4*)(R + off + bj * 8) = w4; } }
            asm volatile("" ::: "memory"); }
    }
};

__device__ __forceinline__ void ln_phase(const bf16_t* R, const float* gain, const float* bias, float* OUTF, bf16_t* XB, unsigned char* X8, unsigned char* X4) {
    const int tid_ = ptid(), lane = tid_ & 63, wave = tid_ >> 6;
    const int gw = blockIdx.x * NWAVES + wave, NGW = gridDim.x * NWAVES;
    for (int row = gw; row < MTOK; row += NGW) {
        const u32x4* rp = (const u32x4*)(R + (size_t)row * DM) + lane;
        float v[8][8]; float s = 0.f;
#pragma unroll
        for (int j = 0; j < 8; ++j) { const u32x4 w = rp[64 * j];
            v[j][0] = __uint_as_float(w.x << 16); v[j][1] = __uint_as_float(w.x & 0xffff0000u); v[j][2] = __uint_as_float(w.y << 16); v[j][3] = __uint_as_float(w.y & 0xffff0000u);
            v[j][4] = __uint_as_float(w.z << 16); v[j][5] = __uint_as_float(w.z & 0xffff0000u); v[j][6] = __uint_as_float(w.w << 16); v[j][7] = __uint_as_float(w.w & 0xffff0000u);
#pragma unroll
            for (int e = 0; e < 8; ++e) s += v[j][e]; }
        const float mean = wave_sum(s) * (1.0f / DM); float q = 0.f;
#pragma unroll
        for (int j = 0; j < 8; ++j)
#pragma unroll
            for (int e = 0; e < 8; ++e) { v[j][e] -= mean; q += v[j][e] * v[j][e]; }
        const float rstd = __builtin_amdgcn_rsqf(wave_sum(q) * (1.0f / DM) + LN_EPS);
#pragma unroll
        for (int j = 0; j < 8; ++j) { const int c8 = (lane + 64 * j) * 8;
            const f32x4 g0 = *(const f32x4*)(gain + c8), g1 = *(const f32x4*)(gain + c8 + 4), b0 = *(const f32x4*)(bias + c8), b1 = *(const f32x4*)(bias + c8 + 4);
            const f32x4 o0 = (f32x4){v[j][0], v[j][1], v[j][2], v[j][3]} * rstd * g0 + b0, o1 = (f32x4){v[j][4], v[j][5], v[j][6], v[j][7]} * rstd * g1 + b1;
            if (OUTF) { *(f32x4*)(OUTF + (size_t)row * DM + c8) = o0; *(f32x4*)(OUTF + (size_t)row * DM + c8 + 4) = o1; }
            if (XB) { u32x4 w; w.x = cvt_pk_bf16(o0[0], o0[1]); w.y = cvt_pk_bf16(o0[2], o0[3]); w.z = cvt_pk_bf16(o1[0], o1[1]); w.w = cvt_pk_bf16(o1[2], o1[3]); *(u32x4*)(XB + (size_t)row * DM + c8) = w;
                int w0 = 0, w1 = 0; w0 = __builtin_amdgcn_cvt_pk_fp8_f32(o0[0], o0[1], w0, false); w0 = __builtin_amdgcn_cvt_pk_fp8_f32(o0[2], o0[3], w0, true);
                w1 = __builtin_amdgcn_cvt_pk_fp8_f32(o1[0], o1[1], w1, false); w1 = __builtin_amdgcn_cvt_pk_fp8_f32(o1[2], o1[3], w1, true);
                *(u32x2*)(X8 + (size_t)row * DM + c8) = (u32x2){(unsigned)w0, (unsigned)w1};
                *(unsigned*)(X4 + (((size_t)row * DM + c8) >> 1)) = pack_fp4x8(o0[0] * FP4_XS, o0[1] * FP4_XS, o0[2] * FP4_XS, o0[3] * FP4_XS, o1[0] * FP4_XS, o1[1] * FP4_XS, o1[2] * FP4_XS, o1[3] * FP4_XS); } }
    }
}
__device__ __forceinline__ void cumsum_phase(const float* SM, const float* f_bias, float* CUM) {
    if ((int)blockIdx.x < (int)gridDim.x - BATCH) return;
    const int tid_ = ptid(), b = (int)blockIdx.x - ((int)gridDim.x - BATCH), h = tid_ >> 6, lane = tid_ & 63;
    const float fb = f_bias[h];
    const float* src = SM + ((size_t)b * SEQ + lane * 64) * 256 + SMC_BF + h;
    float run = 0.f; float vals[64];
#pragma unroll
    for (int j = 0; j < 64; ++j) { const float xv = src[(size_t)j * 256] + fb; const float ls = fminf(xv, 0.f) - log1pf(__expf(-fabsf(xv))); run += ls; vals[j] = run; }
    float incl = run;
#pragma unroll
    for (int o = 1; o < 64; o <<= 1) { const float t = __shfl_up(incl, o); if (lane >= o) incl += t; }
    const float offs = incl - run;
    float* dst = CUM + ((size_t)b * 8 + h) * SEQ + lane * 64;
#pragma unroll
    for (int j = 0; j < 64; j += 4) *(f32x4*)(dst + j) = (f32x4){(vals[j] + offs) * LOG2E, (vals[j + 1] + offs) * LOG2E, (vals[j + 2] + offs) * LOG2E, (vals[j + 3] + offs) * LOG2E};
}
__device__ __forceinline__ void krope_phase(const float* SM, const float* CS, unsigned char* D8) {
    const size_t gt = (size_t)blockIdx.x * NTHREADS + ptid(), GT = (size_t)gridDim.x * NTHREADS;
    for (size_t i = gt; i < (size_t)MTOK * 32; i += GT) {
        const size_t row = i >> 5; const int p = (int)(i & 31);
        const f32x2 t = *(const f32x2*)(SM + row * 256 + SMC_DKR + 2 * p), cs = *(const f32x2*)(CS + row * 64 + 2 * p);
        { int w = 0; w = __builtin_amdgcn_cvt_pk_fp8_f32(t[0] * cs[0] - t[1] * cs[1], t[0] * cs[1] + t[1] * cs[0], w, false); *(unsigned short*)(D8 + row * D8W + 2048 + 2 * p) = (unsigned short)w; }
    }
}

__device__ __forceinline__ int wave_count7(unsigned c) { int t = 0;
#pragma unroll
    for (int b = 0; b < 7; ++b) t += __builtin_popcountll(__ballot((c >> b) & 1u)) << b;
    return t; }
__device__ __forceinline__ unsigned f2ord(float f) { const unsigned u = __float_as_uint(f); return u ^ ((u >> 31) ? 0xffffffffu : 0x80000000u); }
template <int DBG = 0>
__device__ __forceinline__ void indexer_unit(LAS unsigned char* lds, const bf16_t* P, const float* SM, float* SC, unsigned long long* MASK, int b, int qb) {
    constexpr int QSTR = 2064 + 256;
    constexpr int L_IQ = 0, L_STG = 32 * QSTR;
    const int tid = ptid(), wid = __builtin_amdgcn_readfirstlane(tid >> 6), lane = tid & 63, r32 = lane & 31, hi = lane >> 5;
    const int t0 = qb * 32; const size_t row0 = (size_t)b * SEQ + t0;
#pragma unroll
    for (int i = 0; i < 8; ++i) { const int ci = tid + 512 * i, r = ci >> 7, cc = ci & 127;
        const bf16x8 v = *(const bf16x8*)(P + (row0 + r) * INP + PC_AIQ + cc * 8);
        *(LAS bf16x8*)(lds + L_IQ + r * QSTR + cc * 16) = v; }
    float w[16];
    { const float* wp = SM + (row0 + r32) * 256 + SMC_AIW;
#pragma unroll
      for (int j = 0; j < 4; ++j) { const f32x4 v = *(const f32x4*)(wp + 4 * j); w[4 * j] = v[0] * 0.03125f; w[4 * j + 1] = v[1] * 0.03125f; w[4 * j + 2] = v[2] * 0.03125f; w[4 * j + 3] = v[3] * 0.03125f; } }
    __syncthreads();
    { const int r = tid >> 4, d0 = (tid & 15) * 4;
      const float* wp = SM + (row0 + r) * 256 + SMC_AIW; float qb4[4] = {0.f, 0.f, 0.f, 0.f};
#pragma unroll
      for (int h = 0; h < 16; ++h) { const float wh = wp[h] * 0.03125f; const u32x2 q2 = *(const LAS u32x2*)(lds + L_IQ + r * QSTR + (h * 64 + d0) * 2);
          qb4[0] = fmaf(wh, __uint_as_float(q2.x << 16), qb4[0]); qb4[1] = fmaf(wh, __uint_as_float(q2.x & 0xffff0000u), qb4[1]);
          qb4[2] = fmaf(wh, __uint_as_float(q2.y << 16), qb4[2]); qb4[3] = fmaf(wh, __uint_as_float(q2.y & 0xffff0000u), qb4[3]); }
      u32x2 hi2, lo2; hi2.x = cvt_pk_bf16(qb4[0], qb4[1]); hi2.y = cvt_pk_bf16(qb4[2], qb4[3]);
      lo2.x = cvt_pk_bf16(qb4[0] - __uint_as_float(hi2.x << 16), qb4[1] - __uint_as_float(hi2.x & 0xffff0000u)); lo2.y = cvt_pk_bf16(qb4[2] - __uint_as_float(hi2.y << 16), qb4[3] - __uint_as_float(hi2.y & 0xffff0000u));
      *(LAS u32x2*)(lds + L_IQ + r * QSTR + (1024 + d0) * 2) = hi2; *(LAS u32x2*)(lds + L_IQ + r * QSTR + (1088 + d0) * 2) = lo2; }
    __syncthreads();
    LAS float* stg = (LAS float*)(lds + L_STG + wid * 4608);
    const int nkt = qb + 1;
    bf16x8 kfn[4];
    if (wid < nkt) { const bf16_t* kp = P + ((size_t)b * SEQ + wid * 32 + r32) * INP + PC_AIK + 8 * hi;
#pragma unroll
      for (int st = 0; st < 4; ++st) kfn[st] = *(const bf16x8*)(kp + 16 * st); }
    for (int kt = wid; kt < (DBG == 2 ? 0 : nkt); kt += NWAVES) {
        const int s0 = kt * 32;
        int qoff = L_IQ + r32 * QSTR + hi * 16; asm volatile("" : "+v"(qoff));
        bf16x8 kf[4];
#pragma unroll
        for (int st = 0; st < 4; ++st) kf[st] = kfn[st];
        if (kt + NWAVES < nkt) { const bf16_t* kp = P + ((size_t)b * SEQ + s0 + NWAVES * 32 + r32) * INP + PC_AIK + 8 * hi;
#pragma unroll
          for (int st = 0; st < 4; ++st) kfn[st] = *(const bf16x8*)(kp + 16 * st); }
        f32x16 sc;
#pragma unroll
        for (int r = 0; r < 16; ++r) sc[r] = 0.f;
#pragma unroll
        for (int st = 0; st < 8; ++st) { const bf16x8 qf = *(const LAS bf16x8*)(lds + qoff + (1024 + 16 * st) * 2);
            sc = __builtin_amdgcn_mfma_f32_32x32x16_bf16(kf[st & 3], qf, sc, 0, 0, 0); }
        f32x16 accA, accB;
#define IDX_MM(dst, h_) do { _Pragma("unroll") for (int r = 0; r < 16; ++r) dst[r] = 0.f; \
            _Pragma("unroll") for (int st = 0; st < 4; ++st) { const bf16x8 qf = *(const LAS bf16x8*)(lds + qoff + ((h_) * 64 + 16 * st) * 2); dst = __builtin_amdgcn_mfma_f32_32x32x16_bf16(kf[st], qf, dst, 0, 0, 0); } } while (0)
#define IDX_FMA(src, h_) do { asm volatile("s_nop 15" ::: ); \
            _Pragma("unroll") for (int r = 0; r < 16; ++r) asm volatile("v_fma_f32 %0, %1, |%2|, %0" : "+v"(sc[r]) : "v"(w[h_]), "v"(src[r])); } while (0)
        IDX_MM(accA, 0);
#pragma unroll
        for (int h = 0; h < 16; h += 2) {
            IDX_MM(accB, h + 1);
            __builtin_amdgcn_sched_barrier(0);
            IDX_FMA(accA, h);
            __builtin_amdgcn_sched_barrier(0);
            if (h + 2 < 16) IDX_MM(accA, h + 2);
            __builtin_amdgcn_sched_barrier(0);
            if (h + 2 >= 16) asm volatile("s_nop 15" ::: );
            IDX_FMA(accB, h + 1);
            __builtin_amdgcn_sched_barrier(0);
        }
#undef IDX_MM
#undef IDX_FMA
#pragma unroll
        for (int g = 0; g < 4; ++g) *(LAS f32x4*)(stg + r32 * 36 + 8 * g + 4 * hi) = (f32x4){sc[4 * g], sc[4 * g + 1], sc[4 * g + 2], sc[4 * g + 3]};
        LDS_WAIT();
#pragma unroll
        for (int i = 0; i < 16; ++i) { const float v = stg[(2 * i + hi) * 36 + r32]; SC[(row0 + 2 * i + hi) * SEQ + s0 + r32] = v; }
        LDS_WAIT();
    }
    VM_WAIT();
    __syncthreads();
#define IDX_LOADROW(dst, qi_) do { int ln_ = lane; asm volatile("" : "+v"(ln_)); const float* sr_ = SC + (row0 + wid * 4 + (qi_)) * SEQ + ln_; \
        _Pragma("unroll") for (int j = 0; j < 64; ++j) dst[j] = __float_as_uint(sr_[64 * j]); } while (0)
    auto process = [&](unsigned (&key)[64], const int qi) __attribute__((always_inline)) {
        const int t = t0 + wid * 4 + qi, n = t + 1;
        int ln = lane; asm volatile("" : "+v"(ln));
#pragma unroll
        for (int j = 0; j < 64; ++j) asm volatile("" : "+v"(key[j]));
#pragma unroll
        for (int j = 0; j < 64; ++j) key[j] = (ln < n - 64 * j) ? f2ord(__uint_as_float(key[j])) : 0u;
        unsigned T = 0u; int need = 0;
        const int ng = (n + 511) >> 9;
        if (n > 256) {
            bool exact = false;
#pragma unroll 1
            for (int bit = 31; bit >= 0; --bit) {
                const unsigned cand = T | (1u << bit); int cnt = 0;
#pragma unroll
                for (int g = 0; g < 8; ++g) { if (g < ng) {
#pragma unroll
                    for (int jj = 0; jj < 8; ++jj) cnt += __builtin_popcountll(__ballot(key[8 * g + jj] >= cand)); }
                    __builtin_amdgcn_sched_barrier(0); }
                if (cnt == 256) { T = cand - 1u; exact = true; break; }
                if (cnt > 256) T = cand;
            }
            if (!exact) {
                int cgt = 0;
#pragma unroll
                for (int g = 0; g < 8; ++g) { if (g < ng) {
#pragma unroll
                    for (int jj = 0; jj < 8; ++jj) cgt += __builtin_popcountll(__ballot(key[8 * g + jj] > T)); }
                    __builtin_amdgcn_sched_barrier(0); }
                need = 256 - cgt;
            }
        }
        int mwlo = 0, mwhi = 0, run = 0; int ln2 = ln; asm volatile("" : "+v"(ln2));
#pragma unroll
        for (int g = 0; g < 8; ++g) { if (g < ng) {
#pragma unroll
            for (int jj = 0; jj < 8; ++jj) { const int j = 8 * g + jj;
                const bool eq = key[j] == T;
                const unsigned long long eqm = __ballot(eq);
                const int rank = run + (int)__builtin_amdgcn_mbcnt_hi((unsigned)(eqm >> 32), __builtin_amdgcn_mbcnt_lo((unsigned)eqm, 0u));
                const unsigned long long sel = __ballot(key[j] > T || (eq && rank < need));
                run += __builtin_popcountll(eqm);
                mwlo = (ln2 == j) ? (int)(unsigned)sel : mwlo; mwhi = (ln2 == j) ? (int)(unsigned)(sel >> 32) : mwhi;
                __builtin_amdgcn_sched_barrier(0); } }
        }
        MASK[(row0 + wid * 4 + qi) * 64 + lane] = ((unsigned long long)(unsigned)mwhi << 32) | (unsigned)mwlo;
    };
    if (DBG != 1) {
        unsigned ka[64], kb[64];
        IDX_LOADROW(ka, 0);
#pragma unroll 1
        for (int pr = 0; pr < 2; ++pr) {
            IDX_LOADROW(kb, 2 * pr + 1);
            process(ka, 2 * pr);
            if (pr == 0) IDX_LOADROW(ka, 2);
            process(kb, 2 * pr + 1);
        }
    }
#undef IDX_LOADROW
    __syncthreads();
}
template <int DBG = 0>
__device__ __forceinline__ void indexer_phase(LAS unsigned char* lds, const Args& a) {
    const bf16_t* P = (const bf16_t*)(a.ws + WS_P); const float* SM = (const float*)(a.ws + WS_SM); float* SC = (float*)(a.ws + WS_SC); unsigned long long* MASK = (unsigned long long*)(a.ws + WS_MASK);
    for (int p = blockIdx.x; p < 256; p += gridDim.x) { const int b = p >> 6, q = p & 63;
#pragma unroll 1
        for (int k = 0; k < 2; ++k) indexer_unit<DBG>(lds, P, SM, SC, MASK, b, k == 0 ? 127 - q : q); }
}

template <int OFF> __device__ __forceinline__ s16x4 tr_read(int vb) { s16x4 r; asm volatile("ds_read_b64_tr_b16 %0, %1 offset:%2" : "=&v"(r) : "v"(vb), "i"(OFF) : "memory"); return r; }
using pg8::v8i_t; using pg8::cat8;
__device__ __forceinline__ u32x2 bf8_to_fp8(bf16x8 v) { const u32x4 w = __builtin_bit_cast(u32x4, v); int a = 0, b = 0;
    a = __builtin_amdgcn_cvt_pk_fp8_f32(__uint_as_float(w.x << 16), __uint_as_float(w.x & 0xffff0000u), a, false); a = __builtin_amdgcn_cvt_pk_fp8_f32(__uint_as_float(w.y << 16), __uint_as_float(w.y & 0xffff0000u), a, true);
    b = __builtin_amdgcn_cvt_pk_fp8_f32(__uint_as_float(w.z << 16), __uint_as_float(w.z & 0xffff0000u), b, false); b = __builtin_amdgcn_cvt_pk_fp8_f32(__uint_as_float(w.w << 16), __uint_as_float(w.w & 0xffff0000u), b, true);
    return (u32x2){(unsigned)a, (unsigned)b}; }
#ifndef ATT_PV8_MASK
#define ATT_PV8_MASK 0xB
#endif
#ifndef ATT_Q8_MASK
#define ATT_Q8_MASK 0xF
#endif
template <int VAR, int DBG = 0>
__device__ __forceinline__ void attn_unit(LAS unsigned char* lds, const Args& a, int layer, int b, int hidx, int qblk, unsigned* qh, volatile LAS unsigned* bw) {
    constexpr int DQK = (VAR == 2) ? 64 : (VAR == 3 ? 192 : 128), DV = (VAR == 2) ? 64 : 128;
    constexpr bool Q8 = ((ATT_Q8_MASK >> VAR) & 1) != 0;
    constexpr bool PV8 = Q8 && ((ATT_PV8_MASK >> VAR) & 1) != 0 && DV == 128;
    constexpr bool KV8S = PV8 && VAR != 2;
    constexpr int KSTR = Q8 ? DQK + 16 : DQK * 2 + 16, VSTR = PV8 ? DV + 32 : DV * 2 + 64;
    constexpr int KCH = DQK / 8, VCH = DV / 8, KPT = DQK / 64, VPT = DV / 64, NST = DQK / 16, ND0 = DV / 32;
    constexpr int LK = 0, LV = 2 * 64 * KSTR, LCK = LV + 2 * 64 * VSTR;
    constexpr float THR = 8.0f;
    const int tid = ptid(), wid = __builtin_amdgcn_readfirstlane(tid >> 6), lane = tid & 63, r32 = lane & 31, hi = lane >> 5;
    const bf16_t* P = (const bf16_t*)(a.ws + WS_P);
    int head, q0u, tq0w, kt_lo, kt_hi, kt_last_w;
    if constexpr (VAR == 0) { head = hidx * 4 + (wid >> 1); q0u = qblk * 64; tq0w = q0u + 32 * (wid & 1); kt_lo = 0; kt_hi = qblk; kt_last_w = qblk; }
    else if constexpr (VAR == 2) { head = hidx * 8 + wid; q0u = qblk * 32; tq0w = q0u; kt_lo = (q0u > 127 ? q0u - 127 : 0) >> 6; kt_hi = (q0u + 31) >> 6; kt_last_w = kt_hi; }
    else { head = hidx; q0u = qblk * 256; tq0w = q0u + 32 * wid; kt_lo = 0; kt_hi = 4 * qblk + 3; kt_last_w = 4 * qblk + (wid >> 1); }
    const int tq = tq0w + r32; const size_t rowq = (size_t)b * SEQ + tq;
    const bf16_t* qp;
    if constexpr (VAR == 0) qp = P + rowq * INP + PC_AQ + head * 128;
    else if constexpr (VAR == 1) qp = P + rowq * INP + PC_BQ + head * 128;
    else if constexpr (VAR == 2) qp = P + rowq * INP + PC_CQ + head * 64;
    else qp = (const bf16_t*)(a.ws + WS_DQ) + rowq * 1536 + head * 192;
    bf16x8 qf[Q8 ? 1 : NST]; v8i_t q8[Q8 ? NST / 4 : 1];
    if constexpr (Q8) {
        const unsigned char* q8p = (VAR == 3) ? a.ws + WS_DQ + rowq * 1536 + head * 192
                                 : a.ws + WS_Q8 + rowq * 3072 + (VAR == 0 ? head * 128 : (VAR == 1 ? 1024 + head * 128 : 2048 + head * 64));
#pragma unroll
        for (int s4 = 0; s4 < NST / 4; ++s4) { const u32x4 c0 = *(const u32x4*)(q8p + 64 * s4 + 32 * hi), c1 = *(const u32x4*)(q8p + 64 * s4 + 32 * hi + 16);
            q8[s4] = (v8i_t){(int)c0.x, (int)c0.y, (int)c0.z, (int)c0.w, (int)c1.x, (int)c1.y, (int)c1.z, (int)c1.w}; }
    } else {
#pragma unroll
        for (int st = 0; st < NST; ++st) qf[st] = *(const bf16x8*)(qp + 16 * st + 8 * hi); }
    const bf16_t *kb, *vb_, *kb2 = nullptr; int ldk;
    if constexpr (VAR == 0) { kb = P + PC_AK + hidx * 128; vb_ = P + PC_AV + hidx * 128; ldk = INP; }
    else if constexpr (VAR == 1) { kb = P + PC_BK + head * 128; vb_ = P + PC_BV + head * 128; ldk = INP; }
    else if constexpr (VAR == 2) { kb = P + PC_CK + hidx * 64; vb_ = P + PC_CV + hidx * 64; ldk = INP; }
    else { kb = (const bf16_t*)(a.ws + WS_DKV) + head * 256; vb_ = kb + 128; kb2 = (const bf16_t*)(a.ws + WS_DKR); ldk = 2048; }
    const size_t brow = (size_t)b * SEQ;
    unsigned gk[KPT], lk[KPT], gv[VPT], lv[VPT]; bool krope[KPT];
#pragma unroll
    for (int i = 0; i < KPT; ++i) { const int ci = tid + 512 * i, kr = ci / KCH, kc = ci % KCH; krope[i] = (VAR == 3) && kc >= 16;
        gk[i] = krope[i] ? (unsigned)(kr * 64 + (kc - 16) * 8) * 2u : (unsigned)(kr * ldk + kc * 8) * 2u; lk[i] = (unsigned)(LK + kr * KSTR + kc * (Q8 ? 8 : 16)); }
#pragma unroll
    for (int i = 0; i < VPT; ++i) { const int ci = tid + 512 * i, vr = ci / VCH, vc = ci % VCH; gv[i] = (unsigned)(vr * ldk + vc * 8) * 2u; const int vrp = PV8 ? ((vr & ~15) | (vr & 3) | ((vr & 8) >> 1) | ((vr & 4) << 1)) : vr; lv[i] = (unsigned)(LV + vrp * VSTR + vc * (PV8 ? 8 : 16)); }
    const int r8_ = tid >> 3, c8_ = tid & 7, r8p_ = (r8_ & ~15) | (r8_ & 3) | ((r8_ & 8) >> 1) | ((r8_ & 4) << 1);
    constexpr int W8 = (VAR == 3) ? D8W : KV8W, VOFF8 = (VAR == 0) ? 256 : (VAR == 1 ? 1024 : 128);
    const unsigned char* kv8p = a.ws + (VAR == 3 ? WS_D8 : WS_KV8) + (VAR == 0 ? hidx * 128 : (VAR == 1 ? 512 + head * 128 : head * 256)) + (size_t)r8_ * W8 + c8_ * 16;
    const unsigned char* kr8p = a.ws + WS_D8 + 2048 + (size_t)(tid >> 2) * D8W + (tid & 3) * 16; const unsigned lkr8 = (unsigned)(LK + (tid >> 2) * KSTR + 128 + (tid & 3) * 16); u32x4 kr8 = (u32x4){0u, 0u, 0u, 0u};
    const unsigned lk8 = (unsigned)(LK + r8_ * KSTR + c8_ * 16), lv8 = (unsigned)(LV + r8p_ * VSTR + c8_ * 16); u32x4 ks8 = (u32x4){0u, 0u, 0u, 0u}, vs8 = (u32x4){0u, 0u, 0u, 0u};
    bf16x8 ks[1][KPT], vs[1][VPT]; float ckv[1] = {0.f}; unsigned long long mnx[1] = {0ull};
    const float* cum = (const float*)(a.ws + WS_CUM) + ((size_t)b * 8 + head) * SEQ;
    float cref = 0.f; if constexpr (VAR == 1) cref = cum[q0u];
    const unsigned long long* mrow = (const unsigned long long*)(a.ws + WS_MASK) + rowq * 64;
#define AT_ISSUE(kt_, S_) do { const int k0_ = (kt_) * 64; \
        const char* kt_base_ = (const char*)(kb + (brow + k0_) * ldk); const char* vt_base_ = (const char*)(vb_ + (brow + k0_) * ldk); \
        const char* k2_base_ = (VAR == 3) ? (const char*)(kb2 + (brow + k0_) * 64) : kt_base_; \
        if constexpr (KV8S) { ks8 = *(const u32x4*)(kv8p + (brow + k0_) * W8); vs8 = *(const u32x4*)(kv8p + (brow + k0_) * W8 + VOFF8); \
            if (VAR == 3 && tid < 256) kr8 = *(const u32x4*)(kr8p + (brow + k0_) * D8W); } \
        else { _Pragma("unroll") for (int i = 0; i < KPT; ++i) ks[S_][i] = *(const bf16x8*)((krope[i] ? k2_base_ : kt_base_) + gk[i]); \
               _Pragma("unroll") for (int i = 0; i < VPT; ++i) vs[S_][i] = *(const bf16x8*)(vt_base_ + gv[i]); } \
        if (VAR == 1 && tid < 64) ckv[S_] = cum[k0_ + tid]; \
        if (VAR == 0) mnx[S_] = mrow[(kt_)]; } while (0)
#define AT_WRITE(buf_, S_) do { \
        if constexpr (KV8S) { *(LAS u32x4*)(lds + (buf_) * 64 * KSTR + lk8) = ks8; *(LAS u32x4*)(lds + (buf_) * 64 * VSTR + lv8) = vs8; \
            if (VAR == 3 && tid < 256) *(LAS u32x4*)(lds + (buf_) * 64 * KSTR + lkr8) = kr8; } else { \
        _Pragma("unroll") for (int i = 0; i < KPT; ++i) { if constexpr (Q8) *(LAS u32x2*)(lds + (buf_) * 64 * KSTR + lk[i]) = bf8_to_fp8(ks[S_][i]); else *(LAS bf16x8*)(lds + (buf_) * 64 * KSTR + lk[i]) = ks[S_][i]; } \
        _Pragma("unroll") for (int i = 0; i < VPT; ++i) { if constexpr (PV8) *(LAS u32x2*)(lds + (buf_) * 64 * VSTR + lv[i]) = bf8_to_fp8(vs[S_][i]); else *(LAS bf16x8*)(lds + (buf_) * 64 * VSTR + lv[i]) = vs[S_][i]; } } \
        if (VAR == 1 && tid < 64) *(LAS float*)(lds + LCK + (buf_) * 256 + tid * 4) = cref - ckv[S_]; } while (0)
    f32x16 o[ND0];
#pragma unroll
    for (int d = 0; d < ND0; ++d)
#pragma unroll
        for (int r = 0; r < 16; ++r) o[d][r] = 0.f;
    constexpr bool MF = (VAR != 1);
    float m = MF ? -65536.0f : -1e30f, l = 0.f;
    float slope2 = 0.f;
    if constexpr (VAR == 0) slope2 = __builtin_amdgcn_exp2f(-(float)(head + 1)) * LOG2E;
    if constexpr (VAR == 2) slope2 = __builtin_amdgcn_exp2f(-0.5f * (float)(head + 1)) * LOG2E;
    const int g4 = lane >> 4, i16 = lane & 15;
    const int kq_off = r32 * KSTR + hi * (Q8 ? 32 : 16);
    const int vrd0 = (int)(uintptr_t)(lds + LV) + (4 * (g4 >> 1) + (i16 >> 2)) * VSTR + (16 * (g4 & 1) + 4 * (i16 & 3)) * 2;
    const int vrd8 = (int)(uintptr_t)(lds + LV) + (8 * (g4 >> 1) + (i16 >> 1)) * VSTR + 16 * (g4 & 1) + 8 * (i16 & 1);
    AT_ISSUE(kt_lo, 0); unsigned long long mcur = 0ull; if constexpr (VAR == 0) mcur = mnx[0];
    AT_WRITE(0, 0);
    if (DBG != 4 && kt_lo < kt_hi) AT_ISSUE(kt_lo + 1, 0);
    __syncthreads();
    bf16x8 pb[4]; v8i_t p8 = (v8i_t){0, 0, 0, 0, 0, 0, 0, 0};
#define AT_PV(D0, vrd) do { \
                const s16x4 l0 = tr_read<0 * 16 * VSTR + (D0) * 64>(vrd), h0 = tr_read<0 * 16 * VSTR + 8 * VSTR + (D0) * 64>(vrd); \
                const s16x4 l1 = tr_read<1 * 16 * VSTR + (D0) * 64>(vrd), h1 = tr_read<1 * 16 * VSTR + 8 * VSTR + (D0) * 64>(vrd); \
                const s16x4 l2 = tr_read<2 * 16 * VSTR + (D0) * 64>(vrd), h2 = tr_read<2 * 16 * VSTR + 8 * VSTR + (D0) * 64>(vrd); \
                const s16x4 l3 = tr_read<3 * 16 * VSTR + (D0) * 64>(vrd), h3 = tr_read<3 * 16 * VSTR + 8 * VSTR + (D0) * 64>(vrd); \
                asm volatile("s_waitcnt lgkmcnt(0)" ::: "memory"); __builtin_amdgcn_sched_barrier(0); \
                o[D0] = __builtin_amdgcn_mfma_f32_32x32x16_bf16((bf16x8){l0[0], l0[1], l0[2], l0[3], h0[0], h0[1], h0[2], h0[3]}, pb[0], o[D0], 0, 0, 0); \
                o[D0] = __builtin_amdgcn_mfma_f32_32x32x16_bf16((bf16x8){l1[0], l1[1], l1[2], l1[3], h1[0], h1[1], h1[2], h1[3]}, pb[1], o[D0], 0, 0, 0); \
                o[D0] = __builtin_amdgcn_mfma_f32_32x32x16_bf16((bf16x8){l2[0], l2[1], l2[2], l2[3], h2[0], h2[1], h2[2], h2[3]}, pb[2], o[D0], 0, 0, 0); \
                o[D0] = __builtin_amdgcn_mfma_f32_32x32x16_bf16((bf16x8){l3[0], l3[1], l3[2], l3[3], h3[0], h3[1], h3[2], h3[3]}, pb[3], o[D0], 0, 0, 0); } while (0)
#define AT_PV8(D0, vrd) do { \
                u32x2 t0_, t1_, t2_, t3_; \
                asm volatile("ds_read_b64_tr_b8 %0, %1 offset:%2" : "=&v"(t0_) : "v"(vrd), "i"(0 * 16 * VSTR + (D0) * 32) : "memory"); \
                asm volatile("ds_read_b64_tr_b8 %0, %1 offset:%2" : "=&v"(t1_) : "v"(vrd), "i"(1 * 16 * VSTR + (D0) * 32) : "memory"); \
                asm volatile("ds_read_b64_tr_b8 %0, %1 offset:%2" : "=&v"(t2_) : "v"(vrd), "i"(2 * 16 * VSTR + (D0) * 32) : "memory"); \
                asm volatile("ds_read_b64_tr_b8 %0, %1 offset:%2" : "=&v"(t3_) : "v"(vrd), "i"(3 * 16 * VSTR + (D0) * 32) : "memory"); \
                asm volatile("s_waitcnt lgkmcnt(0)" : "+v"(t0_), "+v"(t1_), "+v"(t2_), "+v"(t3_) :: "memory"); __builtin_amdgcn_sched_barrier(0); \
                { const v8i_t va_ = (v8i_t){(int)t0_.x, (int)t0_.y, (int)t1_.x, (int)t1_.y, (int)t2_.x, (int)t2_.y, (int)t3_.x, (int)t3_.y}; \
                  asm volatile("v_mfma_f32_32x32x64_f8f6f4 %0, %1, %2, %0" : "+v"(o[D0]) : "v"(va_), "v"(p8)); } } while (0)
#define AT_PV_ALL(vbuf_) do { if constexpr (PV8) { const int vrd_ = vrd8 + (vbuf_) * 64 * VSTR; asm volatile("s_nop 1" ::: "memory"); AT_PV8(0, vrd_); AT_PV8(1, vrd_); AT_PV8(2, vrd_); AT_PV8(3, vrd_); } \
        else { const int vrd_ = vrd0 + (vbuf_) * 64 * VSTR; AT_PV(0, vrd_); AT_PV(1, vrd_); if constexpr (ND0 == 4) { AT_PV(2, vrd_); AT_PV(3, vrd_); } } } while (0)
    for (int kt2 = kt_lo; kt2 <= kt_hi; kt2 += 2) {
#pragma unroll
    for (int hs = 0; hs < 2; ++hs) {
        const int kt = kt2 + hs; if (kt > kt_hi) break;
        const int buf = hs, k0 = kt * 64;
        if (kt <= kt_last_w && !(DBG == 6 && wid >= 4)) {
            f32x16 p[2];
            const int dq = tq - k0 - 4 * hi;
            if constexpr (VAR == 0 || VAR == 2) { const float base = -slope2 * (float)dq - m;
#pragma unroll
                for (int sub = 0; sub < 2; ++sub)
#pragma unroll
                    for (int r = 0; r < 16; ++r) p[sub][r] = fmaf(slope2, (float)(32 * sub + (r & 3) + 8 * (r >> 2)), base); }
            else if constexpr (VAR == 1) { const LAS float* ck = (const LAS float*)(lds + LCK + buf * 256);
#pragma unroll
                for (int sub = 0; sub < 2; ++sub)
#pragma unroll
                    for (int g = 0; g < 4; ++g) { const f32x4 c4 = *(const LAS f32x4*)(ck + 32 * sub + 8 * g + 4 * hi);
                        p[sub][4 * g] = c4[0]; p[sub][4 * g + 1] = c4[1]; p[sub][4 * g + 2] = c4[2]; p[sub][4 * g + 3] = c4[3]; } }
            else {
#pragma unroll
                for (int sub = 0; sub < 2; ++sub)
#pragma unroll
                    for (int r = 0; r < 16; ++r) p[sub][r] = -m; }
            const LAS unsigned char* kbuf = lds + LK + buf * 64 * KSTR + kq_off;
            if constexpr (Q8) {
                asm volatile("s_nop 1" ::: "memory");
#pragma unroll
                for (int s4 = 0; s4 < NST / 4; ++s4) {
                    const v8i_t ka = cat8(*(const LAS bf16x8*)(kbuf + s4 * 64), *(const LAS bf16x8*)(kbuf + s4 * 64 + 16));
                    const v8i_t kb8 = cat8(*(const LAS bf16x8*)(kbuf + 32 * KSTR + s4 * 64), *(const LAS bf16x8*)(kbuf + 32 * KSTR + s4 * 64 + 16));
                    if (DBG != 3) { asm volatile("v_mfma_f32_32x32x64_f8f6f4 %0, %1, %2, %0" : "+v"(p[0]) : "v"(ka), "v"(q8[s4]));
                                    asm volatile("v_mfma_f32_32x32x64_f8f6f4 %0, %1, %2, %0" : "+v"(p[1]) : "v"(kb8), "v"(q8[s4])); } }
                asm volatile("s_nop 15\n\ts_nop 7" : "+v"(p[0]), "+v"(p[1]) :: "memory");
            } else {
            constexpr int GS = (VAR == 3) ? 1 : 2, NG = NST / GS;
            bf16x8 kfa[2 * GS], kfb[2 * GS];
#define AT_LDK(dst, g_) do { _Pragma("unroll") for (int e = 0; e < GS; ++e) { dst[2 * e] = *(const LAS bf16x8*)(kbuf + (GS * (g_) + e) * 32); dst[2 * e + 1] = *(const LAS bf16x8*)(kbuf + 32 * KSTR + (GS * (g_) + e) * 32); } } while (0)
#define AT_MMK(src, g_) do { _Pragma("unroll") for (int e = 0; e < GS; ++e) { p[0] = __builtin_amdgcn_mfma_f32_32x32x16_bf16(src[2 * e], qf[GS * (g_) + e], p[0], 0, 0, 0); \
                                 p[1] = __builtin_amdgcn_mfma_f32_32x32x16_bf16(src[2 * e + 1], qf[GS * (g_) + e], p[1], 0, 0, 0); } } while (0)
            AT_LDK(kfa, 0);
#pragma unroll
            for (int g = 0; g < NG; g += 2) {
                if (g + 1 < NG) AT_LDK(kfb, g + 1);
                __builtin_amdgcn_sched_barrier(0);
                if (DBG != 3) AT_MMK(kfa, g);
                if (g + 1 < NG) { if (g + 2 < NG) AT_LDK(kfa, g + 2);
                    __builtin_amdgcn_sched_barrier(0);
                    if (DBG != 3) AT_MMK(kfb, g + 1); }
            }
#undef AT_LDK
#undef AT_MMK
            }
            if constexpr (VAR == 0) {
#pragma unroll
                for (int sub = 0; sub < 2; ++sub) { const unsigned wb = (unsigned)(mcur >> (32 * sub)) >> (4 * hi);
#pragma unroll
                    for (int r = 0; r < 16; ++r) p[sub][r] = ((wb >> ((r & 3) + 8 * (r >> 2))) & 1u) ? p[sub][r] : -INFINITY; }
            } else if constexpr (VAR == 2) {
#pragma unroll
                for (int sub = 0; sub < 2; ++sub)
#pragma unroll
                    for (int r = 0; r < 16; ++r) p[sub][r] = ((unsigned)(dq - (32 * sub + (r & 3) + 8 * (r >> 2))) <= 127u) ? p[sub][r] : -INFINITY;
            } else {
                if (k0 + 63 > tq0w) {
#pragma unroll
                    for (int sub = 0; sub < 2; ++sub)
#pragma unroll
                        for (int r = 0; r < 16; ++r) p[sub][r] = ((32 * sub + (r & 3) + 8 * (r >> 2)) <= dq) ? p[sub][r] : -INFINITY; }
            }
            if constexpr (DBG != 2) {
            asm volatile("s_nop 15\n\ts_nop 7" ::: "memory");
            float pm;
            { float ma, mb_;
              asm volatile("v_max3_f32 %0, %1, %2, %3" : "=v"(ma) : "v"(p[0][0]), "v"(p[0][1]), "v"(p[1][0]));
              asm volatile("v_max3_f32 %0, %1, %2, %3" : "=v"(mb_) : "v"(p[0][2]), "v"(p[0][3]), "v"(p[1][1]));
              asm volatile("v_max3_f32 %0, %1, %2, %3" : "+v"(ma) : "v"(ma), "v"(p[1][2]), "v"(p[1][3]));
#pragma unroll
              for (int r = 4; r < 16; r += 4) {
                  asm volatile("v_max3_f32 %0, %1, %2, %3" : "+v"(ma) : "v"(ma), "v"(p[0][r]), "v"(p[0][r + 1]));
                  asm volatile("v_max3_f32 %0, %1, %2, %3" : "+v"(mb_) : "v"(mb_), "v"(p[0][r + 2]), "v"(p[0][r + 3]));
                  asm volatile("v_max3_f32 %0, %1, %2, %3" : "+v"(ma) : "v"(ma), "v"(p[1][r]), "v"(p[1][r + 1]));
                  asm volatile("v_max3_f32 %0, %1, %2, %3" : "+v"(mb_) : "v"(mb_), "v"(p[1][r + 2]), "v"(p[1][r + 3])); }
              asm volatile("v_max_f32 %0, %1, %2" : "=v"(pm) : "v"(ma), "v"(mb_)); }
            { auto rr = __builtin_amdgcn_permlane32_swap(__float_as_uint(pm), __float_as_uint(pm), false, false); pm = fmaxf(__uint_as_float(rr[0]), __uint_as_float(rr[1])); }
            if constexpr (MF) {
                if (!__all(pm <= THR)) {
                    const float dm = fmaxf(pm, 0.f), alpha = __builtin_amdgcn_exp2f(-dm); m += dm; l *= alpha;
#pragma unroll
                    for (int d = 0; d < ND0; ++d)
#pragma unroll
                        for (int r = 0; r < 16; ++r) o[d][r] *= alpha;
#pragma unroll
                    for (int sub = 0; sub < 2; ++sub)
#pragma unroll
                        for (int r = 0; r < 16; ++r) p[sub][r] -= dm;
                }
            } else if (!__all(pm - m <= THR)) {
                const float mn = fmaxf(m, pm), alpha = __builtin_amdgcn_exp2f(m - mn); m = mn; l *= alpha;
#pragma unroll
                for (int d = 0; d < ND0; ++d)
#pragma unroll
                    for (int r = 0; r < 16; ++r) o[d][r] *= alpha;
            }
#pragma unroll
            for (int sub = 0; sub < 2; ++sub)
#pragma unroll
                for (int r = 0; r < 16; ++r) p[sub][r] = __builtin_amdgcn_exp2f(MF ? p[sub][r] : p[sub][r] - m);
            __builtin_amdgcn_sched_barrier(0);
            { float s0 = p[0][0], s1 = p[0][1], s2 = p[1][0], s3 = p[1][1];
#pragma unroll
              for (int r = 2; r < 16; r += 2) { s0 += p[0][r]; s1 += p[0][r + 1]; s2 += p[1][r]; s3 += p[1][r + 1]; }
              l += (s0 + s1) + (s2 + s3); }
            }
            if constexpr (PV8) {
#pragma unroll
                for (int w = 0; w < 8; ++w) { const int sub = w >> 2, r4 = 4 * (w & 3); int t = 0;
                    t = __builtin_amdgcn_cvt_pk_fp8_f32(p[sub][r4], p[sub][r4 + 1], t, false); t = __builtin_amdgcn_cvt_pk_fp8_f32(p[sub][r4 + 2], p[sub][r4 + 3], t, true); p8[w] = t; }
            } else {
#pragma unroll
            for (int s = 0; s < 4; ++s) { const int sub = s >> 1, k8 = 8 * (s & 1);
                u32x4 wv; wv.x = cvt_pk_bf16(p[sub][k8], p[sub][k8 + 1]); wv.y = cvt_pk_bf16(p[sub][k8 + 2], p[sub][k8 + 3]); wv.z = cvt_pk_bf16(p[sub][k8 + 4], p[sub][k8 + 5]); wv.w = cvt_pk_bf16(p[sub][k8 + 6], p[sub][k8 + 7]);
                pb[s] = __builtin_bit_cast(bf16x8, wv); }
            }
        }
        if (DBG != 4 && kt < kt_hi) AT_WRITE(buf ^ 1, 0);
        if constexpr (VAR == 0) mcur = mnx[0];
        if (DBG != 4 && kt + 1 < kt_hi) AT_ISSUE(kt + 2, 0);
        if (kt <= kt_last_w && !(DBG == 6 && wid >= 4)) {
            if (DBG != 1) AT_PV_ALL(buf);
            if (DBG == 1) { _Pragma("unroll") for (int i = 0; i < 4; ++i) o[0][i] += __uint_as_float((unsigned)pb[i][0]); }
        }
        if (DBG != 5) __syncthreads();
    }
    }
#undef AT_PV_ALL
#undef AT_PV8
#undef AT_PV
#undef AT_ISSUE
#undef AT_WRITE
    if constexpr (PV8) asm volatile("s_nop 15\n\ts_nop 15" : "+v"(o[0]), "+v"(o[1]), "+v"(o[ND0 - 2]), "+v"(o[ND0 - 1]) :: "memory");
    unsigned nx = 0u; if (threadIdx.x == 0) nx = __hip_atomic_fetch_add(qh, 1u, RLX_AGENT);
    { auto rr = __builtin_amdgcn_permlane32_swap(__float_as_uint(l), __float_as_uint(l), false, false); l = __uint_as_float(rr[0]) + __uint_as_float(rr[1]); }
    if constexpr (VAR == 2) l += __builtin_amdgcn_exp2f(a.sinks[layer * 16 + head] * LOG2E - m);
    const float inv = 1.0f / l;
    int zc, bc;
    if constexpr (VAR == 0) { zc = PC_AZ + head * 128; bc = 0 + head * 128; }
    else if constexpr (VAR == 1) { zc = PC_BZ + head * 128; bc = 1024 + head * 128; }
    else if constexpr (VAR == 2) { zc = PC_CZ + head * 64; bc = 2048 + head * 64; }
    else { zc = PC_DZ + head * 128; bc = 3072 + head * 128; }
    const unsigned char* zp = a.ws + WS_Z8 + rowq * 4096 + bc + 16 * hi; (void)zc; unsigned char* op = a.ws + (DBG ? WS_SC : WS_BR) + rowq * 4096 + bc + 16 * hi;
#pragma unroll
    for (int d = 0; d < ND0; ++d) {
#pragma unroll
        for (int jj = 0; jj < 8; ++jj) { const int r0 = jj, r1 = 8 + jj;
            const auto sw = __builtin_amdgcn_permlane32_swap(__float_as_uint(o[d][r0]), __float_as_uint(o[d][r1]), false, false);
            o[d][r0] = __uint_as_float(sw[0]); o[d][r1] = __uint_as_float(sw[1]); }
        const u32x4 za = *(const u32x4*)(zp + 32 * d);
        const unsigned zw[4] = {za.x, za.y, za.z, za.w};
        u32x4 wo;
#pragma unroll
        for (int q4 = 0; q4 < 4; ++q4) { const int rb = (q4 & 1) * 8 + (q4 >> 1) * 4;
            const f32x2 zl = __builtin_amdgcn_cvt_pk_f32_fp8((int)zw[q4], false), zh = __builtin_amdgcn_cvt_pk_f32_fp8((int)zw[q4], true); const float z0 = zl[0], z1 = zl[1], z2 = zh[0], z3 = zh[1];
            const float v0 = o[d][rb] * inv * (z0 * fast_sigmoid(z0)), v1 = o[d][rb + 1] * inv * (z1 * fast_sigmoid(z1));
            const float v2 = o[d][rb + 2] * inv * (z2 * fast_sigmoid(z2)), v3 = o[d][rb + 3] * inv * (z3 * fast_sigmoid(z3));
            int w8 = 0; w8 = __builtin_amdgcn_cvt_pk_fp8_f32(v0 * 8.0f, v1 * 8.0f, w8, false); w8 = __builtin_amdgcn_cvt_pk_fp8_f32(v2 * 8.0f, v3 * 8.0f, w8, true);
            if (q4 == 0) wo.x = (unsigned)w8; else if (q4 == 1) wo.y = (unsigned)w8; else if (q4 == 2) wo.z = (unsigned)w8; else wo.w = (unsigned)w8; }
        *(u32x4*)(op + 32 * d) = wo; }
    if (threadIdx.x == 0) bw[0] = nx;
}
template <int VAR, int DBG = 0>
__device__ __forceinline__ void attn_queue(LAS unsigned char* lds, const Args& a, int layer) {
    constexpr int NUX = (VAR == 2) ? 128 : 64;
    unsigned* qbase = (unsigned*)(a.ws + WS_CTL) + CW_Q + 64 * 8 * (layer * 4 + VAR);
    layer &= 1;
    volatile LAS unsigned* bw = (volatile LAS unsigned*)(lds + MISC_OFF + 64);
    const int myx = (int)(xb_xcc_id() & 7u);
    for (int qi = 0; qi < 8; ++qi) {
        const int x = (myx + qi) & 7;
        unsigned* qh = qbase + 64 * x;
        if (threadIdx.x == 0) bw[0] = __hip_atomic_fetch_add(qh, 1u, RLX_AGENT);
        for (;;) {
            __syncthreads();
            const int idx = (int)bw[0];
            __syncthreads();
            if (idx >= NUX) break;
            int b, hidx, qblk;
            if constexpr (VAR == 0) { qblk = 63 - idx; b = x >> 1; hidx = x & 1; }
            else if constexpr (VAR == 2) { qblk = idx; b = x >> 1; hidx = x & 1; }
            else { const int pr = 4 * x + 2 * (idx >> 5) + (idx & 1); qblk = 15 - ((idx & 31) >> 1); b = pr >> 3; hidx = pr & 7; }
            attn_unit<VAR, DBG>(lds, a, layer, b, hidx, qblk, qh, bw);
        }
    }
}

constexpr int N_PHASES = 1 + 6 * DEPTH;
#ifndef DUP_PHASE
#define DUP_PHASE -1
#endif
__global__ void __launch_bounds__(NTHREADS, 2) mega_fwd(Args a) {
    extern __shared__ __attribute__((aligned(16))) unsigned char lds_raw[];
    LAS unsigned char* lds = (LAS unsigned char*)lds_raw;
    const int tid = threadIdx.x;
    for (int u = tid; u < (LDS_BYTES - LDSCTL_OFF) / 4; u += NTHREADS) ((LAS unsigned*)(lds + LDSCTL_OFF))[u] = 0u;
    __syncthreads();
    unsigned* ctl = (unsigned*)(a.ws + WS_CTL);
    const int lo = a.ph_lo, hi = a.ph_hi;
    const bool multi = (hi - lo) > 1;
    XcdBarrier bar; bar.bar = ctl + CW_BAR; bar.x = 0; bar.st = nullptr;
    if (multi) bar = xcd_barrier_post(ctl + CW_BAR, (volatile LAS unsigned*)(lds + MISC_OFF + 32));
#define IN(k) (lo <= (k) && (k) < hi)
#define SEAM(k) do { if (IN(k) && IN((k) + 1)) xcd_barrier(bar); } while (0)
    unsigned char* ws = a.ws;
    bf16_t* XB = (bf16_t*)(ws + WS_XB); bf16_t* P = (bf16_t*)(ws + WS_P); unsigned char* Gt = ws + WS_G;
    float* SM = (float*)(ws + WS_SM); float* RSS = (float*)(ws + WS_RSS); float* CS = (float*)(ws + WS_CS);
    unsigned char* W = ws + WS_W;

    if (IN(0)) { convert_weights(a, 0, lds); prologue_misc(a); }
    SEAM(0);
    for (int layer = 0; layer < DEPTH; ++layer) {
        const int pb = 1 + 6 * layer;
        if (IN(pb + 0)) {
            { pg8::Gemm g{(const bf16_t*)(ws + WS_X4), (const bf16_t*)(W + WO_WG8), DM / 4, DM / 4, DM / 4, 0, 0}; pg8::StaticOrder S; S.init(MTOK, NGATE, gridDim.x, blockIdx.x, 8);
              EpiGate E{Gt, -LOG2E / (FP4_XS * FP4_WS * 0.9761f)};
              pg8::gemm_phase<EpiGate, pg8::StaticOrder, true, false, true>(lds, g, S, E);
#if DUP_PHASE == 1001
              pg8::gemm_phase<EpiGate, pg8::StaticOrder, true, true>(lds, g, S, E);
#endif
#if DUP_PHASE == 1002
              { EpiNull E0{(float*)(ws + WS_SC)}; pg8::gemm_phase<EpiNull, pg8::StaticOrder, true, true>(lds, g, S, E0); }
#endif
              }
            { pg8::Gemm g{(const bf16_t*)(ws + WS_X8), (const bf16_t*)(W + WO_WIN8), DM / 2, DM / 2, DM / 2, 0, 0}; pg8::StaticOrder S; S.init(MTOK, NIN8, gridDim.x, blockIdx.x);
              EpiIn E{P, SM, RSS, 1, ws + WS_KV8, ws + WS_L8, ws + WS_Z8, ws + WS_Q8};
              pg8::gemm_phase<EpiIn, pg8::StaticOrder, true, true>(lds, g, S, E); }
            { pg8::Gemm g{(const bf16_t*)(ws + WS_X4), (const bf16_t*)(W + WO_WZ4), DM / 4, DM / 4, DM / 4, 0, 0}; pg8::StaticOrder S; S.init(MTOK, NINZ, gridDim.x, blockIdx.x, 8);
              EpiIn E{P, SM, RSS, 2, ws + WS_KV8, ws + WS_L8, ws + WS_Z8, ws + WS_Q8};
              pg8::gemm_phase<EpiIn, pg8::StaticOrder, true, false, true>(lds, g, S, E); }
            { pg8::Gemm g{XB, (const bf16_t*)(W + WO_WINB), DM, DM, DM, 0, 0}; pg8::StaticOrder S; S.init(MTOK, NINB, gridDim.x, (blockIdx.x + 64) % gridDim.x, 2);
              EpiIn E{P, SM, RSS, 0, ws + WS_KV8, ws + WS_L8, ws + WS_Z8, ws + WS_Q8};
              pg8::gemm_phase<EpiIn, pg8::StaticOrder>(lds, g, S, E); }
        }
        SEAM(pb + 0);
        if (IN(pb + 1)) {
            cumsum_phase(SM, a.f_bias + layer * 8, (float*)(ws + WS_CUM));
            krope_phase(SM, CS, ws + WS_D8);
            { pg8::Gemm g{(const bf16_t*)(ws + WS_L8), (const bf16_t*)(W + WO_DQUP), 384, 512, 384, 0, 0}; pg8::StaticOrder S; S.init(MTOK, 1536, gridDim.x, blockIdx.x);
              EpiDq E{ws + WS_DQ, RSS, CS, 1.0f / DQ_WS};
              pg8::gemm_phase<EpiDq, pg8::StaticOrder, true, true>(lds, g, S, E); }
            { pg8::Gemm g{(const bf16_t*)(ws + WS_L8 + 768), (const bf16_t*)(W + WO_DKVUP), 128, 512, 128, 0, 0}; pg8::StaticOrder S; S.init(MTOK, 2048, gridDim.x, blockIdx.x);
              EpiDkv E{ws + WS_D8, RSS, 1.0f / DKV_WS};
              pg8::gemm_phase<EpiDkv, pg8::StaticOrder, true, true>(lds, g, S, E); }
            indexer_phase(lds, a);
#if DUP_PHASE == 1 || DUP_PHASE == 11
            { pg8::Gemm g{P + PC_DCQ, (const bf16_t*)(W + WO_DQUP), 768, INP, 768, 0, 0}; pg8::StaticOrder S; S.init(MTOK, 1536, gridDim.x, blockIdx.x);
              EpiDq E{(bf16_t*)(ws + WS_DQ), RSS, CS};
              pg8::gemm_phase<EpiDq, pg8::StaticOrder>(lds, g, S, E); }
            { pg8::Gemm g{P + PC_DCKV, (const bf16_t*)(W + WO_DKVUP), 256, INP, 256, 0, 0}; pg8::StaticOrder S; S.init(MTOK, 2048, gridDim.x, blockIdx.x);
              EpiDkv E{ws + WS_D8, RSS};
              pg8::gemm_phase<EpiDkv, pg8::StaticOrder>(lds, g, S, E); }
#endif
#if DUP_PHASE == 1 || DUP_PHASE == 12
            indexer_phase(lds, a);
#endif
        }
        SEAM(pb + 1);
        if (IN(pb + 2)) {
            attn_queue<3>(lds, a, layer);
            attn_queue<1>(lds, a, layer);
            attn_queue<0>(lds, a, layer);
            attn_queue<2>(lds, a, layer);
#if DUP_PHASE == 2 || DUP_PHASE == 23
            attn_queue<3>(lds, a, layer + 2);
#endif
#if DUP_PHASE == 2 || DUP_PHASE == 21
            attn_queue<1>(lds, a, layer + 2);
#endif
#if DUP_PHASE >= 210 && DUP_PHASE <= 219
            attn_queue<1, DUP_PHASE - 210>(lds, a, layer + 2);
#endif
#if DUP_PHASE == 2 || DUP_PHASE == 20
            attn_queue<0>(lds, a, layer + 2);
#endif
#if DUP_PHASE == 2 || DUP_PHASE == 22
            attn_queue<2>(lds, a, layer + 2);
#endif
        }
        SEAM(pb + 2);
        if (IN(pb + 3)) {
            pg8::Gemm g{(const bf16_t*)(ws + WS_BR), (const bf16_t*)(W + WO_WBR), 512, 2048, 512, (size_t)1024, (size_t)DM * 1024};
            pg8::ZOrder<4> S; S.init(MTOK, DM, gridDim.x, blockIdx.x);
            EpiMerge E{Gt, ws + WS_MRG};
            pg8::gemm_phase<EpiMerge, pg8::ZOrder<4>, true, true>(lds, g, S, E);
#if DUP_PHASE == 3
            pg8::gemm_phase<EpiMerge, pg8::ZOrder<4>, true, true>(lds, g, S, E);
#endif
        }
        SEAM(pb + 3);
        if (IN(pb + 4)) {
            pg8::Gemm g{(const bf16_t*)(ws + WS_MRG), (const bf16_t*)(W + WO_WOUT), DM / 2, DM / 2, DM / 2, 0, 0}; pg8::StaticOrder S; S.init(MTOK, DM, gridDim.x, blockIdx.x);
            EpiOut E{XB, (bf16_t*)(ws + WS_R)};
            pg8::gemm_phase<EpiOut, pg8::StaticOrder, true, true>(lds, g, S, E);
#if DUP_PHASE == 4
            pg8::gemm_phase<EpiOut, pg8::StaticOrder, true, true>(lds, g, S, E);
#endif
        }
        SEAM(pb + 4);
        if (IN(pb + 5)) {
            ln_phase((const bf16_t*)(ws + WS_R), a.ln_gain + layer * DM, a.ln_bias + layer * DM, layer + 1 < DEPTH ? nullptr : a.out, layer + 1 < DEPTH ? XB : nullptr, ws + WS_X8, ws + WS_X4);
            if (layer + 1 < DEPTH) convert_weights(a, layer + 1, lds);
#if DUP_PHASE == 5
            ln_phase((const bf16_t*)(ws + WS_R), a.ln_gain + layer * DM, a.ln_bias + layer * DM, layer + 1 < DEPTH ? nullptr : a.out, layer + 1 < DEPTH ? XB : nullptr, ws + WS_X8, ws + WS_X4);
            if (layer + 1 < DEPTH) convert_weights(a, layer + 1, lds);
#endif
        }
        if (layer + 1 < DEPTH) SEAM(pb + 5);
    }
#undef IN
#undef SEAM
}

#ifdef PROBE_KERNEL
__global__ void __launch_bounds__(NTHREADS, 2) probe_fwd(Args a) {
    extern __shared__ __attribute__((aligned(16))) unsigned char lds_raw[];
    LAS unsigned char* lds = (LAS unsigned char*)lds_raw;
    unsigned char* ws = a.ws; unsigned char* W = ws + WS_W;
#if PROBE_KERNEL == 1 || PROBE_KERNEL == 2 || PROBE_KERNEL == 4
    pg8::Gemm g{(const bf16_t*)(ws + WS_X8), (const bf16_t*)(W + WO_WG8), DM / 2, DM / 2, DM / 2, 0, 0}; pg8::StaticOrder S; S.init(MTOK, NGATE, gridDim.x, blockIdx.x);
#if PROBE_KERNEL == 1
    EpiGate E{ws + WS_G}; pg8::gemm_phase<EpiGate, pg8::StaticOrder, true, true>(lds, g, S, E);
#elif PROBE_KERNEL == 4
    EpiGate E{ws + WS_G}; pg8::gemm_phase<EpiGate, pg8::StaticOrder, false, true>(lds, g, S, E);
#else
    EpiNull E{(float*)(ws + WS_SC)}; pg8::gemm_phase<EpiNull, pg8::StaticOrder, true, true>(lds, g, S, E);
#endif
#endif
#if PROBE_KERNEL >= 10 && PROBE_KERNEL < 20
    attn_queue<1, PROBE_KERNEL - 10>(lds, a, 3);
#endif
#if PROBE_KERNEL == 20 || PROBE_KERNEL == 21
    { pg8::Gemm g{(const bf16_t*)(ws + WS_BR), (const bf16_t*)(W + WO_WBR), 512, 2048, 512, (size_t)1024, (size_t)DM * 1024}; pg8::ZOrder<4> S; S.init(MTOK, DM, gridDim.x, blockIdx.x);
#if PROBE_KERNEL == 20
      EpiMerge E{ws + WS_G, ws + WS_MRG}; pg8::gemm_phase<EpiMerge, pg8::ZOrder<4>, true, true>(lds, g, S, E);
#else
      EpiNull E{(float*)(ws + WS_SC)}; pg8::gemm_phase<EpiNull, pg8::ZOrder<4>, true, true>(lds, g, S, E);
#endif
    }
#endif
#if PROBE_KERNEL == 22
    { pg8::Gemm g{(const bf16_t*)(ws + WS_MRG), (const bf16_t*)(W + WO_WOUT), DM / 2, DM / 2, DM / 2, 0, 0}; pg8::StaticOrder S; S.init(MTOK, DM, gridDim.x, blockIdx.x);
      EpiOut E{(const bf16_t*)(ws + WS_XB), (bf16_t*)(ws + WS_SC)}; pg8::gemm_phase<EpiOut, pg8::StaticOrder, true, true>(lds, g, S, E); }
#endif
#if PROBE_KERNEL == 30
    convert_weights(a, 1, lds);
#endif
#if PROBE_KERNEL == 31
    ln_phase((const bf16_t*)(ws + WS_R), a.ln_gain + DM, a.ln_bias + DM, a.out, nullptr, ws + WS_X8);
#endif
#if PROBE_KERNEL == 32
    indexer_phase(lds, a);
#endif
#if PROBE_KERNEL == 33
    indexer_phase<1>(lds, a);
#endif
#if PROBE_KERNEL == 34
    indexer_phase<2>(lds, a);
#endif
#if PROBE_KERNEL == 3
    pg8::Gemm g{(const bf16_t*)(ws + WS_XB), (const bf16_t*)(W + WO_WG8), DM / 2, DM / 2, DM / 2, 0, 0}; pg8::StaticOrder S; S.init(MTOK, NGATE, gridDim.x, blockIdx.x);
    EpiNull E{(float*)(ws + WS_SC)}; pg8::gemm_phase<EpiNull, pg8::StaticOrder, true, false>(lds, g, S, E);
#endif
}
#endif

#ifndef MK_N_LAUNCHES
#define MK_N_LAUNCHES 1
#endif
extern "C" void kernel_launch(void* const* d_in, const int* in_sizes, int n_in, void* d_out, int out_size, void* d_ws, size_t ws_size, hipStream_t stream) {
    static int grid = 0;
    if (grid == 0) {
        if (n_in != 14 || in_sizes[0] != MTOK * DM || out_size != MTOK * DM || ws_size < WS_END) {
            fprintf(stderr, "kernel_launch: unexpected shapes / workspace: n_in %d in0 %d out %d ws %zu (need >= %zu)\n", n_in, n_in > 0 ? in_sizes[0] : -1, out_size, ws_size, (size_t)WS_END); grid = -1; return; }
        int dev = 0, cus = 0, per_cu = 0;
        if (hipGetDevice(&dev) != hipSuccess || hipDeviceGetAttribute(&cus, hipDeviceAttributeMultiprocessorCount, dev) != hipSuccess) { grid = -1; return; }
        if (hipFuncSetAttribute((const void*)mega_fwd, hipFuncAttributeMaxDynamicSharedMemorySize, LDS_BYTES) != hipSuccess) { fprintf(stderr, "kernel_launch: hipFuncSetAttribute failed\n"); grid = -1; return; }
        if (hipOccupancyMaxActiveBlocksPerMultiprocessor(&per_cu, (const void*)mega_fwd, NTHREADS, LDS_BYTES) != hipSuccess || per_cu < 1) {
            fprintf(stderr, "kernel_launch: occupancy query reports %d workgroups per CU\n", per_cu); }
        (void)hipGetLastError();
        grid = cus;
    }
    if (grid < 0) return;
    (void)hipMemsetAsync((char*)d_ws + WS_CTL, 0, CTL_ZERO_BYTES, stream);
    Args a{};
    a.x = (const float*)d_in[0]; a.pos = (const int*)d_in[1]; a.w_in = (const float*)d_in[2]; a.w_gate = (const float*)d_in[3]; a.w_branch = (const float*)d_in[4]; a.w_out = (const float*)d_in[5];
    a.dq_gain = (const float*)d_in[6]; a.dq_up = (const float*)d_in[7]; a.dkv_gain = (const float*)d_in[8]; a.dkv_up = (const float*)d_in[9]; a.f_bias = (const float*)d_in[10];
    a.sinks = (const float*)d_in[11]; a.ln_gain = (const float*)d_in[12]; a.ln_bias = (const float*)d_in[13];
    a.out = (float*)d_out; a.ws = (unsigned char*)d_ws;
#if MK_N_LAUNCHES == 1
    a.ph_lo = 0; a.ph_hi = N_PHASES;
    hipLaunchKernelGGL(mega_fwd, dim3(grid), dim3(NTHREADS), LDS_BYTES, stream, a);
#else
    for (int p = 0; p < N_PHASES; ++p) { a.ph_lo = p; a.ph_hi = p + 1; hipLaunchKernelGGL(mega_fwd, dim3(grid), dim3(NTHREADS), LDS_BYTES, stream, a); }
#endif
#ifdef PROBE_KERNEL
    { static int once = 0; if (!once) { (void)hipFuncSetAttribute((const void*)probe_fwd, hipFuncAttributeMaxDynamicSharedMemorySize, LDS_BYTES); once = 1; }
      hipLaunchKernelGGL(probe_fwd, dim3(grid), dim3(NTHREADS), LDS_BYTES, stream, a); }
#endif
    const hipError_t le = hipPeekAtLastError();
    if (le != hipSuccess) fprintf(stderr, "kernel_launch: launch failed: %s\n", hipGetErrorName(le));
}
```

```cpp
#include <hip/hip_runtime.h>
#include <cstdio>
#include <cstdint>

#define LAS __attribute__((address_space(3)))
#define GAS __attribute__((address_space(1)))
typedef unsigned short bf16_t;
typedef short bf16x8 __attribute__((ext_vector_type(8)));
typedef short s16x4 __attribute__((ext_vector_type(4)));
typedef float f32x4 __attribute__((ext_vector_type(4)));
typedef float f32x2 __attribute__((ext_vector_type(2)));
typedef float f32x16 __attribute__((ext_vector_type(16)));
typedef unsigned u32x4 __attribute__((ext_vector_type(4)));
typedef unsigned u32x2 __attribute__((ext_vector_type(2)));

typedef __bf16 bf16x2_t __attribute__((ext_vector_type(2)));
__device__ __forceinline__ unsigned cvt_pk_bf16(float lo, float hi) { const f32x2 v = {lo, hi}; const bf16x2_t b = __builtin_convertvector(v, bf16x2_t); return __builtin_bit_cast(unsigned, b); }
__device__ __forceinline__ int ptid() { int t = threadIdx.x; asm volatile("" : "+v"(t)); return t; }
__device__ __forceinline__ float bf2f(unsigned short b) { return __uint_as_float(((unsigned)b) << 16); }

namespace pg8 {
constexpr int BM = 256, BK = 64, HALF = 128, HTB = HALF * BK * 2  , STAGE_BYTES = 8 * HTB, NXCD = 8, WGM = 4;
__host__ __device__ __forceinline__ int lds_byte(int r, int c) { const int st = (r >> 4) * 2 + (c >> 5), rr = r & 15, cc = c & 31, ob = rr * 64 + cc * 2; return st * 1024 + (ob ^ (((ob >> 9) & 1) << 5)); }
__host__ __device__ __forceinline__ void stage_rc(int b, int& R, int& C) { const int st = b / 1024, sb = b % 1024, swz = sb ^ (((sb >> 9) & 1) << 5); R = (st >> 1) * 16 + swz / 64; C = (st & 1) * 32 + (swz % 64) / 2; }
__host__ __device__ __forceinline__ int perm32(int rho) { const int n = rho >> 4, i = rho & 15; return 8 * (i >> 2) + 4 * n + (i & 3); }

struct Unit { int pm, pn, z; };
struct Gemm { const bf16_t* A; const bf16_t* Bt; int K, lda, ldb; size_t zA, zB; };

__device__ __forceinline__ void tile_of(int L, int nM, int nN, int& pm, int& pn, int WGM = pg8::WGM) {
    const int nwg = nM * nN; int wgid = L; { const int q = nwg / NXCD, r = nwg % NXCD, xcd = wgid % NXCD, off = wgid / NXCD; wgid = (xcd < r ? xcd * (q + 1) : r * (q + 1) + (xcd - r) * q) + off; }
    const int nig = WGM * nN, gid = wgid / nig, fm = gid * WGM, gsz = (nM - fm) < WGM ? (nM - fm) : WGM;
    pm = fm + ((wgid % nig) % gsz); pn = (wgid % nig) / gsz;
}
struct StaticOrder {
    int nM, nN, nwg, G, c, wgm;
    __device__ void init(int M, int N, int G_, int c_, int wgm_ = WGM) { nM = M / BM; nN = N / BM; nwg = nM * nN; G = G_; c = c_; wgm = wgm_; }
    __device__ bool next(int i, Unit& u) const { const long L = (long)i * G + c; if (L >= nwg) return false; tile_of((int)L, nM, nN, u.pm, u.pn, wgm); u.z = 0; return true; }
};
template <int Z> struct ZOrder {
    int nM, nN, nwg, G, c;
    __device__ void init(int M, int N, int G_, int c_) { nM = M / BM; nN = N / BM; nwg = nM * nN; G = G_; c = c_; }
    __device__ bool next(int i, Unit& u) const { const long L = (long)(i / Z) * G + c; if (L >= nwg) return false; tile_of((int)L, nM, nN, u.pm, u.pn); u.z = i % Z; return true; }
};

typedef int v8i_t __attribute__((ext_vector_type(8)));
typedef int v4i_t __attribute__((ext_vector_type(4)));
__device__ __forceinline__ v8i_t cat8(bf16x8 lo, bf16x8 hi) { const v4i_t a = __builtin_bit_cast(v4i_t, lo), b = __builtin_bit_cast(v4i_t, hi); return __builtin_shufflevector(a, b, 0, 1, 2, 3, 4, 5, 6, 7); }
template <class Epi, class Sched, bool ALIGN_EPI = true, bool F8 = false, bool F4 = false>
__device__ __forceinline__ void gemm_phase(LAS unsigned char* lds, const Gemm g, const Sched& S, const Epi& E) {
    const int tid = ptid(), wid = __builtin_amdgcn_readfirstlane(tid >> 6), lane = tid & 63, wr = wid >> 2, wc = wid & 3, fr = lane & 15, fq = lane >> 4;
    const int K = g.K, nt = K / BK;
    unsigned voffA[2], voffB[2];
#pragma unroll
    for (int i = 0; i < 2; ++i) { int R, C; stage_rc(tid * 16 + i * 8192, R, C);
        const int Rb = (int)Epi::PERM == 2 ? (64 * (R >> 5) + 16 * ((R >> 2) & 3) + 4 * ((R >> 4) & 1) + (R & 3)) : ((int)Epi::PERM == 1 ? ((R & ~31) + perm32(R & 31)) : R);
        voffA[i] = (unsigned)(R * g.lda + C) * 2u; voffB[i] = (unsigned)(Rb * g.ldb + C) * 2u; }
    const size_t kstep = (size_t)(BK * 2);
    const size_t hstepA = (size_t)HALF * g.lda * 2, hstepB = (size_t)((int)Epi::PERM == 2 ? 8 : HALF) * g.ldb * 2;
    const size_t tstepA = 2 * hstepA, tstepB = (size_t)BM * g.ldb * 2;
    const unsigned ldsw = (unsigned)wid * 1024u;
    const int aoff = lds_byte(wr * 64 + fr, fq * 8), boff = lds_byte(wc * 32 + fr, fq * 8);
#define PG8_SA(b, h) (((b) * 2 + (h)) * HTB)
#define PG8_SB(b, h) ((4 + (b) * 2 + (h)) * HTB)
#define PG8_STAGE(bufoff, gbase, voff) do { _Pragma("unroll") for (int _i = 0; _i < 2; ++_i) \
        __builtin_amdgcn_global_load_lds((const unsigned*)((const char*)(gbase) + (voff)[_i]), (LAS unsigned*)(lds + (bufoff) + ldsw + _i * 8192), 16, 0, 0); } while (0)
#define PG8_LDA(dst, b, h) do { _Pragma("unroll") for (int m = 0; m < 4; ++m) { if constexpr (F8) dst##8[m] = cat8(*(const LAS bf16x8*)(lds + PG8_SA(b, h) + aoff + m * 2048), *(const LAS bf16x8*)(lds + PG8_SA(b, h) + aoff + m * 2048 + 1024)); \
        else { _Pragma("unroll") for (int k = 0; k < 2; ++k) dst[m][k] = *(const LAS bf16x8*)(lds + PG8_SA(b, h) + aoff + m * 2048 + k * 1024); } } } while (0)
#define PG8_LDB(dst, b, h) do { _Pragma("unroll") for (int n = 0; n < 2; ++n) { if constexpr (F8) dst##8[n] = cat8(*(const LAS bf16x8*)(lds + PG8_SB(b, h) + boff + n * 2048), *(const LAS bf16x8*)(lds + PG8_SB(b, h) + boff + n * 2048 + 1024)); \
        else { _Pragma("unroll") for (int k = 0; k < 2; ++k) dst[n][k] = *(const LAS bf16x8*)(lds + PG8_SB(b, h) + boff + n * 2048 + k * 1024); } } } while (0)
#define PG8_MMA(ai, bj, At, Bt) do { __builtin_amdgcn_s_setprio(1); _Pragma("unroll") for (int m = 0; m < 4; ++m) _Pragma("unroll") for (int n = 0; n < 2; ++n) { \
        if constexpr (F8) asm volatile("v_mfma_f32_16x16x128_f8f6f4 %0, %1, %2, %0" : "+v"(acc[ai][bj][m][n]) : "v"(Bt##8[n]), "v"(At##8[m]));   \
        else if constexpr (F4) { _Pragma("unroll") for (int k = 0; k < 2; ++k) asm volatile("v_mfma_f32_16x16x128_f8f6f4 %0, %1, %2, %0 cbsz:4 blgp:4" : "+v"(acc[ai][bj][m][n]) : "v"(Bt[n][k]), "v"(At[m][k])); } \
        else { _Pragma("unroll") for (int k = 0; k < 2; ++k) acc[ai][bj][m][n] = __builtin_amdgcn_mfma_f32_16x16x32_bf16(Bt[n][k], At[m][k], acc[ai][bj][m][n], 0, 0, 0); } } \
        __builtin_amdgcn_s_setprio(0); } while (0)
#define PG8_WAIT_V(n) asm volatile("s_waitcnt vmcnt(" #n ")" ::: "memory")
#define PG8_WAIT_L(n) asm volatile("s_waitcnt lgkmcnt(" #n ")" ::: "memory")
#define PG8_BAR __builtin_amdgcn_s_barrier()
#define PG8_SCHED __builtin_amdgcn_sched_barrier(0)
    Unit cur, nxt; int ui = 0;
    if (!S.next(0, cur)) return;
    f32x4 acc[2][2][4][2];
#pragma unroll
    for (int a = 0; a < 2; ++a)
#pragma unroll
        for (int b = 0; b < 2; ++b)
#pragma unroll
            for (int m = 0; m < 4; ++m)
#pragma unroll
                for (int n = 0; n < 2; ++n) acc[a][b][m][n] = (f32x4){0.f, 0.f, 0.f, 0.f};
    bf16x8 At[4][2], B0[2][2], B1[2][2]; v8i_t At8[4], B08[2], B18[2];
    const char* cA = (const char*)g.A + (size_t)cur.z * g.zA + (size_t)cur.pm * tstepA; const char* cB = (const char*)g.Bt + (size_t)cur.z * g.zB + (size_t)cur.pn * tstepB;
    PG8_STAGE(PG8_SB(0, 0), cB, voffB); PG8_STAGE(PG8_SB(0, 1), cB + hstepB, voffB); PG8_STAGE(PG8_SA(0, 0), cA, voffA); PG8_STAGE(PG8_SA(0, 1), cA + hstepA, voffA);
    if (wr == 1) PG8_BAR;
    PG8_WAIT_V(2); PG8_BAR;
    PG8_STAGE(PG8_SB(1, 0), cB + kstep, voffB); PG8_STAGE(PG8_SA(1, 0), cA + kstep, voffA); PG8_STAGE(PG8_SB(1, 1), cB + hstepB + kstep, voffB);
    PG8_WAIT_V(6); PG8_BAR;
    for (;;) {
        const bool has_next = S.next(ui + 1, nxt);
        const char* nA = has_next ? (const char*)g.A + (size_t)nxt.z * g.zA + (size_t)nxt.pm * tstepA : cA; const char* nB = has_next ? (const char*)g.Bt + (size_t)nxt.z * g.zB + (size_t)nxt.pn * tstepB : cB;
#pragma unroll 1
        for (int t = 0; t < nt; t += 2) {
            const bool last = (t == nt - 2);
            const char* a1 = cA + (size_t)(t + 1) * kstep;
            const char* a2 = last ? nA : cA + (size_t)(t + 2) * kstep; const char* b2 = last ? nB : cB + (size_t)(t + 2) * kstep;
            const char* a3 = a2 + kstep; const char* b3 = b2 + kstep;
            PG8_LDB(B0, 0, 0); PG8_LDB(B1, 0, 1); PG8_SCHED; PG8_LDA(At, 0, 0); PG8_STAGE(PG8_SA(1, 1), a1 + hstepA, voffA);
            PG8_WAIT_V(8); PG8_WAIT_L(0); PG8_BAR; PG8_MMA(0, 0, At, B0); PG8_MMA(0, 1, At, B1); PG8_BAR; PG8_SCHED;
            PG8_LDA(At, 0, 1); PG8_STAGE(PG8_SB(0, 0), b2, voffB); PG8_STAGE(PG8_SB(0, 1), b2 + hstepB, voffB); PG8_STAGE(PG8_SA(0, 0), a2, voffA);
            PG8_WAIT_V(8); PG8_WAIT_L(0); PG8_BAR; PG8_MMA(1, 0, At, B0); PG8_MMA(1, 1, At, B1); PG8_BAR; PG8_SCHED;
            PG8_LDB(B0, 1, 0); PG8_LDB(B1, 1, 1); PG8_SCHED; PG8_LDA(At, 1, 0); PG8_STAGE(PG8_SA(0, 1), a2 + hstepA, voffA);
            PG8_WAIT_V(8); PG8_WAIT_L(0); PG8_BAR; PG8_MMA(0, 0, At, B0); PG8_MMA(0, 1, At, B1); PG8_BAR; PG8_SCHED;
            PG8_LDA(At, 1, 1); PG8_STAGE(PG8_SB(1, 0), b3, voffB); PG8_STAGE(PG8_SB(1, 1), b3 + hstepB, voffB); PG8_STAGE(PG8_SA(1, 0), a3, voffA);
            PG8_WAIT_V(8); PG8_WAIT_L(0); PG8_BAR; PG8_MMA(1, 0, At, B0); PG8_MMA(1, 1, At, B1); PG8_BAR; PG8_SCHED;
        }
        if constexpr (ALIGN_EPI) { if (wr == 0) PG8_BAR; }
        if constexpr (F8 || F4) asm volatile("s_nop 15\n\ts_nop 15" ::: "memory");
        E(acc, cur, wr, wc, fr, fq);
        if (!has_next) break;
        if (!(Epi::CARRY && nxt.z != 0))
#pragma unroll
        for (int a = 0; a < 2; ++a)
#pragma unroll
            for (int b = 0; b < 2; ++b)
#pragma unroll
                for (int m = 0; m < 4; ++m)
#pragma unroll
                    for (int n = 0; n < 2; ++n) acc[a][b][m][n] = (f32x4){0.f, 0.f, 0.f, 0.f};
        cur = nxt; cA = nA; cB = nB; ++ui;
        if constexpr (ALIGN_EPI) { if (wr == 1) PG8_BAR; }
    }
    PG8_WAIT_V(0);
    if constexpr (!ALIGN_EPI) { if (wr == 0) PG8_BAR; }
    PG8_BAR;
#undef PG8_SA
#undef PG8_SB
#undef PG8_STAGE
#undef PG8_LDA
#undef PG8_LDB
#undef PG8_MMA
#undef PG8_WAIT_V
#undef PG8_WAIT_L
#undef PG8_BAR
#undef PG8_SCHED
}
}

constexpr int BATCH = 4, SEQ = 4096, DM = 4096, MTOK = BATCH * SEQ, DEPTH = 2;
constexpr int INW = 12184, INP = 12288, NGATE = 4 * DM, N1 = INP + NGATE;
constexpr float LOG2E = 1.4426950408889634f;
constexpr float RMS_EPS = 1e-6f, LN_EPS = 1e-5f;
constexpr float DN_ALPHA = 1.4142135623730951f;
constexpr int PC_AQ = 0, PC_AK = 1024, PC_AV = 1280, PC_AIQ = 1536, PC_AZ = 2560, PC_BQ = 3584, PC_BK = 4608, PC_BV = 5632, PC_BZ = 6656,
              PC_CQ = 7680, PC_CK = 8704, PC_CV = 8832, PC_CZ = 8960, PC_DCQ = 9984, PC_DCKV = 10752, PC_DZ = 11008,
              PC_AIK = 12032, PC_AIW = 12096, PC_BF = 12112, PC_DKR = 12120, PC_END = 12184;
constexpr int SC_AQ = 0, SC_AK = 1024, SC_AV = 1280, SC_AIQ = 1536, SC_AIK = 2560, SC_AIW = 2624, SC_AZ = 2640, SC_BQ = 3664, SC_BK = 4688, SC_BV = 5712,
              SC_BF = 6736, SC_BZ = 6744, SC_CQ = 7768, SC_CK = 8792, SC_CV = 8920, SC_CZ = 9048, SC_DCQ = 10072, SC_DCKV = 10840, SC_DKR = 11096, SC_DZ = 11160;
static_assert(SC_DZ + 1024 == INW, "w_in column partition");
constexpr int SMC_AIK = 0, SMC_AIW = 64, SMC_BF = 80, SMC_DKR = 88;

constexpr size_t MiB = 1u << 20;
constexpr size_t WS_CTL = 0, CTL_ZERO_BYTES = 1 * MiB;
constexpr size_t WS_W = 2 * MiB;
constexpr int NIN8 = 27 * 256, NINZ = 16 * 256, NINB = 5 * 256;
constexpr size_t WO_WIN8 = 0                                         , WO_WZ4 = WO_WIN8 + (size_t)NIN8 * DM  ,
                 WO_WINB = WO_WZ4 + (size_t)NINZ * (DM / 2)          ,
                 WO_WG8 = WO_WINB + (size_t)NINB * DM * 2            , WO_WBR = WO_WG8 + (size_t)NGATE * DM  ,
                 WO_WOUT = WO_WBR + (size_t)4 * DM * 1024            , WO_DQUP = WO_WOUT + (size_t)DM * DM,
                 WO_DKVUP = WO_DQUP + (size_t)1536 * 768 * 2, WO_END = WO_DKVUP + (size_t)2048 * 256 * 2;
static_assert(WO_END <= 292 * MiB, "weights region");
constexpr size_t WS_XB = 294 * MiB;
constexpr size_t WS_P = 422 * MiB;
constexpr size_t WS_MRGF = WS_P;
constexpr size_t WS_G = 806 * MiB;
constexpr size_t WS_R = WS_G;
constexpr size_t WS_SC = 1318 * MiB;
constexpr size_t WS_MRG = WS_SC;
constexpr size_t WS_BR = 1574 * MiB;
constexpr size_t WS_DQ = 1702 * MiB;
constexpr size_t WS_DKV = 1750 * MiB;
constexpr size_t WS_MASK = 1814 * MiB;
constexpr size_t WS_SM = 1822 * MiB;
constexpr size_t WS_CS = 1838 * MiB;
constexpr size_t WS_RSS = 1842 * MiB;
constexpr size_t WS_CUM = 1843 * MiB;
constexpr size_t WS_DKR = 1844 * MiB;
constexpr size_t WS_X8 = 1846 * MiB;
constexpr size_t WS_KV8 = 1096 * MiB;
constexpr int KV8W = 2560;
constexpr size_t WS_D8 = 1136 * MiB;
constexpr int D8W = 2112;
constexpr size_t WS_L8 = 1170 * MiB;
constexpr float DQ_WS = 64.0f, DKV_WS = 8.0f;
constexpr size_t WS_Z8 = 1188 * MiB;
constexpr size_t WS_Q8 = 1252 * MiB;
constexpr size_t WS_X4 = 1062 * MiB;
constexpr size_t WS_END = 1910 * MiB;
constexpr int CW_TMO = 0;
constexpr int CW_Q = 64;
constexpr int CW_BAR = 16384;

constexpr int RING_BYTES = 131072;
constexpr int LDSCTL_OFF = RING_BYTES, MISC_OFF = LDSCTL_OFF + 320;
constexpr int LDS_BYTES = 147456;
constexpr int NWAVES = 8, NTHREADS = 512;

#define RLX_AGENT __ATOMIC_RELAXED, __HIP_MEMORY_SCOPE_AGENT
#define LDS_WAIT() asm volatile("s_waitcnt lgkmcnt(0)" ::: "memory")
#define VM_WAIT() asm volatile("s_waitcnt vmcnt(0)" ::: "memory")

#define XB_TMO      128
#define XB_XCNT(j)  (256  + 64 * (j))
#define XB_XSUB(j)  (1280 + 64 * (j))
#define XB_XGEN(j)  (2304 + 64 * (j))
#define XB_TOP      3328
#define XB_TOPGEN   3392
#define XCD_BAR_WORDS 3456
#define XB_SPIN_CAP (1u << 23)
__device__ __forceinline__ unsigned xb_ld(unsigned* p)              { return __hip_atomic_load(p, __ATOMIC_RELAXED, __HIP_MEMORY_SCOPE_AGENT); }
__device__ __forceinline__ unsigned xb_add(unsigned* p, unsigned v) { return __hip_atomic_fetch_add(p, v, __ATOMIC_RELAXED, __HIP_MEMORY_SCOPE_AGENT); }
__device__ __forceinline__ unsigned xb_xcc_id() { return (unsigned)__builtin_amdgcn_s_getreg((3 << 11) | 20) & 0xFu; }
#define XB_SPIN(cond, bar) do { unsigned _sp = 0; while (cond) { __builtin_amdgcn_s_sleep(1); \
    if ((++_sp & 255u) == 0u) { if (xb_ld(&(bar)[XB_TMO])) break; if (_sp > XB_SPIN_CAP) { atomicAdd(&(bar)[XB_TMO], 1u); break; } } } } while (0)
struct XcdBarrier { unsigned* bar; unsigned x; volatile LAS unsigned* st; };
__device__ __forceinline__ XcdBarrier xcd_barrier_post(unsigned* bar, volatile LAS unsigned* st) {
    XcdBarrier b; b.bar = bar; b.x = xb_xcc_id(); b.st = st;
    if (threadIdx.x == 0) (void)xb_add(&bar[XB_XCNT(b.x)], 1u);
    return b;
}
__device__ __forceinline__ void xcd_barrier_complete(unsigned* bar, unsigned x, unsigned& nloc, unsigned& nx) {
    const unsigned G = gridDim.x * gridDim.y * gridDim.z;
    unsigned sum, cnt, mine, sp = 0u;
    for (;;) {
        sum = 0u; cnt = 0u; mine = 0u;
#pragma unroll
        for (unsigned j = 0; j < 16; ++j) { const unsigned c = xb_ld(&bar[XB_XCNT(j)]); sum += c; cnt += (c > 0u) ? 1u : 0u; mine = (j == x) ? c : mine; }
        if (sum == G) break;
        __builtin_amdgcn_s_sleep(1);
        if ((++sp & 255u) == 0u) { if (xb_ld(&bar[XB_TMO])) break; if (sp > XB_SPIN_CAP) { atomicAdd(&bar[XB_TMO], 1u); break; } }
    }
    nloc = mine > 0u ? mine : 1u; nx = cnt > 0u ? cnt : 1u;
}
__device__ __forceinline__ void xcd_barrier(const XcdBarrier& b) {
    asm volatile("s_waitcnt vmcnt(0)" ::: "memory");
    __syncthreads();
    if (threadIdx.x == 0) {
        unsigned* bar = b.bar;
        __builtin_amdgcn_s_waitcnt(0);
        unsigned nloc = b.st[0], nx = b.st[1];
        if (nloc == 0u) { xcd_barrier_complete(bar, b.x, nloc, nx); b.st[0] = nloc; b.st[1] = nx; }
        const unsigned old = xb_add(&bar[XB_XSUB(b.x)], 1u);
        const unsigned gen = old / nloc;
        if (old + 1u == (gen + 1u) * nloc) {
            __builtin_amdgcn_fence(__ATOMIC_RELEASE, "agent");
            asm volatile("s_waitcnt vmcnt(0)" ::: "memory");
            const unsigned og = xb_add(&bar[XB_TOP], 1u);
            const unsigned tg = og / nx;
            if (og + 1u == (tg + 1u) * nx) xb_add(&bar[XB_TOPGEN], 1u);
            else XB_SPIN(xb_ld(&bar[XB_TOPGEN]) == tg, bar);
            __builtin_amdgcn_fence(__ATOMIC_ACQUIRE, "agent");
            xb_add(&bar[XB_XGEN(b.x)], 1u);
            asm volatile("s_waitcnt vmcnt(0)" ::: "memory");
        } else {
            XB_SPIN(xb_ld(&bar[XB_XGEN(b.x)]) == gen, bar);
            __builtin_amdgcn_fence(__ATOMIC_ACQUIRE, "agent");
            asm volatile("s_waitcnt vmcnt(0)" ::: "memory");
        }
    }
    __syncthreads();
}

struct Args {
    const float* x; const int* pos; const float* w_in; const float* w_gate; const float* w_branch; const float* w_out;
    const float* dq_gain; const float* dq_up; const float* dkv_gain; const float* dkv_up; const float* f_bias; const float* sinks; const float* ln_gain; const float* ln_bias;
    float* out; unsigned char* ws; int ph_lo, ph_hi;
};

__device__ __forceinline__ float wave_sum(float v) {
#pragma unroll
    for (int o = 1; o < 64; o <<= 1) v += __shfl_xor(v, o);
    return v;
}
__device__ __forceinline__ unsigned pack_fp4x8(float a0, float a1, float a2, float a3, float a4, float a5, float a6, float a7) {
    unsigned w = 0u;
    w = __builtin_amdgcn_cvt_scalef32_pk_fp4_f32(w, a0, a1, 1.0f, 0); w = __builtin_amdgcn_cvt_scalef32_pk_fp4_f32(w, a2, a3, 1.0f, 1);
    w = __builtin_amdgcn_cvt_scalef32_pk_fp4_f32(w, a4, a5, 1.0f, 2); w = __builtin_amdgcn_cvt_scalef32_pk_fp4_f32(w, a6, a7, 1.0f, 3);
    return w; }
constexpr float FP4_XS = 2.0f, FP4_WS = 128.0f;
__device__ __forceinline__ float fast_sigmoid(float v) { return __builtin_amdgcn_rcpf(1.0f + __builtin_amdgcn_exp2f(-v * LOG2E)); }

__device__ __forceinline__ int in_src(int j, float& sc) {
    sc = 1.0f;
    if (j < PC_AK)   return SC_AQ + (j - PC_AQ);
    if (j < PC_AV)   return SC_AK + (j - PC_AK);
    if (j < PC_AIQ)  return SC_AV + (j - PC_AV);
    if (j < PC_AZ)   return SC_AIQ + (j - PC_AIQ);
    if (j < PC_BQ)   return SC_AZ + (j - PC_AZ);
    if (j < PC_BK)   return SC_BQ + (j - PC_BQ);
    if (j < PC_BV)   return SC_BK + (j - PC_BK);
    if (j < PC_BZ)   return SC_BV + (j - PC_BV);
    if (j < PC_CQ)   return SC_BZ + (j - PC_BZ);
    if (j < PC_CK)   return SC_CQ + (j - PC_CQ);
    if (j < PC_CV)   return SC_CK + (j - PC_CK);
    if (j < PC_CZ)   return SC_CV + (j - PC_CV);
    if (j < PC_DCQ)  return SC_CZ + (j - PC_CZ);
    if (j < PC_DCKV) return SC_DCQ + (j - PC_DCQ);
    if (j < PC_DZ)   return SC_DCKV + (j - PC_DCKV);
    if (j < PC_AIK)  return SC_DZ + (j - PC_DZ);
    if (j < PC_AIW)  return SC_AIK + (j - PC_AIK);
    if (j < PC_BF)   return SC_AIW + (j - PC_AIW);
    if (j < PC_DKR)  return SC_BF + (j - PC_BF);
    if (j < PC_END)  { const int p = j - PC_DKR; return SC_DKR + (p >> 1) + 32 * (p & 1); }
    return -1;
}
__host__ __device__ __forceinline__ int in8_tile(int i) { return i < 6 ? i : (i < 22 ? i + 4 : i + 8); }
__host__ __device__ __forceinline__ int inz_tile(int j) { return j < 4 ? 26 + j : 31 + j; }
struct CvtItem {
    const float* p;
    unsigned ld;
    const float* gain;
    float sc;
    unsigned char* dst;
    int K, n0, k0, f8;
};
__device__ __forceinline__ CvtItem cvt_decode(const Args& a, int layer, int it, int lane) {
    unsigned char* W = a.ws + WS_W;
    constexpr int I_IN8 = (NIN8 / 32) * (DM / 64), I_INZ = (NINZ / 32) * (DM / 64), I_INB = (NINB / 32) * (DM / 64), I_G = (NGATE / 32) * (DM / 64), I_BR = 4 * (DM / 32) * (1024 / 64), I_OUT = (DM / 32) * (DM / 64), I_DQ = (1536 / 32) * (768 / 64);
    CvtItem d; d.gain = nullptr; d.sc = 1.0f; d.f8 = 1; d.K = DM; d.ld = DM;
    const int ln = lane & 31; int r = it;
    if (r < I_IN8) { const int nb = r % (NIN8 / 32), kb = r / (NIN8 / 32); d.n0 = nb * 32; d.k0 = kb * 64;
        const int j = in8_tile(d.n0 >> 8) * 256 + (d.n0 & 255) + ln; float s_; const int c = in_src(j, s_);
        d.p = a.w_in + (size_t)layer * DM * INW + (c < 0 ? 0 : c); d.ld = INW; d.sc = c < 0 ? 0.f : 64.0f; d.dst = W + WO_WIN8; return d; }
    r -= I_IN8;
    if (r < I_INZ) { const int nb = r % (NINZ / 32), kb = r / (NINZ / 32); d.n0 = nb * 32; d.k0 = kb * 64;
        const int j = inz_tile(d.n0 >> 8) * 256 + (d.n0 & 255) + ln; float s_; const int c = in_src(j, s_);
        d.p = a.w_in + (size_t)layer * DM * INW + (c < 0 ? 0 : c); d.ld = INW; d.sc = c < 0 ? 0.f : FP4_WS; d.dst = W + WO_WZ4; d.f8 = 2; return d; }
    r -= I_INZ;
    if (r < I_INB) { const int nb = r % (NINB / 32), kb = r / (NINB / 32); d.n0 = nb * 32; d.k0 = kb * 64;
        const int j = d.n0 + ln + (d.n0 < 1024 ? 1536 : 12032 - 1024); float s_; const int c = in_src(j, s_);
        d.p = a.w_in + (size_t)layer * DM * INW + (c < 0 ? 0 : c); d.ld = INW; d.sc = c < 0 ? 0.f : 1.0f; d.dst = W + WO_WINB; d.f8 = 0; return d; }
    r -= I_INB;
    if (r < I_G) { const int nb = r % (NGATE / 32), kb = r / (NGATE / 32), g = nb / (DM / 32); d.n0 = (nb % (DM / 32)) * 32; d.k0 = kb * 64;
        d.p = a.w_gate + ((size_t)layer * 4 + g) * DM * DM + d.n0 + ln; d.sc = FP4_WS; d.dst = W + WO_WG8 + (size_t)g * DM * (DM / 2); d.f8 = 2; return d; }
    r -= I_G;
    if (r < I_BR) { const int n = r / ((DM / 32) * 16), q = r % ((DM / 32) * 16), nb = q % (DM / 32), kb = q / (DM / 32); d.n0 = nb * 32; d.k0 = kb * 64;
        d.p = a.w_branch + ((size_t)layer * 4 + n) * 1024 * DM + d.n0 + ln; d.sc = 64.0f; d.dst = W + WO_WBR + (size_t)n * DM * 1024; d.K = 1024; return d; }
    r -= I_BR;
    if (r < I_OUT) { const int nb = r % (DM / 32), kb = r / (DM / 32); d.n0 = nb * 32; d.k0 = kb * 64;
        d.p = a.w_out + (size_t)layer * DM * DM + d.n0 + ln; d.sc = 128.0f; d.dst = W + WO_WOUT; return d; }
    r -= I_OUT;
    if (r < I_DQ) { const int nb = r % 48, kb = r / 48; d.n0 = nb * 32; d.k0 = kb * 64;
        const int j = d.n0 + ln, h = j / 192, wv = j % 192; int c = wv; if (wv >= 128) { const int q = wv - 128; c = 128 + (q >> 1) + 32 * (q & 1); }
        d.p = a.dq_up + (size_t)layer * 768 * 1536 + h * 192 + c; d.ld = 1536; d.gain = a.dq_gain + layer * 768; d.sc = 0.07216878364870322f * LOG2E * DQ_WS; d.dst = W + WO_DQUP; d.K = 768; d.f8 = 1; return d; }
    r -= I_DQ;
    { const int nb = r % 64, kb = r / 64; d.n0 = nb * 32; d.k0 = kb * 64;
      d.p = a.dkv_up + (size_t)layer * 256 * 2048 + d.n0 + ln; d.ld = 2048; d.gain = a.dkv_gain + layer * 256; d.sc = DKV_WS; d.dst = W + WO_DKVUP; d.K = 256; d.f8 = 1; return d; }
}
__device__ __forceinline__ void cvt_load(const CvtItem& d, float (&v)[32], int lane) {
    const float* p = d.p + (size_t)(d.k0 + (lane >> 5)) * d.ld;
#pragma unroll
    for (int i = 0; i < 32; ++i) v[i] = p[(size_t)(2 * i) * d.ld];
}
__device__ __forceinline__ void cvt_finish(const CvtItem& d, const float (&v)[32], LAS float* scr, int lane) {
#pragma unroll
    for (int i = 0; i < 32; ++i) { const int kk = 2 * i + (lane >> 5); float x = v[i] * d.sc; if (d.gain) x *= d.gain[d.k0 + kk]; scr[kk * 33 + (lane & 31)] = x; }
    LDS_WAIT(); asm volatile("" ::: "memory");
    const int c = lane & 7;
#pragma unroll
    for (int j = 0; j < 4; ++j) { const int n = (lane >> 3) + 8 * j; const LAS float* s = scr + (8 * c) * 33 + n;
        if (d.f8 == 2) *(unsigned*)(d.dst + (((size_t)(d.n0 + n) * d.K + d.k0 + 8 * c) >> 1)) = pack_fp4x8(s[0], s[33], s[2 * 33], s[3 * 33], s[4 * 33], s[5 * 33], s[6 * 33], s[7 * 33]);
        else if (d.f8) { int w0 = 0, w1 = 0;
            w0 = __builtin_amdgcn_cvt_pk_fp8_f32(s[0], s[33], w0, false); w0 = __builtin_amdgcn_cvt_pk_fp8_f32(s[2 * 33], s[3 * 33], w0, true);
            w1 = __builtin_amdgcn_cvt_pk_fp8_f32(s[4 * 33], s[5 * 33], w1, false); w1 = __builtin_amdgcn_cvt_pk_fp8_f32(s[6 * 33], s[7 * 33], w1, true);
            *(u32x2*)(d.dst + (size_t)(d.n0 + n) * d.K + d.k0 + 8 * c) = (u32x2){(unsigned)w0, (unsigned)w1}; }
        else { u32x4 o; o.x = cvt_pk_bf16(s[0], s[33]); o.y = cvt_pk_bf16(s[2 * 33], s[3 * 33]); o.z = cvt_pk_bf16(s[4 * 33], s[5 * 33]); o.w = cvt_pk_bf16(s[6 * 33], s[7 * 33]);
            *(u32x4*)((bf16_t*)d.dst + (size_t)(d.n0 + n) * d.K + d.k0 + 8 * c) = o; } }
    LDS_WAIT(); asm volatile("" ::: "memory");
}
__device__ __forceinline__ void convert_weights(const Args& a, int layer, LAS unsigned char* lds) {
    const int tid = ptid(), lane = tid & 63, wave = tid >> 6;
    LAS float* scr = (LAS float*)(lds + wave * 8448);
    const int NGW = gridDim.x * NWAVES, gw = blockIdx.x * NWAVES + wave;
    constexpr int NITEMS = (NIN8 / 32) * (DM / 64) + (NINZ / 32) * (DM / 64) + (NINB / 32) * (DM / 64) + (NGATE / 32) * (DM / 64) + 4 * (DM / 32) * (1024 / 64) + (DM / 32) * (DM / 64) + (1536 / 32) * (768 / 64) + (2048 / 32) * (256 / 64);
    float va[32], vb[32]; CvtItem da, db;
    int it = gw;
    if (it < NITEMS) { da = cvt_decode(a, layer, it, lane); cvt_load(da, va, lane); }
    while (it < NITEMS) {
        const int itb = it + NGW;
        if (itb < NITEMS) { db = cvt_decode(a, layer, itb, lane); cvt_load(db, vb, lane); }
        cvt_finish(da, va, scr, lane);
        if (itb >= NITEMS) break;
        const int ita = itb + NGW;
        if (ita < NITEMS) { da = cvt_decode(a, layer, ita, lane); cvt_load(da, va, lane); }
        cvt_finish(db, vb, scr, lane);
        it = ita;
    }
    __syncthreads();
}
__device__ __forceinline__ void prologue_misc(const Args& a) {
    const size_t gt = (size_t)blockIdx.x * NTHREADS + ptid(), GT = (size_t)gridDim.x * NTHREADS;
    bf16_t* XB = (bf16_t*)(a.ws + WS_XB);
    constexpr size_t NCH = (size_t)MTOK * DM / 8;
    for (size_t i0 = gt; i0 < NCH; i0 += 4 * GT) {
        f32x4 v0[4], v1[4];
#pragma unroll
        for (int u = 0; u < 4; ++u) { const size_t i = i0 + u * GT; if (i < NCH) { v0[u] = *(const f32x4*)(a.x + i * 8); v1[u] = *(const f32x4*)(a.x + i * 8 + 4); } }
#pragma unroll
        for (int u = 0; u < 4; ++u) { const size_t i = i0 + u * GT; if (i < NCH) {
            u32x4 o; o.x = cvt_pk_bf16(v0[u][0], v0[u][1]); o.y = cvt_pk_bf16(v0[u][2], v0[u][3]); o.z = cvt_pk_bf16(v1[u][0], v1[u][1]); o.w = cvt_pk_bf16(v1[u][2], v1[u][3]);
            *(u32x4*)(XB + i * 8) = o;
            int w0 = 0, w1 = 0;
            w0 = __builtin_amdgcn_cvt_pk_fp8_f32(v0[u][0], v0[u][1], w0, false); w0 = __builtin_amdgcn_cvt_pk_fp8_f32(v0[u][2], v0[u][3], w0, true);
            w1 = __builtin_amdgcn_cvt_pk_fp8_f32(v1[u][0], v1[u][1], w1, false); w1 = __builtin_amdgcn_cvt_pk_fp8_f32(v1[u][2], v1[u][3], w1, true);
            *(u32x2*)(a.ws + WS_X8 + i * 8) = (u32x2){(unsigned)w0, (unsigned)w1};
            *(unsigned*)(a.ws + WS_X4 + i * 4) = pack_fp4x8(v0[u][0] * FP4_XS, v0[u][1] * FP4_XS, v0[u][2] * FP4_XS, v0[u][3] * FP4_XS, v1[u][0] * FP4_XS, v1[u][1] * FP4_XS, v1[u][2] * FP4_XS, v1[u][3] * FP4_XS); } }
    }
    f32x2* CS = (f32x2*)(a.ws + WS_CS);
    for (size_t i = gt; i < (size_t)MTOK * 32; i += GT) {
        const int row = (int)(i >> 5), fi = (int)(i & 31);
        const float invf = __builtin_amdgcn_exp2f(-(float)fi * (13.287712379549449f / 32.0f));
        const float ang = (float)a.pos[row] * invf;
        const double rev = (double)ang * 0.15915494309189535;
        const float fr = (float)(rev - floor(rev));
        CS[i] = (f32x2){__builtin_amdgcn_cosf(fr), __builtin_amdgcn_sinf(fr)};
    }
}

struct EpiIn {
    static constexpr int PERM = 2; static constexpr bool CARRY = false;
    bf16_t* P; float* SM; float* RSS; int f8; unsigned char* KV8; unsigned char* L8; unsigned char* Z8; unsigned char* Q8;
    template <int MODE>
    __device__ __forceinline__ void run(const f32x4 (&acc)[2][2][4][2], int pn, int row0, int cw, int wc, int fq, float sc) const {
        bf16_t* base = P + (size_t)pn * 256 + cw;
        unsigned char* k8b = (MODE == 6) ? Q8 + (pn < 4 ? pn * 256 : (pn < 18 ? 1024 + (pn - 14) * 256 : 2048 + (pn - 30) * 256)) + cw
                           : (MODE == 5) ? Z8 + (pn < 14 ? (pn - 10) * 256 : (pn < 30 ? 1024 + (pn - 26) * 256 : (pn < 39 ? 2048 + (pn - 35) * 256 : 3072 + (pn - 43) * 256))) + cw
                           : (MODE == 3) ? L8 + (pn - 39) * 256 + cw : KV8 + (pn < 6 ? (pn - 4) * 256 : 512 + (pn - 18) * 256) + cw;
#pragma unroll
        for (int ai = 0; ai < 2; ++ai)
#pragma unroll
            for (int m = 0; m < 4; ++m) { const int row = row0 + ai * 128 + m * 16; bf16_t* rowp = base + (size_t)row * INP; float ss = 0.f;
                u32x4 k8w;
#pragma unroll
                for (int bj = 0; bj < 2; ++bj) { f32x4 v0 = acc[ai][bj][m][0] * sc, v1 = acc[ai][bj][m][1] * sc;
                    if constexpr (MODE == 3) ss += ((v0[0] * v0[0] + v0[1] * v0[1]) + (v0[2] * v0[2] + v0[3] * v0[3])) + ((v1[0] * v1[0] + v1[1] * v1[1]) + (v1[2] * v1[2] + v1[3] * v1[3]));
                    if constexpr (MODE == 4 || MODE == 3 || MODE == 5 || MODE == 6) { int w0 = 0, w1 = 0;
                        w0 = __builtin_amdgcn_cvt_pk_fp8_f32(v0[0], v0[1], w0, false); w0 = __builtin_amdgcn_cvt_pk_fp8_f32(v0[2], v0[3], w0, true);
                        w1 = __builtin_amdgcn_cvt_pk_fp8_f32(v1[0], v1[1], w1, false); w1 = __builtin_amdgcn_cvt_pk_fp8_f32(v1[2], v1[3], w1, true);
                        if (bj == 0) { k8w.x = (unsigned)w0; k8w.y = (unsigned)w1; } else { k8w.z = (unsigned)w0; k8w.w = (unsigned)w1; } continue; }
                    if constexpr (MODE == 1) {
#pragma unroll
                        for (int j = 0; j < 4; ++j) { v0[j] = v0[j] * fast_sigmoid(v0[j]); v1[j] = v1[j] * fast_sigmoid(v1[j]); } }
                    if constexpr (MODE == 2) { float* sp = SM + (size_t)row * 256 + cw + bj * 8; *(f32x4*)sp = v0; *(f32x4*)(sp + 4) = v1; }
                    u32x4 w; w.x = cvt_pk_bf16(v0[0], v0[1]); w.y = cvt_pk_bf16(v0[2], v0[3]); w.z = cvt_pk_bf16(v1[0], v1[1]); w.w = cvt_pk_bf16(v1[2], v1[3]);
                    *(u32x4*)(rowp + bj * 8) = w; }
                if constexpr (MODE == 4) *(u32x4*)(k8b + (size_t)row * KV8W) = k8w;
                if constexpr (MODE == 3) *(u32x4*)(k8b + (size_t)row * 1024) = k8w;
                if constexpr (MODE == 5) *(u32x4*)(k8b + (size_t)row * 4096) = k8w;
                if constexpr (MODE == 6) *(u32x4*)(k8b + (size_t)row * 3072) = k8w;
                if constexpr (MODE == 3) { ss += __shfl_xor(ss, 16); ss += __shfl_xor(ss, 32); if (fq == 0) RSS[(size_t)row * 16 + (pn - 39) * 4 + wc] = ss; }
                asm volatile("" ::: "memory"); }
    }
    __device__ __forceinline__ void operator()(f32x4 (&acc)[2][2][4][2], const pg8::Unit& u, int wr, int wc, int fr, int fq) const {
        asm volatile("" : "+v"(fr), "+v"(fq));
        const int pn = f8 == 1 ? in8_tile(u.pn) : (f8 == 2 ? inz_tile(u.pn) : (u.pn < 4 ? u.pn + 6 : 47)), row0 = u.pm * 256 + wr * 64 + fr, cw = wc * 64 + 16 * fq;
        const float qs = (pn < 4 || (pn >= 14 && pn < 18)) ? 0.08838834764831845f * LOG2E : ((pn >= 30 && pn < 34) ? 0.125f * LOG2E : 1.0f), sc = f8 == 1 ? qs * 0.015625f : (f8 == 2 ? 1.0f / (FP4_XS * FP4_WS * 0.9761f) : qs);
        if (pn == 47) run<2>(acc, pn, row0, cw, wc, fq, sc);
        else if (pn >= 39 && pn < 43) run<3>(acc, pn, row0, cw, wc, fq, sc);
        else if (pn == 4 || pn == 5 || (pn >= 18 && pn < 26)) run<4>(acc, pn, row0, cw, wc, fq, sc);
        else if (pn < 4 || (pn >= 14 && pn < 18) || (pn >= 30 && pn < 34)) run<6>(acc, pn, row0, cw, wc, fq, sc);
        else if ((pn >= 10 && pn < 14) || (pn >= 26 && pn < 30) || (pn >= 35 && pn < 39) || (pn >= 43 && pn < 47)) run<5>(acc, pn, row0, cw, wc, fq, sc);
        else run<0>(acc, pn, row0, cw, wc, fq, sc);
    }
};
struct EpiGate {
    static constexpr int PERM = 2; static constexpr bool CARRY = false;
    unsigned char* G; float sc;
    __device__ __forceinline__ void operator()(f32x4 (&acc)[2][2][4][2], const pg8::Unit& u, int wr, int wc, int fr, int fq) const {
        asm volatile("" : "+v"(fr), "+v"(fq));
        unsigned char* base = G + ((((size_t)u.pm * 64 + u.pn) * 8 + (wr * 4 + wc)) * 8) * 1024 + (fq * 16 + fr) * 16;
#pragma unroll
        for (int ai = 0; ai < 2; ++ai)
#pragma unroll
            for (int m = 0; m < 4; ++m) { unsigned char* rowp = base + (ai * 4 + m) * 1024; u32x4 w;
#pragma unroll
                for (int bj = 0; bj < 2; ++bj) { const f32x4 v0 = acc[ai][bj][m][0] * sc, v1 = acc[ai][bj][m][1] * sc; int w0 = 0, w1 = 0;
                    w0 = __builtin_amdgcn_cvt_pk_fp8_f32(v0[0], v0[1], w0, false); w0 = __builtin_amdgcn_cvt_pk_fp8_f32(v0[2], v0[3], w0, true);
                    w1 = __builtin_amdgcn_cvt_pk_fp8_f32(v1[0], v1[1], w1, false); w1 = __builtin_amdgcn_cvt_pk_fp8_f32(v1[2], v1[3], w1, true);
                    if (bj == 0) { w.x = (unsigned)w0; w.y = (unsigned)w1; } else { w.z = (unsigned)w0; w.w = (unsigned)w1; } }
                *(u32x4*)rowp = w; }
    }
};
struct EpiNull {
    static constexpr int PERM = 1; static constexpr bool CARRY = false;
    float* D;
    __device__ __forceinline__ void operator()(f32x4 (&acc)[2][2][4][2], const pg8::Unit& u, int wr, int wc, int fr, int fq) const {
        f32x4 s = (f32x4){0.f, 0.f, 0.f, 0.f};
#pragma unroll
        for (int ai = 0; ai < 2; ++ai)
#pragma unroll
            for (int bj = 0; bj < 2; ++bj)
#pragma unroll
                for (int m = 0; m < 4; ++m)
#pragma unroll
                    for (int n = 0; n < 2; ++n) s += acc[ai][bj][m][n];
        *(f32x4*)(D + ((size_t)(u.pm * 64 + u.pn) * 512 + wr * 256 + wc * 64 + fq * 16 + fr) * 4) = s;
    }
};
struct EpiDq {
    static constexpr int PERM = 2; static constexpr bool CARRY = false;
    unsigned char* DQ; const float* RSS; const float* CS; float wsc;
    __device__ __forceinline__ void operator()(f32x4 (&acc)[2][2][4][2], const pg8::Unit& u, int wr, int wc, int fr, int fq) const {
        asm volatile("" : "+v"(fr), "+v"(fq));
        const int row0 = u.pm * 256 + wr * 64 + fr, col0 = u.pn * 256 + wc * 64 + 16 * fq;
#pragma unroll
        for (int ai = 0; ai < 2; ++ai)
#pragma unroll
            for (int m = 0; m < 4; ++m) { const int row = row0 + ai * 128 + m * 16;
                const f32x4 r0 = *(const f32x4*)(RSS + (size_t)row * 16), r1 = *(const f32x4*)(RSS + (size_t)row * 16 + 4), r2 = *(const f32x4*)(RSS + (size_t)row * 16 + 8);
                const float ss = ((r0[0] + r0[1]) + (r0[2] + r0[3])) + ((r1[0] + r1[1]) + (r1[2] + r1[3])) + ((r2[0] + r2[1]) + (r2[2] + r2[3]));
                const float rs = __builtin_amdgcn_rsqf(ss * (1.0f / 768.0f) + RMS_EPS) * wsc;
                unsigned char* rowp = DQ + (size_t)row * 1536 + col0; u32x4 q16;
#pragma unroll
                for (int bj = 0; bj < 2; ++bj) { f32x4 v[2];
#pragma unroll
                    for (int n = 0; n < 2; ++n) { v[n] = acc[ai][bj][m][n] * rs; const int c = col0 + bj * 8 + 4 * n, w = c % 192;
                        if (w >= 128) { const f32x4 cs = *(const f32x4*)(CS + (size_t)row * 64 + (w - 128));
                            const f32x4 t = v[n]; v[n][0] = t[0] * cs[0] - t[1] * cs[1]; v[n][1] = t[0] * cs[1] + t[1] * cs[0]; v[n][2] = t[2] * cs[2] - t[3] * cs[3]; v[n][3] = t[2] * cs[3] + t[3] * cs[2]; } }
                    int w0 = 0, w1 = 0;
                    w0 = __builtin_amdgcn_cvt_pk_fp8_f32(v[0][0], v[0][1], w0, false); w0 = __builtin_amdgcn_cvt_pk_fp8_f32(v[0][2], v[0][3], w0, true);
                    w1 = __builtin_amdgcn_cvt_pk_fp8_f32(v[1][0], v[1][1], w1, false); w1 = __builtin_amdgcn_cvt_pk_fp8_f32(v[1][2], v[1][3], w1, true);
                    if (bj == 0) { q16.x = (unsigned)w0; q16.y = (unsigned)w1; } else { q16.z = (unsigned)w0; q16.w = (unsigned)w1; } }
                *(u32x4*)rowp = q16;
                asm volatile("" ::: "memory"); }
    }
};
struct EpiDkv {
    static constexpr int PERM = 2; static constexpr bool CARRY = false;
    unsigned char* D8; const float* RSS; float wsc;
    __device__ __forceinline__ void operator()(f32x4 (&acc)[2][2][4][2], const pg8::Unit& u, int wr, int wc, int fr, int fq) const {
        asm volatile("" : "+v"(fr), "+v"(fq));
        const int row0 = u.pm * 256 + wr * 64 + fr, col0 = u.pn * 256 + wc * 64 + 16 * fq;
        f32x4 r3v[2][4];
#pragma unroll
        for (int ai = 0; ai < 2; ++ai)
#pragma unroll
            for (int m = 0; m < 4; ++m) r3v[ai][m] = *(const f32x4*)(RSS + (size_t)(row0 + ai * 128 + m * 16) * 16 + 12);
#pragma unroll
        for (int ai = 0; ai < 2; ++ai)
#pragma unroll
            for (int m = 0; m < 4; ++m) { const int row = row0 + ai * 128 + m * 16;
                const f32x4 r3 = r3v[ai][m];
                const float rs = __builtin_amdgcn_rsqf(((r3[0] + r3[1]) + (r3[2] + r3[3])) * (1.0f / 256.0f) + RMS_EPS) * wsc;
                u32x4 w4;
#pragma unroll
                for (int bj = 0; bj < 2; ++bj) { const f32x4 v0 = acc[ai][bj][m][0] * rs, v1 = acc[ai][bj][m][1] * rs; int w0 = 0, w1 = 0;
                    w0 = __builtin_amdgcn_cvt_pk_fp8_f32(v0[0], v0[1], w0, false); w0 = __builtin_amdgcn_cvt_pk_fp8_f32(v0[2], v0[3], w0, true);
                    w1 = __builtin_amdgcn_cvt_pk_fp8_f32(v1[0], v1[1], w1, false); w1 = __builtin_amdgcn_cvt_pk_fp8_f32(v1[2], v1[3], w1, true);
                    if (bj == 0) { w4.x = (unsigned)w0; w4.y = (unsigned)w1; } else { w4.z = (unsigned)w0; w4.w = (unsigned)w1; } }
                *(u32x4*)(D8 + (size_t)row * D8W + col0) = w4;
                asm volatile("" ::: "memory"); }
    }
};
struct EpiMerge {
    static constexpr int PERM = 2; static constexpr bool CARRY = true;
    const unsigned char* G; unsigned char* MRG;
    __device__ __forceinline__ void operator()(f32x4 (&acc)[2][2][4][2], const pg8::Unit& u, int wr, int wc, int fr, int fq) const {
        asm volatile("" : "+v"(fr), "+v"(fq));
        const int row0 = u.pm * 256 + wr * 64 + fr, col0 = u.pn * 256 + wc * 64 + 16 * fq, z = u.z;
        const float fin = 0.001953125f * 16.0f;
        u32x4 ga[2][4], gb[2][4];
        const unsigned char* gta = G + ((((size_t)u.pm * 64 + z * 16 + u.pn) * 8 + (wr * 4 + wc)) * 8) * 1024 + (fq * 16 + fr) * 16;
        const unsigned char* gtb = gta + (z < 3 ? (size_t)16 * 8 * 8 * 1024 : 0);
#define MG_LOAD(ai_, m_) do { ga[ai_][m_] = *(const u32x4*)(gta + ((ai_) * 4 + (m_)) * 1024); \
            gb[ai_][m_] = *(const u32x4*)(gtb + ((ai_) * 4 + (m_)) * 1024); } while (0)
#pragma unroll
        for (int m = 0; m < 4; ++m) MG_LOAD(0, m);
#pragma unroll
        for (int ai = 0; ai < 2; ++ai) {
#pragma unroll
            for (int m = 0; m < 4; ++m) { const size_t row = (size_t)(row0 + ai * 128 + m * 16); u32x4 wo;
                if (ai == 0) MG_LOAD(1, m);
#pragma unroll
                for (int bj = 0; bj < 2; ++bj) { const unsigned ax = bj ? ga[ai][m].z : ga[ai][m].x, ay = bj ? ga[ai][m].w : ga[ai][m].y, bx = bj ? gb[ai][m].z : gb[ai][m].x, by = bj ? gb[ai][m].w : gb[ai][m].y;
                    float fa[8], fb[8];
                    { const f32x2 t0 = __builtin_amdgcn_cvt_pk_f32_fp8((int)ax, false), t1 = __builtin_amdgcn_cvt_pk_f32_fp8((int)ax, true), t2 = __builtin_amdgcn_cvt_pk_f32_fp8((int)ay, false), t3 = __builtin_amdgcn_cvt_pk_f32_fp8((int)ay, true);
                      fa[0] = t0[0]; fa[1] = t0[1]; fa[2] = t1[0]; fa[3] = t1[1]; fa[4] = t2[0]; fa[5] = t2[1]; fa[6] = t3[0]; fa[7] = t3[1]; }
                    { const f32x2 t0 = __builtin_amdgcn_cvt_pk_f32_fp8((int)bx, false), t1 = __builtin_amdgcn_cvt_pk_f32_fp8((int)bx, true), t2 = __builtin_amdgcn_cvt_pk_f32_fp8((int)by, false), t3 = __builtin_amdgcn_cvt_pk_f32_fp8((int)by, true);
                      fb[0] = t0[0]; fb[1] = t0[1]; fb[2] = t1[0]; fb[3] = t1[1]; fb[4] = t2[0]; fb[5] = t2[1]; fb[6] = t3[0]; fb[7] = t3[1]; }
                    float f[8];
#pragma unroll
                    for (int e = 0; e < 8; ++e) { const float ra = __builtin_amdgcn_rcpf(1.0f + __builtin_amdgcn_exp2f(fa[e]));
                        f[e] = (z < 3) ? ra * (1.0f + __builtin_amdgcn_exp2f(fb[e])) : ra * fin; }
                    f32x4 v0 = acc[ai][bj][m][0], v1 = acc[ai][bj][m][1];
                    v0[0] *= f[0]; v0[1] *= f[1]; v0[2] *= f[2]; v0[3] *= f[3]; v1[0] *= f[4]; v1[1] *= f[5]; v1[2] *= f[6]; v1[3] *= f[7];
                    if (z < 3) { acc[ai][bj][m][0] = v0; acc[ai][bj][m][1] = v1; }
                    else { int w0 = 0, w1 = 0;
                        w0 = __builtin_amdgcn_cvt_pk_fp8_f32(v0[0], v0[1], w0, false); w0 = __builtin_amdgcn_cvt_pk_fp8_f32(v0[2], v0[3], w0, true);
                        w1 = __builtin_amdgcn_cvt_pk_fp8_f32(v1[0], v1[1], w1, false); w1 = __builtin_amdgcn_cvt_pk_fp8_f32(v1[2], v1[3], w1, true);
                        if (bj == 0) { wo.x = (unsigned)w0; wo.y = (unsigned)w1; } else { wo.z = (unsigned)w0; wo.w = (unsigned)w1; } } }
                if (z == 3) *(u32x4*)(MRG + row * DM + col0) = wo; }
            asm volatile("" ::: "memory"); }
#undef MG_LOAD
    }
};
struct EpiOut {
    static constexpr int PERM = 2; static constexpr bool CARRY = false;
    const bf16_t* XBr; bf16_t* R;
    __device__ __forceinline__ void operator()(f32x4 (&acc)[2][2][4][2], const pg8::Unit& u, int wr, int wc, int fr, int fq) const {
        asm volatile("" : "+v"(fr), "+v"(fq));
        const int row0 = u.pm * 256 + wr * 64 + fr, col0 = u.pn * 256 + wc * 64 + 16 * fq;
        u32x4 xw[2][4][2];
#pragma unroll
        for (int ai = 0; ai < 2; ++ai)
#pragma unroll
            for (int m = 0; m < 4; ++m) { const size_t off = (size_t)(row0 + ai * 128 + m * 16) * DM + col0;
#pragma unroll
                for (int bj = 0; bj < 2; ++bj) xw[ai][m][bj] = *(const u32x4*)(XBr + off + bj * 8); }
#pragma unroll
        for (int ai = 0; ai < 2; ++ai) {
#pragma unroll
            for (int m = 0; m < 4; ++m) { const size_t off = (size_t)(row0 + ai * 128 + m * 16) * DM + col0;
#pragma unroll
                for (int bj = 0; bj < 2; ++bj) { const u32x4 w = xw[ai][m][bj];
                    const f32x4 x0 = (f32x4){__uint_as_float(w.x << 16), __uint_as_float(w.x & 0xffff0000u), __uint_as_float(w.y << 16), __uint_as_float(w.y & 0xffff0000u)};
                    const f32x4 x1 = (f32x4){__uint_as_float(w.z << 16), __uint_as_float(w.z & 0xffff0000u), __uint_as_float(w.w << 16), __uint_as_float(w.w & 0xffff0000u)};
                    const f32x4 r0 = x0 * DN_ALPHA + acc[ai][bj][m][0] * 0.00048828125f, r1 = x1 * DN_ALPHA + acc[ai][bj][m][1] * 0.00048828125f;
                    u32x4 w4; w4.x = cvt_pk_bf16(r0[0], r0[1]); w4.y = cvt_pk_bf16(r0[2], r0[3]); w4.z = cvt_pk_bf16(r1[0], r1[1]); w4.w = cvt_pk_bf16(r1[2], r1[3]);
                    *(u32x4*)(R + off + bj * 8) = w4; } }
            asm volatile("" ::: "memory"); }
    }
};

__device__ __forceinline__ void ln_phase(const bf16_t* R, const float* gain, const float* bias, float* OUTF, bf16_t* XB, unsigned char* X8, unsigned char* X4) {
    const int tid_ = ptid(), lane = tid_ & 63, wave = tid_ >> 6;
    const int gw = blockIdx.x * NWAVES + wave, NGW = gridDim.x * NWAVES;
    for (int row = gw; row < MTOK; row += NGW) {
        const u32x4* rp = (const u32x4*)(R + (size_t)row * DM) + lane;
        float v[8][8]; float s = 0.f;
#pragma unroll
        for (int j = 0; j < 8; ++j) { const u32x4 w = rp[64 * j];
            v[j][0] = __uint_as_float(w.x << 16); v[j][1] = __uint_as_float(w.x & 0xffff0000u); v[j][2] = __uint_as_float(w.y << 16); v[j][3] = __uint_as_float(w.y & 0xffff0000u);
            v[j][4] = __uint_as_float(w.z << 16); v[j][5] = __uint_as_float(w.z & 0xffff0000u); v[j][6] = __uint_as_float(w.w << 16); v[j][7] = __uint_as_float(w.w & 0xffff0000u);
#pragma unroll
            for (int e = 0; e < 8; ++e) s += v[j][e]; }
        const float mean = wave_sum(s) * (1.0f / DM); float q = 0.f;
#pragma unroll
        for (int j = 0; j < 8; ++j)
#pragma unroll
            for (int e = 0; e < 8; ++e) { v[j][e] -= mean; q += v[j][e] * v[j][e]; }
        const float rstd = __builtin_amdgcn_rsqf(wave_sum(q) * (1.0f / DM) + LN_EPS);
#pragma unroll
        for (int j = 0; j < 8; ++j) { const int c8 = (lane + 64 * j) * 8;
            const f32x4 g0 = *(const f32x4*)(gain + c8), g1 = *(const f32x4*)(gain + c8 + 4), b0 = *(const f32x4*)(bias + c8), b1 = *(const f32x4*)(bias + c8 + 4);
            const f32x4 o0 = (f32x4){v[j][0], v[j][1], v[j][2], v[j][3]} * rstd * g0 + b0, o1 = (f32x4){v[j][4], v[j][5], v[j][6], v[j][7]} * rstd * g1 + b1;
            if (OUTF) { *(f32x4*)(OUTF + (size_t)row * DM + c8) = o0; *(f32x4*)(OUTF + (size_t)row * DM + c8 + 4) = o1; }
            if (XB) { u32x4 w; w.x = cvt_pk_bf16(o0[0], o0[1]); w.y = cvt_pk_bf16(o0[2], o0[3]); w.z = cvt_pk_bf16(o1[0], o1[1]); w.w = cvt_pk_bf16(o1[2], o1[3]); *(u32x4*)(XB + (size_t)row * DM + c8) = w;
                int w0 = 0, w1 = 0; w0 = __builtin_amdgcn_cvt_pk_fp8_f32(o0[0], o0[1], w0, false); w0 = __builtin_amdgcn_cvt_pk_fp8_f32(o0[2], o0[3], w0, true);
                w1 = __builtin_amdgcn_cvt_pk_fp8_f32(o1[0], o1[1], w1, false); w1 = __builtin_amdgcn_cvt_pk_fp8_f32(o1[2], o1[3], w1, true);
                *(u32x2*)(X8 + (size_t)row * DM + c8) = (u32x2){(unsigned)w0, (unsigned)w1};
                *(unsigned*)(X4 + (((size_t)row * DM + c8) >> 1)) = pack_fp4x8(o0[0] * FP4_XS, o0[1] * FP4_XS, o0[2] * FP4_XS, o0[3] * FP4_XS, o1[0] * FP4_XS, o1[1] * FP4_XS, o1[2] * FP4_XS, o1[3] * FP4_XS); } }
    }
}
__device__ __forceinline__ void cumsum_phase(const float* SM, const float* f_bias, float* CUM) {
    if ((int)blockIdx.x < (int)gridDim.x - BATCH) return;
    const int tid_ = ptid(), b = (int)blockIdx.x - ((int)gridDim.x - BATCH), h = tid_ >> 6, lane = tid_ & 63;
    const float fb = f_bias[h];
    const float* src = SM + ((size_t)b * SEQ + lane * 64) * 256 + SMC_BF + h;
    float run = 0.f; float vals[64];
#pragma unroll
    for (int j = 0; j < 64; ++j) { const float xv = src[(size_t)j * 256] + fb; const float ls = fminf(xv, 0.f) - log1pf(__expf(-fabsf(xv))); run += ls; vals[j] = run; }
    float incl = run;
#pragma unroll
    for (int o = 1; o < 64; o <<= 1) { const float t = __shfl_up(incl, o); if (lane >= o) incl += t; }
    const float offs = incl - run;
    float* dst = CUM + ((size_t)b * 8 + h) * SEQ + lane * 64;
#pragma unroll
    for (int j = 0; j < 64; j += 4) *(f32x4*)(dst + j) = (f32x4){(vals[j] + offs) * LOG2E, (vals[j + 1] + offs) * LOG2E, (vals[j + 2] + offs) * LOG2E, (vals[j + 3] + offs) * LOG2E};
}
__device__ __forceinline__ void krope_phase(const float* SM, const float* CS, unsigned char* D8) {
    const size_t gt = (size_t)blockIdx.x * NTHREADS + ptid(), GT = (size_t)gridDim.x * NTHREADS;
    for (size_t i = gt; i < (size_t)MTOK * 32; i += GT) {
        const size_t row = i >> 5; const int p = (int)(i & 31);
        const f32x2 t = *(const f32x2*)(SM + row * 256 + SMC_DKR + 2 * p), cs = *(const f32x2*)(CS + row * 64 + 2 * p);
        { int w = 0; w = __builtin_amdgcn_cvt_pk_fp8_f32(t[0] * cs[0] - t[1] * cs[1], t[0] * cs[1] + t[1] * cs[0], w, false); *(unsigned short*)(D8 + row * D8W + 2048 + 2 * p) = (unsigned short)w; }
    }
}

__device__ __forceinline__ int wave_count7(unsigned c) { int t = 0;
#pragma unroll
    for (int b = 0; b < 7; ++b) t += __builtin_popcountll(__ballot((c >> b) & 1u)) << b;
    return t; }
__device__ __forceinline__ unsigned f2ord(float f) { const unsigned u = __float_as_uint(f); return u ^ ((u >> 31) ? 0xffffffffu : 0x80000000u); }
template <int DBG = 0>
__device__ __forceinline__ void indexer_unit(LAS unsigned char* lds, const bf16_t* P, const float* SM, float* SC, unsigned long long* MASK, int b, int qb) {
    constexpr int QSTR = 2064 + 256;
    constexpr int L_IQ = 0, L_STG = 32 * QSTR;
    const int tid = ptid(), wid = __builtin_amdgcn_readfirstlane(tid >> 6), lane = tid & 63, r32 = lane & 31, hi = lane >> 5;
    const int t0 = qb * 32; const size_t row0 = (size_t)b * SEQ + t0;
#pragma unroll
    for (int i = 0; i < 8; ++i) { const int ci = tid + 512 * i, r = ci >> 7, cc = ci & 127;
        const bf16x8 v = *(const bf16x8*)(P + (row0 + r) * INP + PC_AIQ + cc * 8);
        *(LAS bf16x8*)(lds + L_IQ + r * QSTR + cc * 16) = v; }
    float w[16];
    { const float* wp = SM + (row0 + r32) * 256 + SMC_AIW;
#pragma unroll
      for (int j = 0; j < 4; ++j) { const f32x4 v = *(const f32x4*)(wp + 4 * j); w[4 * j] = v[0] * 0.03125f; w[4 * j + 1] = v[1] * 0.03125f; w[4 * j + 2] = v[2] * 0.03125f; w[4 * j + 3] = v[3] * 0.03125f; } }
    __syncthreads();
    { const int r = tid >> 4, d0 = (tid & 15) * 4;
      const float* wp = SM + (row0 + r) * 256 + SMC_AIW; float qb4[4] = {0.f, 0.f, 0.f, 0.f};
#pragma unroll
      for (int h = 0; h < 16; ++h) { const float wh = wp[h] * 0.03125f; const u32x2 q2 = *(const LAS u32x2*)(lds + L_IQ + r * QSTR + (h * 64 + d0) * 2);
          qb4[0] = fmaf(wh, __uint_as_float(q2.x << 16), qb4[0]); qb4[1] = fmaf(wh, __uint_as_float(q2.x & 0xffff0000u), qb4[1]);
          qb4[2] = fmaf(wh, __uint_as_float(q2.y << 16), qb4[2]); qb4[3] = fmaf(wh, __uint_as_float(q2.y & 0xffff0000u), qb4[3]); }
      u32x2 hi2, lo2; hi2.x = cvt_pk_bf16(qb4[0], qb4[1]); hi2.y = cvt_pk_bf16(qb4[2], qb4[3]);
      lo2.x = cvt_pk_bf16(qb4[0] - __uint_as_float(hi2.x << 16), qb4[1] - __uint_as_float(hi2.x & 0xffff0000u)); lo2.y = cvt_pk_bf16(qb4[2] - __uint_as_float(hi2.y << 16), qb4[3] - __uint_as_float(hi2.y & 0xffff0000u));
      *(LAS u32x2*)(lds + L_IQ + r * QSTR + (1024 + d0) * 2) = hi2; *(LAS u32x2*)(lds + L_IQ + r * QSTR + (1088 + d0) * 2) = lo2; }
    __syncthreads();
    LAS float* stg = (LAS float*)(lds + L_STG + wid * 4608);
    const int nkt = qb + 1;
    bf16x8 kfn[4];
    if (wid < nkt) { const bf16_t* kp = P + ((size_t)b * SEQ + wid * 32 + r32) * INP + PC_AIK + 8 * hi;
#pragma unroll
      for (int st = 0; st < 4; ++st) kfn[st] = *(const bf16x8*)(kp + 16 * st); }
    for (int kt = wid; kt < (DBG == 2 ? 0 : nkt); kt += NWAVES) {
        const int s0 = kt * 32;
        int qoff = L_IQ + r32 * QSTR + hi * 16; asm volatile("" : "+v"(qoff));
        bf16x8 kf[4];
#pragma unroll
        for (int st = 0; st < 4; ++st) kf[st] = kfn[st];
        if (kt + NWAVES < nkt) { const bf16_t* kp = P + ((size_t)b * SEQ + s0 + NWAVES * 32 + r32) * INP + PC_AIK + 8 * hi;
#pragma unroll
          for (int st = 0; st < 4; ++st) kfn[st] = *(const bf16x8*)(kp + 16 * st); }
        f32x16 sc;
#pragma unroll
        for (int r = 0; r < 16; ++r) sc[r] = 0.f;
#pragma unroll
        for (int st = 0; st < 8; ++st) { const bf16x8 qf = *(const LAS bf16x8*)(lds + qoff + (1024 + 16 * st) * 2);
            sc = __builtin_amdgcn_mfma_f32_32x32x16_bf16(kf[st & 3], qf, sc, 0, 0, 0); }
        f32x16 accA, accB;
#define IDX_MM(dst, h_) do { _Pragma("unroll") for (int r = 0; r < 16; ++r) dst[r] = 0.f; \
            _Pragma("unroll") for (int st = 0; st < 4; ++st) { const bf16x8 qf = *(const LAS bf16x8*)(lds + qoff + ((h_) * 64 + 16 * st) * 2); dst = __builtin_amdgcn_mfma_f32_32x32x16_bf16(kf[st], qf, dst, 0, 0, 0); } } while (0)
#define IDX_FMA(src, h_) do { asm volatile("s_nop 15" ::: ); \
            _Pragma("unroll") for (int r = 0; r < 16; ++r) asm volatile("v_fma_f32 %0, %1, |%2|, %0" : "+v"(sc[r]) : "v"(w[h_]), "v"(src[r])); } while (0)
        IDX_MM(accA, 0);
#pragma unroll
        for (int h = 0; h < 16; h += 2) {
            IDX_MM(accB, h + 1);
            __builtin_amdgcn_sched_barrier(0);
            IDX_FMA(accA, h);
            __builtin_amdgcn_sched_barrier(0);
            if (h + 2 < 16) IDX_MM(accA, h + 2);
            __builtin_amdgcn_sched_barrier(0);
            if (h + 2 >= 16) asm volatile("s_nop 15" ::: );
            IDX_FMA(accB, h + 1);
            __builtin_amdgcn_sched_barrier(0);
        }
#undef IDX_MM
#undef IDX_FMA
#pragma unroll
        for (int g = 0; g < 4; ++g) *(LAS f32x4*)(stg + r32 * 36 + 8 * g + 4 * hi) = (f32x4){sc[4 * g], sc[4 * g + 1], sc[4 * g + 2], sc[4 * g + 3]};
        LDS_WAIT();
#pragma unroll
        for (int i = 0; i < 16; ++i) { const float v = stg[(2 * i + hi) * 36 + r32]; SC[(row0 + 2 * i + hi) * SEQ + s0 + r32] = v; }
        LDS_WAIT();
    }
    VM_WAIT();
    __syncthreads();
#define IDX_LOADROW(dst, qi_) do { int ln_ = lane; asm volatile("" : "+v"(ln_)); const float* sr_ = SC + (row0 + wid * 4 + (qi_)) * SEQ + ln_; \
        _Pragma("unroll") for (int j = 0; j < 64; ++j) dst[j] = __float_as_uint(sr_[64 * j]); } while (0)
    auto process = [&](unsigned (&key)[64], const int qi) __attribute__((always_inline)) {
        const int t = t0 + wid * 4 + qi, n = t + 1;
        int ln = lane; asm volatile("" : "+v"(ln));
#pragma unroll
        for (int j = 0; j < 64; ++j) asm volatile("" : "+v"(key[j]));
#pragma unroll
        for (int g = 0; g < 8; ++g) {
            if (512 * g >= n) { _Pragma("unroll") for (int jj = 0; jj < 8; ++jj) key[8 * g + jj] = 0u; }
            else if (512 * (g + 1) <= n) { _Pragma("unroll") for (int jj = 0; jj < 8; ++jj) key[8 * g + jj] = f2ord(__uint_as_float(key[8 * g + jj])); }
            else { _Pragma("unroll") for (int jj = 0; jj < 8; ++jj) { const int j = 8 * g + jj; key[j] = (ln < n - 64 * j) ? f2ord(__uint_as_float(key[j])) : 0u; } } }
        unsigned T = 0u; int need = 0;
        const int ng = (n + 511) >> 9;
        if (n > 256) {
            bool exact = false;
#pragma unroll 1
            for (int bit = 31; bit >= 0; --bit) {
                const unsigned cand = T | (1u << bit); int cnt = 0;
#pragma unroll
                for (int g = 0; g < 8; ++g) { if (g < ng) {
#pragma unroll
                    for (int jj = 0; jj < 8; ++jj) cnt += __builtin_popcountll(__ballot(key[8 * g + jj] >= cand)); }
                    __builtin_amdgcn_sched_barrier(0); }
                if (cnt == 256) { T = cand - 1u; exact = true; break; }
                if (cnt > 256) T = cand;
            }
            if (!exact) {
                int cgt = 0;
#pragma unroll
                for (int g = 0; g < 8; ++g) { if (g < ng) {
#pragma unroll
                    for (int jj = 0; jj < 8; ++jj) cgt += __builtin_popcountll(__ballot(key[8 * g + jj] > T)); }
                    __builtin_amdgcn_sched_barrier(0); }
                need = 256 - cgt;
            }
        }
        int mwlo = 0, mwhi = 0, run = 0; int ln2 = ln; asm volatile("" : "+v"(ln2));
        if (need == 0) {
#pragma unroll
            for (int g = 0; g < 8; ++g) { if (g < ng) {
#pragma unroll
                for (int jj = 0; jj < 8; ++jj) { const int j = 8 * g + jj;
                    const unsigned long long sel = __ballot(key[j] > T);
                    mwlo = (ln2 == j) ? (int)(unsigned)sel : mwlo; mwhi = (ln2 == j) ? (int)(unsigned)(sel >> 32) : mwhi;
                    __builtin_amdgcn_sched_barrier(0); } } }
        } else
#pragma unroll
        for (int g = 0; g < 8; ++g) { if (g < ng) {
#pragma unroll
            for (int jj = 0; jj < 8; ++jj) { const int j = 8 * g + jj;
                const bool eq = key[j] == T;
                const unsigned long long eqm = __ballot(eq);
                const int rank = run + (int)__builtin_amdgcn_mbcnt_hi((unsigned)(eqm >> 32), __builtin_amdgcn_mbcnt_lo((unsigned)eqm, 0u));
                const unsigned long long sel = __ballot(key[j] > T || (eq && rank < need));
                run += __builtin_popcountll(eqm);
                mwlo = (ln2 == j) ? (int)(unsigned)sel : mwlo; mwhi = (ln2 == j) ? (int)(unsigned)(sel >> 32) : mwhi;
                __builtin_amdgcn_sched_barrier(0); } }
        }
        MASK[(row0 + wid * 4 + qi) * 64 + lane] = ((unsigned long long)(unsigned)mwhi << 32) | (unsigned)mwlo;
    };
    if (DBG != 1) {
        unsigned ka[64], kb[64];
        IDX_LOADROW(ka, 0);
#pragma unroll 1
        for (int pr = 0; pr < 2; ++pr) {
            IDX_LOADROW(kb, 2 * pr + 1);
            process(ka, 2 * pr);
            if (pr == 0) IDX_LOADROW(ka, 2);
            process(kb, 2 * pr + 1);
        }
    }
#undef IDX_LOADROW
    __syncthreads();
}
template <int DBG = 0>
__device__ __forceinline__ void indexer_phase(LAS unsigned char* lds, const Args& a) {
    const bf16_t* P = (const bf16_t*)(a.ws + WS_P); const float* SM = (const float*)(a.ws + WS_SM); float* SC = (float*)(a.ws + WS_SC); unsigned long long* MASK = (unsigned long long*)(a.ws + WS_MASK);
    for (int p = blockIdx.x; p < 256; p += gridDim.x) { const int b = p >> 6, q = p & 63;
#pragma unroll 1
        for (int k = 0; k < 2; ++k) indexer_unit<DBG>(lds, P, SM, SC, MASK, b, k == 0 ? 127 - q : q); }
}

template <int OFF> __device__ __forceinline__ s16x4 tr_read(int vb) { s16x4 r; asm volatile("ds_read_b64_tr_b16 %0, %1 offset:%2" : "=&v"(r) : "v"(vb), "i"(OFF) : "memory"); return r; }
using pg8::v8i_t; using pg8::cat8;
__device__ __forceinline__ u32x2 bf8_to_fp8(bf16x8 v) { const u32x4 w = __builtin_bit_cast(u32x4, v); int a = 0, b = 0;
    a = __builtin_amdgcn_cvt_pk_fp8_f32(__uint_as_float(w.x << 16), __uint_as_float(w.x & 0xffff0000u), a, false); a = __builtin_amdgcn_cvt_pk_fp8_f32(__uint_as_float(w.y << 16), __uint_as_float(w.y & 0xffff0000u), a, true);
    b = __builtin_amdgcn_cvt_pk_fp8_f32(__uint_as_float(w.z << 16), __uint_as_float(w.z & 0xffff0000u), b, false); b = __builtin_amdgcn_cvt_pk_fp8_f32(__uint_as_float(w.w << 16), __uint_as_float(w.w & 0xffff0000u), b, true);
    return (u32x2){(unsigned)a, (unsigned)b}; }
#ifndef ATT_PV8_MASK
#define ATT_PV8_MASK 0xB
#endif
#ifndef ATT_Q8_MASK
#define ATT_Q8_MASK 0xF
#endif
template <int VAR, int DBG = 0>
__device__ __forceinline__ void attn_unit(LAS unsigned char* lds, const Args& a, int layer, int b, int hidx, int qblk, unsigned* qh, volatile LAS unsigned* bw) {
    constexpr int DQK = (VAR == 2) ? 64 : (VAR == 3 ? 192 : 128), DV = (VAR == 2) ? 64 : 128;
    constexpr bool Q8 = ((ATT_Q8_MASK >> VAR) & 1) != 0;
    constexpr bool PV8 = Q8 && ((ATT_PV8_MASK >> VAR) & 1) != 0 && DV == 128;
    constexpr bool KV8S = PV8 && VAR != 2;
    constexpr int KSTR = Q8 ? DQK + 16 : DQK * 2 + 16, VSTR = PV8 ? DV + 32 : DV * 2 + 64;
    constexpr int KCH = DQK / 8, VCH = DV / 8, KPT = DQK / 64, VPT = DV / 64, NST = DQK / 16, ND0 = DV / 32;
    constexpr int LK = 0, LV = 2 * 64 * KSTR, LCK = LV + 2 * 64 * VSTR;
    constexpr float THR = 8.0f;
    const int tid = ptid(), wid = __builtin_amdgcn_readfirstlane(tid >> 6), lane = tid & 63, r32 = lane & 31, hi = lane >> 5;
    const bf16_t* P = (const bf16_t*)(a.ws + WS_P);
    int head, q0u, tq0w, kt_lo, kt_hi, kt_last_w;
    if constexpr (VAR == 0) { head = hidx * 4 + (wid >> 1); q0u = qblk * 64; tq0w = q0u + 32 * (wid & 1); kt_lo = 0; kt_hi = qblk; kt_last_w = qblk; }
    else if constexpr (VAR == 2) { head = hidx * 8 + wid; q0u = qblk * 32; tq0w = q0u; kt_lo = (q0u > 127 ? q0u - 127 : 0) >> 6; kt_hi = (q0u + 31) >> 6; kt_last_w = kt_hi; }
    else { head = hidx; q0u = qblk * 256; tq0w = q0u + 32 * wid; kt_lo = 0; kt_hi = 4 * qblk + 3; kt_last_w = 4 * qblk + (wid >> 1); }
    const int tq = tq0w + r32; const size_t rowq = (size_t)b * SEQ + tq;
    const bf16_t* qp;
    if constexpr (VAR == 0) qp = P + rowq * INP + PC_AQ + head * 128;
    else if constexpr (VAR == 1) qp = P + rowq * INP + PC_BQ + head * 128;
    else if constexpr (VAR == 2) qp = P + rowq * INP + PC_CQ + head * 64;
    else qp = (const bf16_t*)(a.ws + WS_DQ) + rowq * 1536 + head * 192;
    bf16x8 qf[Q8 ? 1 : NST]; v8i_t q8[Q8 ? NST / 4 : 1];
    if constexpr (Q8) {
        const unsigned char* q8p = (VAR == 3) ? a.ws + WS_DQ + rowq * 1536 + head * 192
                                 : a.ws + WS_Q8 + rowq * 3072 + (VAR == 0 ? head * 128 : (VAR == 1 ? 1024 + head * 128 : 2048 + head * 64));
#pragma unroll
        for (int s4 = 0; s4 < NST / 4; ++s4) { const u32x4 c0 = *(const u32x4*)(q8p + 64 * s4 + 32 * hi), c1 = *(const u32x4*)(q8p + 64 * s4 + 32 * hi + 16);
            q8[s4] = (v8i_t){(int)c0.x, (int)c0.y, (int)c0.z, (int)c0.w, (int)c1.x, (int)c1.y, (int)c1.z, (int)c1.w}; }
    } else {
#pragma unroll
        for (int st = 0; st < NST; ++st) qf[st] = *(const bf16x8*)(qp + 16 * st + 8 * hi); }
    const bf16_t *kb, *vb_, *kb2 = nullptr; int ldk;
    if constexpr (VAR == 0) { kb = P + PC_AK + hidx * 128; vb_ = P + PC_AV + hidx * 128; ldk = INP; }
    else if constexpr (VAR == 1) { kb = P + PC_BK + head * 128; vb_ = P + PC_BV + head * 128; ldk = INP; }
    else if constexpr (VAR == 2) { kb = P + PC_CK + hidx * 64; vb_ = P + PC_CV + hidx * 64; ldk = INP; }
    else { kb = (const bf16_t*)(a.ws + WS_DKV) + head * 256; vb_ = kb + 128; kb2 = (const bf16_t*)(a.ws + WS_DKR); ldk = 2048; }
    const size_t brow = (size_t)b * SEQ;
    unsigned gk[KPT], lk[KPT], gv[VPT], lv[VPT]; bool krope[KPT];
#pragma unroll
    for (int i = 0; i < KPT; ++i) { const int ci = tid + 512 * i, kr = ci / KCH, kc = ci % KCH; krope[i] = (VAR == 3) && kc >= 16;
        gk[i] = krope[i] ? (unsigned)(kr * 64 + (kc - 16) * 8) * 2u : (unsigned)(kr * ldk + kc * 8) * 2u; lk[i] = (unsigned)(LK + kr * KSTR + kc * (Q8 ? 8 : 16)); }
#pragma unroll
    for (int i = 0; i < VPT; ++i) { const int ci = tid + 512 * i, vr = ci / VCH, vc = ci % VCH; gv[i] = (unsigned)(vr * ldk + vc * 8) * 2u; const int vrp = PV8 ? ((vr & ~15) | (vr & 3) | ((vr & 8) >> 1) | ((vr & 4) << 1)) : vr; lv[i] = (unsigned)(LV + vrp * VSTR + vc * (PV8 ? 8 : 16)); }
    const int r8_ = tid >> 3, c8_ = tid & 7, r8p_ = (r8_ & ~15) | (r8_ & 3) | ((r8_ & 8) >> 1) | ((r8_ & 4) << 1);
    constexpr int W8 = (VAR == 3) ? D8W : KV8W, VOFF8 = (VAR == 0) ? 256 : (VAR == 1 ? 1024 : 128);
    const unsigned char* kv8p = a.ws + (VAR == 3 ? WS_D8 : WS_KV8) + (VAR == 0 ? hidx * 128 : (VAR == 1 ? 512 + head * 128 : head * 256)) + (size_t)r8_ * W8 + c8_ * 16;
    const unsigned char* kr8p = a.ws + WS_D8 + 2048 + (size_t)(tid >> 2) * D8W + (tid & 3) * 16; const unsigned lkr8 = (unsigned)(LK + (tid >> 2) * KSTR + 128 + (tid & 3) * 16); u32x4 kr8 = (u32x4){0u, 0u, 0u, 0u};
    const unsigned lk8 = (unsigned)(LK + r8_ * KSTR + c8_ * 16), lv8 = (unsigned)(LV + r8p_ * VSTR + c8_ * 16); u32x4 ks8 = (u32x4){0u, 0u, 0u, 0u}, vs8 = (u32x4){0u, 0u, 0u, 0u};
    bf16x8 ks[1][KPT], vs[1][VPT]; float ckv[1] = {0.f}; unsigned long long mnx[1] = {0ull};
    const float* cum = (const float*)(a.ws + WS_CUM) + ((size_t)b * 8 + head) * SEQ;
    float cref = 0.f; if constexpr (VAR == 1) cref = cum[q0u];
    const unsigned long long* mrow = (const unsigned long long*)(a.ws + WS_MASK) + rowq * 64;
#define AT_ISSUE(kt_, S_) do { const int k0_ = (kt_) * 64; \
        const char* kt_base_ = (const char*)(kb + (brow + k0_) * ldk); const char* vt_base_ = (const char*)(vb_ + (brow + k0_) * ldk); \
        const char* k2_base_ = (VAR == 3) ? (const char*)(kb2 + (brow + k0_) * 64) : kt_base_; \
        if constexpr (KV8S) { ks8 = *(const u32x4*)(kv8p + (brow + k0_) * W8); vs8 = *(const u32x4*)(kv8p + (brow + k0_) * W8 + VOFF8); \
            if (VAR == 3 && tid < 256) kr8 = *(const u32x4*)(kr8p + (brow + k0_) * D8W); } \
        else { _Pragma("unroll") for (int i = 0; i < KPT; ++i) ks[S_][i] = *(const bf16x8*)((krope[i] ? k2_base_ : kt_base_) + gk[i]); \
               _Pragma("unroll") for (int i = 0; i < VPT; ++i) vs[S_][i] = *(const bf16x8*)(vt_base_ + gv[i]); } \
        if (VAR == 1 && tid < 64) ckv[S_] = cum[k0_ + tid]; \
        if (VAR == 0) mnx[S_] = mrow[(kt_)]; } while (0)
#define AT_WRITE(buf_, S_) do { \
        if constexpr (KV8S) { *(LAS u32x4*)(lds + (buf_) * 64 * KSTR + lk8) = ks8; *(LAS u32x4*)(lds + (buf_) * 64 * VSTR + lv8) = vs8; \
            if (VAR == 3 && tid < 256) *(LAS u32x4*)(lds + (buf_) * 64 * KSTR + lkr8) = kr8; } else { \
        _Pragma("unroll") for (int i = 0; i < KPT; ++i) { if constexpr (Q8) *(LAS u32x2*)(lds + (buf_) * 64 * KSTR + lk[i]) = bf8_to_fp8(ks[S_][i]); else *(LAS bf16x8*)(lds + (buf_) * 64 * KSTR + lk[i]) = ks[S_][i]; } \
        _Pragma("unroll") for (int i = 0; i < VPT; ++i) { if constexpr (PV8) *(LAS u32x2*)(lds + (buf_) * 64 * VSTR + lv[i]) = bf8_to_fp8(vs[S_][i]); else *(LAS bf16x8*)(lds + (buf_) * 64 * VSTR + lv[i]) = vs[S_][i]; } } \
        if (VAR == 1 && tid < 64) *(LAS float*)(lds + LCK + (buf_) * 256 + tid * 4) = cref - ckv[S_]; } while (0)
    f32x16 o[ND0];
#pragma unroll
    for (int d = 0; d < ND0; ++d)
#pragma unroll
        for (int r = 0; r < 16; ++r) o[d][r] = 0.f;
    constexpr bool MF = (VAR != 1);
    float m = MF ? -65536.0f : -1e30f, l = 0.f;
    float slope2 = 0.f;
    if constexpr (VAR == 0) slope2 = __builtin_amdgcn_exp2f(-(float)(head + 1)) * LOG2E;
    if constexpr (VAR == 2) slope2 = __builtin_amdgcn_exp2f(-0.5f * (float)(head + 1)) * LOG2E;
    const int g4 = lane >> 4, i16 = lane & 15;
    const int kq_off = r32 * KSTR + hi * (Q8 ? 32 : 16);
    const int vrd0 = (int)(uintptr_t)(lds + LV) + (4 * (g4 >> 1) + (i16 >> 2)) * VSTR + (16 * (g4 & 1) + 4 * (i16 & 3)) * 2;
    const int vrd8 = (int)(uintptr_t)(lds + LV) + (8 * (g4 >> 1) + (i16 >> 1)) * VSTR + 16 * (g4 & 1) + 8 * (i16 & 1);
    AT_ISSUE(kt_lo, 0); unsigned long long mcur = 0ull; if constexpr (VAR == 0) mcur = mnx[0];
    AT_WRITE(0, 0);
    if (DBG != 4 && kt_lo < kt_hi) AT_ISSUE(kt_lo + 1, 0);
    __syncthreads();
    bf16x8 pb[4]; v8i_t p8 = (v8i_t){0, 0, 0, 0, 0, 0, 0, 0};
#define AT_PV(D0, vrd) do { \
                const s16x4 l0 = tr_read<0 * 16 * VSTR + (D0) * 64>(vrd), h0 = tr_read<0 * 16 * VSTR + 8 * VSTR + (D0) * 64>(vrd); \
                const s16x4 l1 = tr_read<1 * 16 * VSTR + (D0) * 64>(vrd), h1 = tr_read<1 * 16 * VSTR + 8 * VSTR + (D0) * 64>(vrd); \
                const s16x4 l2 = tr_read<2 * 16 * VSTR + (D0) * 64>(vrd), h2 = tr_read<2 * 16 * VSTR + 8 * VSTR + (D0) * 64>(vrd); \
                const s16x4 l3 = tr_read<3 * 16 * VSTR + (D0) * 64>(vrd), h3 = tr_read<3 * 16 * VSTR + 8 * VSTR + (D0) * 64>(vrd); \
                asm volatile("s_waitcnt lgkmcnt(0)" ::: "memory"); __builtin_amdgcn_sched_barrier(0); \
                o[D0] = __builtin_amdgcn_mfma_f32_32x32x16_bf16((bf16x8){l0[0], l0[1], l0[2], l0[3], h0[0], h0[1], h0[2], h0[3]}, pb[0], o[D0], 0, 0, 0); \
                o[D0] = __builtin_amdgcn_mfma_f32_32x32x16_bf16((bf16x8){l1[0], l1[1], l1[2], l1[3], h1[0], h1[1], h1[2], h1[3]}, pb[1], o[D0], 0, 0, 0); \
                o[D0] = __builtin_amdgcn_mfma_f32_32x32x16_bf16((bf16x8){l2[0], l2[1], l2[2], l2[3], h2[0], h2[1], h2[2], h2[3]}, pb[2], o[D0], 0, 0, 0); \
                o[D0] = __builtin_amdgcn_mfma_f32_32x32x16_bf16((bf16x8){l3[0], l3[1], l3[2], l3[3], h3[0], h3[1], h3[2], h3[3]}, pb[3], o[D0], 0, 0, 0); } while (0)
#define AT_PV8(D0, vrd) do { \
                u32x2 t0_, t1_, t2_, t3_; \
                asm volatile("ds_read_b64_tr_b8 %0, %1 offset:%2" : "=&v"(t0_) : "v"(vrd), "i"(0 * 16 * VSTR + (D0) * 32) : "memory"); \
                asm volatile("ds_read_b64_tr_b8 %0, %1 offset:%2" : "=&v"(t1_) : "v"(vrd), "i"(1 * 16 * VSTR + (D0) * 32) : "memory"); \
                asm volatile("ds_read_b64_tr_b8 %0, %1 offset:%2" : "=&v"(t2_) : "v"(vrd), "i"(2 * 16 * VSTR + (D0) * 32) : "memory"); \
                asm volatile("ds_read_b64_tr_b8 %0, %1 offset:%2" : "=&v"(t3_) : "v"(vrd), "i"(3 * 16 * VSTR + (D0) * 32) : "memory"); \
                asm volatile("s_waitcnt lgkmcnt(0)" : "+v"(t0_), "+v"(t1_), "+v"(t2_), "+v"(t3_) :: "memory"); __builtin_amdgcn_sched_barrier(0); \
                { const v8i_t va_ = (v8i_t){(int)t0_.x, (int)t0_.y, (int)t1_.x, (int)t1_.y, (int)t2_.x, (int)t2_.y, (int)t3_.x, (int)t3_.y}; \
                  asm volatile("v_mfma_f32_32x32x64_f8f6f4 %0, %1, %2, %0" : "+v"(o[D0]) : "v"(va_), "v"(p8)); } } while (0)
#define AT_PV_ALL(vbuf_) do { if constexpr (PV8) { const int vrd_ = vrd8 + (vbuf_) * 64 * VSTR; asm volatile("s_nop 1" ::: "memory"); AT_PV8(0, vrd_); AT_PV8(1, vrd_); AT_PV8(2, vrd_); AT_PV8(3, vrd_); } \
        else { const int vrd_ = vrd0 + (vbuf_) * 64 * VSTR; AT_PV(0, vrd_); AT_PV(1, vrd_); if constexpr (ND0 == 4) { AT_PV(2, vrd_); AT_PV(3, vrd_); } } } while (0)
    for (int kt2 = kt_lo; kt2 <= kt_hi; kt2 += 2) {
#pragma unroll
    for (int hs = 0; hs < 2; ++hs) {
        const int kt = kt2 + hs; if (kt > kt_hi) break;
        const int buf = hs, k0 = kt * 64;
        if (kt <= kt_last_w && !(DBG == 6 && wid >= 4)) {
            f32x16 p[2];
            const int dq = tq - k0 - 4 * hi;
            if constexpr (VAR == 0 || VAR == 2) { const float base = -slope2 * (float)dq - m;
#pragma unroll
                for (int sub = 0; sub < 2; ++sub)
#pragma unroll
                    for (int r = 0; r < 16; ++r) p[sub][r] = fmaf(slope2, (float)(32 * sub + (r & 3) + 8 * (r >> 2)), base); }
            else if constexpr (VAR == 1) { const LAS float* ck = (const LAS float*)(lds + LCK + buf * 256);
#pragma unroll
                for (int sub = 0; sub < 2; ++sub)
#pragma unroll
                    for (int g = 0; g < 4; ++g) { const f32x4 c4 = *(const LAS f32x4*)(ck + 32 * sub + 8 * g + 4 * hi);
                        p[sub][4 * g] = c4[0]; p[sub][4 * g + 1] = c4[1]; p[sub][4 * g + 2] = c4[2]; p[sub][4 * g + 3] = c4[3]; } }
            else {
#pragma unroll
                for (int sub = 0; sub < 2; ++sub)
#pragma unroll
                    for (int r = 0; r < 16; ++r) p[sub][r] = -m; }
            const LAS unsigned char* kbuf = lds + LK + buf * 64 * KSTR + kq_off;
            if constexpr (Q8) {
                asm volatile("s_nop 1" ::: "memory");
#pragma unroll
                for (int s4 = 0; s4 < NST / 4; ++s4) {
                    const v8i_t ka = cat8(*(const LAS bf16x8*)(kbuf + s4 * 64), *(const LAS bf16x8*)(kbuf + s4 * 64 + 16));
                    const v8i_t kb8 = cat8(*(const LAS bf16x8*)(kbuf + 32 * KSTR + s4 * 64), *(const LAS bf16x8*)(kbuf + 32 * KSTR + s4 * 64 + 16));
                    if (DBG != 3) { asm volatile("v_mfma_f32_32x32x64_f8f6f4 %0, %1, %2, %0" : "+v"(p[0]) : "v"(ka), "v"(q8[s4]));
                                    asm volatile("v_mfma_f32_32x32x64_f8f6f4 %0, %1, %2, %0" : "+v"(p[1]) : "v"(kb8), "v"(q8[s4])); } }
                asm volatile("s_nop 15\n\ts_nop 7" : "+v"(p[0]), "+v"(p[1]) :: "memory");
            } else {
            constexpr int GS = (VAR == 3) ? 1 : 2, NG = NST / GS;
            bf16x8 kfa[2 * GS], kfb[2 * GS];
#define AT_LDK(dst, g_) do { _Pragma("unroll") for (int e = 0; e < GS; ++e) { dst[2 * e] = *(const LAS bf16x8*)(kbuf + (GS * (g_) + e) * 32); dst[2 * e + 1] = *(const LAS bf16x8*)(kbuf + 32 * KSTR + (GS * (g_) + e) * 32); } } while (0)
#define AT_MMK(src, g_) do { _Pragma("unroll") for (int e = 0; e < GS; ++e) { p[0] = __builtin_amdgcn_mfma_f32_32x32x16_bf16(src[2 * e], qf[GS * (g_) + e], p[0], 0, 0, 0); \
                                 p[1] = __builtin_amdgcn_mfma_f32_32x32x16_bf16(src[2 * e + 1], qf[GS * (g_) + e], p[1], 0, 0, 0); } } while (0)
            AT_LDK(kfa, 0);
#pragma unroll
            for (int g = 0; g < NG; g += 2) {
                if (g + 1 < NG) AT_LDK(kfb, g + 1);
                __builtin_amdgcn_sched_barrier(0);
                if (DBG != 3) AT_MMK(kfa, g);
                if (g + 1 < NG) { if (g + 2 < NG) AT_LDK(kfa, g + 2);
                    __builtin_amdgcn_sched_barrier(0);
                    if (DBG != 3) AT_MMK(kfb, g + 1); }
            }
#undef AT_LDK
#undef AT_MMK
            }
            if constexpr (VAR == 0) {
#pragma unroll
                for (int sub = 0; sub < 2; ++sub) { const unsigned wb = (unsigned)(mcur >> (32 * sub)) >> (4 * hi);
#pragma unroll
                    for (int r = 0; r < 16; ++r) p[sub][r] = ((wb >> ((r & 3) + 8 * (r >> 2))) & 1u) ? p[sub][r] : -INFINITY; }
            } else if constexpr (VAR == 2) {
#pragma unroll
                for (int sub = 0; sub < 2; ++sub)
#pragma unroll
                    for (int r = 0; r < 16; ++r) p[sub][r] = ((unsigned)(dq - (32 * sub + (r & 3) + 8 * (r >> 2))) <= 127u) ? p[sub][r] : -INFINITY;
            } else {
                if (k0 + 63 > tq0w) {
#pragma unroll
                    for (int sub = 0; sub < 2; ++sub)
#pragma unroll
                        for (int r = 0; r < 16; ++r) p[sub][r] = ((32 * sub + (r & 3) + 8 * (r >> 2)) <= dq) ? p[sub][r] : -INFINITY; }
            }
            if constexpr (DBG != 2) {
            asm volatile("s_nop 15\n\ts_nop 7" ::: "memory");
            float pm;
            { float ma, mb_;
              asm volatile("v_max3_f32 %0, %1, %2, %3" : "=v"(ma) : "v"(p[0][0]), "v"(p[0][1]), "v"(p[1][0]));
              asm volatile("v_max3_f32 %0, %1, %2, %3" : "=v"(mb_) : "v"(p[0][2]), "v"(p[0][3]), "v"(p[1][1]));
              asm volatile("v_max3_f32 %0, %1, %2, %3" : "+v"(ma) : "v"(ma), "v"(p[1][2]), "v"(p[1][3]));
#pragma unroll
              for (int r = 4; r < 16; r += 4) {
                  asm volatile("v_max3_f32 %0, %1, %2, %3" : "+v"(ma) : "v"(ma), "v"(p[0][r]), "v"(p[0][r + 1]));
                  asm volatile("v_max3_f32 %0, %1, %2, %3" : "+v"(mb_) : "v"(mb_), "v"(p[0][r + 2]), "v"(p[0][r + 3]));
                  asm volatile("v_max3_f32 %0, %1, %2, %3" : "+v"(ma) : "v"(ma), "v"(p[1][r]), "v"(p[1][r + 1]));
                  asm volatile("v_max3_f32 %0, %1, %2, %3" : "+v"(mb_) : "v"(mb_), "v"(p[1][r + 2]), "v"(p[1][r + 3])); }
              asm volatile("v_max_f32 %0, %1, %2" : "=v"(pm) : "v"(ma), "v"(mb_)); }
            { auto rr = __builtin_amdgcn_permlane32_swap(__float_as_uint(pm), __float_as_uint(pm), false, false); pm = fmaxf(__uint_as_float(rr[0]), __uint_as_float(rr[1])); }
            if constexpr (MF) {
                if (!__all(pm <= THR)) {
                    const float dm = fmaxf(pm, 0.f), alpha = __builtin_amdgcn_exp2f(-dm); m += dm; l *= alpha;
#pragma unroll
                    for (int d = 0; d < ND0; ++d)
#pragma unroll
                        for (int r = 0; r < 16; ++r) o[d][r] *= alpha;
#pragma unroll
                    for (int sub = 0; sub < 2; ++sub)
#pragma unroll
                        for (int r = 0; r < 16; ++r) p[sub][r] -= dm;
                }
            } else if (!__all(pm - m <= THR)) {
                const float mn = fmaxf(m, pm), alpha = __builtin_amdgcn_exp2f(m - mn); m = mn; l *= alpha;
#pragma unroll
                for (int d = 0; d < ND0; ++d)
#pragma unroll
                    for (int r = 0; r < 16; ++r) o[d][r] *= alpha;
            }
#pragma unroll
            for (int sub = 0; sub < 2; ++sub)
#pragma unroll
                for (int r = 0; r < 16; ++r) p[sub][r] = __builtin_amdgcn_exp2f(MF ? p[sub][r] : p[sub][r] - m);
            __builtin_amdgcn_sched_barrier(0);
            { float s0 = p[0][0], s1 = p[0][1], s2 = p[1][0], s3 = p[1][1];
#pragma unroll
              for (int r = 2; r < 16; r += 2) { s0 += p[0][r]; s1 += p[0][r + 1]; s2 += p[1][r]; s3 += p[1][r + 1]; }
              l += (s0 + s1) + (s2 + s3); }
            }
            if constexpr (PV8) {
#pragma unroll
                for (int w = 0; w < 8; ++w) { const int sub = w >> 2, r4 = 4 * (w & 3); int t = 0;
                    t = __builtin_amdgcn_cvt_pk_fp8_f32(p[sub][r4], p[sub][r4 + 1], t, false); t = __builtin_amdgcn_cvt_pk_fp8_f32(p[sub][r4 + 2], p[sub][r4 + 3], t, true); p8[w] = t; }
            } else {
#pragma unroll
            for (int s = 0; s < 4; ++s) { const int sub = s >> 1, k8 = 8 * (s & 1);
                u32x4 wv; wv.x = cvt_pk_bf16(p[sub][k8], p[sub][k8 + 1]); wv.y = cvt_pk_bf16(p[sub][k8 + 2], p[sub][k8 + 3]); wv.z = cvt_pk_bf16(p[sub][k8 + 4], p[sub][k8 + 5]); wv.w = cvt_pk_bf16(p[sub][k8 + 6], p[sub][k8 + 7]);
                pb[s] = __builtin_bit_cast(bf16x8, wv); }
            }
        }
        if (DBG != 4 && kt < kt_hi) AT_WRITE(buf ^ 1, 0);
        if constexpr (VAR == 0) mcur = mnx[0];
        if (DBG != 4 && kt + 1 < kt_hi) AT_ISSUE(kt + 2, 0);
        if (kt <= kt_last_w && !(DBG == 6 && wid >= 4)) {
            if (DBG != 1) AT_PV_ALL(buf);
            if (DBG == 1) { _Pragma("unroll") for (int i = 0; i < 4; ++i) o[0][i] += __uint_as_float((unsigned)pb[i][0]); }
        }
        if (DBG != 5) __syncthreads();
    }
    }
#undef AT_PV_ALL
#undef AT_PV8
#undef AT_PV
#undef AT_ISSUE
#undef AT_WRITE
    if constexpr (PV8) asm volatile("s_nop 15\n\ts_nop 15" : "+v"(o[0]), "+v"(o[1]), "+v"(o[ND0 - 2]), "+v"(o[ND0 - 1]) :: "memory");
    unsigned nx = 0u; if (threadIdx.x == 0) nx = __hip_atomic_fetch_add(qh, 1u, RLX_AGENT);
    { auto rr = __builtin_amdgcn_permlane32_swap(__float_as_uint(l), __float_as_uint(l), false, false); l = __uint_as_float(rr[0]) + __uint_as_float(rr[1]); }
    if constexpr (VAR == 2) l += __builtin_amdgcn_exp2f(a.sinks[layer * 16 + head] * LOG2E - m);
    const float inv = 1.0f / l;
    int zc, bc;
    if constexpr (VAR == 0) { zc = PC_AZ + head * 128; bc = 0 + head * 128; }
    else if constexpr (VAR == 1) { zc = PC_BZ + head * 128; bc = 1024 + head * 128; }
    else if constexpr (VAR == 2) { zc = PC_CZ + head * 64; bc = 2048 + head * 64; }
    else { zc = PC_DZ + head * 128; bc = 3072 + head * 128; }
    const unsigned char* zp = a.ws + WS_Z8 + rowq * 4096 + bc + 16 * hi; (void)zc; unsigned char* op = a.ws + (DBG ? WS_SC : WS_BR) + rowq * 4096 + bc + 16 * hi;
#pragma unroll
    for (int d = 0; d < ND0; ++d) {
#pragma unroll
        for (int jj = 0; jj < 8; ++jj) { const int r0 = jj, r1 = 8 + jj;
            const auto sw = __builtin_amdgcn_permlane32_swap(__float_as_uint(o[d][r0]), __float_as_uint(o[d][r1]), false, false);
            o[d][r0] = __uint_as_float(sw[0]); o[d][r1] = __uint_as_float(sw[1]); }
        const u32x4 za = *(const u32x4*)(zp + 32 * d);
        const unsigned zw[4] = {za.x, za.y, za.z, za.w};
        u32x4 wo;
#pragma unroll
        for (int q4 = 0; q4 < 4; ++q4) { const int rb = (q4 & 1) * 8 + (q4 >> 1) * 4;
            const f32x2 zl = __builtin_amdgcn_cvt_pk_f32_fp8((int)zw[q4], false), zh = __builtin_amdgcn_cvt_pk_f32_fp8((int)zw[q4], true); const float z0 = zl[0], z1 = zl[1], z2 = zh[0], z3 = zh[1];
            const float v0 = o[d][rb] * inv * (z0 * fast_sigmoid(z0)), v1 = o[d][rb + 1] * inv * (z1 * fast_sigmoid(z1));
            const float v2 = o[d][rb + 2] * inv * (z2 * fast_sigmoid(z2)), v3 = o[d][rb + 3] * inv * (z3 * fast_sigmoid(z3));
            int w8 = 0; w8 = __builtin_amdgcn_cvt_pk_fp8_f32(v0 * 8.0f, v1 * 8.0f, w8, false); w8 = __builtin_amdgcn_cvt_pk_fp8_f32(v2 * 8.0f, v3 * 8.0f, w8, true);
            if (q4 == 0) wo.x = (unsigned)w8; else if (q4 == 1) wo.y = (unsigned)w8; else if (q4 == 2) wo.z = (unsigned)w8; else wo.w = (unsigned)w8; }
        *(u32x4*)(op + 32 * d) = wo; }
    if (threadIdx.x == 0) bw[0] = nx;
}
template <int VAR, int DBG = 0>
__device__ __forceinline__ void attn_queue(LAS unsigned char* lds, const Args& a, int layer) {
    constexpr int NUX = (VAR == 2) ? 128 : 64;
    unsigned* qbase = (unsigned*)(a.ws + WS_CTL) + CW_Q + 64 * 8 * (layer * 4 + VAR);
    layer &= 1;
    volatile LAS unsigned* bw = (volatile LAS unsigned*)(lds + MISC_OFF + 64);
    const int myx = (int)(xb_xcc_id() & 7u);
    for (int qi = 0; qi < 8; ++qi) {
        const int x = (myx + qi) & 7;
        unsigned* qh = qbase + 64 * x;
        if (threadIdx.x == 0) bw[0] = __hip_atomic_fetch_add(qh, 1u, RLX_AGENT);
        for (;;) {
            __syncthreads();
            const int idx = (int)bw[0];
            __syncthreads();
            if (idx >= NUX) break;
            int b, hidx, qblk;
            if constexpr (VAR == 0) { qblk = 63 - idx; b = x >> 1; hidx = x & 1; }
            else if constexpr (VAR == 2) { qblk = idx; b = x >> 1; hidx = x & 1; }
            else { const int pr = 4 * x + 2 * (idx >> 5) + (idx & 1); qblk = 15 - ((idx & 31) >> 1); b = pr >> 3; hidx = pr & 7; }
            attn_unit<VAR, DBG>(lds, a, layer, b, hidx, qblk, qh, bw);
        }
    }
}

constexpr int N_PHASES = 1 + 6 * DEPTH;
#ifndef DUP_PHASE
#define DUP_PHASE -1
#endif
__global__ void __launch_bounds__(NTHREADS, 2) mega_fwd(Args a) {
    extern __shared__ __attribute__((aligned(16))) unsigned char lds_raw[];
    LAS unsigned char* lds = (LAS unsigned char*)lds_raw;
    const int tid = threadIdx.x;
    for (int u = tid; u < (LDS_BYTES - LDSCTL_OFF) / 4; u += NTHREADS) ((LAS unsigned*)(lds + LDSCTL_OFF))[u] = 0u;
    __syncthreads();
    unsigned* ctl = (unsigned*)(a.ws + WS_CTL);
    const int lo = a.ph_lo, hi = a.ph_hi;
    const bool multi = (hi - lo) > 1;
    XcdBarrier bar; bar.bar = ctl + CW_BAR; bar.x = 0; bar.st = nullptr;
    if (multi) bar = xcd_barrier_post(ctl + CW_BAR, (volatile LAS unsigned*)(lds + MISC_OFF + 32));
#define IN(k) (lo <= (k) && (k) < hi)
#define SEAM(k) do { if (IN(k) && IN((k) + 1)) xcd_barrier(bar); } while (0)
    unsigned char* ws = a.ws;
    bf16_t* XB = (bf16_t*)(ws + WS_XB); bf16_t* P = (bf16_t*)(ws + WS_P); unsigned char* Gt = ws + WS_G;
    float* SM = (float*)(ws + WS_SM); float* RSS = (float*)(ws + WS_RSS); float* CS = (float*)(ws + WS_CS);
    unsigned char* W = ws + WS_W;

    if (IN(0)) { convert_weights(a, 0, lds); prologue_misc(a); }
    SEAM(0);
    for (int layer = 0; layer < DEPTH; ++layer) {
        const int pb = 1 + 6 * layer;
        if (IN(pb + 0)) {
            { pg8::Gemm g{(const bf16_t*)(ws + WS_X4), (const bf16_t*)(W + WO_WG8), DM / 4, DM / 4, DM / 4, 0, 0}; pg8::StaticOrder S; S.init(MTOK, NGATE, gridDim.x, blockIdx.x, 8);
              EpiGate E{Gt, -LOG2E / (FP4_XS * FP4_WS * 0.9761f)};
              pg8::gemm_phase<EpiGate, pg8::StaticOrder, true, false, true>(lds, g, S, E);
#if DUP_PHASE == 1001
              pg8::gemm_phase<EpiGate, pg8::StaticOrder, true, true>(lds, g, S, E);
#endif
#if DUP_PHASE == 1002
              { EpiNull E0{(float*)(ws + WS_SC)}; pg8::gemm_phase<EpiNull, pg8::StaticOrder, true, true>(lds, g, S, E0); }
#endif
              }
            { pg8::Gemm g{(const bf16_t*)(ws + WS_X8), (const bf16_t*)(W + WO_WIN8), DM / 2, DM / 2, DM / 2, 0, 0}; pg8::StaticOrder S; S.init(MTOK, NIN8, gridDim.x, blockIdx.x);
              EpiIn E{P, SM, RSS, 1, ws + WS_KV8, ws + WS_L8, ws + WS_Z8, ws + WS_Q8};
              pg8::gemm_phase<EpiIn, pg8::StaticOrder, true, true>(lds, g, S, E); }
            { pg8::Gemm g{(const bf16_t*)(ws + WS_X4), (const bf16_t*)(W + WO_WZ4), DM / 4, DM / 4, DM / 4, 0, 0}; pg8::StaticOrder S; S.init(MTOK, NINZ, gridDim.x, blockIdx.x, 8);
              EpiIn E{P, SM, RSS, 2, ws + WS_KV8, ws + WS_L8, ws + WS_Z8, ws + WS_Q8};
              pg8::gemm_phase<EpiIn, pg8::StaticOrder, true, false, true>(lds, g, S, E); }
            { pg8::Gemm g{XB, (const bf16_t*)(W + WO_WINB), DM, DM, DM, 0, 0}; pg8::StaticOrder S; S.init(MTOK, NINB, gridDim.x, (blockIdx.x + 64) % gridDim.x, 2);
              EpiIn E{P, SM, RSS, 0, ws + WS_KV8, ws + WS_L8, ws + WS_Z8, ws + WS_Q8};
              pg8::gemm_phase<EpiIn, pg8::StaticOrder>(lds, g, S, E); }
        }
        SEAM(pb + 0);
        if (IN(pb + 1)) {
            cumsum_phase(SM, a.f_bias + layer * 8, (float*)(ws + WS_CUM));
            krope_phase(SM, CS, ws + WS_D8);
            { pg8::Gemm g{(const bf16_t*)(ws + WS_L8), (const bf16_t*)(W + WO_DQUP), 384, 512, 384, 0, 0}; pg8::StaticOrder S; S.init(MTOK, 1536, gridDim.x, blockIdx.x);
              EpiDq E{ws + WS_DQ, RSS, CS, 1.0f / DQ_WS};
              pg8::gemm_phase<EpiDq, pg8::StaticOrder, true, true>(lds, g, S, E); }
            { pg8::Gemm g{(const bf16_t*)(ws + WS_L8 + 768), (const bf16_t*)(W + WO_DKVUP), 128, 512, 128, 0, 0}; pg8::StaticOrder S; S.init(MTOK, 2048, gridDim.x, blockIdx.x);
              EpiDkv E{ws + WS_D8, RSS, 1.0f / DKV_WS};
              pg8::gemm_phase<EpiDkv, pg8::StaticOrder, true, true>(lds, g, S, E); }
            indexer_phase(lds, a);
#if DUP_PHASE == 1 || DUP_PHASE == 11
            { pg8::Gemm g{P + PC_DCQ, (const bf16_t*)(W + WO_DQUP), 768, INP, 768, 0, 0}; pg8::StaticOrder S; S.init(MTOK, 1536, gridDim.x, blockIdx.x);
              EpiDq E{(bf16_t*)(ws + WS_DQ), RSS, CS};
              pg8::gemm_phase<EpiDq, pg8::StaticOrder>(lds, g, S, E); }
            { pg8::Gemm g{P + PC_DCKV, (const bf16_t*)(W + WO_DKVUP), 256, INP, 256, 0, 0}; pg8::StaticOrder S; S.init(MTOK, 2048, gridDim.x, blockIdx.x);
              EpiDkv E{ws + WS_D8, RSS};
              pg8::gemm_phase<EpiDkv, pg8::StaticOrder>(lds, g, S, E); }
#endif
#if DUP_PHASE == 1 || DUP_PHASE == 12
            indexer_phase(lds, a);
#endif
        }
        SEAM(pb + 1);
        if (IN(pb + 2)) {
            attn_queue<3>(lds, a, layer);
            attn_queue<1>(lds, a, layer);
            attn_queue<0>(lds, a, layer);
            attn_queue<2>(lds, a, layer);
#if DUP_PHASE == 2 || DUP_PHASE == 23
            attn_queue<3>(lds, a, layer + 2);
#endif
#if DUP_PHASE == 2 || DUP_PHASE == 21
            attn_queue<1>(lds, a, layer + 2);
#endif
#if DUP_PHASE >= 210 && DUP_PHASE <= 219
            attn_queue<1, DUP_PHASE - 210>(lds, a, layer + 2);
#endif
#if DUP_PHASE == 2 || DUP_PHASE == 20
            attn_queue<0>(lds, a, layer + 2);
#endif
#if DUP_PHASE == 2 || DUP_PHASE == 22
            attn_queue<2>(lds, a, layer + 2);
#endif
        }
        SEAM(pb + 2);
        if (IN(pb + 3)) {
            pg8::Gemm g{(const bf16_t*)(ws + WS_BR), (const bf16_t*)(W + WO_WBR), 512, 2048, 512, (size_t)1024, (size_t)DM * 1024};
            pg8::ZOrder<4> S; S.init(MTOK, DM, gridDim.x, blockIdx.x);
            EpiMerge E{Gt, ws + WS_MRG};
            pg8::gemm_phase<EpiMerge, pg8::ZOrder<4>, true, true>(lds, g, S, E);
#if DUP_PHASE == 3
            pg8::gemm_phase<EpiMerge, pg8::ZOrder<4>, true, true>(lds, g, S, E);
#endif
        }
        SEAM(pb + 3);
        if (IN(pb + 4)) {
            pg8::Gemm g{(const bf16_t*)(ws + WS_MRG), (const bf16_t*)(W + WO_WOUT), DM / 2, DM / 2, DM / 2, 0, 0}; pg8::StaticOrder S; S.init(MTOK, DM, gridDim.x, blockIdx.x);
            EpiOut E{XB, (bf16_t*)(ws + WS_R)};
            pg8::gemm_phase<EpiOut, pg8::StaticOrder, true, true>(lds, g, S, E);
#if DUP_PHASE == 4
            pg8::gemm_phase<EpiOut, pg8::StaticOrder, true, true>(lds, g, S, E);
#endif
        }
        SEAM(pb + 4);
        if (IN(pb + 5)) {
            ln_phase((const bf16_t*)(ws + WS_R), a.ln_gain + layer * DM, a.ln_bias + layer * DM, layer + 1 < DEPTH ? nullptr : a.out, layer + 1 < DEPTH ? XB : nullptr, ws + WS_X8, ws + WS_X4);
            if (layer + 1 < DEPTH) convert_weights(a, layer + 1, lds);
#if DUP_PHASE == 5
            ln_phase((const bf16_t*)(ws + WS_R), a.ln_gain + layer * DM, a.ln_bias + layer * DM, layer + 1 < DEPTH ? nullptr : a.out, layer + 1 < DEPTH ? XB : nullptr, ws + WS_X8, ws + WS_X4);
            if (layer + 1 < DEPTH) convert_weights(a, layer + 1, lds);
#endif
        }
        if (layer + 1 < DEPTH) SEAM(pb + 5);
    }
#undef IN
#undef SEAM
}

#ifdef PROBE_KERNEL
__global__ void __launch_bounds__(NTHREADS, 2) probe_fwd(Args a) {
    extern __shared__ __attribute__((aligned(16))) unsigned char lds_raw[];
    LAS unsigned char* lds = (LAS unsigned char*)lds_raw;
    unsigned char* ws = a.ws; unsigned char* W = ws + WS_W;
#if PROBE_KERNEL == 1 || PROBE_KERNEL == 2 || PROBE_KERNEL == 4
    pg8::Gemm g{(const bf16_t*)(ws + WS_X8), (const bf16_t*)(W + WO_WG8), DM / 2, DM / 2, DM / 2, 0, 0}; pg8::StaticOrder S; S.init(MTOK, NGATE, gridDim.x, blockIdx.x);
#if PROBE_KERNEL == 1
    EpiGate E{ws + WS_G}; pg8::gemm_phase<EpiGate, pg8::StaticOrder, true, true>(lds, g, S, E);
#elif PROBE_KERNEL == 4
    EpiGate E{ws + WS_G}; pg8::gemm_phase<EpiGate, pg8::StaticOrder, false, true>(lds, g, S, E);
#else
    EpiNull E{(float*)(ws + WS_SC)}; pg8::gemm_phase<EpiNull, pg8::StaticOrder, true, true>(lds, g, S, E);
#endif
#endif
#if PROBE_KERNEL >= 10 && PROBE_KERNEL < 20
    attn_queue<1, PROBE_KERNEL - 10>(lds, a, 3);
#endif
#if PROBE_KERNEL == 20 || PROBE_KERNEL == 21
    { pg8::Gemm g{(const bf16_t*)(ws + WS_BR), (const bf16_t*)(W + WO_WBR), 512, 2048, 512, (size_t)1024, (size_t)DM * 1024}; pg8::ZOrder<4> S; S.init(MTOK, DM, gridDim.x, blockIdx.x);
#if PROBE_KERNEL == 20
      EpiMerge E{ws + WS_G, ws + WS_MRG}; pg8::gemm_phase<EpiMerge, pg8::ZOrder<4>, true, true>(lds, g, S, E);
#else
      EpiNull E{(float*)(ws + WS_SC)}; pg8::gemm_phase<EpiNull, pg8::ZOrder<4>, true, true>(lds, g, S, E);
#endif
    }
#endif
#if PROBE_KERNEL == 22
    { pg8::Gemm g{(const bf16_t*)(ws + WS_MRG), (const bf16_t*)(W + WO_WOUT), DM / 2, DM / 2, DM / 2, 0, 0}; pg8::StaticOrder S; S.init(MTOK, DM, gridDim.x, blockIdx.x);
      EpiOut E{(const bf16_t*)(ws + WS_XB), (bf16_t*)(ws + WS_SC)}; pg8::gemm_phase<EpiOut, pg8::StaticOrder, true, true>(lds, g, S, E); }
#endif
#if PROBE_KERNEL == 30
    convert_weights(a, 1, lds);
#endif
#if PROBE_KERNEL == 31
    ln_phase((const bf16_t*)(ws + WS_R), a.ln_gain + DM, a.ln_bias + DM, a.out, nullptr, ws + WS_X8);
#endif
#if PROBE_KERNEL == 32
    indexer_phase(lds, a);
#endif
#if PROBE_KERNEL == 33
    indexer_phase<1>(lds, a);
#endif
#if PROBE_KERNEL == 34
    indexer_phase<2>(lds, a);
#endif
#if PROBE_KERNEL == 3
    pg8::Gemm g{(const bf16_t*)(ws + WS_XB), (const bf16_t*)(W + WO_WG8), DM / 2, DM / 2, DM / 2, 0, 0}; pg8::StaticOrder S; S.init(MTOK, NGATE, gridDim.x, blockIdx.x);
    EpiNull E{(float*)(ws + WS_SC)}; pg8::gemm_phase<EpiNull, pg8::StaticOrder, true, false>(lds, g, S, E);
#endif
}
#endif

#ifndef MK_N_LAUNCHES
#define MK_N_LAUNCHES 1
#endif
extern "C" void kernel_launch(void* const* d_in, const int* in_sizes, int n_in, void* d_out, int out_size, void* d_ws, size_t ws_size, hipStream_t stream) {
    static int grid = 0;
    if (grid == 0) {
        if (n_in != 14 || in_sizes[0] != MTOK * DM || out_size != MTOK * DM || ws_size < WS_END) {
            fprintf(stderr, "kernel_launch: unexpected shapes / workspace: n_in %d in0 %d out %d ws %zu (need >= %zu)\n", n_in, n_in > 0 ? in_sizes[0] : -1, out_size, ws_size, (size_t)WS_END); grid = -1; return; }
        int dev = 0, cus = 0, per_cu = 0;
        if (hipGetDevice(&dev) != hipSuccess || hipDeviceGetAttribute(&cus, hipDeviceAttributeMultiprocessorCount, dev) != hipSuccess) { grid = -1; return; }
        if (hipFuncSetAttribute((const void*)mega_fwd, hipFuncAttributeMaxDynamicSharedMemorySize, LDS_BYTES) != hipSuccess) { fprintf(stderr, "kernel_launch: hipFuncSetAttribute failed\n"); grid = -1; return; }
        if (hipOccupancyMaxActiveBlocksPerMultiprocessor(&per_cu, (const void*)mega_fwd, NTHREADS, LDS_BYTES) != hipSuccess || per_cu < 1) {
            fprintf(stderr, "kernel_launch: occupancy query reports %d workgroups per CU\n", per_cu); }
        (void)hipGetLastError();
        grid = cus;
    }
    if (grid < 0) return;
    (void)hipMemsetAsync((char*)d_ws + WS_CTL, 0, CTL_ZERO_BYTES, stream);
    Args a{};
    a.x = (const float*)d_in[0]; a.pos = (const int*)d_in[1]; a.w_in = (const float*)d_in[2]; a.w_gate = (const float*)d_in[3]; a.w_branch = (const float*)d_in[4]; a.w_out = (const float*)d_in[5];
    a.dq_gain = (const float*)d_in[6]; a.dq_up = (const float*)d_in[7]; a.dkv_gain = (const float*)d_in[8]; a.dkv_up = (const float*)d_in[9]; a.f_bias = (const float*)d_in[10];
    a.sinks = (const float*)d_in[11]; a.ln_gain = (const float*)d_in[12]; a.ln_bias = (const float*)d_in[13];
    a.out = (float*)d_out; a.ws = (unsigned char*)d_ws;
#if MK_N_LAUNCHES == 1
    a.ph_lo = 0; a.ph_hi = N_PHASES;
    hipLaunchKernelGGL(mega_fwd, dim3(grid), dim3(NTHREADS), LDS_BYTES, stream, a);
#else
    for (int p = 0; p < N_PHASES; ++p) { a.ph_lo = p; a.ph_hi = p + 1; hipLaunchKernelGGL(mega_fwd, dim3(grid), dim3(NTHREADS), LDS_BYTES, stream, a); }
#endif
#ifdef PROBE_KERNEL
    { static int once = 0; if (!once) { (void)hipFuncSetAttribute((const void*)probe_fwd, hipFuncAttributeMaxDynamicSharedMemorySize, LDS_BYTES); once = 1; }
      hipLaunchKernelGGL(probe_fwd, dim3(grid), dim3(NTHREADS), LDS_BYTES, stream, a); }
#endif
    const hipError_t le = hipPeekAtLastError();
    if (le != hipSuccess) fprintf(stderr, "kernel_launch: launch failed: %s\n", hipGetErrorName(le));
}
```
